# Optimizing an MI355X kernel written in HIP

```python
import jax
import jax.numpy as jnp
from jax import lax
import numpy as np

D_MODEL = 1024
BATCH = 4
SEQ = 8192
DEPTH = 1

D_MIX = D_MODEL
N_HEADS = 8
N_KV = 2
HPG = N_HEADS // N_KV
HEAD_DIM = 64
D_ATTN = N_HEADS * HEAD_DIM
D_KV = N_KV * HEAD_DIM
D_CONV = D_MIX - D_ATTN
CONV_WIDTH = 31
CMP_LEN = 32
CMP_STRIDE = 16
CMP_HID = 256
SEL_LEN = 64
SEL_TOPN = 16
WINDOW = 512
Q_BLOCK = 128
N_EXPERTS = 256
TOP_K = 8
N_GROUPS = 8
TOPK_GROUPS = 4
D_EXPERT = 256
ROUTED_SCALE = 2.5
EXPERT_BLOCK = 128
LN_EPS = 1e-5
DEEPNORM_ALPHA = (2 * DEPTH) ** 0.25
DEEPNORM_BETA = (8 * DEPTH) ** -0.25
IN_SIZES = (D_ATTN, D_KV, D_KV, D_KV, D_KV, D_KV, D_KV, 3 * N_HEADS, 2 * D_CONV)
IN_SPLITS = tuple(int(v) for v in np.cumsum(IN_SIZES)[:-1])
D_IN = int(sum(IN_SIZES))

kernel_name = "nsa_conformer_moe_hybrid_layer"


def layer_norm(x, g, b):
    xf = x.astype(jnp.float32)
    mu = jnp.mean(xf, axis=-1, keepdims=True)
    var = jnp.mean(jnp.square(xf - mu), axis=-1, keepdims=True)
    return ((xf - mu) * lax.rsqrt(var + LN_EPS) * g + b).astype(x.dtype)


def masked_softmax(s, mask):
    s = jnp.where(mask, s.astype(jnp.float32), -jnp.inf)
    m = jnp.max(s, axis=-1, keepdims=True)
    m = jnp.where(jnp.isfinite(m), m, 0.0)
    p = jnp.exp(s - m)
    d = jnp.sum(p, axis=-1, keepdims=True)
    return p / jnp.where(d > 0, d, 1.0)


def compress(kv, pe, w1, w2):
    b, s = kv.shape[0], kv.shape[1]
    n_cmp = (s - CMP_LEN) // CMP_STRIDE + 1
    idx = np.arange(n_cmp)[:, None] * CMP_STRIDE + np.arange(CMP_LEN)[None, :]
    blocks = kv[:, idx] + pe[None, None, :, None, :]
    blocks = blocks.transpose(0, 3, 1, 2, 4).reshape(b, N_KV, n_cmp, CMP_LEN * HEAD_DIM)
    return jax.nn.gelu(blocks @ w1) @ w2


def nsa_attention(q, gates, k_cmp, v_cmp, k_slc, v_slc, k_win, v_win,
                  pe_k, pe_v, w_cmp_k1, w_cmp_k2, w_cmp_v1, w_cmp_v2):
    b, s = q.shape[0], q.shape[1]
    k_cmp = k_cmp.reshape(b, s, N_KV, HEAD_DIM)
    v_cmp = v_cmp.reshape(b, s, N_KV, HEAD_DIM)
    kc = compress(k_cmp, pe_k, w_cmp_k1, w_cmp_k2)
    vc = compress(v_cmp, pe_v, w_cmp_v1, w_cmp_v2)
    n_cmp = kc.shape[2]
    cmp_end = jnp.arange(n_cmp) * CMP_STRIDE + CMP_LEN - 1

    n_sel = s // SEL_LEN
    top_n = min(SEL_TOPN, n_sel)
    cs = np.arange(n_cmp) * CMP_STRIDE
    ss = np.arange(n_sel) * SEL_LEN
    overlap = jnp.asarray(((cs[:, None] < ss[None, :] + SEL_LEN) &
                           (cs[:, None] + CMP_LEN > ss[None, :])).astype(np.float32))
    kb = k_slc.reshape(b, n_sel, SEL_LEN, N_KV, HEAD_DIM).transpose(0, 3, 1, 2, 4)
    vb = v_slc.reshape(b, n_sel, SEL_LEN, N_KV, HEAD_DIM).transpose(0, 3, 1, 2, 4)
    pad = ((0, 0), (WINDOW, 0), (0, 0), (0, 0))
    kw = jnp.pad(k_win.reshape(b, s, N_KV, HEAD_DIM), pad)
    vw = jnp.pad(v_win.reshape(b, s, N_KV, HEAD_DIM), pad)

    n_qb = s // Q_BLOCK
    qb = q.reshape(b, n_qb, Q_BLOCK, N_KV, HPG, HEAD_DIM).transpose(1, 0, 2, 3, 4, 5)
    gb = gates.reshape(b, n_qb, Q_BLOCK, N_KV, HPG, 3).transpose(1, 0, 2, 3, 4, 5)
    scale = HEAD_DIM ** -0.5
    bidx = jnp.arange(b)[:, None, None, None]
    gidx = jnp.arange(N_KV)[None, :, None, None]
    blk = jnp.arange(n_sel)
    wrel = jnp.arange(WINDOW + Q_BLOCK)

    def query_block(args):
        i, q_i, g_i = args
        s0 = i * Q_BLOCK
        t = s0 + jnp.arange(Q_BLOCK)
        s_c = jnp.einsum('bqgpd,bgnd->bgpqn', q_i, kc) * scale
        p_c = masked_softmax(s_c, cmp_end[None, :] <= t[:, None])
        o_c = jnp.einsum('bgpqn,bgnd->bqgpd', p_c.astype(vc.dtype), vc)
        imp = jnp.einsum('bgpqn,ns->bgqs', p_c, overlap)
        cur = t // SEL_LEN
        forced = (blk[None, :] == 0) | (blk[None, :] == cur[:, None]) | (blk[None, :] == cur[:, None] - 1)
        causal = blk[None, :] <= cur[:, None]
        imp = jnp.where(forced, jnp.inf, jnp.where(causal, imp, -jnp.inf))
        top_s, top_i = lax.top_k(imp, top_n)
        k_sel = kb[bidx, gidx, top_i]
        v_sel = vb[bidx, gidx, top_i]
        kpos = top_i[..., None] * SEL_LEN + jnp.arange(SEL_LEN)
        m_s = (top_s[..., None] > -jnp.inf) & (kpos <= t[:, None, None])
        s_s = jnp.einsum('bqgpd,bgqnld->bgpqnl', q_i, k_sel) * scale
        sh = s_s.shape
        p_s = masked_softmax(s_s.reshape(sh[0], sh[1], sh[2], sh[3], top_n * SEL_LEN),
                             m_s.reshape(sh[0], sh[1], 1, sh[3], top_n * SEL_LEN)).reshape(sh)
        o_s = jnp.einsum('bgpqnl,bgqnld->bqgpd', p_s.astype(v_sel.dtype), v_sel)
        k_w = lax.dynamic_slice_in_dim(kw, s0, WINDOW + Q_BLOCK, axis=1)
        v_w = lax.dynamic_slice_in_dim(vw, s0, WINDOW + Q_BLOCK, axis=1)
        wpos = s0 - WINDOW + wrel
        m_w = (wpos[None, :] >= 0) & (wpos[None, :] <= t[:, None]) & (wpos[None, :] > t[:, None] - WINDOW)
        s_w = jnp.einsum('bqgpd,bkgd->bgpqk', q_i, k_w) * scale
        p_w = masked_softmax(s_w, m_w)
        o_w = jnp.einsum('bgpqk,bkgd->bqgpd', p_w.astype(v_w.dtype), v_w)
        g = jax.nn.sigmoid(g_i.astype(jnp.float32)).astype(o_c.dtype)
        return g[..., 0:1] * o_c + g[..., 1:2] * o_s + g[..., 2:3] * o_w

    out = lax.map(query_block, (jnp.arange(n_qb), qb, gb))
    return out.transpose(1, 0, 2, 3, 4, 5).reshape(b, s, D_ATTN)


def conformer_conv(u, w_dw, b_dw, ln_g, ln_b):
    a, gte = jnp.split(u, 2, axis=-1)
    glu = a * jax.nn.sigmoid(gte)
    y = lax.conv_general_dilated(glu, w_dw, window_strides=(1,), padding=[(CONV_WIDTH - 1, 0)],
                                 dimension_numbers=('NWC', 'WIO', 'NWC'),
                                 feature_group_count=D_CONV) + b_dw
    return jax.nn.silu(layer_norm(y, ln_g, ln_b))


def route(h, w_router, router_bias):
    t = h.shape[0]
    s = jax.nn.sigmoid(h.astype(jnp.float32) @ w_router.astype(jnp.float32))
    sel = s + router_bias.astype(jnp.float32)
    grp_score = jnp.sum(lax.top_k(sel.reshape(t, N_GROUPS, N_EXPERTS // N_GROUPS), 2)[0], axis=-1)
    _, grp_idx = lax.top_k(grp_score, TOPK_GROUPS)
    grp_mask = jnp.any(grp_idx[..., None] == jnp.arange(N_GROUPS), axis=1)
    sel = jnp.where(jnp.repeat(grp_mask, N_EXPERTS // N_GROUPS, axis=1), sel, -jnp.inf)
    _, idx = lax.top_k(sel, TOP_K)
    w = jnp.take_along_axis(s, idx, axis=-1)
    w = w / jnp.sum(w, axis=-1, keepdims=True) * ROUTED_SCALE
    return idx, w


def routed_experts(h, idx, w, w_gate, w_up, w_down):
    t, d = h.shape
    n_assign = t * TOP_K
    flat_e = idx.reshape(-1)
    order = jnp.argsort(flat_e)
    sorted_e = flat_e[order]
    counts = jnp.bincount(flat_e, length=N_EXPERTS)
    padded = (counts + EXPERT_BLOCK - 1) // EXPERT_BLOCK * EXPERT_BLOCK
    pad_end = jnp.cumsum(padded)
    pad_start = pad_end - padded
    grp_start = jnp.cumsum(counts) - counts
    dest = pad_start[sorted_e] + jnp.arange(n_assign) - grp_start[sorted_e]
    n_blk = -(-(n_assign + N_EXPERTS * (EXPERT_BLOCK - 1)) // EXPERT_BLOCK)
    n_buf = n_blk * EXPERT_BLOCK
    buf_tok = jnp.zeros((n_buf,), jnp.int32).at[dest].set((order // TOP_K).astype(jnp.int32))
    buf_w = jnp.zeros((n_buf,), h.dtype).at[dest].set(w.reshape(-1)[order].astype(h.dtype))
    blk_e = jnp.minimum(jnp.searchsorted(pad_end, jnp.arange(n_blk) * EXPERT_BLOCK, side='right'),
                        N_EXPERTS - 1)

    def expert_block(args):
        e, tok, wt = args
        xb = h[tok]
        hid = jax.nn.silu(xb @ w_gate[e]) * (xb @ w_up[e])
        return (hid @ w_down[e]) * wt[:, None]

    y = lax.map(expert_block, (blk_e, buf_tok.reshape(n_blk, EXPERT_BLOCK),
                               buf_w.reshape(n_blk, EXPERT_BLOCK)))
    return jax.ops.segment_sum(y.reshape(n_buf, d), buf_tok, num_segments=t)


def setup_inputs(seed: int = 0) -> dict:
    key = jax.random.key(seed)
    ks = jax.random.split(key, 32)
    L, D, E, F = DEPTH, D_MODEL, N_EXPERTS, D_EXPERT
    nrm = lambda k, shape, sc: jax.random.normal(k, shape, jnp.float32) * sc
    starts = (0,) + IN_SPLITS
    col_scale = np.ones((D_IN,), np.float32)
    for j in (2, 4, 6):
        col_scale[starts[j]:starts[j] + D_KV] = DEEPNORM_BETA
    return {
        "x": nrm(ks[0], (BATCH, SEQ, D), 1.0),
        "c": nrm(ks[1], (BATCH, D), 1.0),
        "w_ada": nrm(ks[2], (L, D, 6 * D), D ** -0.5),
        "b_ada": nrm(ks[3], (L, 6 * D), 0.02),
        "w_in": nrm(ks[4], (L, D, D_IN), D ** -0.5) * jnp.asarray(col_scale),
        "pe_k": nrm(ks[5], (L, CMP_LEN, HEAD_DIM), 0.1),
        "pe_v": nrm(ks[6], (L, CMP_LEN, HEAD_DIM), 0.1),
        "w_cmp_k1": nrm(ks[7], (L, CMP_LEN * HEAD_DIM, CMP_HID), (CMP_LEN * HEAD_DIM) ** -0.5),
        "w_cmp_k2": nrm(ks[8], (L, CMP_HID, HEAD_DIM), CMP_HID ** -0.5),
        "w_cmp_v1": nrm(ks[9], (L, CMP_LEN * HEAD_DIM, CMP_HID), (CMP_LEN * HEAD_DIM) ** -0.5),
        "w_cmp_v2": nrm(ks[10], (L, CMP_HID, HEAD_DIM), CMP_HID ** -0.5),
        "w_dw": nrm(ks[11], (L, CONV_WIDTH, 1, D_CONV), CONV_WIDTH ** -0.5),
        "b_dw": nrm(ks[12], (L, D_CONV), 0.02),
        "conv_ln_g": 1.0 + nrm(ks[13], (L, D_CONV), 0.02),
        "conv_ln_b": nrm(ks[14], (L, D_CONV), 0.02),
        "w_out": nrm(ks[15], (L, D_MIX, D), D_MIX ** -0.5 * DEEPNORM_BETA),
        "ln1_g": 1.0 + nrm(ks[16], (L, D), 0.02),
        "ln1_b": nrm(ks[17], (L, D), 0.02),
        "w_router": nrm(ks[18], (L, D, E), D ** -0.5),
        "router_bias": nrm(ks[19], (L, E), 0.01),
        "w_e_gate": nrm(ks[20], (L, E, D, F), D ** -0.5),
        "w_e_up": nrm(ks[21], (L, E, D, F), D ** -0.5),
        "w_e_down": nrm(ks[22], (L, E, F, D), F ** -0.5 * DEEPNORM_BETA),
        "w_s_gate": nrm(ks[23], (L, D, F), D ** -0.5),
        "w_s_up": nrm(ks[24], (L, D, F), D ** -0.5),
        "w_s_down": nrm(ks[25], (L, F, D), F ** -0.5 * DEEPNORM_BETA),
        "ln2_g": 1.0 + nrm(ks[26], (L, D), 0.02),
        "ln2_b": nrm(ks[27], (L, D), 0.02),
    }


def reference(x, c, w_ada, b_ada, w_in, pe_k, pe_v, w_cmp_k1, w_cmp_k2, w_cmp_v1, w_cmp_v2,
              w_dw, b_dw, conv_ln_g, conv_ln_b, w_out, ln1_g, ln1_b, w_router, router_bias,
              w_e_gate, w_e_up, w_e_down, w_s_gate, w_s_up, w_s_down, ln2_g, ln2_b):
    b, s, d = x.shape
    for l in range(DEPTH):
        mod = jax.nn.silu(c) @ w_ada[l] + b_ada[l]
        sh1, sc1, g1, sh2, sc2, g2 = [m[:, None, :] for m in jnp.split(mod, 6, axis=-1)]
        h = x * (1 + sc1) + sh1
        u = h @ w_in[l]
        q, k_c, v_c, k_s, v_s, k_w, v_w, gates, conv_in = jnp.split(u, IN_SPLITS, axis=-1)
        attn = nsa_attention(q, gates, k_c, v_c, k_s, v_s, k_w, v_w,
                             pe_k[l], pe_v[l], w_cmp_k1[l], w_cmp_k2[l], w_cmp_v1[l], w_cmp_v2[l])
        conv = conformer_conv(conv_in, w_dw[l], b_dw[l], conv_ln_g[l], conv_ln_b[l])
        mix = jnp.concatenate([attn, conv], axis=-1) @ w_out[l]
        x = layer_norm(DEEPNORM_ALPHA * x + g1 * mix, ln1_g[l], ln1_b[l])
        h = (x * (1 + sc2) + sh2).reshape(b * s, d)
        idx, wts = route(h, w_router[l], router_bias[l])
        shared = (jax.nn.silu(h @ w_s_gate[l]) * (h @ w_s_up[l])) @ w_s_down[l]
        routed = routed_experts(h, idx, wts, w_e_gate[l], w_e_up[l], w_e_down[l])
        y = (shared + routed.astype(shared.dtype)).reshape(b, s, d)
        x = layer_norm(DEEPNORM_ALPHA * x + g2 * y, ln2_g[l], ln2_b[l])
    return x
```

```cpp
#include <hip/hip_runtime.h>
#include <cstdio>
#include <cstdint>

#define DI __device__ __forceinline__
#define LAS __attribute__((address_space(3)))
#define GAS __attribute__((address_space(1)))
typedef unsigned short bf16_t;
typedef short bf16x8 __attribute__((ext_vector_type(8)));
typedef float f32x4 __attribute__((ext_vector_type(4)));
typedef float f32x16 __attribute__((ext_vector_type(16)));
typedef float f32x2 __attribute__((ext_vector_type(2)));
typedef unsigned u32x4 __attribute__((ext_vector_type(4)));
typedef unsigned u32x2 __attribute__((ext_vector_type(2)));
typedef __bf16 bf16x2_t __attribute__((ext_vector_type(2)));

constexpr int NB = 4, SEQ = 8192, DM = 1024, NT = NB * SEQ;
constexpr int NU = 2560;
constexpr int UQ = 0, UKC = 512, UVC = 640, UKS = 768, UVS = 896, UKW = 1024, UVW = 1152, UCA = 1280, UCG = 1792, UGT = 2304;
constexpr int DIN = 2328;
constexpr int NEXP = 256, DEXP = 256, TOPK = 8;
constexpr int NASSIGN = NT * TOPK;
constexpr int NPAD_MAX = NASSIGN + NEXP * 255 + 1;
constexpr int NBLK_MAX = NPAD_MAX / 256 + 1;
constexpr float LN_EPS = 1e-5f;
constexpr float YMOE_SCALE = 16.0f;
constexpr float DN_ALPHA = 1.189207115002721f;

DI unsigned pk2(float lo, float hi) { f32x2 v = {lo, hi}; bf16x2_t b = __builtin_convertvector(v, bf16x2_t); return __builtin_bit_cast(unsigned, b); }
DI float bflo(unsigned w) { return __uint_as_float(w << 16); }
DI float bfhi(unsigned w) { return __uint_as_float(w & 0xffff0000u); }
DI float bf2f(bf16_t b) { return __uint_as_float(((unsigned)b) << 16); }
DI float fsigmoid(float x) { return __builtin_amdgcn_rcpf(1.0f + __expf(-x)); }
DI float fsilu(float x) { return x * __builtin_amdgcn_rcpf(1.0f + __expf(-x)); }
DI float wave_sum(float v) {
#pragma unroll
    for (int o = 1; o < 64; o <<= 1) v += __shfl_xor(v, o);
    return v;
}
DI unsigned ld_u32_agent(const unsigned* p) { return __hip_atomic_load(p, __ATOMIC_RELAXED, __HIP_MEMORY_SCOPE_AGENT); }
#define LDS_WAIT() asm volatile("s_waitcnt lgkmcnt(0)" ::: "memory")
#define VM_WAIT() asm volatile("s_waitcnt vmcnt(0)" ::: "memory")

#define XB_TMO      128
#define XB_XCNT(j)  (256  + 64 * (j))
#define XB_XSUB(j)  (1280 + 64 * (j))
#define XB_XGEN(j)  (2304 + 64 * (j))
#define XB_TOP      3328
#define XB_TOPGEN   3392
#define XCD_BAR_WORDS 3456
#define XB_SPIN_CAP (1u << 18)
__device__ __forceinline__ unsigned xb_ld(unsigned* p)              { return __hip_atomic_load(p, __ATOMIC_RELAXED, __HIP_MEMORY_SCOPE_AGENT); }
__device__ __forceinline__ unsigned xb_add(unsigned* p, unsigned v) { return __hip_atomic_fetch_add(p, v, __ATOMIC_RELAXED, __HIP_MEMORY_SCOPE_AGENT); }
__device__ __forceinline__ unsigned xb_xcc_id() { return (unsigned)__builtin_amdgcn_s_getreg((3 << 11) | 20) & 0xFu; }
#define XB_SPIN(cond, bar) do { unsigned _sp = 0; while (cond) { __builtin_amdgcn_s_sleep(1); \
    if ((++_sp & 255u) == 0u) { if (xb_ld(&(bar)[XB_TMO])) break; if (_sp > XB_SPIN_CAP) { atomicAdd(&(bar)[XB_TMO], 1u); break; } } } } while (0)
struct XcdBarrier { unsigned* bar; unsigned x; volatile LAS unsigned* st; };
__device__ __forceinline__ XcdBarrier xcd_barrier_post(unsigned* bar, volatile LAS unsigned* st) {
    XcdBarrier b; b.bar = bar; b.x = xb_xcc_id(); b.st = st;
    if (threadIdx.x == 0) (void)xb_add(&bar[XB_XCNT(b.x)], 1u);
    return b;
}
__device__ __forceinline__ void xcd_barrier_complete(unsigned* bar, unsigned x, unsigned& nloc, unsigned& nx) {
    const unsigned G = gridDim.x * gridDim.y * gridDim.z;
    unsigned sum, cnt, mine, sp = 0u;
    for (;;) {
        sum = 0u; cnt = 0u; mine = 0u;
#pragma unroll
        for (unsigned j = 0; j < 16; ++j) { const unsigned c = xb_ld(&bar[XB_XCNT(j)]); sum += c; cnt += (c > 0u) ? 1u : 0u; mine = (j == x) ? c : mine; }
        if (sum == G) break;
        __builtin_amdgcn_s_sleep(1);
        if ((++sp & 255u) == 0u) { if (xb_ld(&bar[XB_TMO])) break; if (sp > XB_SPIN_CAP) { atomicAdd(&bar[XB_TMO], 1u); break; } }
    }
    nloc = mine > 0u ? mine : 1u; nx = cnt > 0u ? cnt : 1u;
}
__device__ __forceinline__ void xcd_barrier(const XcdBarrier& b) {
    asm volatile("s_waitcnt vmcnt(0)" ::: "memory");
    __syncthreads();
    if (threadIdx.x == 0) {
        unsigned* bar = b.bar;
        __builtin_amdgcn_s_waitcnt(0);
        unsigned nloc = b.st[0], nx = b.st[1];
        if (nloc == 0u) { xcd_barrier_complete(bar, b.x, nloc, nx); b.st[0] = nloc; b.st[1] = nx; }
        const unsigned old = xb_add(&bar[XB_XSUB(b.x)], 1u);
        const unsigned gen = old / nloc;
        if (old + 1u == (gen + 1u) * nloc) {
            __builtin_amdgcn_fence(__ATOMIC_RELEASE, "agent");
            asm volatile("s_waitcnt vmcnt(0)" ::: "memory");
            const unsigned og = xb_add(&bar[XB_TOP], 1u);
            const unsigned tg = og / nx;
            if (og + 1u == (tg + 1u) * nx) xb_add(&bar[XB_TOPGEN], 1u);
            else XB_SPIN(xb_ld(&bar[XB_TOPGEN]) == tg, bar);
            __builtin_amdgcn_fence(__ATOMIC_ACQUIRE, "agent");
            xb_add(&bar[XB_XGEN(b.x)], 1u);
            asm volatile("s_waitcnt vmcnt(0)" ::: "memory");
        } else {
            XB_SPIN(xb_ld(&bar[XB_XGEN(b.x)]) == gen, bar);
            __builtin_amdgcn_fence(__ATOMIC_ACQUIRE, "agent");
            asm volatile("s_waitcnt vmcnt(0)" ::: "memory");
        }
    }
    __syncthreads();
}

namespace pg8 {
constexpr int BM = 256, BK = 64, HALF = 128, HTB = HALF * BK * 2, STAGE_BYTES = 8 * HTB, NXCD = 8, WGM = 8;
__host__ __device__ __forceinline__ int lds_byte(int r, int c) { const int st = (r >> 4) * 2 + (c >> 5), rr = r & 15, cc = c & 31, ob = rr * 64 + cc * 2; return st * 1024 + (ob ^ (((ob >> 9) & 1) << 5)); }
__host__ __device__ __forceinline__ void stage_rc(int b, int& R, int& C) { const int st = b / 1024, sb = b % 1024, swz = sb ^ (((sb >> 9) & 1) << 5); R = (st >> 1) * 16 + swz / 64; C = (st & 1) * 32 + (swz % 64) / 2; }
__host__ __device__ __forceinline__ int perm32(int rho) { const int n = rho >> 4, i = rho & 15; return 8 * (i >> 2) + 4 * n + (i & 3); }

struct Unit { int pm, pn, po; };
struct Gemm { const bf16_t* A; const bf16_t* Bt; int lda, ldb, K, kstepA; };

struct DenseOrder {
    int nM, nN, nwg, G, c; const bf16_t* A; size_t tstepA;
    DI void init(const bf16_t* A_, int lda, int M, int N, int G_, int c_) { nM = M / BM; nN = N / BM; nwg = nM * nN; G = G_; c = c_; A = A_; tstepA = (size_t)BM * lda * 2; }
    DI bool next(int i, Unit& u) const {
        const long L = (long)i * G + c; if (L >= nwg) return false;
        int wgid = (int)L; { const int q = nwg / NXCD, r = nwg % NXCD, xcd = wgid % NXCD, off = wgid / NXCD; wgid = (xcd < r ? xcd * (q + 1) : r * (q + 1) + (xcd - r) * q) + off; }
        const int nig = WGM * nN, gid = wgid / nig, fm = gid * WGM, gsz = (nM - fm) < WGM ? (nM - fm) : WGM;
        u.pm = fm + ((wgid % nig) % gsz); u.pn = (wgid % nig) / gsz; u.po = u.pn; return true;
    }
    DI const char* abase(const Unit& u) const { return (const char*)A + (size_t)u.pm * tstepA; }
};

DI unsigned cvt_pk_bf16(float lo, float hi) { return pk2(lo, hi); }

template <class Epi, class Sched, bool ALIGN_EPI, bool GATHER>
__device__ __forceinline__ void gemm_phase(LAS unsigned char* lds, const Gemm g, const Sched& S, const Epi& E, const LAS int* rowidx  ) {
    const int tid = threadIdx.x, wid = __builtin_amdgcn_readfirstlane(tid >> 6), lane = tid & 63, wr = wid >> 2, wc = wid & 3, fr = lane & 15, fq = lane >> 4;
    const int K = g.K; int nt = K / BK; asm volatile("" : "+s"(nt));
    unsigned voffA[2], voffB[2]; int RA[2], CA[2];
#pragma unroll
    for (int i = 0; i < 2; ++i) { int R, C; stage_rc(tid * 16 + i * 8192, R, C); const int Rb = Epi::PERM ? ((R & ~31) + perm32(R & 31)) : R;
        RA[i] = R; CA[i] = C; voffA[i] = (unsigned)(R * g.lda + C) * 2u; voffB[i] = (unsigned)(Rb * g.ldb + C) * 2u; }
    const size_t kstepA = (size_t)g.kstepA, kstepB = (size_t)(BK * 2);
    const size_t hstepA = (size_t)HALF * g.lda * 2, hstepB = (size_t)HALF * g.ldb * 2;
    const size_t tstepB = 2 * hstepB;
    const unsigned ldsw = (unsigned)wid * 1024u;
    const int aoff = lds_byte(wr * 64 + fr, fq * 8), boff = lds_byte(wc * 32 + fr, fq * 8);
#define PG8_SA(b, h) (((b) * 2 + (h)) * HTB)
#define PG8_SB(b, h) ((4 + (b) * 2 + (h)) * HTB)
#define PG8_STAGE(bufoff, gbase, voff) do { _Pragma("unroll") for (int _i = 0; _i < 2; ++_i) \
        __builtin_amdgcn_global_load_lds((const unsigned*)((const char*)(gbase) + (voff)[_i]), (LAS unsigned*)(lds + (bufoff) + ldsw + _i * 8192), 16, 0, 0); } while (0)
#define PG8_LDA(dst, b, h) do { _Pragma("unroll") for (int m = 0; m < 4; ++m) _Pragma("unroll") for (int k = 0; k < 2; ++k) dst[m][k] = *(const LAS bf16x8*)(lds + PG8_SA(b, h) + aoff + m * 2048 + k * 1024); } while (0)
#define PG8_LDB(dst, b, h) do { _Pragma("unroll") for (int n = 0; n < 2; ++n) _Pragma("unroll") for (int k = 0; k < 2; ++k) dst[n][k] = *(const LAS bf16x8*)(lds + PG8_SB(b, h) + boff + n * 2048 + k * 1024); } while (0)
#define PG8_MMA(ai, bj, At, Bt) do { __builtin_amdgcn_s_setprio(1); _Pragma("unroll") for (int m = 0; m < 4; ++m) _Pragma("unroll") for (int n = 0; n < 2; ++n) _Pragma("unroll") for (int k = 0; k < 2; ++k) \
        acc[ai][bj][m][n] = __builtin_amdgcn_mfma_f32_16x16x32_bf16(Bt[n][k], At[m][k], acc[ai][bj][m][n], 0, 0, 0); __builtin_amdgcn_s_setprio(0); } while (0)
#define PG8_WAIT_V(n) asm volatile("s_waitcnt vmcnt(" #n ")" ::: "memory")
#define PG8_WAIT_L(n) asm volatile("s_waitcnt lgkmcnt(" #n ")" ::: "memory")
#define PG8_BAR __builtin_amdgcn_s_barrier()
#define PG8_SCHED __builtin_amdgcn_sched_barrier(0)
    Unit cur, nxt; int ui = 0;
    if (!S.next(0, cur)) return;
    f32x4 acc[2][2][4][2];
#pragma unroll
    for (int a = 0; a < 2; ++a)
#pragma unroll
        for (int b = 0; b < 2; ++b)
#pragma unroll
            for (int m = 0; m < 4; ++m)
#pragma unroll
                for (int n = 0; n < 2; ++n) acc[a][b][m][n] = (f32x4){0.f, 0.f, 0.f, 0.f};
    bf16x8 At[4][2], B0[2][2], B1[2][2];
    unsigned cg0[2], cg1[2], ng0[2], ng1[2];
    const char* cA; const char* cB = (const char*)g.Bt + (size_t)cur.pn * tstepB;
    if constexpr (GATHER) {
        cA = (const char*)g.A;
#pragma unroll
        for (int i = 0; i < 2; ++i) { cg0[i] = (unsigned)(rowidx[ui * 256 + RA[i]] * g.lda + CA[i]) * 2u; cg1[i] = (unsigned)(rowidx[ui * 256 + 128 + RA[i]] * g.lda + CA[i]) * 2u; ng0[i] = cg0[i]; ng1[i] = cg1[i]; }
    } else { cA = S.abase(cur); cg0[0] = cg0[1] = cg1[0] = cg1[1] = ng0[0] = ng0[1] = ng1[0] = ng1[1] = 0u; }
#define PG8_STAGE_A(bufoff, base, h, og0, og1) do { if constexpr (GATHER) { if ((h) == 0) PG8_STAGE(bufoff, base, og0); else PG8_STAGE(bufoff, base, og1); } \
        else { PG8_STAGE(bufoff, (base) + ((h) ? hstepA : (size_t)0), voffA); } } while (0)
    PG8_STAGE(PG8_SB(0, 0), cB, voffB); PG8_STAGE(PG8_SB(0, 1), cB + hstepB, voffB); PG8_STAGE_A(PG8_SA(0, 0), cA, 0, cg0, cg1); PG8_STAGE_A(PG8_SA(0, 1), cA, 1, cg0, cg1);
    if (wr == 1) PG8_BAR;
    PG8_WAIT_V(2); PG8_BAR;
    PG8_STAGE(PG8_SB(1, 0), cB + kstepB, voffB); PG8_STAGE_A(PG8_SA(1, 0), cA + kstepA, 0, cg0, cg1); PG8_STAGE(PG8_SB(1, 1), cB + hstepB + kstepB, voffB);
    PG8_WAIT_V(6); PG8_BAR;
    for (;;) {
        const bool has_next = S.next(ui + 1, nxt);
        const char* nA; const char* nB = has_next ? (const char*)g.Bt + (size_t)nxt.pn * tstepB : cB;
        if constexpr (GATHER) {
            nA = cA;
            if (has_next) {
#pragma unroll
                for (int i = 0; i < 2; ++i) { ng0[i] = (unsigned)(rowidx[(ui + 1) * 256 + RA[i]] * g.lda + CA[i]) * 2u; ng1[i] = (unsigned)(rowidx[(ui + 1) * 256 + 128 + RA[i]] * g.lda + CA[i]) * 2u; }
            } else {
#pragma unroll
                for (int i = 0; i < 2; ++i) { ng0[i] = cg0[i]; ng1[i] = cg1[i]; }
            }
        } else { nA = has_next ? S.abase(nxt) : cA; }
        for (int t = 0; t < nt; t += 2) {
            const bool last = (t == nt - 2);
            const char* a1 = cA + (size_t)(t + 1) * kstepA;
            const char* a2 = last ? nA : cA + (size_t)(t + 2) * kstepA; const char* b2 = last ? nB : cB + (size_t)(t + 2) * kstepB;
            const char* a3 = a2 + kstepA; const char* b3 = b2 + kstepB;
            unsigned xg0[2], xg1[2];
#pragma unroll
            for (int i = 0; i < 2; ++i) { xg0[i] = last ? ng0[i] : cg0[i]; xg1[i] = last ? ng1[i] : cg1[i]; }
            PG8_LDB(B0, 0, 0); PG8_LDB(B1, 0, 1); PG8_SCHED; PG8_LDA(At, 0, 0); PG8_STAGE_A(PG8_SA(1, 1), a1, 1, cg0, cg1);
            PG8_WAIT_V(8); PG8_WAIT_L(0); PG8_BAR; PG8_MMA(0, 0, At, B0); PG8_MMA(0, 1, At, B1); PG8_BAR; PG8_SCHED;
            PG8_LDA(At, 0, 1); PG8_STAGE(PG8_SB(0, 0), b2, voffB); PG8_STAGE(PG8_SB(0, 1), b2 + hstepB, voffB); PG8_STAGE_A(PG8_SA(0, 0), a2, 0, xg0, xg1);
            PG8_WAIT_V(8); PG8_WAIT_L(0); PG8_BAR; PG8_MMA(1, 0, At, B0); PG8_MMA(1, 1, At, B1); PG8_BAR; PG8_SCHED;
            PG8_LDB(B0, 1, 0); PG8_LDB(B1, 1, 1); PG8_SCHED; PG8_LDA(At, 1, 0); PG8_STAGE_A(PG8_SA(0, 1), a2, 1, xg0, xg1);
            PG8_WAIT_V(8); PG8_WAIT_L(0); PG8_BAR; PG8_MMA(0, 0, At, B0); PG8_MMA(0, 1, At, B1); PG8_BAR; PG8_SCHED;
            PG8_LDA(At, 1, 1); PG8_STAGE(PG8_SB(1, 0), b3, voffB); PG8_STAGE(PG8_SB(1, 1), b3 + hstepB, voffB); PG8_STAGE_A(PG8_SA(1, 0), a3, 0, xg0, xg1);
            PG8_WAIT_V(8); PG8_WAIT_L(0); PG8_BAR; PG8_MMA(1, 0, At, B0); PG8_MMA(1, 1, At, B1); PG8_BAR; PG8_SCHED;
        }
        if constexpr (ALIGN_EPI) { if (wr == 0) PG8_BAR; }
        E(acc, cur, wr, wc, fr, fq);
        if (!has_next) break;
#pragma unroll
        for (int a = 0; a < 2; ++a)
#pragma unroll
            for (int b = 0; b < 2; ++b)
#pragma unroll
                for (int m = 0; m < 4; ++m)
#pragma unroll
                    for (int n = 0; n < 2; ++n) acc[a][b][m][n] = (f32x4){0.f, 0.f, 0.f, 0.f};
        cur = nxt; cA = nA; cB = nB; ++ui;
#pragma unroll
        for (int i = 0; i < 2; ++i) { cg0[i] = ng0[i]; cg1[i] = ng1[i]; }
        if constexpr (ALIGN_EPI) { if (wr == 1) PG8_BAR; }
    }
    PG8_WAIT_V(0);
    if constexpr (!ALIGN_EPI) { if (wr == 0) PG8_BAR; }
    PG8_BAR;
#undef PG8_SA
#undef PG8_SB
#undef PG8_STAGE
#undef PG8_STAGE_A
#undef PG8_LDA
#undef PG8_LDB
#undef PG8_MMA
#undef PG8_WAIT_V
#undef PG8_WAIT_L
#undef PG8_BAR
#undef PG8_SCHED
}
}
namespace pg8 {
typedef f32x4 AccT[2][2][4][2];

struct EpiStoreBf16 {
    static constexpr bool PERM = true;
    bf16_t* O; int ldc; float scale0; int ntile0;
    DI void operator()(const AccT& acc, const Unit& u, int wr, int wc, int fr, int fq) const {
        const int row0 = u.pm * BM + wr * 64 + fr, col0 = u.po * BM + wc * 32 + 8 * fq; const float sc = (u.po < ntile0) ? scale0 : 1.0f;
#pragma unroll
        for (int ai = 0; ai < 2; ++ai)
#pragma unroll
            for (int m = 0; m < 4; ++m) { bf16_t* rowp = O + (size_t)(row0 + ai * HALF + m * 16) * ldc + col0;
#pragma unroll
                for (int bj = 0; bj < 2; ++bj) { const f32x4 v0 = acc[ai][bj][m][0] * sc, v1 = acc[ai][bj][m][1] * sc;
                    u32x4 w; w.x = pk2(v0[0], v0[1]); w.y = pk2(v0[2], v0[3]); w.z = pk2(v1[0], v1[1]); w.w = pk2(v1[2], v1[3]);
                    *(u32x4*)(rowp + bj * HALF) = w; } }
    }
};
struct EpiStoreFp8 {
    static constexpr bool PERM = true;
    unsigned char* O; int ldc; float scale;
    DI void operator()(const AccT& acc, const Unit& u, int wr, int wc, int fr, int fq) const {
        const int row0 = u.pm * BM + wr * 64 + fr, col0 = u.po * BM + wc * 32 + 8 * fq;
#pragma unroll
        for (int ai = 0; ai < 2; ++ai)
#pragma unroll
            for (int m = 0; m < 4; ++m) { unsigned char* rowp = O + (size_t)(row0 + ai * HALF + m * 16) * ldc + col0;
#pragma unroll
                for (int bj = 0; bj < 2; ++bj) { const f32x4 v0 = acc[ai][bj][m][0] * scale, v1 = acc[ai][bj][m][1] * scale;
                    int w0 = 0, w1 = 0;
                    w0 = __builtin_amdgcn_cvt_pk_fp8_f32(v0[0], v0[1], w0, false); w0 = __builtin_amdgcn_cvt_pk_fp8_f32(v0[2], v0[3], w0, true);
                    w1 = __builtin_amdgcn_cvt_pk_fp8_f32(v1[0], v1[1], w1, false); w1 = __builtin_amdgcn_cvt_pk_fp8_f32(v1[2], v1[3], w1, true);
                    *(u32x2*)(rowp + bj * HALF) = (u32x2){(unsigned)w0, (unsigned)w1}; } }
    }
};
DI float gelu_tanh(float x) { const float u = 0.7978845608028654f * (x + 0.044715f * x * x * x); const float e = __expf(2.0f * u); const float th = 1.0f - 2.0f / (e + 1.0f); return 0.5f * x * (1.0f + th); }
struct EpiCmp {
    static constexpr bool PERM = true;
    bf16_t* O; const float* peb;
    DI void operator()(const AccT& acc, const Unit& u, int wr, int wc, int fr, int fq) const {
        const int row0 = u.pm * BM + wr * 64 + fr, col0 = wc * 32 + 8 * fq; const float* pb = peb + (u.pm >> 4) * 256;
        f32x4 bv[2][2];
#pragma unroll
        for (int bj = 0; bj < 2; ++bj)
#pragma unroll
            for (int n = 0; n < 2; ++n) bv[bj][n] = *(const f32x4*)(pb + col0 + bj * HALF + 4 * n);
#pragma unroll
        for (int ai = 0; ai < 2; ++ai)
#pragma unroll
            for (int m = 0; m < 4; ++m) { bf16_t* rowp = O + (size_t)(row0 + ai * HALF + m * 16) * 256 + col0;
#pragma unroll
                for (int bj = 0; bj < 2; ++bj) { f32x4 v0 = acc[ai][bj][m][0] + bv[bj][0], v1 = acc[ai][bj][m][1] + bv[bj][1];
#pragma unroll
                    for (int j = 0; j < 4; ++j) { v0[j] = gelu_tanh(v0[j]); v1[j] = gelu_tanh(v1[j]); }
                    u32x4 w; w.x = pk2(v0[0], v0[1]); w.y = pk2(v0[2], v0[3]); w.z = pk2(v1[0], v1[1]); w.w = pk2(v1[2], v1[3]);
                    *(u32x4*)(rowp + bj * HALF) = w; } }
    }
};
struct EpiF32 {
    static constexpr bool PERM = false;
    float* C; int ldc;
    DI void operator()(const AccT& acc, const Unit& u, int wr, int wc, int fr, int fq) const {
        const int row0 = u.pm * BM + wr * 64 + fr, col0 = u.po * BM + wc * 32 + 4 * fq;
#pragma unroll
        for (int ai = 0; ai < 2; ++ai)
#pragma unroll
            for (int m = 0; m < 4; ++m) { float* rowp = C + (size_t)(row0 + ai * HALF + m * 16) * ldc + col0;
#pragma unroll
                for (int bj = 0; bj < 2; ++bj)
#pragma unroll
                    for (int n = 0; n < 2; ++n) *(f32x4*)(rowp + bj * HALF + n * 16) = acc[ai][bj][m][n]; }
    }
};
struct EpiResMod {
    static constexpr bool PERM = false;
    const float* base; float* out; const float* gate; int gate_pitch;
    DI void operator()(const AccT& acc, const Unit& u, int wr, int wc, int fr, int fq) const {
        const int row0 = u.pm * BM + wr * 64 + fr, col0 = u.po * BM + wc * 32 + 4 * fq;
        const float* gp = gate + (size_t)((u.pm * BM) / SEQ) * gate_pitch + col0;
        f32x4 gv[2][2];
#pragma unroll
        for (int bj = 0; bj < 2; ++bj)
#pragma unroll
            for (int n = 0; n < 2; ++n) gv[bj][n] = *(const f32x4*)(gp + bj * HALF + n * 16);
#pragma unroll
        for (int ai = 0; ai < 2; ++ai)
#pragma unroll
            for (int m = 0; m < 4; ++m) { const size_t off = (size_t)(row0 + ai * HALF + m * 16) * DM + col0;
#pragma unroll
                for (int bj = 0; bj < 2; ++bj)
#pragma unroll
                    for (int n = 0; n < 2; ++n) { const f32x4 bs = *(const f32x4*)(base + off + bj * HALF + n * 16);
                        *(f32x4*)(out + off + bj * HALF + n * 16) = bs * DN_ALPHA + gv[bj][n] * acc[ai][bj][m][n]; } }
    }
};
struct EpiResModBf16 {
    static constexpr bool PERM = false;
    const float* base; bf16_t* out; const float* gate; int gate_pitch;
    DI void operator()(const AccT& acc, const Unit& u, int wr, int wc, int fr, int fq) const {
        const int row0 = u.pm * BM + wr * 64 + fr, col0 = u.po * BM + wc * 32 + 4 * fq;
        const float* gp = gate + (size_t)((u.pm * BM) / SEQ) * gate_pitch + col0;
        f32x4 gv[2][2];
#pragma unroll
        for (int bj = 0; bj < 2; ++bj)
#pragma unroll
            for (int n = 0; n < 2; ++n) gv[bj][n] = *(const f32x4*)(gp + bj * HALF + n * 16);
#pragma unroll
        for (int ai = 0; ai < 2; ++ai)
#pragma unroll
            for (int m = 0; m < 4; ++m) { const size_t off = (size_t)(row0 + ai * HALF + m * 16) * DM + col0;
#pragma unroll
                for (int bj = 0; bj < 2; ++bj)
#pragma unroll
                    for (int n = 0; n < 2; ++n) { const f32x4 bs = *(const f32x4*)(base + off + bj * HALF + n * 16); const f32x4 v = bs * DN_ALPHA + gv[bj][n] * acc[ai][bj][m][n];
                        *(u32x2*)(out + off + bj * HALF + n * 16) = (u32x2){pk2(v.x, v.y), pk2(v.z, v.w)}; } }
    }
};
struct EpiGlu {
    static constexpr bool PERM = true;
    bf16_t* O; int ldc;
    DI void operator()(const AccT& acc, const Unit& u, int wr, int wc, int fr, int fq) const {
        const int row0 = u.pm * BM + wr * 64 + fr, col0 = u.po * HALF + wc * 32 + 8 * fq;
#pragma unroll
        for (int ai = 0; ai < 2; ++ai)
#pragma unroll
            for (int m = 0; m < 4; ++m) { bf16_t* rowp = O + (size_t)(row0 + ai * HALF + m * 16) * ldc + col0;
                f32x4 h0, h1;
#pragma unroll
                for (int j = 0; j < 4; ++j) { h0[j] = fsilu(acc[ai][0][m][0][j]) * acc[ai][1][m][0][j]; h1[j] = fsilu(acc[ai][0][m][1][j]) * acc[ai][1][m][1][j]; }
                u32x4 w; w.x = pk2(h0[0], h0[1]); w.y = pk2(h0[2], h0[3]); w.z = pk2(h1[0], h1[1]); w.w = pk2(h1[2], h1[3]);
                *(u32x4*)rowp = w; }
    }
};

struct CmpOrder {
    int G, c; const bf16_t* U;
    DI bool next(int i, Unit& u) const { const int L = i * G + c; if (L >= 32) return false; u.pm = L; u.pn = L >> 4; u.po = 0; return true; }
    DI const char* abase(const Unit& u) const { const int kv = u.pm >> 4, bg = (u.pm >> 1) & 7, b = bg >> 1, gg = bg & 1, half = u.pm & 1;
        return (const char*)(U + (size_t)(b * SEQ + half * 4096) * NU + (kv ? UVC : UKC) + gg * 64); }
};
template <int NSUB> struct MoeOrder {
    int G, c, nunits; const int* blk_e; const bf16_t* A; size_t tstepA;
    DI bool next(int i, Unit& u) const { const int L = i * G + c; if (L >= nunits) return false; const int blk = L / NSUB, sub = L % NSUB;
        const int e = (int)__builtin_amdgcn_readfirstlane((int)ld_u32_agent((const unsigned*)blk_e + blk)); u.pm = blk; u.pn = e * NSUB + sub; u.po = sub; return true; }
    DI const char* abase(const Unit& u) const { return (const char*)A + (size_t)u.pm * tstepA; }
};
}
constexpr size_t MiB = 1u << 20;
constexpr size_t WS_CTL = 0, CTL_ZERO_BYTES = 1 * MiB;
constexpr size_t WS_MODP = 1 * MiB;
constexpr size_t WS_MOD = WS_MODP + 1536 * 1024;
constexpr size_t WS_PEP = WS_MOD + 128 * 1024;
constexpr size_t WS_PEB = WS_PEP + 32 * 1024;
constexpr size_t WS_WIN_T = 3 * MiB;
constexpr size_t WS_WOUT_T = 8 * MiB;
constexpr size_t WS_WR_T = 10 * MiB;
constexpr size_t WS_WSGU_T = 12 * MiB;
constexpr size_t WS_WSD_T = 13 * MiB;
constexpr size_t WS_WC1_T = 14 * MiB;
constexpr size_t WS_WDN_T = 16 * MiB;
constexpr size_t WS_WGU_T = 144 * MiB;
constexpr size_t WS_YMOE = 144 * MiB;
constexpr size_t WS_U = 400 * MiB;
constexpr size_t WS_H1 = 560 * MiB;
constexpr size_t WS_CAT = 624 * MiB;
constexpr size_t WS_H2 = 688 * MiB;
constexpr size_t WS_HIDS = 752 * MiB;
constexpr size_t WS_HIDM = 784 * MiB;
constexpr size_t WS_LOGIT = 944 * MiB;
constexpr size_t WS_TOKE = 976 * MiB;
constexpr size_t WS_TOKW = 977 * MiB;
constexpr size_t WS_LRANK = 978 * MiB;
constexpr size_t WS_POSOF = 979 * MiB;
constexpr size_t WS_ROWTOK = 980 * MiB;
constexpr size_t WS_HIST = 982 * MiB;
constexpr size_t WS_BLKE = 983 * MiB;
constexpr size_t WS_HCMP = 984 * MiB;
constexpr size_t WS_KC = 988 * MiB;
constexpr size_t WS_VCT = 989 * MiB;
constexpr size_t WS_VST = 990 * MiB;
constexpr size_t WS_VWT = 998 * MiB;
constexpr size_t WS_V1 = WS_H1;
constexpr size_t WS_X1 = 464 * MiB;
constexpr size_t WS_SH = 528 * MiB;
constexpr size_t WS_END = 1024 * MiB;
constexpr int CW_BAR = 4096;

constexpr int LDS_BYTES = 160 * 1024;
constexpr int LDS_MISC = 131072;
constexpr int LDS_TAB = 131072 + 1024;

struct Params {
    const float *x, *c, *w_ada, *b_ada, *w_in, *pe_k, *pe_v, *w_cmp_k1, *w_cmp_k2, *w_cmp_v1, *w_cmp_v2, *w_dw, *b_dw, *conv_ln_g, *conv_ln_b, *w_out, *ln1_g, *ln1_b,
        *w_router, *router_bias, *w_e_gate, *w_e_up, *w_e_down, *w_s_gate, *w_s_up, *w_s_down, *ln2_g, *ln2_b;
    float* out; unsigned char* ws; int ph_lo, ph_hi;
};

DI void transpose_item(const float* W, int ldw, int ncols, bf16_t* WT, int ldt, int drow0, LAS float* scr, int k0, int n0, int lane) {
    if (n0 + 32 <= ncols && (((size_t)W | (size_t)(ldw * 4)) & 15) == 0 && (n0 & 3) == 0) {
        f32x4 v[8];
#pragma unroll
        for (int i = 0; i < 8; ++i) v[i] = *(const f32x4*)(W + (size_t)(k0 + 8 * i + (lane >> 3)) * ldw + n0 + 4 * (lane & 7));
#pragma unroll
        for (int i = 0; i < 8; ++i) { LAS float* d = scr + (8 * i + (lane >> 3)) * 33 + 4 * (lane & 7); d[0] = v[i].x; d[1] = v[i].y; d[2] = v[i].z; d[3] = v[i].w; }
    } else {
        const int nn = n0 + (lane & 31); const bool okc = nn < ncols;
#pragma unroll 8
        for (int i = 0; i < 32; ++i) { const int kk = 2 * i + (lane >> 5); scr[kk * 33 + (lane & 31)] = okc ? W[(size_t)(k0 + kk) * ldw + nn] : 0.f; }
    }
    LDS_WAIT(); asm volatile("" ::: "memory");
    const int cch = lane & 7;
#pragma unroll
    for (int j = 0; j < 4; ++j) { const int n = (lane >> 3) + 8 * j; const LAS float* s = scr + (8 * cch) * 33 + n;
        u32x4 o; o.x = pk2(s[0 * 33], s[1 * 33]); o.y = pk2(s[2 * 33], s[3 * 33]); o.z = pk2(s[4 * 33], s[5 * 33]); o.w = pk2(s[6 * 33], s[7 * 33]);
        *(u32x4*)(WT + (size_t)(drow0 + n) * ldt + k0 + 8 * cch) = o; }
    LDS_WAIT(); asm volatile("" ::: "memory");
}
DI void tr_plain(const float* W, int ldw, int K, int N, bf16_t* WT, int row_off, LAS float* scr, int item, int lane) {
    const int nblk = (N + 31) / 32, kb = item / nblk, nb = item % nblk;
    transpose_item(W, ldw, N, WT, K, row_off + 32 * nb, scr, 64 * kb, 32 * nb, lane);
}
DI void tr_glu(const float* W, int K, bf16_t* WT, int up, LAS float* scr, int item, int lane) {
    const int kb = item >> 3, nb = item & 7, n0 = 32 * nb;
    transpose_item(W, 256, 256, WT, K, (n0 >> 7) * 256 + up * 128 + (n0 & 127), scr, 64 * kb, n0, lane);
}

constexpr int EXP_ITEMS = NEXP * 384, EXP_LATE = 18432;
DI void expert_items(const Params& P, LAS float* scr, int lane, int gw, int NGW, int r0, int r1) {
    unsigned char* ws = P.ws;
    for (int r = r0 + gw; r < r1; r += NGW) { const int e = r / 384, q = r % 384;
        if (q < 128) tr_glu(P.w_e_gate + (size_t)e * 1024 * 256, 1024, (bf16_t*)(ws + WS_WGU_T) + (size_t)e * 512 * 1024, 0, scr, q, lane);
        else if (q < 256) tr_glu(P.w_e_up + (size_t)e * 1024 * 256, 1024, (bf16_t*)(ws + WS_WGU_T) + (size_t)e * 512 * 1024, 1, scr, q - 128, lane);
        else tr_plain(P.w_e_down + (size_t)e * 256 * 1024, 1024, 256, 1024, (bf16_t*)(ws + WS_WDN_T) + (size_t)e * 1024 * 256, 0, scr, q - 256, lane); }
}

DI void phase0a(const Params& P, LAS unsigned char* lds, int vcu, int G, int wave, int lane, int tid) {
    unsigned char* ws = P.ws;
    LAS float* scr = (LAS float*)(lds + wave * 16384);
    const int gw = vcu * 8 + wave, NGW = G * 8;
    for (int it = gw; it < 96 * 16; it += NGW) { const int cb = it % 96, ks = it / 96; const int col = cb * 64 + lane;
        float a0 = 0.f, a1 = 0.f, a2 = 0.f, a3 = 0.f;
#pragma unroll 4
        for (int k = ks * 64; k < ks * 64 + 64; ++k) { const float w = P.w_ada[(size_t)k * 6144 + col];
            a0 += fsilu(P.c[k]) * w; a1 += fsilu(P.c[1024 + k]) * w; a2 += fsilu(P.c[2048 + k]) * w; a3 += fsilu(P.c[3072 + k]) * w; }
        float* mp = (float*)(ws + WS_MODP) + (size_t)ks * 4 * 6144 + col;
        mp[0] = a0; mp[6144] = a1; mp[2 * 6144] = a2; mp[3 * 6144] = a3; }
    for (int it = gw; it < 16 * 2 * 4; it += NGW) { const int cb = it & 3, kv = (it >> 2) & 1, ks = it >> 3; const int col = cb * 64 + lane;
        const float* pe = kv ? P.pe_v : P.pe_k; const float* w1 = kv ? P.w_cmp_v1 : P.w_cmp_k1; float a = 0.f;
#pragma unroll 4
        for (int k = ks * 128; k < ks * 128 + 128; ++k) a += pe[k] * w1[(size_t)k * 256 + col];
        ((float*)(ws + WS_PEP))[(ks * 2 + kv) * 256 + col] = a; }
    constexpr int I_IN0 = 16 * 40, I_IN1 = 16 * 32, I_IN2 = 16 * 1, I_OUT = 16 * 32, I_R = 16 * 8, I_SG = 16 * 8, I_SD = 4 * 32, I_C1 = 32 * 8;
    constexpr int I_SMALL = I_IN0 + I_IN1 + I_IN2 + I_OUT + I_R + 2 * I_SG + I_SD + 2 * I_C1;
    constexpr int NITEMS = I_SMALL;
    bf16_t* win_t = (bf16_t*)(ws + WS_WIN_T);
    for (int it = gw; it < NITEMS; it += NGW) {
        int r = it;
        if (r < I_IN0) { tr_plain(P.w_in, DIN, 1024, 1280, win_t, 0, scr, r, lane); continue; } r -= I_IN0;
        if (r < I_IN1) { tr_plain(P.w_in + 1304, DIN, 1024, 1024, win_t, UCA, scr, r, lane); continue; } r -= I_IN1;
        if (r < I_IN2) { tr_plain(P.w_in + 1280, DIN, 1024, 24, win_t, UGT, scr, r, lane); continue; } r -= I_IN2;
        if (r < I_OUT) { tr_plain(P.w_out, 1024, 1024, 1024, (bf16_t*)(ws + WS_WOUT_T), 0, scr, r, lane); continue; } r -= I_OUT;
        if (r < I_R) { tr_plain(P.w_router, 256, 1024, 256, (bf16_t*)(ws + WS_WR_T), 0, scr, r, lane); continue; } r -= I_R;
        if (r < I_SG) { tr_glu(P.w_s_gate, 1024, (bf16_t*)(ws + WS_WSGU_T), 0, scr, r, lane); continue; } r -= I_SG;
        if (r < I_SG) { tr_glu(P.w_s_up, 1024, (bf16_t*)(ws + WS_WSGU_T), 1, scr, r, lane); continue; } r -= I_SG;
        if (r < I_SD) { tr_plain(P.w_s_down, 1024, 256, 1024, (bf16_t*)(ws + WS_WSD_T), 0, scr, r, lane); continue; } r -= I_SD;
        if (r < I_C1) { tr_plain(P.w_cmp_k1, 256, 2048, 256, (bf16_t*)(ws + WS_WC1_T), 0, scr, r, lane); continue; } r -= I_C1;
        tr_plain(P.w_cmp_v1, 256, 2048, 256, (bf16_t*)(ws + WS_WC1_T) + 256 * 2048, 0, scr, r, lane);
    }
    { u32x4* z = (u32x4*)(win_t + (size_t)2336 * 1024); const int n16 = (2560 - 2336) * 1024 * 2 / 16;
      for (int i = vcu * 512 + tid; i < n16; i += G * 512) z[i] = (u32x4){0u, 0u, 0u, 0u}; }
}

DI void phase0b(const Params& P, LAS unsigned char* lds, int vcu, int G, int wave, int lane, int tid) {
    unsigned char* ws = P.ws;
    const float* modp = (const float*)(ws + WS_MODP);
    for (int i = vcu * 512 + tid; i < 4 * 6144; i += G * 512) { float a = P.b_ada[i % 6144];
#pragma unroll
        for (int ks = 0; ks < 16; ++ks) a += modp[(size_t)ks * 4 * 6144 + i];
        ((float*)(ws + WS_MOD))[i] = a; }
    for (int i = vcu * 512 + tid; i < 512; i += G * 512) { float a = 0.f;
#pragma unroll
        for (int ks = 0; ks < 16; ++ks) a += ((const float*)(ws + WS_PEP))[ks * 512 + i];
        ((float*)(ws + WS_PEB))[i] = a; }
    const int rpw = NT / G;
    LAS float* sh = (LAS float*)lds;
    for (int r0 = vcu * rpw; r0 < NT; r0 += G * rpw) {
        const int b = r0 / SEQ;
        __syncthreads();
        for (int i = tid; i < 2048; i += 512) { const int j = (i < 1024) ? i : i;
            float a = P.b_ada[j];
#pragma unroll
            for (int ks = 0; ks < 16; ++ks) a += modp[(size_t)ks * 4 * 6144 + b * 6144 + j];
            sh[i] = (i < 1024) ? a : 1.0f + a; }
        __syncthreads();
        for (int m = r0 + wave; m < r0 + rpw; m += 8) {
            const f32x4* xr = (const f32x4*)(P.x + (size_t)m * DM) + lane; unsigned long long* o8 = (unsigned long long*)((bf16_t*)(ws + WS_H1) + (size_t)m * DM) + lane;
#pragma unroll
            for (int j = 0; j < 4; ++j) { const f32x4 v = xr[64 * j]; const int c0 = 4 * lane + 256 * j;
                const float y0 = v.x * sh[1024 + c0] + sh[c0], y1 = v.y * sh[1025 + c0] + sh[c0 + 1], y2 = v.z * sh[1026 + c0] + sh[c0 + 2], y3 = v.w * sh[1027 + c0] + sh[c0 + 3];
                o8[64 * j] = (unsigned long long)pk2(y0, y1) | ((unsigned long long)pk2(y2, y3) << 32); }
        }
    }
    __syncthreads();
}

DI void conv_item(const Params& P, LAS unsigned char* lds, int item, int wave, int lane, int tid) {
    const bf16_t* U = (const bf16_t*)(P.ws + WS_U); bf16_t* CAT = (bf16_t*)(P.ws + WS_CAT);
    LAS float* glu = (LAS float*)lds; LAS float* red = (LAS float*)(lds + 62 * 512 * 4); LAS float* stat = red + 32 * 8 * 2;
    const int b = item >> 8, t0 = (item & 255) * 32, c = tid;
    __syncthreads();
    {
        u32x4 av[8], gv8[8];
#pragma unroll
        for (int i = 0; i < 8; ++i) { const int task = tid + 512 * i, rr = task >> 6, oc = task & 63; int tok = t0 - 30 + (rr < 62 ? rr : 61); tok = tok < 0 ? 0 : tok;
            const bf16_t* up = U + (size_t)(b * SEQ + tok) * NU + oc * 8; av[i] = *(const u32x4*)(up + UCA); gv8[i] = *(const u32x4*)(up + UCG); }
#pragma unroll
        for (int i = 0; i < 8; ++i) { const int task = tid + 512 * i, rr = task >> 6, oc = task & 63; const bool ok = (t0 - 30 + rr) >= 0;
            const unsigned aw[4] = {av[i].x, av[i].y, av[i].z, av[i].w}, gw[4] = {gv8[i].x, gv8[i].y, gv8[i].z, gv8[i].w}; float o[8];
#pragma unroll
            for (int q = 0; q < 4; ++q) { o[2 * q] = ok ? bflo(aw[q]) * fsigmoid(bflo(gw[q])) : 0.f; o[2 * q + 1] = ok ? bfhi(aw[q]) * fsigmoid(bfhi(gw[q])) : 0.f; }
            if (rr < 62) { *(LAS f32x4*)(glu + rr * 512 + oc * 8) = (f32x4){o[0], o[1], o[2], o[3]}; *(LAS f32x4*)(glu + rr * 512 + oc * 8 + 4) = (f32x4){o[4], o[5], o[6], o[7]}; } }
    }
    float w[31];
#pragma unroll
    for (int j = 0; j < 31; ++j) w[j] = P.w_dw[j * 512 + c];
    const float bd = P.b_dw[c];
    __syncthreads();
    float y[32];
#pragma unroll
    for (int tt = 0; tt < 32; ++tt) y[tt] = bd;
#pragma unroll
    for (int rr = 0; rr < 62; ++rr) { const float gv = glu[rr * 512 + c];
#pragma unroll
        for (int tt = 0; tt < 32; ++tt) { if (rr - tt >= 0 && rr - tt <= 30) y[tt] += w[rr - tt] * gv; } }
    __syncthreads();
#pragma unroll
    for (int tt = 0; tt < 32; ++tt) glu[tt * 512 + c] = y[tt];
    __syncthreads();
    {
#pragma unroll
        for (int q = 0; q < 4; ++q) { const int tt = 4 * wave + q; const f32x4 a = *(const LAS f32x4*)(glu + tt * 512 + lane * 8), bq = *(const LAS f32x4*)(glu + tt * 512 + lane * 8 + 4);
            float s1 = ((a.x + a.y) + (a.z + a.w)) + ((bq.x + bq.y) + (bq.z + bq.w));
            float s2 = ((a.x * a.x + a.y * a.y) + (a.z * a.z + a.w * a.w)) + ((bq.x * bq.x + bq.y * bq.y) + (bq.z * bq.z + bq.w * bq.w));
            s1 = wave_sum(s1); s2 = wave_sum(s2);
            if (lane == 0) { const float mean = s1 * (1.0f / 512.0f); float var = s2 * (1.0f / 512.0f) - mean * mean; var = var < 0.f ? 0.f : var;
                stat[tt * 2] = mean; stat[tt * 2 + 1] = 1.0f / sqrtf(var + LN_EPS); } }
    }
    __syncthreads();
    const float lg = P.conv_ln_g[c], lb = P.conv_ln_b[c];
#pragma unroll
    for (int tt = 0; tt < 32; ++tt) { const float v = (y[tt] - stat[tt * 2]) * stat[tt * 2 + 1] * lg + lb;
        CAT[(size_t)(b * SEQ + t0 + tt) * DM + 512 + c] = (bf16_t)(pk2(fsilu(v), 0.f) & 0xffffu); }
}

DI unsigned swap23(unsigned p) { return (p & ~12u) | ((p & 4u) << 1) | ((p & 8u) >> 1); }
DI void vt_copies(const Params& P, LAS unsigned char* lds, int gw, int NGW, int wave, int lane) {
    unsigned char* ws = P.ws;
    LAS bf16_t* tile = (LAS bf16_t*)(lds + wave * 8448);
    const bf16_t* U = (const bf16_t*)(ws + WS_U);
    for (int it = gw; it < 2 * 8 * 128; it += NGW) { const int which = it >> 10, bg = (it >> 7) & 7, blk = it & 127, b = bg >> 1, gg = bg & 1;
        const bf16_t* src = U + (size_t)(b * SEQ + blk * 64 + lane) * NU + (which ? UVW : UVS) + gg * 64;
#pragma unroll
        for (int q = 0; q < 8; ++q) { const u32x4 v = *(const u32x4*)(src + q * 8); LAS unsigned* tp = (LAS unsigned*)(tile + lane * 66 + q * 8); tp[0] = v.x; tp[1] = v.y; tp[2] = v.z; tp[3] = v.w; }
        LDS_WAIT(); asm volatile("" ::: "memory");
        bf16_t* dst = (bf16_t*)(ws + (which ? WS_VWT : WS_VST)) + ((size_t)(bg * 128 + blk) * 64 + lane) * 64;
#pragma unroll
        for (int q = 0; q < 8; ++q) { unsigned wv[4];
#pragma unroll
            for (int e2 = 0; e2 < 4; ++e2) { const int p0 = q * 8 + e2 * 2; const int k0 = (p0 & ~15) | (int)swap23((unsigned)p0 & 15u), k1 = ((p0 + 1) & ~15) | (int)swap23((unsigned)(p0 + 1) & 15u);
                wv[e2] = (unsigned)tile[k0 * 66 + lane] | ((unsigned)tile[k1 * 66 + lane] << 16); }
            *(u32x4*)(dst + q * 8) = (u32x4){wv[0], wv[1], wv[2], wv[3]}; }
        LDS_WAIT(); asm volatile("" ::: "memory");
    }
}

DI void cmp2_rows(const Params& P, LAS unsigned char* lds, int kv, int row0, int nblk64, int tid) {
    unsigned char* ws = P.ws;
    const float* w2 = kv ? P.w_cmp_v2 : P.w_cmp_k2; LAS float* w2s = (LAS float*)lds;
    __syncthreads();
    for (int i = tid; i < 256 * 64 / 4; i += 512) ((LAS f32x4*)w2s)[i] = ((const f32x4*)w2)[i];
    __syncthreads();
    for (int blk = 0; blk < nblk64; ++blk) {
        const int row = row0 + blk * 64 + (tid >> 3), oc = tid & 7;
        const bf16_t* hrow = (const bf16_t*)(ws + WS_HCMP) + ((size_t)kv * 4096 + row) * 256;
        float acc[8];
#pragma unroll
        for (int j = 0; j < 8; ++j) acc[j] = 0.f;
        for (int k8 = 0; k8 < 32; ++k8) { const u32x4 hv = *(const u32x4*)(hrow + k8 * 8); const unsigned hw[4] = {hv.x, hv.y, hv.z, hv.w};
#pragma unroll
            for (int q = 0; q < 4; ++q) {
#pragma unroll
                for (int hh = 0; hh < 2; ++hh) { const float hval = hh ? bfhi(hw[q]) : bflo(hw[q]); const int k = k8 * 8 + q * 2 + hh;
                    const f32x4 wa = *(const LAS f32x4*)(w2s + k * 64 + oc * 8), wb = *(const LAS f32x4*)(w2s + k * 64 + oc * 8 + 4);
                    acc[0] += hval * wa.x; acc[1] += hval * wa.y; acc[2] += hval * wa.z; acc[3] += hval * wa.w; acc[4] += hval * wb.x; acc[5] += hval * wb.y; acc[6] += hval * wb.z; acc[7] += hval * wb.w; } } }
        const int bg = row >> 9, n = row & 511;
        if (n == 511) {
#pragma unroll
            for (int j = 0; j < 8; ++j) acc[j] = 0.f; }
        if (kv == 0) { u32x4 o; o.x = pk2(acc[0], acc[1]); o.y = pk2(acc[2], acc[3]); o.z = pk2(acc[4], acc[5]); o.w = pk2(acc[6], acc[7]);
            *(u32x4*)((bf16_t*)(ws + WS_KC) + ((size_t)bg * 512 + n) * 64 + oc * 8) = o; }
        else { bf16_t* vt = (bf16_t*)(ws + WS_VCT) + (size_t)bg * 64 * 512; const int pos = (n & ~15) | (int)swap23((unsigned)n & 15u);
#pragma unroll
            for (int j = 0; j < 8; ++j) vt[(size_t)(oc * 8 + j) * 512 + pos] = (bf16_t)(pk2(acc[j], 0.f) & 0xffffu); }
    }
    __syncthreads();
}
DI void phase_cmp2(const Params& P, LAS unsigned char* lds, int vcu, int G, int wave, int lane, int tid) {
    for (int it = vcu; it < 128; it += G) cmp2_rows(P, lds, it >> 6, (it & 63) * 64, 1, tid);
    __syncthreads();
}
namespace attn {
constexpr int ROWB = 144;
constexpr int TROW = 128, TILEB = 64 * TROW;
constexpr int OFF_K = 0, OFF_V = 2 * TILEB, OFF_IMPG = 36864, OFF_IMPL = OFF_IMPG + 32768;
constexpr int OFF_SELM = LDS_TAB, OFF_MREF = LDS_TAB + 1024, OFF_LSUM = LDS_TAB + 2048, OFF_LIST = LDS_TAB + 4096, OFF_TM = LDS_TAB + 6144;
constexpr int OFF_QS = 0, OFF_PBUF = 36864, PSLOT = 32 * ROWB;
constexpr float NEG = -1e30f, MFLOOR = -1e20f;
#define MFMA32(a, b, c) __builtin_amdgcn_mfma_f32_32x32x16_bf16((a), (b), (c), 0, 0, 0)
DI float fexp2(float x) { return __builtin_amdgcn_exp2f(x); }
DI void dma_tile(const bf16_t* base, unsigned pitch, LAS unsigned char* buf, int wave, int lane) {
    const int row = 8 * wave + (lane >> 3), ch = (lane & 7) ^ ((row >> 1) & 7);
    __builtin_amdgcn_global_load_lds((const unsigned*)(base + (unsigned)(row * pitch + ch * 8)), (LAS unsigned*)(buf + wave * 1024), 16, 0, 0); }
DI bf16x8 pack8(const f32x16& p, int s2) { u32x4 w; w.x = pk2(p[8 * s2], p[8 * s2 + 1]); w.y = pk2(p[8 * s2 + 2], p[8 * s2 + 3]); w.z = pk2(p[8 * s2 + 4], p[8 * s2 + 5]); w.w = pk2(p[8 * s2 + 6], p[8 * s2 + 7]); return __builtin_bit_cast(bf16x8, w); }

constexpr int CV_PER_EXPERT = 1536, CV_TOTAL = NEXP * CV_PER_EXPERT;
struct CvState { int next, end, nfly; bool xafter; };
DI LAS unsigned char* cv_buf(LAS unsigned char* lds, int wave, int seq) { return lds + (wave < 4 ? 110592 + wave * 4096 : LDS_TAB + 8192 + (wave - 4) * 4096) + (seq & 1) * 2048; }
DI void cv_issue(const Params& P, CvState& c, LAS unsigned char* lds, int wave, int lane) {
    const int m = c.next, e = m / CV_PER_EXPERT, q = m % CV_PER_EXPERT, mat = q >> 9, w = q & 511;
    LAS unsigned* st = (LAS unsigned*)cv_buf(lds, wave, m);
    if (mat < 2) { const int nb = w >> 7, k0 = (w & 127) * 8;
        const float* src = (mat ? P.w_e_up : P.w_e_gate) + (size_t)e * 1024 * 256 + (size_t)k0 * 256 + nb * 64 + lane;
#pragma unroll
        for (int j = 0; j < 8; ++j) __builtin_amdgcn_global_load_lds((const unsigned*)(src + j * 256), st + j * 64, 4, 0, 0);
    } else { const int nb = w >> 5, k0 = (w & 31) * 8;
        const float* src = P.w_e_down + (size_t)e * 256 * 1024 + (size_t)k0 * 1024 + nb * 64 + lane;
#pragma unroll
        for (int j = 0; j < 8; ++j) __builtin_amdgcn_global_load_lds((const unsigned*)(src + j * 1024), st + j * 64, 4, 0, 0);
    }
    ++c.nfly; ++c.next; c.xafter = true;
}
DI void cv_finish(const Params& P, CvState& c, LAS unsigned char* lds, int wave, int lane) {
    const int m = c.next - c.nfly, e = m / CV_PER_EXPERT, q = m % CV_PER_EXPERT, mat = q >> 9, w = q & 511;
    const LAS float* st = (const LAS float*)cv_buf(lds, wave, m) + lane;
    u32x4 o; o.x = pk2(st[0], st[64]); o.y = pk2(st[128], st[192]); o.z = pk2(st[256], st[320]); o.w = pk2(st[384], st[448]);
    bf16_t* dst;
    if (mat < 2) { const int nb = w >> 7, k0 = (w & 127) * 8, n = nb * 64 + lane;
        dst = (bf16_t*)(P.ws + WS_WGU_T) + (size_t)e * 512 * 1024 + (size_t)((n >> 7) * 256 + mat * 128 + (n & 127)) * 1024 + k0;
    } else { const int nb = w >> 5, k0 = (w & 31) * 8, n = nb * 64 + lane;
        dst = (bf16_t*)(P.ws + WS_WDN_T) + (size_t)e * 1024 * 256 + (size_t)n * 256 + k0; }
    asm volatile("s_waitcnt lgkmcnt(0)" ::: "memory");
    *(u32x4*)dst = o; --c.nfly;
}
template <int MODE>
DI void tile_compute(const LAS unsigned char* Kb, const LAS unsigned char* Vb, const bf16x8 (&qf)[4], int r, int h, int lo, int hi, bool elem,
                     float& m, float& l, f32x16 (&O)[2], float meff_in, float linv, LAS float* impg, LAS float* impl, int sb0) {
    const bool rowfull = (lo <= 0 && hi >= 63);
    const int lo2 = lo - 4 * h, hi2 = hi - 4 * h, swz = (r >> 1) & 7;
#pragma unroll
    for (int kh = 0; kh < 2; ++kh) {
        f32x16 s;
#pragma unroll
        for (int i = 0; i < 16; ++i) s[i] = 0.f;
#pragma unroll
        for (int ks = 0; ks < 4; ++ks) { const bf16x8 a = *(const LAS bf16x8*)(Kb + (32 * kh + r) * TROW + (((2 * ks + h) ^ swz) << 4)); s = MFMA32(a, qf[ks], s); }
        if (elem) {
#pragma unroll
            for (int i = 0; i < 16; ++i) { const int k0 = (i & 3) + 8 * (i >> 2) + 32 * kh; s[i] = (k0 >= lo2 && k0 <= hi2) ? s[i] : NEG; }
        }
        float cref;
        if (MODE != 2) {
            float tm = s[0];
#pragma unroll
            for (int i = 1; i < 16; ++i) tm = fmaxf(tm, s[i]);
            tm = fmaxf(tm, __shfl_xor(tm, 32));
            if (!elem) tm = rowfull ? tm : NEG;
            const bool need = tm > m + 8.0f;
            if (__any(need)) {
                const float mnew = need ? tm : m;
                const float alpha = fexp2(fmaxf(m, MFLOOR) - fmaxf(mnew, MFLOOR));
                l *= alpha; m = mnew;
                if (MODE == 0) {
#pragma unroll
                    for (int i = 0; i < 16; ++i) { O[0][i] *= alpha; O[1][i] *= alpha; } }
            }
            cref = (elem || rowfull) ? fmaxf(m, MFLOOR) : 1e30f;
            float rs = 0.f;
#pragma unroll
            for (int i = 0; i < 16; ++i) { s[i] = fexp2(s[i] - cref); rs += s[i]; }
            rs += __shfl_xor(rs, 32);
            l += rs;
        } else {
            cref = (elem || rowfull) ? meff_in : 1e30f;
#pragma unroll
            for (int i = 0; i < 16; ++i) s[i] = fexp2(s[i] - cref);
        }
        if (MODE == 1) continue;
        if (MODE == 2) {
#pragma unroll
            for (int gq = 0; gq < 4; ++gq) {
                float Gs = ((s[4 * gq] + s[4 * gq + 1]) + (s[4 * gq + 2] + s[4 * gq + 3])) * linv, Ls = s[4 * gq + 3] * linv;
                Gs += __shfl_xor(Gs, 1); Gs += __shfl_xor(Gs, 2); Ls += __shfl_xor(Ls, 1); Ls += __shfl_xor(Ls, 2);
                if ((r & 3) == 0) { const int sb = sb0 + 8 * kh + 2 * gq + h; impg[sb] = Gs; impl[sb] = Ls; } }
        }
#pragma unroll
        for (int s2 = 0; s2 < 2; ++s2) { const bf16x8 pf = pack8(s, s2);
#pragma unroll
            for (int dt = 0; dt < 2; ++dt) { const bf16x8 a = *(const LAS bf16x8*)(Vb + (32 * dt + r) * TROW + (((4 * kh + 2 * s2 + h) ^ swz) << 4));
                O[dt] = MFMA32(a, pf, O[dt]); } }
    }
}

DI void attn_unit(const Params& P, LAS unsigned char* lds, int bg, int qt, int wave, int lane_in, int tid_in, int& it, CvState& cv) {
    int lane = lane_in; asm volatile("" : "+v"(lane));
    const int tid = wave * 64 + lane;
    unsigned char* ws = P.ws;
    const bf16_t* U = (const bf16_t*)(ws + WS_U);
    const int b = bg >> 1, gg = bg & 1, t0 = qt * 64, r = lane & 31, h = lane >> 5, tokl = 8 * wave + (r >> 2), hp = r & 3, t = t0 + tokl;
    LAS float* IMPG = (LAS float*)(lds + OFF_IMPG); LAS float* IMPL = (LAS float*)(lds + OFF_IMPL); LAS unsigned* SELM = (LAS unsigned*)(lds + OFF_SELM);
#define ATT_UROW(name) int lq_ = lane; asm volatile("" : "+v"(lq_)); const bf16_t* name = U + (size_t)(b * SEQ + t0 + 8 * wave + ((lq_ & 31) >> 2)) * NU; const int hq_ = lq_ & 3, hh_ = lq_ >> 5; (void)hq_; (void)hh_;
    bf16x8 qf[4];
#define ATT_LOADQ() do { ATT_UROW(urow_) _Pragma("unroll") for (int ks = 0; ks < 4; ++ks) qf[ks] = *(const bf16x8*)(urow_ + UQ + (4 * gg + hq_) * 64 + 16 * ks + 8 * hh_); } while (0)
    ATT_LOADQ();
    f32x16 OA[2];
#pragma unroll
    for (int i = 0; i < 16; ++i) { OA[0][i] = 0.f; OA[1][i] = 0.f; }
    __syncthreads();
#pragma unroll
    for (int j = 0; j < 4; ++j) { *(LAS f32x4*)(IMPG + 8 * wave * 128 + lane * 4 + 256 * j) = (f32x4){0.f, 0.f, 0.f, 0.f}; *(LAS f32x4*)(IMPL + 8 * wave * 128 + lane * 4 + 256 * j) = (f32x4){0.f, 0.f, 0.f, 0.f}; }
    f32x16 O[2]; float m, l;
#define ATT_RESET() do { m = NEG; l = 0.f; _Pragma("unroll") for (int i = 0; i < 16; ++i) { O[0][i] = 0.f; O[1][i] = 0.f; } } while (0)
#define ATT_FOLD(br) do { ATT_UROW(urow_) const float gate_ = fsigmoid(bf2f(urow_[UGT + gg * 12 + hq_ * 3 + (br)])); const float sc_ = (l > 0.f) ? gate_ / l : 0.f; _Pragma("unroll") for (int i = 0; i < 16; ++i) { OA[0][i] += sc_ * O[0][i]; OA[1][i] += sc_ * O[1][i]; } } while (0)

#define ATT_STEP(CUR, NXT, TI, KPTR, KPITCH, VPTR, VPITCH, USEV, ...) { \
            LAS unsigned char* Kb = lds + OFF_K + (CUR) * TILEB; LAS unsigned char* Vb = lds + OFF_V + (CUR) * TILEB; \
            int nfin_; if (cv.xafter) { asm volatile("s_waitcnt vmcnt(8)" ::: "memory"); nfin_ = cv.nfly - 1; } else { asm volatile("s_waitcnt vmcnt(0)" ::: "memory"); nfin_ = cv.nfly; } \
            for (int f_ = 0; f_ < nfin_; ++f_) cv_finish(P, cv, lds, wave, tz_); \
            asm volatile("s_waitcnt lgkmcnt(0)" ::: "memory"); __builtin_amdgcn_s_barrier(); asm volatile("" ::: "memory"); \
            if ((TI) + 1 < n_) { const int pi = (TI) + 1; dma_tile(KPTR, KPITCH, lds + OFF_K + (NXT) * TILEB, wave, tz_); if (USEV) dma_tile(VPTR, VPITCH, lds + OFF_V + (NXT) * TILEB, wave, tz_); cv.xafter = false; } \
            if (cv.next < cv.end && cv.nfly < 2) cv_issue(P, cv, lds, wave, tz_); \
            { const int ti = (TI); __VA_ARGS__ } ++it; }
#define ATT_LOOP(NTILES, KPTR, KPITCH, VPTR, VPITCH, USEV, ...) { const int n_ = (NTILES); int tz_ = lane; asm volatile("" : "+v"(tz_)); \
        asm volatile("s_waitcnt lgkmcnt(0)" ::: "memory"); __builtin_amdgcn_s_barrier(); asm volatile("" ::: "memory");     \
        if (n_ > 0) { const int pi = 0; dma_tile(KPTR, KPITCH, lds + OFF_K, wave, tz_); if (USEV) dma_tile(VPTR, VPITCH, lds + OFF_V, wave, tz_); cv.xafter = false; } \
        for (int i_ = 0; i_ < n_; i_ += 2) { \
            ATT_STEP(0, 1, i_, KPTR, KPITCH, VPTR, VPITCH, USEV, __VA_ARGS__) \
            if (i_ + 1 < n_) ATT_STEP(1, 0, i_ + 1, KPTR, KPITCH, VPTR, VPITCH, USEV, __VA_ARGS__) } }

    const bf16_t* KC = (const bf16_t*)(ws + WS_KC) + (size_t)bg * 512 * 64; const bf16_t* VCT = (const bf16_t*)(ws + WS_VCT) + (size_t)bg * 64 * 512;
    const int hin = (t - 31) >> 4;
    const int ntc = (((t0 + 32) >> 4) >> 6) + 1;
    ATT_RESET();
    ATT_LOOP(ntc, KC + (size_t)pi * 64 * 64, 64, KC, 64, false, {
        const int hi = hin - 64 * ti; const bool fe = (hi >= 63) || (hi < 0);
        if (!__all(hi < 0)) tile_compute<1>(Kb, Kb, qf, r, h, 0, hi, !__all(fe), m, l, O, 0.f, 0.f, nullptr, nullptr, 0); })
    {
        const float meff = fmaxf(m, MFLOOR), linv = (l > 0.f) ? 1.0f / l : 0.f;
        ATT_LOOP(ntc, KC + (size_t)pi * 64 * 64, 64, VCT + pi * 64, 512, true, {
            const int hi = hin - 64 * ti; const bool fe = (hi >= 63) || (hi < 0);
            float md = m, ld_ = l;
            if (!__all(hi < 0)) tile_compute<2>(Kb, Vb, qf, r, h, 0, hi, !__all(fe), md, ld_, O, meff, linv, IMPG + tokl * 128, IMPL + tokl * 128, 16 * ti); })
        ATT_FOLD(0);
    }
    for (int tk = 0; tk < 8; ++tk) { const int trow = 8 * wave + tk;
        const float ilo = IMPG[trow * 128 + lane] + (lane > 0 ? IMPL[trow * 128 + lane - 1] : 0.f), ihi = IMPG[trow * 128 + 64 + lane] + IMPL[trow * 128 + 63 + lane];
        const int slo = lane, shi = 64 + lane;
        const bool clo = slo <= qt, chi = shi <= qt, flo = (slo == 0) || (slo == qt) || (slo + 1 == qt), fhi = (shi == qt) || (shi + 1 == qt);
        const unsigned klo = clo ? ((flo ? 0xFFFFFF80u : (__float_as_uint(ilo) & 0xFFFFFF80u)) | (unsigned)(127 - slo)) : 0u;
        const unsigned khi = chi ? ((fhi ? 0xFFFFFF80u : (__float_as_uint(ihi) & 0xFFFFFF80u)) | (unsigned)(127 - shi)) : 0u;
        unsigned T = 0u;
        for (int bit = 31; bit >= 0; --bit) { const unsigned cand = T | (1u << bit);
            const int cnt = __popcll(__ballot(klo >= cand)) + __popcll(__ballot(khi >= cand)); if (cnt >= 16) T = cand; }
        const unsigned long long blo = __ballot(klo >= T && klo != 0u), bhi = __ballot(khi >= T && khi != 0u);
        if (lane == 0) { *(LAS u32x4*)(SELM + trow * 4) = (u32x4){(unsigned)blo, (unsigned)(blo >> 32), (unsigned)bhi, (unsigned)(bhi >> 32)}; }
    }
    { int lp_ = lane; asm volatile("" : "+v"(lp_)); float* oapark = (float*)(ws + WS_HIDM) + ((size_t)(blockIdx.x * 8 + wave) * 32) * 64 + lp_;
#pragma unroll
      for (int i = 0; i < 16; ++i) { oapark[i * 64] = OA[0][i]; oapark[(16 + i) * 64] = OA[1][i]; } }
    ATT_RESET();
    const bf16_t* KS = U + (size_t)(b * SEQ) * NU + UKS + gg * 64; const bf16_t* VST = (const bf16_t*)(ws + WS_VST) + (size_t)bg * 128 * 4096;
    constexpr int QT_COMPACT = 96;
    if (qt < QT_COMPACT) {
        const u32x4 selw = *(const LAS u32x4*)(SELM + tokl * 4);
        ATT_LOOP(qt + 1, KS + (size_t)pi * 64 * NU, NU, VST + (size_t)pi * 4096, 64, true, {
            const int j = ti;
            const unsigned wsel = (j < 32) ? selw.x : (j < 64) ? selw.y : (j < 96) ? selw.z : selw.w; const bool sel = (wsel >> (j & 31)) & 1u;
            const int hi = !sel ? -1 : (j == qt ? tokl : 63);
            if (!__all(!sel)) tile_compute<0>(Kb, Vb, qf, r, h, 0, hi, j == qt, m, l, O, 0.f, 0.f, nullptr, nullptr, 0); })
    } else {
        {
#define JMAP(i) ((i) == 0 ? 0 : qt - (2 - (i)))
            ATT_LOOP(3, KS + (size_t)JMAP(pi) * 64 * NU, NU, VST + (size_t)JMAP(pi) * 4096, 64, true, {
                const int j = JMAP(ti);
                tile_compute<0>(Kb, Vb, qf, r, h, 0, (j == qt ? tokl : 63), j == qt, m, l, O, 0.f, 0.f, nullptr, nullptr, 0); })
#undef JMAP
        }
        int lz = lane; asm volatile("" : "+v"(lz));
        const int r = lz & 31, h = lz >> 5, hp = r & 3, tokl = 8 * wave + (r >> 2), lane = lz, tid = wave * 64 + lz;
        LAS unsigned char* Qs = lds + OFF_QS; LAS float* MREF = (LAS float*)(lds + OFF_MREF); LAS float* LSUM = (LAS float*)(lds + OFF_LSUM); LAS int* LIST = (LAS int*)(lds + OFF_LIST) + wave * 64;
        LAS unsigned long long* TM = (LAS unsigned long long*)(lds + OFF_TM);
        if (h == 0) MREF[32 * wave + r] = fmaxf(m, MFLOOR);
        for (int j = wave; j < 128; j += 8) { const unsigned long long mk = __ballot((SELM[lane * 4 + (j >> 5)] >> (j & 31)) & 1u); if (lane == 0) TM[j] = mk; }
        __syncthreads();
#pragma unroll
        for (int q4 = 0; q4 < 4; ++q4) { const int ch = tid + 512 * q4, row = ch >> 3, c8 = ch & 7;
            *(LAS u32x4*)(Qs + row * ROWB + c8 * 16) = *(const u32x4*)(U + (size_t)(b * SEQ + t0 + (row >> 2)) * NU + UQ + (4 * gg + (row & 3)) * 64 + c8 * 8); }
        __syncthreads();
        const int jend = qt - 2; int jn = 1, rk = 0;
        const unsigned long long ltl = (1ull << tokl) - 1ull;
        int pjs = 0, pcnt = 0;
#define FAR_TM(dst, jj) { const unsigned long long tv_ = TM[(jj) <= jend ? (jj) : 0]; const unsigned lo_ = __builtin_amdgcn_readfirstlane((unsigned)tv_), hi_ = __builtin_amdgcn_readfirstlane((unsigned)(tv_ >> 32)); \
            dst = ((jj) <= jend) ? (((unsigned long long)hi_ << 32) | lo_) : 0ull; }
        for (;;) {
            int cnt = 0, used = 0, myj = -1, myc = 0; unsigned long long mymask = 0ull;
#pragma unroll
            for (int i = 0; i < 8; ++i) { const int jj = jn + i; unsigned long long mk; FAR_TM(mk, jj) const int nch = (__popcll(mk) + 7) >> 3;
                const bool take = (cnt == i) && (jj <= jend) && (used + nch <= 8);
                if (take) { if (wave >= used && wave < used + nch) { myj = jj; myc = wave - used; mymask = mk; } used += nch; ++cnt; } }
            if (cnt == 0 && pcnt == 0) break;
            const int cjs = jn; jn += cnt;
            bf16x8 kf[2][4], vf[2][4];
            if (myj >= 0) { const bf16_t* Kg = KS + (size_t)(myj * 64 + r) * NU + 8 * h; const bf16_t* Vg = VST + (size_t)myj * 4096 + r * 64 + 8 * h;
#pragma unroll
                for (int kh = 0; kh < 2; ++kh)
#pragma unroll
                    for (int ks = 0; ks < 4; ++ks) { kf[kh][ks] = *(const bf16x8*)(Kg + (size_t)(32 * kh) * NU + 16 * ks); vf[kh][ks] = *(const bf16x8*)(Vg + kh * 32 * 64 + ks * 16); } }
            if (pcnt > 0) { int base = 0;
#pragma unroll
                for (int i = 0; i < 8; ++i) { unsigned long long mk; FAR_TM(mk, pjs + i) if (i >= pcnt) mk = 0ull; const int nch = (__popcll(mk) + 7) >> 3;
                    const bool act = (mk >> tokl) & 1ull;
                    if (__any(act)) { const int rank = __popcll(mk & ltl), slot = base + (rank >> 3), prow = (rank & 7) * 4 + hp;
                        const LAS unsigned char* Pb = lds + OFF_PBUF + (((rk + 1) & 1) * 8 + slot) * PSLOT + prow * ROWB + h * 8;
#pragma unroll
                        for (int dt = 0; dt < 2; ++dt)
#pragma unroll
                            for (int gq = 0; gq < 4; ++gq) { u32x2 w = *(const LAS u32x2*)(Pb + (32 * dt + 8 * gq) * 2); if (!act) w = (u32x2){0u, 0u};
                                O[dt][4 * gq] += bflo(w.x); O[dt][4 * gq + 1] += bfhi(w.x); O[dt][4 * gq + 2] += bflo(w.y); O[dt][4 * gq + 3] += bfhi(w.y); }
                        l += act ? LSUM[(((rk + 1) & 1) * 8 + slot) * 32 + prow] : 0.f; }
                    base += nch; } }
            if (myj >= 0) {
                LAS unsigned char* Pw = lds + OFF_PBUF + ((rk & 1) * 8 + wave) * PSLOT;
                if ((mymask >> lane) & 1ull) LIST[__popcll(mymask & ((1ull << lane) - 1ull))] = lane;
                const int rank = 8 * myc + (r >> 2); const bool valid = rank < __popcll(mymask);
                const int tok = valid ? LIST[rank] : 0; const int qrow = tok * 4 + hp;
                bf16x8 qg[4];
#pragma unroll
                for (int ks = 0; ks < 4; ++ks) qg[ks] = *(const LAS bf16x8*)(Qs + qrow * ROWB + ks * 32 + h * 16);
                const float mr = MREF[qrow];
                float rs = 0.f; f32x16 Oc[2];
#pragma unroll
                for (int i = 0; i < 16; ++i) { Oc[0][i] = 0.f; Oc[1][i] = 0.f; }
#pragma unroll
                for (int kh = 0; kh < 2; ++kh) { f32x16 sv;
#pragma unroll
                    for (int i = 0; i < 16; ++i) sv[i] = 0.f;
#pragma unroll
                    for (int ks = 0; ks < 4; ++ks) sv = MFMA32(kf[kh][ks], qg[ks], sv);
#pragma unroll
                    for (int i = 0; i < 16; ++i) { sv[i] = valid ? fexp2(fminf(sv[i] - mr, 100.0f)) : 0.f; rs += sv[i]; }
#pragma unroll
                    for (int s2 = 0; s2 < 2; ++s2) { const bf16x8 pf = pack8(sv, s2);
                        Oc[0] = MFMA32(vf[0][kh * 2 + s2], pf, Oc[0]); Oc[1] = MFMA32(vf[1][kh * 2 + s2], pf, Oc[1]); } }
                rs += __shfl_xor(rs, 32);
                if (h == 0) LSUM[((rk & 1) * 8 + wave) * 32 + r] = rs;
#pragma unroll
                for (int dt = 0; dt < 2; ++dt)
#pragma unroll
                    for (int gq = 0; gq < 4; ++gq) { u32x2 w; w.x = pk2(Oc[dt][4 * gq], Oc[dt][4 * gq + 1]); w.y = pk2(Oc[dt][4 * gq + 2], Oc[dt][4 * gq + 3]);
                        *(LAS u32x2*)(Pw + r * ROWB + (32 * dt + 8 * gq + 4 * h) * 2) = w; }
            }
            __syncthreads();
            pjs = cjs; pcnt = cnt; ++rk;
        }
#undef FAR_TM
    }
    { int lp_ = lane; asm volatile("" : "+v"(lp_)); const float* oapark = (const float*)(ws + WS_HIDM) + ((size_t)(blockIdx.x * 8 + wave) * 32) * 64 + lp_;
#pragma unroll
      for (int i = 0; i < 16; ++i) { OA[0][i] = oapark[i * 64]; OA[1][i] = oapark[(16 + i) * 64]; } }
    ATT_FOLD(1);
    ATT_LOADQ();
    ATT_RESET();
    {
        int lw_ = lane; asm volatile("" : "+v"(lw_)); const int r = lw_ & 31, h = lw_ >> 5, tokl = 8 * wave + (r >> 2);
        const int jlo = qt >= 8 ? qt - 8 : 0;
        const bf16_t* KW = U + (size_t)(b * SEQ + jlo * 64) * NU + UKW + gg * 64; const bf16_t* VWT = (const bf16_t*)(ws + WS_VWT) + ((size_t)bg * 128 + jlo) * 4096;
        ATT_LOOP(qt - jlo + 1, KW + (size_t)pi * 64 * NU, NU, VWT + (size_t)pi * 4096, 64, true, {
            const int j = jlo + ti;
            const bool low = (j + 8 == qt), diag = (j == qt);
            const int lo = low ? tokl + 1 : 0, hi = diag ? tokl : 63;
            tile_compute<0>(Kb, Vb, qf, r, h, lo, hi, low || diag, m, l, O, 0.f, 0.f, nullptr, nullptr, 0); })
        ATT_FOLD(2);
    }
    int lo_ = lane; asm volatile("" : "+v"(lo_)); const int h_o = lo_ >> 5;
    bf16_t* orow = (bf16_t*)(ws + WS_CAT) + (size_t)(b * SEQ + t0 + 8 * wave + ((lo_ & 31) >> 2)) * DM + (4 * gg + (lo_ & 3)) * 64;
#pragma unroll
    for (int dt = 0; dt < 2; ++dt)
#pragma unroll
        for (int gq = 0; gq < 4; ++gq) { u32x2 w; w.x = pk2(OA[dt][4 * gq], OA[dt][4 * gq + 1]); w.y = pk2(OA[dt][4 * gq + 2], OA[dt][4 * gq + 3]);
            *(u32x2*)(orow + 32 * dt + 8 * gq + 4 * h_o) = w; }
#undef ATT_RESET
#undef ATT_FOLD
#undef ATT_LOADQ
#undef ATT_UROW
#undef ATT_LOOP
#undef ATT_STEP
}

DI void attn_phase(const Params& P, LAS unsigned char* lds, int vcu, int G, int wave, int lane, int tid) {
    int it = 0;
    CvState cv; { const int per = CV_TOTAL / (G * 8), gw = vcu * 8 + wave; cv.next = gw * per; cv.end = (gw == G * 8 - 1) ? CV_TOTAL : cv.next + per; cv.nfly = 0; cv.xafter = false; }
    for (int ui = vcu; ui < 1024; ui += G) { const int k = ui >> 8, v = ui & 255, bg = v >> 5, s = v & 31;
        const int qt = (k == 0) ? s : (k == 1) ? 63 - s : (k == 2) ? 64 + s : 127 - s;
        attn_unit(P, lds, bg, qt, wave, lane, tid, it, cv); }
    for (;;) {
        if (cv.nfly > 0) { asm volatile("s_waitcnt vmcnt(0)" ::: "memory"); while (cv.nfly > 0) cv_finish(P, cv, lds, wave, lane); }
        if (cv.next >= cv.end) break;
        cv_issue(P, cv, lds, wave, lane); if (cv.next < cv.end) cv_issue(P, cv, lds, wave, lane); }
    __syncthreads();
}
}
#ifndef CHECK_ATTN
#define CHECK_ATTN 0
#endif
#if CHECK_ATTN
constexpr int CW_ERR = 8192;
namespace attnchk {
DI float wmax(float v) {
#pragma unroll
    for (int o = 1; o < 64; o <<= 1) v = fmaxf(v, __shfl_xor(v, o));
    return v; }
DI void item(const Params& P, LAS float* scr, int bg, int t, int lane, float& se, float& sr) {
    unsigned char* ws = P.ws; const bf16_t* U = (const bf16_t*)(ws + WS_U);
    const int b = bg >> 1, gg = bg & 1;
    LAS float* q = scr; LAS float* pc = scr + 256; LAS float* sc = scr + 768;
    const bf16_t* urow = U + (size_t)(b * SEQ + t) * NU;
    for (int i = lane; i < 256; i += 64) q[i] = bf2f(urow[UQ + gg * 256 + i]);
    const bf16_t* KC = (const bf16_t*)(ws + WS_KC) + (size_t)bg * 512 * 64; const bf16_t* VCT = (const bf16_t*)(ws + WS_VCT) + (size_t)bg * 64 * 512;
    const int nvalid = t >= 31 ? ((t - 31) >> 4) + 1 : 0, cur = t >> 6;
    float oc[4], os[4], ow[4], imp0 = 0.f, imp1 = 0.f;
    for (int p = 0; p < 4; ++p) {
        float sv[8], mx = -3e38f;
        for (int i = 0; i < 8; ++i) { const int n = lane + 64 * i; float a = 0.f;
            if (n < nvalid) { for (int d = 0; d < 64; ++d) a += q[p * 64 + d] * bf2f(KC[n * 64 + d]); mx = fmaxf(mx, a); }
            sv[i] = a; }
        mx = wmax(mx); float ls = 0.f;
        for (int i = 0; i < 8; ++i) { const int n = lane + 64 * i; const float e = (n < nvalid) ? exp2f(sv[i] - mx) : 0.f; sv[i] = e; ls += e; }
        ls = wave_sum(ls); const float inv = ls > 0.f ? 1.f / ls : 0.f;
        for (int i = 0; i < 8; ++i) pc[lane + 64 * i] = sv[i] * inv;
        float o = 0.f;
        for (int n = 0; n < nvalid; ++n) { const int pos = (n & ~15) | (int)swap23((unsigned)n & 15u); o += pc[n] * bf2f(VCT[lane * 512 + pos]); }
        oc[p] = o;
        for (int k = -1; k <= 3; ++k) { const int n0 = 4 * lane + k, n1 = 4 * (lane + 64) + k;
            if (n0 >= 0 && n0 < nvalid) imp0 += pc[n0]; if (n1 < nvalid) imp1 += pc[n1]; }
    }
    const float INF = __builtin_inff();
    const int s0 = lane, s1 = lane + 64;
    const float v0 = (s0 == 0 || s0 == cur || s0 == cur - 1) ? INF : (s0 <= cur ? imp0 : -INF);
    const float v1 = (s1 == cur || s1 == cur - 1) ? INF : (s1 <= cur ? imp1 : -INF);
    int r0 = 0, r1 = 0;
    for (int j = 0; j < 128; ++j) { const float vj = (j < 64) ? __shfl(v0, j) : __shfl(v1, j - 64);
        r0 += (vj > v0 || (vj == v0 && j < s0)) ? 1 : 0; r1 += (vj > v1 || (vj == v1 && j < s1)) ? 1 : 0; }
    const unsigned long long m0 = __ballot(r0 < 16 && v0 > -INF), m1 = __ballot(r1 < 16 && v1 > -INF);
    for (int br = 0; br < 2; ++br) {
        const bf16_t* Kp = U + (size_t)(b * SEQ) * NU + (br ? UKW : UKS) + gg * 64; const bf16_t* Vp = U + (size_t)(b * SEQ) * NU + (br ? UVW : UVS) + gg * 64;
        for (int p = 0; p < 4; ++p) {
            int nk = 0; float mx = -3e38f;
            if (br == 0) {
                for (int j = 0; j < 128; ++j) { const bool on = (j < 64) ? ((m0 >> j) & 1ull) : ((m1 >> (j - 64)) & 1ull); if (!on) continue;
                    const int key = 64 * j + lane; float a = -3e38f;
                    if (key <= t) { a = 0.f; for (int d = 0; d < 64; ++d) a += q[p * 64 + d] * bf2f(Kp[(size_t)key * NU + d]); mx = fmaxf(mx, a); }
                    sc[nk * 64 + lane] = a; ++nk; }
            } else {
                for (int i = 0; i < 8; ++i) { const int key = t - 511 + lane + 64 * i; float a = -3e38f;
                    if (key >= 0 && key <= t) { a = 0.f; for (int d = 0; d < 64; ++d) a += q[p * 64 + d] * bf2f(Kp[(size_t)key * NU + d]); mx = fmaxf(mx, a); }
                    sc[i * 64 + lane] = a; }
                nk = 8;
            }
            mx = wmax(mx); float ls = 0.f;
            for (int i = 0; i < nk; ++i) { const float a = sc[i * 64 + lane]; const float e = (a > -1e38f) ? exp2f(a - mx) : 0.f; sc[i * 64 + lane] = e; ls += e; }
            ls = wave_sum(ls); const float inv = ls > 0.f ? 1.f / ls : 0.f;
            float o = 0.f;
            if (br == 0) { int idx = 0;
                for (int j = 0; j < 128; ++j) { const bool on = (j < 64) ? ((m0 >> j) & 1ull) : ((m1 >> (j - 64)) & 1ull); if (!on) continue;
                    for (int kk = 0; kk < 64; ++kk) { const float pv = sc[idx * 64 + kk]; if (pv != 0.f) o += pv * bf2f(Vp[(size_t)(64 * j + kk) * NU + lane]); }
                    ++idx; }
                os[p] = o * inv;
            } else {
                for (int i = 0; i < 8; ++i) for (int kk = 0; kk < 64; ++kk) { const int key = t - 511 + kk + 64 * i; const float pv = sc[i * 64 + kk]; if (pv != 0.f) o += pv * bf2f(Vp[(size_t)key * NU + lane]); }
                ow[p] = o * inv;
            }
        }
    }
    const bf16_t* cat = (const bf16_t*)(ws + WS_CAT) + (size_t)(b * SEQ + t) * DM;
    for (int p = 0; p < 4; ++p) {
        const float g0 = fsigmoid(bf2f(urow[UGT + gg * 12 + p * 3 + 0])), g1 = fsigmoid(bf2f(urow[UGT + gg * 12 + p * 3 + 1])), g2 = fsigmoid(bf2f(urow[UGT + gg * 12 + p * 3 + 2]));
        const float ref = g0 * oc[p] + g1 * os[p] + g2 * ow[p], got = bf2f(cat[(4 * gg + p) * 64 + lane]);
        se += (ref - got) * (ref - got); sr += ref * ref; }
}
DI void phase(const Params& P, LAS unsigned char* lds, int vcu, int G, int wave, int lane) {
    LAS float* scr = (LAS float*)(lds + wave * 8192);
    float se = 0.f, sr = 0.f;
    for (int it = vcu * 8 + wave; it < 8 * SEQ; it += G * 8) { const int bg = it / SEQ, t = it % SEQ; item(P, scr, bg, t, lane, se, sr); }
    se = wave_sum(se); sr = wave_sum(sr);
    if (lane == 0) { atomicAdd((float*)(P.ws + WS_CTL) + CW_ERR, se); atomicAdd((float*)(P.ws + WS_CTL) + CW_ERR + 1, sr); }
}
}
#endif
DI void phase_ln1(const Params& P, int vcu, int G, int wave, int lane, bf16_t* x1base) {
    const float* mod = (const float*)(P.ws + WS_MOD);
    for (int mrow = vcu * 8 + wave; mrow < NT; mrow += G * 8) { const int b = mrow / SEQ;
        const u32x2* vr = (const u32x2*)((const bf16_t*)(P.ws + WS_V1) + (size_t)mrow * DM) + lane; f32x4 v[4]; float s = 0.f;
#pragma unroll
        for (int j = 0; j < 4; ++j) { const u32x2 q = vr[64 * j]; v[j] = (f32x4){bflo(q.x), bfhi(q.x), bflo(q.y), bfhi(q.y)}; s += (v[j].x + v[j].y) + (v[j].z + v[j].w); }
        const float mean = wave_sum(s) * (1.f / DM); float s2 = 0.f;
#pragma unroll
        for (int j = 0; j < 4; ++j) { v[j] = v[j] - mean; s2 += (v[j].x * v[j].x + v[j].y * v[j].y) + (v[j].z * v[j].z + v[j].w * v[j].w); }
        const float rstd = 1.f / sqrtf(wave_sum(s2) * (1.f / DM) + LN_EPS);
        unsigned long long* o8 = (unsigned long long*)((bf16_t*)(P.ws + WS_H2) + (size_t)mrow * DM) + lane;
        unsigned long long* x8 = (unsigned long long*)(x1base + (size_t)mrow * DM) + lane;
#pragma unroll
        for (int j = 0; j < 4; ++j) { const int c0 = 4 * lane + 256 * j;
            const f32x4 g = *(const f32x4*)(P.ln1_g + c0), bb = *(const f32x4*)(P.ln1_b + c0);
            const f32x4 sh = *(const f32x4*)(mod + b * 6144 + 3 * 1024 + c0), sc = *(const f32x4*)(mod + b * 6144 + 4 * 1024 + c0);
            const f32x4 x1 = v[j] * rstd * g + bb;
            x8[64 * j] = (unsigned long long)pk2(x1.x, x1.y) | ((unsigned long long)pk2(x1.z, x1.w) << 32);
            const f32x4 y = x1 * (sc + 1.0f) + sh;
            o8[64 * j] = (unsigned long long)pk2(y.x, y.y) | ((unsigned long long)pk2(y.z, y.w) << 32); }
    }
}

DI unsigned f2ord(float f) { const unsigned u = __float_as_uint(f); return (u & 0x80000000u) ? ~u : (u | 0x80000000u); }
DI void phase_route(const Params& P, LAS unsigned char* lds, int vcu, int G, int wave, int lane, int tid) {
    unsigned char* ws = P.ws;
    LAS int* hist = (LAS int*)lds;
    const float* logit = (const float*)(ws + WS_LOGIT);
    int* tok_e = (int*)(ws + WS_TOKE); float* tok_w = (float*)(ws + WS_TOKW); int* lrank = (int*)(ws + WS_LRANK);
    { int* rt = (int*)(ws + WS_ROWTOK); for (int i = vcu * 512 + tid; i < NPAD_MAX; i += G * 512) rt[i] = 0; }
    const int hh = lane >> 5;
    float bias[4];
#pragma unroll
    for (int k = 0; k < 4; ++k) bias[k] = P.router_bias[lane + 64 * k];
    const int tpw = NT / G;
    for (int base = vcu * tpw; base < NT; base += G * tpw) {
        __syncthreads();
        if (tid < 256) hist[tid] = 0;
        __syncthreads();
        for (int tq = wave; tq < tpw; tq += 8) { const int tkn = base + tq;
            float s[4], sel[4];
#pragma unroll
            for (int k = 0; k < 4; ++k) { s[k] = fsigmoid(logit[(size_t)tkn * 256 + lane + 64 * k]); sel[k] = s[k] + bias[k]; }
            float t1[4], t2[4];
#pragma unroll
            for (int k = 0; k < 4; ++k) { t1[k] = sel[k]; t2[k] = -3.0e38f; }
#pragma unroll
            for (int o = 1; o < 32; o <<= 1) {
#pragma unroll
                for (int k = 0; k < 4; ++k) { const float a1 = __shfl_xor(t1[k], o), a2 = __shfl_xor(t2[k], o);
                    const float n1 = fmaxf(t1[k], a1), n2 = fmaxf(fminf(t1[k], a1), fmaxf(t2[k], a2)); t1[k] = n1; t2[k] = n2; } }
            float gs[8];
#pragma unroll
            for (int k = 0; k < 4; ++k) { const float mine = t1[k] + t2[k], oth = __shfl_xor(mine, 32); gs[2 * k] = hh ? oth : mine; gs[2 * k + 1] = hh ? mine : oth; }
            bool gsel[8];
#pragma unroll
            for (int a = 0; a < 8; ++a) { int rk = 0;
#pragma unroll
                for (int c2 = 0; c2 < 8; ++c2) rk += (gs[c2] > gs[a] || (gs[c2] == gs[a] && c2 < a)) ? 1 : 0;
                gsel[a] = rk < 4; }
            unsigned key[4];
#pragma unroll
            for (int k = 0; k < 4; ++k) { const bool on = hh ? gsel[2 * k + 1] : gsel[2 * k]; key[k] = on ? f2ord(sel[k]) : 0u; }
            unsigned T = 0u;
            for (int bit = 31; bit >= 0; --bit) { const unsigned cand = T | (1u << bit); int cnt = 0;
#pragma unroll
                for (int k = 0; k < 4; ++k) cnt += __popcll(__ballot(key[k] >= cand));
                if (cnt >= 8) T = cand; }
            int ngt = 0;
#pragma unroll
            for (int k = 0; k < 4; ++k) ngt += __popcll(__ballot(key[k] > T));
            int need = 8 - ngt, npos = 0; const unsigned long long ltmask = (1ull << lane) - 1ull;
            bool chosen[4]; int pos[4];
#pragma unroll
            for (int k = 0; k < 4; ++k) { const unsigned long long eq = __ballot(key[k] == T), gt = __ballot(key[k] > T);
                const int myeq = __popcll(eq & ltmask); const bool ceq = (key[k] == T) && (myeq < need);
                chosen[k] = (key[k] > T) || ceq;
                const unsigned long long cm = __ballot(chosen[k]); pos[k] = npos + __popcll(cm & ltmask); npos += __popcll(cm);
                const int neq = __popcll(eq); need = need > neq ? need - neq : 0; (void)gt; }
            float ssum = 0.f;
#pragma unroll
            for (int k = 0; k < 4; ++k) ssum += chosen[k] ? s[k] : 0.f;
            ssum = wave_sum(ssum);
            const float wn = 2.5f / ssum;
#pragma unroll
            for (int k = 0; k < 4; ++k) if (chosen[k]) { const int e = lane + 64 * k; const int lr = __hip_atomic_fetch_add(hist + e, 1, __ATOMIC_RELAXED, __HIP_MEMORY_SCOPE_WORKGROUP);
                tok_e[tkn * 8 + pos[k]] = e; tok_w[tkn * 8 + pos[k]] = s[k] * wn; lrank[tkn * 8 + pos[k]] = lr; }
        }
        __syncthreads();
        if (tid < 256) ((int*)(ws + WS_HIST))[(base / tpw) * 256 + tid] = hist[tid];
    }
    __syncthreads();
}

DI void phase_scatter(const Params& P, LAS unsigned char* lds, int vcu, int G, int wave, int lane, int tid) {
    unsigned char* ws = P.ws;
    LAS int* sbase = (LAS int*)lds; LAS int* spad = sbase + 256; LAS int* sstart = spad + 256;
    const unsigned* hist = (const unsigned*)(ws + WS_HIST);
    const int* tok_e = (const int*)(ws + WS_TOKE); const int* lrank = (const int*)(ws + WS_LRANK);
    int* rowtok = (int*)(ws + WS_ROWTOK); int* pos_of = (int*)(ws + WS_POSOF); int* blk_e = (int*)(ws + WS_BLKE);
    const int tpw = NT / G, nslots = NT / tpw;
    for (int base = vcu * tpw; base < NT; base += G * tpw) { const int slot = base / tpw;
        __syncthreads();
        if (tid < 256) { int tot = 0, below = 0;
            for (int w2 = 0; w2 < nslots; ++w2) { const int hv = (int)hist[w2 * 256 + tid]; tot += hv; below += (w2 < slot) ? hv : 0; }
            spad[tid] = (tot + 255) & ~255; sbase[tid] = below; }
        __syncthreads();
        if (tid == 0) { int run = 0; for (int e = 0; e < 256; ++e) { sstart[e] = run; run += spad[e]; } sstart[256] = run; }
        __syncthreads();
        for (int i = tid; i < tpw * 8; i += 512) { const int a = base * 8 + i; const int e = tok_e[a]; const int pos = sstart[e] + sbase[e] + lrank[a];
            rowtok[pos] = a >> 3; pos_of[a] = pos; }
        if (slot == 0) {
            if (tid < 256) { const int b0 = sstart[tid] >> 8, b1 = (sstart[tid] + spad[tid]) >> 8; for (int bb = b0; bb < b1; ++bb) blk_e[bb] = tid; }
            if (tid == 0) blk_e[NBLK_MAX] = sstart[256] >> 8;
        }
    }
    __syncthreads();
}

DI void phase_final(const Params& P, int vcu, int G, int wave, int lane, float* dstbase) {
    unsigned char* ws = P.ws;
    const float* mod = (const float*)(ws + WS_MOD);
    const int* pos_of = (const int*)(ws + WS_POSOF); const float* tok_w = (const float*)(ws + WS_TOKW);
    const unsigned char* Y = (const unsigned char*)(ws + WS_YMOE);
    float dbg_scale = 1.0f;
#if CHECK_ATTN
    { const float se = __uint_as_float(ld_u32_agent((const unsigned*)(ws + WS_CTL) + CW_ERR)), sr = __uint_as_float(ld_u32_agent((const unsigned*)(ws + WS_CTL) + CW_ERR + 1)); const float err = sqrtf(se / fmaxf(sr, 1e-30f)); dbg_scale = 1.0f + (err < 0.005f ? 0.f : err < 0.02f ? 0.04f : err < 0.08f ? 0.055f : err < 0.3f ? 0.07f : 0.085f); }
#endif
    for (int mrow = vcu * 8 + wave; mrow < NT; mrow += G * 8) { const int b = mrow / SEQ;
        const u32x2* xr = (const u32x2*)((const bf16_t*)(ws + WS_X1) + (size_t)mrow * DM) + lane; const u32x2* sr = (const u32x2*)((const bf16_t*)(ws + WS_SH) + (size_t)mrow * DM) + lane; f32x4 v[4], ya[4];
#pragma unroll
        for (int j = 0; j < 4; ++j) { const u32x2 q = xr[64 * j], q2 = sr[64 * j]; v[j] = (f32x4){bflo(q.x), bfhi(q.x), bflo(q.y), bfhi(q.y)} * DN_ALPHA; ya[j] = (f32x4){bflo(q2.x), bfhi(q2.x), bflo(q2.y), bfhi(q2.y)}; }
        const int mypos = pos_of[(size_t)mrow * 8 + (lane & 7)]; const float myw = tok_w[(size_t)mrow * 8 + (lane & 7)];
#pragma unroll
        for (int k = 0; k < 8; ++k) { const int pos = __shfl(mypos, k); const float wk = __shfl(myw, k) * (1.0f / YMOE_SCALE);
            const unsigned* yr = (const unsigned*)(Y + (size_t)pos * DM) + lane;
#pragma unroll
            for (int j = 0; j < 4; ++j) { const int q = (int)yr[64 * j]; const f32x2 lo = __builtin_amdgcn_cvt_pk_f32_fp8(q, false), hi = __builtin_amdgcn_cvt_pk_f32_fp8(q, true);
                ya[j].x += wk * lo.x; ya[j].y += wk * lo.y; ya[j].z += wk * hi.x; ya[j].w += wk * hi.y; } }
        float s = 0.f;
#pragma unroll
        for (int j = 0; j < 4; ++j) { const f32x4 g2 = *(const f32x4*)(mod + b * 6144 + 5 * 1024 + 4 * lane + 256 * j); v[j] = v[j] + g2 * ya[j]; s += (v[j].x + v[j].y) + (v[j].z + v[j].w); }
        const float mean = wave_sum(s) * (1.f / DM); float s2 = 0.f;
#pragma unroll
        for (int j = 0; j < 4; ++j) { v[j] = v[j] - mean; s2 += (v[j].x * v[j].x + v[j].y * v[j].y) + (v[j].z * v[j].z + v[j].w * v[j].w); }
        const float rstd = 1.f / sqrtf(wave_sum(s2) * (1.f / DM) + LN_EPS);
#pragma unroll
        for (int j = 0; j < 4; ++j) { const int c0 = 4 * lane + 256 * j; const f32x4 g = *(const f32x4*)(P.ln2_g + c0), bb = *(const f32x4*)(P.ln2_b + c0);
            ((f32x4*)(dstbase + (size_t)mrow * DM) + lane)[64 * j] = (v[j] * rstd * g + bb) * dbg_scale; }
    }
}
#ifndef REP_PHASE
#define REP_PHASE -1
#endif
#ifndef MK_PER_PHASE
#define MK_PER_PHASE 0
#endif
DI void run_phase_0(const Params& P, LAS unsigned char* lds, int vcu, int G, int bx, int wave, int lane, int tid) {
    unsigned char* ws = P.ws; const float* mod = (const float*)(ws + WS_MOD); (void)mod; (void)ws;
 phase0a(P, lds, vcu, G, wave, lane, tid); }
DI void run_phase_1(const Params& P, LAS unsigned char* lds, int vcu, int G, int bx, int wave, int lane, int tid) {
    unsigned char* ws = P.ws; const float* mod = (const float*)(ws + WS_MOD); (void)mod; (void)ws;
 phase0b(P, lds, vcu, G, wave, lane, tid); }
DI void run_phase_2(const Params& P, LAS unsigned char* lds, int vcu, int G, int bx, int wave, int lane, int tid) {
    unsigned char* ws = P.ws; const float* mod = (const float*)(ws + WS_MOD); (void)mod; (void)ws;
        pg8::Gemm g{(const bf16_t*)(ws + WS_H1), (const bf16_t*)(ws + WS_WIN_T), DM, DM, DM, 128};
        pg8::DenseOrder S; S.init(g.A, DM, NT, NU, G, bx);
        pg8::EpiStoreBf16 E{(bf16_t*)(ws + WS_U), NU, 0.125f * 1.4426950408889634f, 2};
        pg8::gemm_phase<pg8::EpiStoreBf16, pg8::DenseOrder, true, false>(lds, g, S, E, nullptr);
    }
DI void run_phase_3(const Params& P, LAS unsigned char* lds, int vcu, int G, int bx, int wave, int lane, int tid) {
    unsigned char* ws = P.ws; const float* mod = (const float*)(ws + WS_MOD); (void)mod; (void)ws;
        if (bx < 32 && G > 32) {
            pg8::Gemm g{(const bf16_t*)(ws + WS_U), (const bf16_t*)(ws + WS_WC1_T), 16 * NU, 2048, 2048, NU * 2};
            pg8::CmpOrder S{G, bx, (const bf16_t*)(ws + WS_U)};
            pg8::EpiCmp E{(bf16_t*)(ws + WS_HCMP), (const float*)(ws + WS_PEB)};
            pg8::gemm_phase<pg8::EpiCmp, pg8::CmpOrder, true, false>(lds, g, S, E, nullptr);
        } else {
            const int nw = (G > 32) ? G - 32 : G, w0 = (G > 32) ? bx - 32 : bx;
            if (G <= 32) { pg8::Gemm g{(const bf16_t*)(ws + WS_U), (const bf16_t*)(ws + WS_WC1_T), 16 * NU, 2048, 2048, NU * 2};
                pg8::CmpOrder S{G, bx, (const bf16_t*)(ws + WS_U)}; pg8::EpiCmp E{(bf16_t*)(ws + WS_HCMP), (const float*)(ws + WS_PEB)};
                pg8::gemm_phase<pg8::EpiCmp, pg8::CmpOrder, true, false>(lds, g, S, E, nullptr); }
            for (int item = w0; item < 1024; item += nw) conv_item(P, lds, item, wave, lane, tid);
            if (REP_PHASE == 31) { for (int item = w0; item < 1024; item += nw) conv_item(P, lds, item, wave, lane, tid); }
            __syncthreads();
            vt_copies(P, lds, w0 * 8 + wave, nw * 8, wave, lane);
            __syncthreads();
        }
    }
DI void run_phase_4(const Params& P, LAS unsigned char* lds, int vcu, int G, int bx, int wave, int lane, int tid) {
    unsigned char* ws = P.ws; const float* mod = (const float*)(ws + WS_MOD); (void)mod; (void)ws;
 phase_cmp2(P, lds, vcu, G, wave, lane, tid); }
DI void run_phase_5(const Params& P, LAS unsigned char* lds, int vcu, int G, int bx, int wave, int lane, int tid) {
    unsigned char* ws = P.ws; const float* mod = (const float*)(ws + WS_MOD); (void)mod; (void)ws;
 attn::attn_phase(P, lds, vcu, G, wave, lane, tid); }
DI void run_phase_6(const Params& P, LAS unsigned char* lds, int vcu, int G, int bx, int wave, int lane, int tid) {
    unsigned char* ws = P.ws; const float* mod = (const float*)(ws + WS_MOD); (void)mod; (void)ws;
#if CHECK_ATTN
        attnchk::phase(P, lds, vcu, G, wave, lane); __syncthreads();
#endif
        pg8::Gemm g{(const bf16_t*)(ws + WS_CAT), (const bf16_t*)(ws + WS_WOUT_T), DM, DM, DM, 128};
        pg8::DenseOrder S; S.init(g.A, DM, NT, DM, G, bx);
        pg8::EpiResModBf16 E{P.x, (bf16_t*)(ws + WS_V1), mod + 2 * 1024, 6144};
        pg8::gemm_phase<pg8::EpiResModBf16, pg8::DenseOrder, true, false>(lds, g, S, E, nullptr);
    }
DI void run_phase_7(const Params& P, LAS unsigned char* lds, int vcu, int G, int bx, int wave, int lane, int tid) {
    unsigned char* ws = P.ws; const float* mod = (const float*)(ws + WS_MOD); (void)mod; (void)ws;
 if (REP_PHASE == 70) { phase_ln1(P, vcu, G, wave, lane, (bf16_t*)(ws + WS_HIDM)); phase_ln1(P, vcu, G, wave, lane, (bf16_t*)(ws + WS_HIDM)); }
    phase_ln1(P, vcu, G, wave, lane, (bf16_t*)(ws + WS_X1)); }
DI void run_phase_8(const Params& P, LAS unsigned char* lds, int vcu, int G, int bx, int wave, int lane, int tid) {
    unsigned char* ws = P.ws; const float* mod = (const float*)(ws + WS_MOD); (void)mod; (void)ws;
        { pg8::Gemm g{(const bf16_t*)(ws + WS_H2), (const bf16_t*)(ws + WS_WR_T), DM, DM, DM, 128};
          pg8::DenseOrder S; S.init(g.A, DM, NT, 256, G, bx);
          pg8::EpiF32 E{(float*)(ws + WS_LOGIT), 256};
          pg8::gemm_phase<pg8::EpiF32, pg8::DenseOrder, true, false>(lds, g, S, E, nullptr); }
        { pg8::Gemm g{(const bf16_t*)(ws + WS_H2), (const bf16_t*)(ws + WS_WSGU_T), DM, DM, DM, 128};
          pg8::DenseOrder S; S.init(g.A, DM, NT, 512, G, bx);
          pg8::EpiGlu E{(bf16_t*)(ws + WS_HIDS), 256};
          pg8::gemm_phase<pg8::EpiGlu, pg8::DenseOrder, true, false>(lds, g, S, E, nullptr); }
    }
DI void run_phase_9(const Params& P, LAS unsigned char* lds, int vcu, int G, int bx, int wave, int lane, int tid) {
    unsigned char* ws = P.ws; const float* mod = (const float*)(ws + WS_MOD); (void)mod; (void)ws;
        phase_route(P, lds, vcu, G, wave, lane, tid);
        if (REP_PHASE == 90) { phase_route(P, lds, vcu, G, wave, lane, tid); phase_route(P, lds, vcu, G, wave, lane, tid); }
        pg8::Gemm g{(const bf16_t*)(ws + WS_HIDS), (const bf16_t*)(ws + WS_WSD_T), 256, 256, 256, 128};
        pg8::DenseOrder S; S.init(g.A, 256, NT, DM, G, bx);
        pg8::EpiStoreBf16 E{(bf16_t*)(ws + WS_SH), DM, 1.0f, 0};
        pg8::gemm_phase<pg8::EpiStoreBf16, pg8::DenseOrder, true, false>(lds, g, S, E, nullptr);
    }
DI void run_phase_10(const Params& P, LAS unsigned char* lds, int vcu, int G, int bx, int wave, int lane, int tid) {
    unsigned char* ws = P.ws; const float* mod = (const float*)(ws + WS_MOD); (void)mod; (void)ws;
 phase_scatter(P, lds, vcu, G, wave, lane, tid); }
DI void run_phase_11(const Params& P, LAS unsigned char* lds, int vcu, int G, int bx, int wave, int lane, int tid) {
    unsigned char* ws = P.ws; const float* mod = (const float*)(ws + WS_MOD); (void)mod; (void)ws;
        const int nblk = (int)__builtin_amdgcn_readfirstlane((int)ld_u32_agent((const unsigned*)(ws + WS_BLKE) + NBLK_MAX));
        const int nunits = 2 * nblk; LAS int* tab = (LAS int*)(lds + LDS_TAB);
        { const int* rowtok = (const int*)(ws + WS_ROWTOK); int i = 0;
          for (int L = vcu; L < nunits && i < 28; L += G, ++i) { if (tid < 256) tab[i * 256 + tid] = rowtok[(L >> 1) * 256 + tid]; } }
        __syncthreads();
        pg8::Gemm g{(const bf16_t*)(ws + WS_H2), (const bf16_t*)(ws + WS_WGU_T), DM, DM, DM, 128};
        pg8::MoeOrder<2> S{G, vcu, nunits, (const int*)(ws + WS_BLKE), g.A, (size_t)0};
        pg8::EpiGlu E{(bf16_t*)(ws + WS_HIDM), 256};
        pg8::gemm_phase<pg8::EpiGlu, pg8::MoeOrder<2>, true, true>(lds, g, S, E, tab);
    }
DI void run_phase_12(const Params& P, LAS unsigned char* lds, int vcu, int G, int bx, int wave, int lane, int tid) {
    unsigned char* ws = P.ws; const float* mod = (const float*)(ws + WS_MOD); (void)mod; (void)ws;
        const int nblk = (int)__builtin_amdgcn_readfirstlane((int)ld_u32_agent((const unsigned*)(ws + WS_BLKE) + NBLK_MAX));
        pg8::Gemm g{(const bf16_t*)(ws + WS_HIDM), (const bf16_t*)(ws + WS_WDN_T), 256, 256, 256, 128};
        pg8::MoeOrder<4> S{G, vcu, 4 * nblk, (const int*)(ws + WS_BLKE), g.A, (size_t)256 * 256 * 2};
        pg8::EpiStoreFp8 E{(unsigned char*)(ws + WS_YMOE), DM, YMOE_SCALE};
        pg8::gemm_phase<pg8::EpiStoreFp8, pg8::MoeOrder<4>, true, false>(lds, g, S, E, nullptr);
    }
DI void run_phase_13(const Params& P, LAS unsigned char* lds, int vcu, int G, int bx, int wave, int lane, int tid) {
    unsigned char* ws = P.ws; const float* mod = (const float*)(ws + WS_MOD); (void)mod; (void)ws;
 if (REP_PHASE == 130) { phase_final(P, vcu, G, wave, lane, (float*)(ws + WS_HIDM)); phase_final(P, vcu, G, wave, lane, (float*)(ws + WS_HIDM)); }
    phase_final(P, vcu, G, wave, lane, P.out); }
constexpr int NPHASE = 14;
__global__ void __launch_bounds__(512, 2) nsa_conformer_moe_fwd(Params P) {
    extern __shared__ __attribute__((aligned(16))) unsigned char lds_raw[];
    LAS unsigned char* lds = (LAS unsigned char*)lds_raw;
    const int tid = threadIdx.x, lane = tid & 63, wave = __builtin_amdgcn_readfirstlane(tid >> 6);
    const int G = gridDim.x, bx = blockIdx.x, vcu = (G % 8 == 0) ? (bx % 8) * (G / 8) + bx / 8 : bx;
    unsigned char* ws = P.ws;
    volatile LAS unsigned* MISC = (volatile LAS unsigned*)(lds + LDS_MISC);
    if (tid < 64) MISC[tid] = 0u;
    __syncthreads();
    const int lo = P.ph_lo, hi = P.ph_hi;
    XcdBarrier bar; bar.bar = (unsigned*)(ws + WS_CTL) + CW_BAR; bar.x = 0; bar.st = MISC + 8;
    if (hi - lo > 1) bar = xcd_barrier_post((unsigned*)(ws + WS_CTL) + CW_BAR, MISC + 8);
#ifdef PH_ONLY
#define IN(k) ((k) == PH_ONLY && lo <= (k) && (k) < hi)
#else
#define IN(k) (lo <= (k) && (k) < hi)
#endif
#define SEAM(k) do { if (IN(k) && IN((k) + 1)) xcd_barrier(bar); } while (0)
    if (IN(0)) run_phase_0(P, lds, vcu, G, bx, wave, lane, tid);
    if (REP_PHASE == 0 && IN(0)) { run_phase_0(P, lds, vcu, G, bx, wave, lane, tid); run_phase_0(P, lds, vcu, G, bx, wave, lane, tid); }
    SEAM(0);
    if (IN(1)) run_phase_1(P, lds, vcu, G, bx, wave, lane, tid);
    if (REP_PHASE == 1 && IN(1)) { run_phase_1(P, lds, vcu, G, bx, wave, lane, tid); run_phase_1(P, lds, vcu, G, bx, wave, lane, tid); }
    SEAM(1);
    if (IN(2)) run_phase_2(P, lds, vcu, G, bx, wave, lane, tid);
    if (REP_PHASE == 2 && IN(2)) { run_phase_2(P, lds, vcu, G, bx, wave, lane, tid); run_phase_2(P, lds, vcu, G, bx, wave, lane, tid); }
    SEAM(2);
    if (IN(3)) run_phase_3(P, lds, vcu, G, bx, wave, lane, tid);
    if (REP_PHASE == 3 && IN(3)) { run_phase_3(P, lds, vcu, G, bx, wave, lane, tid); run_phase_3(P, lds, vcu, G, bx, wave, lane, tid); }
    SEAM(3);
    if (IN(4)) run_phase_4(P, lds, vcu, G, bx, wave, lane, tid);
    if (REP_PHASE == 4 && IN(4)) { run_phase_4(P, lds, vcu, G, bx, wave, lane, tid); run_phase_4(P, lds, vcu, G, bx, wave, lane, tid); }
    SEAM(4);
    if (IN(5)) run_phase_5(P, lds, vcu, G, bx, wave, lane, tid);
    if (REP_PHASE == 5 && IN(5)) { run_phase_5(P, lds, vcu, G, bx, wave, lane, tid); run_phase_5(P, lds, vcu, G, bx, wave, lane, tid); }
    SEAM(5);
    if (IN(6)) run_phase_6(P, lds, vcu, G, bx, wave, lane, tid);
    if (REP_PHASE == 6 && IN(6)) { run_phase_6(P, lds, vcu, G, bx, wave, lane, tid); run_phase_6(P, lds, vcu, G, bx, wave, lane, tid); }
    SEAM(6);
    if (IN(7)) run_phase_7(P, lds, vcu, G, bx, wave, lane, tid);
    if (REP_PHASE == 7 && IN(7)) { run_phase_7(P, lds, vcu, G, bx, wave, lane, tid); run_phase_7(P, lds, vcu, G, bx, wave, lane, tid); }
    SEAM(7);
    if (IN(8)) run_phase_8(P, lds, vcu, G, bx, wave, lane, tid);
    if (REP_PHASE == 8 && IN(8)) { run_phase_8(P, lds, vcu, G, bx, wave, lane, tid); run_phase_8(P, lds, vcu, G, bx, wave, lane, tid); }
    SEAM(8);
    if (IN(9)) run_phase_9(P, lds, vcu, G, bx, wave, lane, tid);
    if (REP_PHASE == 9 && IN(9)) { run_phase_9(P, lds, vcu, G, bx, wave, lane, tid); run_phase_9(P, lds, vcu, G, bx, wave, lane, tid); }
    SEAM(9);
    if (IN(10)) run_phase_10(P, lds, vcu, G, bx, wave, lane, tid);
    if (REP_PHASE == 10 && IN(10)) { run_phase_10(P, lds, vcu, G, bx, wave, lane, tid); run_phase_10(P, lds, vcu, G, bx, wave, lane, tid); }
    SEAM(10);
    if (IN(11)) run_phase_11(P, lds, vcu, G, bx, wave, lane, tid);
    if (REP_PHASE == 11 && IN(11)) { run_phase_11(P, lds, vcu, G, bx, wave, lane, tid); run_phase_11(P, lds, vcu, G, bx, wave, lane, tid); }
    SEAM(11);
    if (IN(12)) run_phase_12(P, lds, vcu, G, bx, wave, lane, tid);
    if (REP_PHASE == 12 && IN(12)) { run_phase_12(P, lds, vcu, G, bx, wave, lane, tid); run_phase_12(P, lds, vcu, G, bx, wave, lane, tid); }
    SEAM(12);
    if (IN(13)) run_phase_13(P, lds, vcu, G, bx, wave, lane, tid);
    if (REP_PHASE == 13 && IN(13)) { run_phase_13(P, lds, vcu, G, bx, wave, lane, tid); run_phase_13(P, lds, vcu, G, bx, wave, lane, tid); }
#undef IN
#undef SEAM
}

extern "C" void kernel_launch(void* const* d_in, const int* in_sizes, int n_in, void* d_out, int out_size, void* d_ws, size_t ws_size, hipStream_t stream) {
    static int grid = 0;
    if (grid == 0) {
        if (n_in != 28 || out_size != NT * DM || ws_size < WS_END) { fprintf(stderr, "kernel_launch: unexpected arguments (n_in %d, out %d, ws %zu); nothing launched\n", n_in, out_size, ws_size); grid = -1; return; }
        int dev = 0, cus = 0, per_cu = 0;
        if (hipGetDevice(&dev) != hipSuccess || hipDeviceGetAttribute(&cus, hipDeviceAttributeMultiprocessorCount, dev) != hipSuccess) { grid = -1; return; }
        if (hipFuncSetAttribute((const void*)nsa_conformer_moe_fwd, hipFuncAttributeMaxDynamicSharedMemorySize, LDS_BYTES) != hipSuccess) { fprintf(stderr, "kernel_launch: hipFuncSetAttribute failed\n"); grid = -1; return; }
        if (hipOccupancyMaxActiveBlocksPerMultiprocessor(&per_cu, (const void*)nsa_conformer_moe_fwd, 512, LDS_BYTES) != hipSuccess || per_cu < 1) { fprintf(stderr, "kernel_launch: occupancy query says %d blocks per CU\n", per_cu); }
        (void)hipGetLastError();
        grid = cus;
    }
    if (grid < 0) return;
    (void)hipMemsetAsync((char*)d_ws + WS_CTL, 0, CTL_ZERO_BYTES, stream);
    Params p{};
    const float** pp = (const float**)&p;
    for (int i = 0; i < 28; ++i) pp[i] = (const float*)d_in[i];
    p.out = (float*)d_out; p.ws = (unsigned char*)d_ws;
#if MK_PER_PHASE
    for (int ph = 0; ph < NPHASE; ++ph) { p.ph_lo = ph; p.ph_hi = ph + 1; hipLaunchKernelGGL(nsa_conformer_moe_fwd, dim3(grid), dim3(512), LDS_BYTES, stream, p); }
#else
    p.ph_lo = 0; p.ph_hi = NPHASE;
    hipLaunchKernelGGL(nsa_conformer_moe_fwd, dim3(grid), dim3(512), LDS_BYTES, stream, p);
#endif
}
```

```cpp
#include <hip/hip_runtime.h>
#include <cstdio>
#include <cstdint>

#define DI __device__ __forceinline__
#define LAS __attribute__((address_space(3)))
#define GAS __attribute__((address_space(1)))
typedef unsigned short bf16_t;
typedef short bf16x8 __attribute__((ext_vector_type(8)));
typedef float f32x4 __attribute__((ext_vector_type(4)));
typedef float f32x16 __attribute__((ext_vector_type(16)));
typedef float f32x2 __attribute__((ext_vector_type(2)));
typedef unsigned u32x4 __attribute__((ext_vector_type(4)));
typedef unsigned u32x2 __attribute__((ext_vector_type(2)));
typedef __bf16 bf16x2_t __attribute__((ext_vector_type(2)));

constexpr int NB = 4, SEQ = 8192, DM = 1024, NT = NB * SEQ;
constexpr int NU = 2560;
constexpr int UQ = 0, UKC = 512, UVC = 640, UKS = 768, UVS = 896, UKW = 1024, UVW = 1152, UCA = 1280, UCG = 1792, UGT = 2304;
constexpr int DIN = 2328;
constexpr int NEXP = 256, DEXP = 256, TOPK = 8;
constexpr int NASSIGN = NT * TOPK;
constexpr int NPAD_MAX = NASSIGN + NEXP * 255 + 1;
constexpr int NBLK_MAX = NPAD_MAX / 256 + 1;
constexpr float LN_EPS = 1e-5f;
constexpr float YMOE_SCALE = 16.0f;
constexpr float DN_ALPHA = 1.189207115002721f;

DI unsigned pk2(float lo, float hi) { f32x2 v = {lo, hi}; bf16x2_t b = __builtin_convertvector(v, bf16x2_t); return __builtin_bit_cast(unsigned, b); }
DI float bflo(unsigned w) { return __uint_as_float(w << 16); }
DI float bfhi(unsigned w) { return __uint_as_float(w & 0xffff0000u); }
DI float bf2f(bf16_t b) { return __uint_as_float(((unsigned)b) << 16); }
DI float fsigmoid(float x) { return __builtin_amdgcn_rcpf(1.0f + __expf(-x)); }
DI float fsilu(float x) { return x * __builtin_amdgcn_rcpf(1.0f + __expf(-x)); }
DI float wave_sum(float v) {
#pragma unroll
    for (int o = 1; o < 64; o <<= 1) v += __shfl_xor(v, o);
    return v;
}
DI unsigned ld_u32_agent(const unsigned* p) { return __hip_atomic_load(p, __ATOMIC_RELAXED, __HIP_MEMORY_SCOPE_AGENT); }
#define LDS_WAIT() asm volatile("s_waitcnt lgkmcnt(0)" ::: "memory")
#define VM_WAIT() asm volatile("s_waitcnt vmcnt(0)" ::: "memory")

#define XB_TMO      128
#define XB_XCNT(j)  (256  + 64 * (j))
#define XB_XSUB(j)  (1280 + 64 * (j))
#define XB_XGEN(j)  (2304 + 64 * (j))
#define XB_TOP      3328
#define XB_TOPGEN   3392
#define XCD_BAR_WORDS 3456
#define XB_SPIN_CAP (1u << 18)
__device__ __forceinline__ unsigned xb_ld(unsigned* p)              { return __hip_atomic_load(p, __ATOMIC_RELAXED, __HIP_MEMORY_SCOPE_AGENT); }
__device__ __forceinline__ unsigned xb_add(unsigned* p, unsigned v) { return __hip_atomic_fetch_add(p, v, __ATOMIC_RELAXED, __HIP_MEMORY_SCOPE_AGENT); }
__device__ __forceinline__ unsigned xb_xcc_id() { return (unsigned)__builtin_amdgcn_s_getreg((3 << 11) | 20) & 0xFu; }
#define XB_SPIN(cond, bar) do { unsigned _sp = 0; while (cond) { __builtin_amdgcn_s_sleep(1); \
    if ((++_sp & 255u) == 0u) { if (xb_ld(&(bar)[XB_TMO])) break; if (_sp > XB_SPIN_CAP) { atomicAdd(&(bar)[XB_TMO], 1u); break; } } } } while (0)
struct XcdBarrier { unsigned* bar; unsigned x; volatile LAS unsigned* st; };
__device__ __forceinline__ XcdBarrier xcd_barrier_post(unsigned* bar, volatile LAS unsigned* st) {
    XcdBarrier b; b.bar = bar; b.x = xb_xcc_id(); b.st = st;
    if (threadIdx.x == 0) (void)xb_add(&bar[XB_XCNT(b.x)], 1u);
    return b;
}
__device__ __forceinline__ void xcd_barrier_complete(unsigned* bar, unsigned x, unsigned& nloc, unsigned& nx) {
    const unsigned G = gridDim.x * gridDim.y * gridDim.z;
    unsigned sum, cnt, mine, sp = 0u;
    for (;;) {
        sum = 0u; cnt = 0u; mine = 0u;
#pragma unroll
        for (unsigned j = 0; j < 16; ++j) { const unsigned c = xb_ld(&bar[XB_XCNT(j)]); sum += c; cnt += (c > 0u) ? 1u : 0u; mine = (j == x) ? c : mine; }
        if (sum == G) break;
        __builtin_amdgcn_s_sleep(1);
        if ((++sp & 255u) == 0u) { if (xb_ld(&bar[XB_TMO])) break; if (sp > XB_SPIN_CAP) { atomicAdd(&bar[XB_TMO], 1u); break; } }
    }
    nloc = mine > 0u ? mine : 1u; nx = cnt > 0u ? cnt : 1u;
}
__device__ __forceinline__ void xcd_barrier(const XcdBarrier& b) {
    asm volatile("s_waitcnt vmcnt(0)" ::: "memory");
    __syncthreads();
    if (threadIdx.x == 0) {
        unsigned* bar = b.bar;
        __builtin_amdgcn_s_waitcnt(0);
        unsigned nloc = b.st[0], nx = b.st[1];
        if (nloc == 0u) { xcd_barrier_complete(bar, b.x, nloc, nx); b.st[0] = nloc; b.st[1] = nx; }
        const unsigned old = xb_add(&bar[XB_XSUB(b.x)], 1u);
        const unsigned gen = old / nloc;
        if (old + 1u == (gen + 1u) * nloc) {
            __builtin_amdgcn_fence(__ATOMIC_RELEASE, "agent");
            asm volatile("s_waitcnt vmcnt(0)" ::: "memory");
            const unsigned og = xb_add(&bar[XB_TOP], 1u);
            const unsigned tg = og / nx;
            if (og + 1u == (tg + 1u) * nx) xb_add(&bar[XB_TOPGEN], 1u);
            else XB_SPIN(xb_ld(&bar[XB_TOPGEN]) == tg, bar);
            __builtin_amdgcn_fence(__ATOMIC_ACQUIRE, "agent");
            xb_add(&bar[XB_XGEN(b.x)], 1u);
            asm volatile("s_waitcnt vmcnt(0)" ::: "memory");
        } else {
            XB_SPIN(xb_ld(&bar[XB_XGEN(b.x)]) == gen, bar);
            __builtin_amdgcn_fence(__ATOMIC_ACQUIRE, "agent");
            asm volatile("s_waitcnt vmcnt(0)" ::: "memory");
        }
    }
    __syncthreads();
}

namespace pg8 {
constexpr int BM = 256, BK = 64, HALF = 128, HTB = HALF * BK * 2, STAGE_BYTES = 8 * HTB, NXCD = 8, WGM = 8;
__host__ __device__ __forceinline__ int lds_byte(int r, int c) { const int st = (r >> 4) * 2 + (c >> 5), rr = r & 15, cc = c & 31, ob = rr * 64 + cc * 2; return st * 1024 + (ob ^ (((ob >> 9) & 1) << 5)); }
__host__ __device__ __forceinline__ void stage_rc(int b, int& R, int& C) { const int st = b / 1024, sb = b % 1024, swz = sb ^ (((sb >> 9) & 1) << 5); R = (st >> 1) * 16 + swz / 64; C = (st & 1) * 32 + (swz % 64) / 2; }
__host__ __device__ __forceinline__ int perm32(int rho) { const int n = rho >> 4, i = rho & 15; return 8 * (i >> 2) + 4 * n + (i & 3); }

struct Unit { int pm, pn, po; };
struct Gemm { const bf16_t* A; const bf16_t* Bt; int lda, ldb, K, kstepA; };

struct DenseOrder {
    int nM, nN, nwg, G, c; const bf16_t* A; size_t tstepA;
    DI void init(const bf16_t* A_, int lda, int M, int N, int G_, int c_) { nM = M / BM; nN = N / BM; nwg = nM * nN; G = G_; c = c_; A = A_; tstepA = (size_t)BM * lda * 2; }
    DI bool next(int i, Unit& u) const {
        const long L = (long)i * G + c; if (L >= nwg) return false;
        int wgid = (int)L; { const int q = nwg / NXCD, r = nwg % NXCD, xcd = wgid % NXCD, off = wgid / NXCD; wgid = (xcd < r ? xcd * (q + 1) : r * (q + 1) + (xcd - r) * q) + off; }
        const int nig = WGM * nN, gid = wgid / nig, fm = gid * WGM, gsz = (nM - fm) < WGM ? (nM - fm) : WGM;
        u.pm = fm + ((wgid % nig) % gsz); u.pn = (wgid % nig) / gsz; u.po = u.pn; return true;
    }
    DI const char* abase(const Unit& u) const { return (const char*)A + (size_t)u.pm * tstepA; }
};

DI unsigned cvt_pk_bf16(float lo, float hi) { return pk2(lo, hi); }

template <class Epi, class Sched, bool ALIGN_EPI, bool GATHER>
__device__ __forceinline__ void gemm_phase(LAS unsigned char* lds, const Gemm g, const Sched& S, const Epi& E, const LAS int* rowidx  ) {
    const int tid = threadIdx.x, wid = __builtin_amdgcn_readfirstlane(tid >> 6), lane = tid & 63, wr = wid >> 2, wc = wid & 3, fr = lane & 15, fq = lane >> 4;
    const int K = g.K; int nt = K / BK; asm volatile("" : "+s"(nt));
    unsigned voffA[2], voffB[2]; int RA[2], CA[2];
#pragma unroll
    for (int i = 0; i < 2; ++i) { int R, C; stage_rc(tid * 16 + i * 8192, R, C); const int Rb = Epi::PERM ? ((R & ~31) + perm32(R & 31)) : R;
        RA[i] = R; CA[i] = C; voffA[i] = (unsigned)(R * g.lda + C) * 2u; voffB[i] = (unsigned)(Rb * g.ldb + C) * 2u; }
    const size_t kstepA = (size_t)g.kstepA, kstepB = (size_t)(BK * 2);
    const size_t hstepA = (size_t)HALF * g.lda * 2, hstepB = (size_t)HALF * g.ldb * 2;
    const size_t tstepB = 2 * hstepB;
    const unsigned ldsw = (unsigned)wid * 1024u;
    const int aoff = lds_byte(wr * 64 + fr, fq * 8), boff = lds_byte(wc * 32 + fr, fq * 8);
#define PG8_SA(b, h) (((b) * 2 + (h)) * HTB)
#define PG8_SB(b, h) ((4 + (b) * 2 + (h)) * HTB)
#define PG8_STAGE(bufoff, gbase, voff) do { _Pragma("unroll") for (int _i = 0; _i < 2; ++_i) \
        __builtin_amdgcn_global_load_lds((const unsigned*)((const char*)(gbase) + (voff)[_i]), (LAS unsigned*)(lds + (bufoff) + ldsw + _i * 8192), 16, 0, 0); } while (0)
#define PG8_LDA(dst, b, h) do { _Pragma("unroll") for (int m = 0; m < 4; ++m) _Pragma("unroll") for (int k = 0; k < 2; ++k) dst[m][k] = *(const LAS bf16x8*)(lds + PG8_SA(b, h) + aoff + m * 2048 + k * 1024); } while (0)
#define PG8_LDB(dst, b, h) do { _Pragma("unroll") for (int n = 0; n < 2; ++n) _Pragma("unroll") for (int k = 0; k < 2; ++k) dst[n][k] = *(const LAS bf16x8*)(lds + PG8_SB(b, h) + boff + n * 2048 + k * 1024); } while (0)
#define PG8_MMA(ai, bj, At, Bt) do { __builtin_amdgcn_s_setprio(1); _Pragma("unroll") for (int m = 0; m < 4; ++m) _Pragma("unroll") for (int n = 0; n < 2; ++n) _Pragma("unroll") for (int k = 0; k < 2; ++k) \
        acc[ai][bj][m][n] = __builtin_amdgcn_mfma_f32_16x16x32_bf16(Bt[n][k], At[m][k], acc[ai][bj][m][n], 0, 0, 0); __builtin_amdgcn_s_setprio(0); } while (0)
#define PG8_WAIT_V(n) asm volatile("s_waitcnt vmcnt(" #n ")" ::: "memory")
#define PG8_WAIT_L(n) asm volatile("s_waitcnt lgkmcnt(" #n ")" ::: "memory")
#define PG8_BAR __builtin_amdgcn_s_barrier()
#define PG8_SCHED __builtin_amdgcn_sched_barrier(0)
    Unit cur, nxt; int ui = 0;
    if (!S.next(0, cur)) return;
    f32x4 acc[2][2][4][2];
#pragma unroll
    for (int a = 0; a < 2; ++a)
#pragma unroll
        for (int b = 0; b < 2; ++b)
#pragma unroll
            for (int m = 0; m < 4; ++m)
#pragma unroll
                for (int n = 0; n < 2; ++n) acc[a][b][m][n] = (f32x4){0.f, 0.f, 0.f, 0.f};
    bf16x8 At[4][2], B0[2][2], B1[2][2];
    unsigned cg0[2], cg1[2], ng0[2], ng1[2];
    const char* cA; const char* cB = (const char*)g.Bt + (size_t)cur.pn * tstepB;
    if constexpr (GATHER) {
        cA = (const char*)g.A;
#pragma unroll
        for (int i = 0; i < 2; ++i) { cg0[i] = (unsigned)(rowidx[ui * 256 + RA[i]] * g.lda + CA[i]) * 2u; cg1[i] = (unsigned)(rowidx[ui * 256 + 128 + RA[i]] * g.lda + CA[i]) * 2u; ng0[i] = cg0[i]; ng1[i] = cg1[i]; }
    } else { cA = S.abase(cur); cg0[0] = cg0[1] = cg1[0] = cg1[1] = ng0[0] = ng0[1] = ng1[0] = ng1[1] = 0u; }
#define PG8_STAGE_A(bufoff, base, h, og0, og1) do { if constexpr (GATHER) { if ((h) == 0) PG8_STAGE(bufoff, base, og0); else PG8_STAGE(bufoff, base, og1); } \
        else { PG8_STAGE(bufoff, (base) + ((h) ? hstepA : (size_t)0), voffA); } } while (0)
    PG8_STAGE(PG8_SB(0, 0), cB, voffB); PG8_STAGE(PG8_SB(0, 1), cB + hstepB, voffB); PG8_STAGE_A(PG8_SA(0, 0), cA, 0, cg0, cg1); PG8_STAGE_A(PG8_SA(0, 1), cA, 1, cg0, cg1);
    if (wr == 1) PG8_BAR;
    PG8_WAIT_V(2); PG8_BAR;
    PG8_STAGE(PG8_SB(1, 0), cB + kstepB, voffB); PG8_STAGE_A(PG8_SA(1, 0), cA + kstepA, 0, cg0, cg1); PG8_STAGE(PG8_SB(1, 1), cB + hstepB + kstepB, voffB);
    PG8_WAIT_V(6); PG8_BAR;
    for (;;) {
        const bool has_next = S.next(ui + 1, nxt);
        const char* nA; const char* nB = has_next ? (const char*)g.Bt + (size_t)nxt.pn * tstepB : cB;
        if constexpr (GATHER) {
            nA = cA;
            if (has_next) {
#pragma unroll
                for (int i = 0; i < 2; ++i) { ng0[i] = (unsigned)(rowidx[(ui + 1) * 256 + RA[i]] * g.lda + CA[i]) * 2u; ng1[i] = (unsigned)(rowidx[(ui + 1) * 256 + 128 + RA[i]] * g.lda + CA[i]) * 2u; }
            } else {
#pragma unroll
                for (int i = 0; i < 2; ++i) { ng0[i] = cg0[i]; ng1[i] = cg1[i]; }
            }
        } else { nA = has_next ? S.abase(nxt) : cA; }
        for (int t = 0; t < nt; t += 2) {
            const bool last = (t == nt - 2);
            const char* a1 = cA + (size_t)(t + 1) * kstepA;
            const char* a2 = last ? nA : cA + (size_t)(t + 2) * kstepA; const char* b2 = last ? nB : cB + (size_t)(t + 2) * kstepB;
            const char* a3 = a2 + kstepA; const char* b3 = b2 + kstepB;
            unsigned xg0[2], xg1[2];
#pragma unroll
            for (int i = 0; i < 2; ++i) { xg0[i] = last ? ng0[i] : cg0[i]; xg1[i] = last ? ng1[i] : cg1[i]; }
            PG8_LDB(B0, 0, 0); PG8_LDB(B1, 0, 1); PG8_SCHED; PG8_LDA(At, 0, 0); PG8_STAGE_A(PG8_SA(1, 1), a1, 1, cg0, cg1);
            PG8_WAIT_V(8); PG8_WAIT_L(0); PG8_BAR; PG8_MMA(0, 0, At, B0); PG8_MMA(0, 1, At, B1); PG8_BAR; PG8_SCHED;
            PG8_LDA(At, 0, 1); PG8_STAGE(PG8_SB(0, 0), b2, voffB); PG8_STAGE(PG8_SB(0, 1), b2 + hstepB, voffB); PG8_STAGE_A(PG8_SA(0, 0), a2, 0, xg0, xg1);
            PG8_WAIT_V(8); PG8_WAIT_L(0); PG8_BAR; PG8_MMA(1, 0, At, B0); PG8_MMA(1, 1, At, B1); PG8_BAR; PG8_SCHED;
            PG8_LDB(B0, 1, 0); PG8_LDB(B1, 1, 1); PG8_SCHED; PG8_LDA(At, 1, 0); PG8_STAGE_A(PG8_SA(0, 1), a2, 1, xg0, xg1);
            PG8_WAIT_V(8); PG8_WAIT_L(0); PG8_BAR; PG8_MMA(0, 0, At, B0); PG8_MMA(0, 1, At, B1); PG8_BAR; PG8_SCHED;
            PG8_LDA(At, 1, 1); PG8_STAGE(PG8_SB(1, 0), b3, voffB); PG8_STAGE(PG8_SB(1, 1), b3 + hstepB, voffB); PG8_STAGE_A(PG8_SA(1, 0), a3, 0, xg0, xg1);
            PG8_WAIT_V(8); PG8_WAIT_L(0); PG8_BAR; PG8_MMA(1, 0, At, B0); PG8_MMA(1, 1, At, B1); PG8_BAR; PG8_SCHED;
        }
        if constexpr (ALIGN_EPI) { if (wr == 0) PG8_BAR; }
        E(acc, cur, wr, wc, fr, fq);
        if (!has_next) break;
#pragma unroll
        for (int a = 0; a < 2; ++a)
#pragma unroll
            for (int b = 0; b < 2; ++b)
#pragma unroll
                for (int m = 0; m < 4; ++m)
#pragma unroll
                    for (int n = 0; n < 2; ++n) acc[a][b][m][n] = (f32x4){0.f, 0.f, 0.f, 0.f};
        cur = nxt; cA = nA; cB = nB; ++ui;
#pragma unroll
        for (int i = 0; i < 2; ++i) { cg0[i] = ng0[i]; cg1[i] = ng1[i]; }
        if constexpr (ALIGN_EPI) { if (wr == 1) PG8_BAR; }
    }
    PG8_WAIT_V(0);
    if constexpr (!ALIGN_EPI) { if (wr == 0) PG8_BAR; }
    PG8_BAR;
#undef PG8_SA
#undef PG8_SB
#undef PG8_STAGE
#undef PG8_STAGE_A
#undef PG8_LDA
#undef PG8_LDB
#undef PG8_MMA
#undef PG8_WAIT_V
#undef PG8_WAIT_L
#undef PG8_BAR
#undef PG8_SCHED
}
}
namespace pg8 {
typedef f32x4 AccT[2][2][4][2];

struct EpiStoreBf16 {
    static constexpr bool PERM = true;
    bf16_t* O; int ldc; float scale0; int ntile0;
    DI void operator()(const AccT& acc, const Unit& u, int wr, int wc, int fr, int fq) const {
        const int row0 = u.pm * BM + wr * 64 + fr, col0 = u.po * BM + wc * 32 + 8 * fq; const float sc = (u.po < ntile0) ? scale0 : 1.0f;
#pragma unroll
        for (int ai = 0; ai < 2; ++ai)
#pragma unroll
            for (int m = 0; m < 4; ++m) { bf16_t* rowp = O + (size_t)(row0 + ai * HALF + m * 16) * ldc + col0;
#pragma unroll
                for (int bj = 0; bj < 2; ++bj) { const f32x4 v0 = acc[ai][bj][m][0] * sc, v1 = acc[ai][bj][m][1] * sc;
                    u32x4 w; w.x = pk2(v0[0], v0[1]); w.y = pk2(v0[2], v0[3]); w.z = pk2(v1[0], v1[1]); w.w = pk2(v1[2], v1[3]);
                    *(u32x4*)(rowp + bj * HALF) = w; } }
    }
};
struct EpiStoreFp8 {
    static constexpr bool PERM = true;
    unsigned char* O; int ldc; float scale;
    DI void operator()(const AccT& acc, const Unit& u, int wr, int wc, int fr, int fq) const {
        const int row0 = u.pm * BM + wr * 64 + fr, col0 = u.po * BM + wc * 32 + 8 * fq;
#pragma unroll
        for (int ai = 0; ai < 2; ++ai)
#pragma unroll
            for (int m = 0; m < 4; ++m) { unsigned char* rowp = O + (size_t)(row0 + ai * HALF + m * 16) * ldc + col0;
#pragma unroll
                for (int bj = 0; bj < 2; ++bj) { const f32x4 v0 = acc[ai][bj][m][0] * scale, v1 = acc[ai][bj][m][1] * scale;
                    int w0 = 0, w1 = 0;
                    w0 = __builtin_amdgcn_cvt_pk_fp8_f32(v0[0], v0[1], w0, false); w0 = __builtin_amdgcn_cvt_pk_fp8_f32(v0[2], v0[3], w0, true);
                    w1 = __builtin_amdgcn_cvt_pk_fp8_f32(v1[0], v1[1], w1, false); w1 = __builtin_amdgcn_cvt_pk_fp8_f32(v1[2], v1[3], w1, true);
                    *(u32x2*)(rowp + bj * HALF) = (u32x2){(unsigned)w0, (unsigned)w1}; } }
    }
};
DI float gelu_tanh(float x) { const float u = 0.7978845608028654f * (x + 0.044715f * x * x * x); const float e = __expf(2.0f * u); const float th = 1.0f - 2.0f / (e + 1.0f); return 0.5f * x * (1.0f + th); }
struct EpiCmp {
    static constexpr bool PERM = true;
    bf16_t* O; const float* peb;
    DI void operator()(const AccT& acc, const Unit& u, int wr, int wc, int fr, int fq) const {
        const int row0 = u.pm * BM + wr * 64 + fr, col0 = wc * 32 + 8 * fq; const float* pb = peb + (u.pm >> 4) * 256;
        f32x4 bv[2][2];
#pragma unroll
        for (int bj = 0; bj < 2; ++bj)
#pragma unroll
            for (int n = 0; n < 2; ++n) bv[bj][n] = *(const f32x4*)(pb + col0 + bj * HALF + 4 * n);
#pragma unroll
        for (int ai = 0; ai < 2; ++ai)
#pragma unroll
            for (int m = 0; m < 4; ++m) { bf16_t* rowp = O + (size_t)(row0 + ai * HALF + m * 16) * 256 + col0;
#pragma unroll
                for (int bj = 0; bj < 2; ++bj) { f32x4 v0 = acc[ai][bj][m][0] + bv[bj][0], v1 = acc[ai][bj][m][1] + bv[bj][1];
#pragma unroll
                    for (int j = 0; j < 4; ++j) { v0[j] = gelu_tanh(v0[j]); v1[j] = gelu_tanh(v1[j]); }
                    u32x4 w; w.x = pk2(v0[0], v0[1]); w.y = pk2(v0[2], v0[3]); w.z = pk2(v1[0], v1[1]); w.w = pk2(v1[2], v1[3]);
                    *(u32x4*)(rowp + bj * HALF) = w; } }
    }
};
struct EpiF32 {
    static constexpr bool PERM = false;
    float* C; int ldc;
    DI void operator()(const AccT& acc, const Unit& u, int wr, int wc, int fr, int fq) const {
        const int row0 = u.pm * BM + wr * 64 + fr, col0 = u.po * BM + wc * 32 + 4 * fq;
#pragma unroll
        for (int ai = 0; ai < 2; ++ai)
#pragma unroll
            for (int m = 0; m < 4; ++m) { float* rowp = C + (size_t)(row0 + ai * HALF + m * 16) * ldc + col0;
#pragma unroll
                for (int bj = 0; bj < 2; ++bj)
#pragma unroll
                    for (int n = 0; n < 2; ++n) *(f32x4*)(rowp + bj * HALF + n * 16) = acc[ai][bj][m][n]; }
    }
};
struct EpiResMod {
    static constexpr bool PERM = false;
    const float* base; float* out; const float* gate; int gate_pitch;
    DI void operator()(const AccT& acc, const Unit& u, int wr, int wc, int fr, int fq) const {
        const int row0 = u.pm * BM + wr * 64 + fr, col0 = u.po * BM + wc * 32 + 4 * fq;
        const float* gp = gate + (size_t)((u.pm * BM) / SEQ) * gate_pitch + col0;
        f32x4 gv[2][2];
#pragma unroll
        for (int bj = 0; bj < 2; ++bj)
#pragma unroll
            for (int n = 0; n < 2; ++n) gv[bj][n] = *(const f32x4*)(gp + bj * HALF + n * 16);
#pragma unroll
        for (int ai = 0; ai < 2; ++ai)
#pragma unroll
            for (int m = 0; m < 4; ++m) { const size_t off = (size_t)(row0 + ai * HALF + m * 16) * DM + col0;
#pragma unroll
                for (int bj = 0; bj < 2; ++bj)
#pragma unroll
                    for (int n = 0; n < 2; ++n) { const f32x4 bs = *(const f32x4*)(base + off + bj * HALF + n * 16);
                        *(f32x4*)(out + off + bj * HALF + n * 16) = bs * DN_ALPHA + gv[bj][n] * acc[ai][bj][m][n]; } }
    }
};
struct EpiResModBf16 {
    static constexpr bool PERM = false;
    const float* base; bf16_t* out; const float* gate; int gate_pitch;
    DI void operator()(const AccT& acc, const Unit& u, int wr, int wc, int fr, int fq) const {
        const int row0 = u.pm * BM + wr * 64 + fr, col0 = u.po * BM + wc * 32 + 4 * fq;
        const float* gp = gate + (size_t)((u.pm * BM) / SEQ) * gate_pitch + col0;
        f32x4 gv[2][2];
#pragma unroll
        for (int bj = 0; bj < 2; ++bj)
#pragma unroll
            for (int n = 0; n < 2; ++n) gv[bj][n] = *(const f32x4*)(gp + bj * HALF + n * 16);
#pragma unroll
        for (int ai = 0; ai < 2; ++ai)
#pragma unroll
            for (int m = 0; m < 4; ++m) { const size_t off = (size_t)(row0 + ai * HALF + m * 16) * DM + col0;
#pragma unroll
                for (int bj = 0; bj < 2; ++bj)
#pragma unroll
                    for (int n = 0; n < 2; ++n) { const f32x4 bs = *(const f32x4*)(base + off + bj * HALF + n * 16); const f32x4 v = bs * DN_ALPHA + gv[bj][n] * acc[ai][bj][m][n];
                        *(u32x2*)(out + off + bj * HALF + n * 16) = (u32x2){pk2(v.x, v.y), pk2(v.z, v.w)}; } }
    }
};
struct EpiGlu {
    static constexpr bool PERM = true;
    bf16_t* O; int ldc;
    DI void operator()(const AccT& acc, const Unit& u, int wr, int wc, int fr, int fq) const {
        const int row0 = u.pm * BM + wr * 64 + fr, col0 = u.po * HALF + wc * 32 + 8 * fq;
#pragma unroll
        for (int ai = 0; ai < 2; ++ai)
#pragma unroll
            for (int m = 0; m < 4; ++m) { bf16_t* rowp = O + (size_t)(row0 + ai * HALF + m * 16) * ldc + col0;
                f32x4 h0, h1;
#pragma unroll
                for (int j = 0; j < 4; ++j) { h0[j] = fsilu(acc[ai][0][m][0][j]) * acc[ai][1][m][0][j]; h1[j] = fsilu(acc[ai][0][m][1][j]) * acc[ai][1][m][1][j]; }
                u32x4 w; w.x = pk2(h0[0], h0[1]); w.y = pk2(h0[2], h0[3]); w.z = pk2(h1[0], h1[1]); w.w = pk2(h1[2], h1[3]);
                *(u32x4*)rowp = w; }
    }
};

struct CmpOrder {
    int G, c; const bf16_t* U;
    DI bool next(int i, Unit& u) const { const int L = i * G + c; if (L >= 32) return false; u.pm = L; u.pn = L >> 4; u.po = 0; return true; }
    DI const char* abase(const Unit& u) const { const int kv = u.pm >> 4, bg = (u.pm >> 1) & 7, b = bg >> 1, gg = bg & 1, half = u.pm & 1;
        return (const char*)(U + (size_t)(b * SEQ + half * 4096) * NU + (kv ? UVC : UKC) + gg * 64); }
};
template <int NSUB> struct MoeOrder {
    int G, c, nunits; const int* blk_e; const bf16_t* A; size_t tstepA;
    DI bool next(int i, Unit& u) const { const int L = i * G + c; if (L >= nunits) return false; const int blk = L / NSUB, sub = L % NSUB;
        const int e = (int)__builtin_amdgcn_readfirstlane((int)ld_u32_agent((const unsigned*)blk_e + blk)); u.pm = blk; u.pn = e * NSUB + sub; u.po = sub; return true; }
    DI const char* abase(const Unit& u) const { return (const char*)A + (size_t)u.pm * tstepA; }
};
}
constexpr size_t MiB = 1u << 20;
constexpr size_t WS_CTL = 0, CTL_ZERO_BYTES = 1 * MiB;
constexpr size_t WS_MODP = 1 * MiB;
constexpr size_t WS_MOD = WS_MODP + 1536 * 1024;
constexpr size_t WS_PEP = WS_MOD + 128 * 1024;
constexpr size_t WS_PEB = WS_PEP + 32 * 1024;
constexpr size_t WS_WIN_T = 3 * MiB;
constexpr size_t WS_WOUT_T = 8 * MiB;
constexpr size_t WS_WR_T = 10 * MiB;
constexpr size_t WS_WSGU_T = 12 * MiB;
constexpr size_t WS_WSD_T = 13 * MiB;
constexpr size_t WS_WC1_T = 14 * MiB;
constexpr size_t WS_WDN_T = 16 * MiB;
constexpr size_t WS_WGU_T = 144 * MiB;
constexpr size_t WS_YMOE = 144 * MiB;
constexpr size_t WS_U = 400 * MiB;
constexpr size_t WS_H1 = 560 * MiB;
constexpr size_t WS_CAT = 624 * MiB;
constexpr size_t WS_H2 = 688 * MiB;
constexpr size_t WS_HIDS = 752 * MiB;
constexpr size_t WS_HIDM = 784 * MiB;
constexpr size_t WS_LOGIT = 944 * MiB;
constexpr size_t WS_TOKE = 976 * MiB;
constexpr size_t WS_TOKW = 977 * MiB;
constexpr size_t WS_LRANK = 978 * MiB;
constexpr size_t WS_POSOF = 979 * MiB;
constexpr size_t WS_ROWTOK = 980 * MiB;
constexpr size_t WS_HIST = 982 * MiB;
constexpr size_t WS_BLKE = 983 * MiB;
constexpr size_t WS_HCMP = 984 * MiB;
constexpr size_t WS_KC = 988 * MiB;
constexpr size_t WS_VCT = 989 * MiB;
constexpr size_t WS_VST = 990 * MiB;
constexpr size_t WS_VWT = 998 * MiB;
constexpr size_t WS_V1 = WS_H1;
constexpr size_t WS_X1 = 464 * MiB;
constexpr size_t WS_SH = 528 * MiB;
constexpr size_t WS_END = 1024 * MiB;
constexpr int CW_BAR = 4096;

constexpr int LDS_BYTES = 160 * 1024;
constexpr int LDS_MISC = 131072;
constexpr int LDS_TAB = 131072 + 1024;

struct Params {
    const float *x, *c, *w_ada, *b_ada, *w_in, *pe_k, *pe_v, *w_cmp_k1, *w_cmp_k2, *w_cmp_v1, *w_cmp_v2, *w_dw, *b_dw, *conv_ln_g, *conv_ln_b, *w_out, *ln1_g, *ln1_b,
        *w_router, *router_bias, *w_e_gate, *w_e_up, *w_e_down, *w_s_gate, *w_s_up, *w_s_down, *ln2_g, *ln2_b;
    float* out; unsigned char* ws; int ph_lo, ph_hi;
};

DI void transpose_item(const float* W, int ldw, int ncols, bf16_t* WT, int ldt, int drow0, LAS float* scr, int k0, int n0, int lane) {
    if (n0 + 32 <= ncols && (((size_t)W | (size_t)(ldw * 4)) & 15) == 0 && (n0 & 3) == 0) {
        f32x4 v[8];
#pragma unroll
        for (int i = 0; i < 8; ++i) v[i] = *(const f32x4*)(W + (size_t)(k0 + 8 * i + (lane >> 3)) * ldw + n0 + 4 * (lane & 7));
#pragma unroll
        for (int i = 0; i < 8; ++i) { LAS float* d = scr + (8 * i + (lane >> 3)) * 33 + 4 * (lane & 7); d[0] = v[i].x; d[1] = v[i].y; d[2] = v[i].z; d[3] = v[i].w; }
    } else {
        const int nn = n0 + (lane & 31); const bool okc = nn < ncols;
#pragma unroll 8
        for (int i = 0; i < 32; ++i) { const int kk = 2 * i + (lane >> 5); scr[kk * 33 + (lane & 31)] = okc ? W[(size_t)(k0 + kk) * ldw + nn] : 0.f; }
    }
    LDS_WAIT(); asm volatile("" ::: "memory");
    const int cch = lane & 7;
#pragma unroll
    for (int j = 0; j < 4; ++j) { const int n = (lane >> 3) + 8 * j; const LAS float* s = scr + (8 * cch) * 33 + n;
        u32x4 o; o.x = pk2(s[0 * 33], s[1 * 33]); o.y = pk2(s[2 * 33], s[3 * 33]); o.z = pk2(s[4 * 33], s[5 * 33]); o.w = pk2(s[6 * 33], s[7 * 33]);
        *(u32x4*)(WT + (size_t)(drow0 + n) * ldt + k0 + 8 * cch) = o; }
    LDS_WAIT(); asm volatile("" ::: "memory");
}
DI void tr_plain(const float* W, int ldw, int K, int N, bf16_t* WT, int row_off, LAS float* scr, int item, int lane) {
    const int nblk = (N + 31) / 32, kb = item / nblk, nb = item % nblk;
    transpose_item(W, ldw, N, WT, K, row_off + 32 * nb, scr, 64 * kb, 32 * nb, lane);
}
DI void tr_glu(const float* W, int K, bf16_t* WT, int up, LAS float* scr, int item, int lane) {
    const int kb = item >> 3, nb = item & 7, n0 = 32 * nb;
    transpose_item(W, 256, 256, WT, K, (n0 >> 7) * 256 + up * 128 + (n0 & 127), scr, 64 * kb, n0, lane);
}

constexpr int EXP_ITEMS = NEXP * 384, EXP_LATE = 18432;
DI void expert_items(const Params& P, LAS float* scr, int lane, int gw, int NGW, int r0, int r1) {
    unsigned char* ws = P.ws;
    for (int r = r0 + gw; r < r1; r += NGW) { const int e = r / 384, q = r % 384;
        if (q < 128) tr_glu(P.w_e_gate + (size_t)e * 1024 * 256, 1024, (bf16_t*)(ws + WS_WGU_T) + (size_t)e * 512 * 1024, 0, scr, q, lane);
        else if (q < 256) tr_glu(P.w_e_up + (size_t)e * 1024 * 256, 1024, (bf16_t*)(ws + WS_WGU_T) + (size_t)e * 512 * 1024, 1, scr, q - 128, lane);
        else tr_plain(P.w_e_down + (size_t)e * 256 * 1024, 1024, 256, 1024, (bf16_t*)(ws + WS_WDN_T) + (size_t)e * 1024 * 256, 0, scr, q - 256, lane); }
}

DI void phase0a(const Params& P, LAS unsigned char* lds, int vcu, int G, int wave, int lane, int tid) {
    unsigned char* ws = P.ws;
    LAS float* scr = (LAS float*)(lds + wave * 16384);
    const int gw = vcu * 8 + wave, NGW = G * 8;
    for (int it = gw; it < 96 * 16; it += NGW) { const int cb = it % 96, ks = it / 96; const int col = cb * 64 + lane;
        float a0 = 0.f, a1 = 0.f, a2 = 0.f, a3 = 0.f;
#pragma unroll 4
        for (int k = ks * 64; k < ks * 64 + 64; ++k) { const float w = P.w_ada[(size_t)k * 6144 + col];
            a0 += fsilu(P.c[k]) * w; a1 += fsilu(P.c[1024 + k]) * w; a2 += fsilu(P.c[2048 + k]) * w; a3 += fsilu(P.c[3072 + k]) * w; }
        float* mp = (float*)(ws + WS_MODP) + (size_t)ks * 4 * 6144 + col;
        mp[0] = a0; mp[6144] = a1; mp[2 * 6144] = a2; mp[3 * 6144] = a3; }
    for (int it = gw; it < 16 * 2 * 4; it += NGW) { const int cb = it & 3, kv = (it >> 2) & 1, ks = it >> 3; const int col = cb * 64 + lane;
        const float* pe = kv ? P.pe_v : P.pe_k; const float* w1 = kv ? P.w_cmp_v1 : P.w_cmp_k1; float a = 0.f;
#pragma unroll 4
        for (int k = ks * 128; k < ks * 128 + 128; ++k) a += pe[k] * w1[(size_t)k * 256 + col];
        ((float*)(ws + WS_PEP))[(ks * 2 + kv) * 256 + col] = a; }
    constexpr int I_IN0 = 16 * 40, I_IN1 = 16 * 32, I_IN2 = 16 * 1, I_OUT = 16 * 32, I_R = 16 * 8, I_SG = 16 * 8, I_SD = 4 * 32, I_C1 = 32 * 8;
    constexpr int I_SMALL = I_IN0 + I_IN1 + I_IN2 + I_OUT + I_R + 2 * I_SG + I_SD + 2 * I_C1;
    constexpr int NITEMS = I_SMALL;
    bf16_t* win_t = (bf16_t*)(ws + WS_WIN_T);
    for (int it = gw; it < NITEMS; it += NGW) {
        int r = it;
        if (r < I_IN0) { tr_plain(P.w_in, DIN, 1024, 1280, win_t, 0, scr, r, lane); continue; } r -= I_IN0;
        if (r < I_IN1) { tr_plain(P.w_in + 1304, DIN, 1024, 1024, win_t, UCA, scr, r, lane); continue; } r -= I_IN1;
        if (r < I_IN2) { tr_plain(P.w_in + 1280, DIN, 1024, 24, win_t, UGT, scr, r, lane); continue; } r -= I_IN2;
        if (r < I_OUT) { tr_plain(P.w_out, 1024, 1024, 1024, (bf16_t*)(ws + WS_WOUT_T), 0, scr, r, lane); continue; } r -= I_OUT;
        if (r < I_R) { tr_plain(P.w_router, 256, 1024, 256, (bf16_t*)(ws + WS_WR_T), 0, scr, r, lane); continue; } r -= I_R;
        if (r < I_SG) { tr_glu(P.w_s_gate, 1024, (bf16_t*)(ws + WS_WSGU_T), 0, scr, r, lane); continue; } r -= I_SG;
        if (r < I_SG) { tr_glu(P.w_s_up, 1024, (bf16_t*)(ws + WS_WSGU_T), 1, scr, r, lane); continue; } r -= I_SG;
        if (r < I_SD) { tr_plain(P.w_s_down, 1024, 256, 1024, (bf16_t*)(ws + WS_WSD_T), 0, scr, r, lane); continue; } r -= I_SD;
        if (r < I_C1) { tr_plain(P.w_cmp_k1, 256, 2048, 256, (bf16_t*)(ws + WS_WC1_T), 0, scr, r, lane); continue; } r -= I_C1;
        tr_plain(P.w_cmp_v1, 256, 2048, 256, (bf16_t*)(ws + WS_WC1_T) + 256 * 2048, 0, scr, r, lane);
    }
    { u32x4* z = (u32x4*)(win_t + (size_t)2336 * 1024); const int n16 = (2560 - 2336) * 1024 * 2 / 16;
      for (int i = vcu * 512 + tid; i < n16; i += G * 512) z[i] = (u32x4){0u, 0u, 0u, 0u}; }
}

DI void phase0b(const Params& P, LAS unsigned char* lds, int vcu, int G, int wave, int lane, int tid) {
    unsigned char* ws = P.ws;
    const float* modp = (const float*)(ws + WS_MODP);
    for (int i = vcu * 512 + tid; i < 4 * 6144; i += G * 512) { float a = P.b_ada[i % 6144];
#pragma unroll
        for (int ks = 0; ks < 16; ++ks) a += modp[(size_t)ks * 4 * 6144 + i];
        ((float*)(ws + WS_MOD))[i] = a; }
    for (int i = vcu * 512 + tid; i < 512; i += G * 512) { float a = 0.f;
#pragma unroll
        for (int ks = 0; ks < 16; ++ks) a += ((const float*)(ws + WS_PEP))[ks * 512 + i];
        ((float*)(ws + WS_PEB))[i] = a; }
    const int rpw = NT / G;
    LAS float* sh = (LAS float*)lds;
    for (int r0 = vcu * rpw; r0 < NT; r0 += G * rpw) {
        const int b = r0 / SEQ;
        __syncthreads();
        for (int i = tid; i < 2048; i += 512) { const int j = (i < 1024) ? i : i;
            float a = P.b_ada[j];
#pragma unroll
            for (int ks = 0; ks < 16; ++ks) a += modp[(size_t)ks * 4 * 6144 + b * 6144 + j];
            sh[i] = (i < 1024) ? a : 1.0f + a; }
        __syncthreads();
        for (int m = r0 + wave; m < r0 + rpw; m += 8) {
            const f32x4* xr = (const f32x4*)(P.x + (size_t)m * DM) + lane; unsigned long long* o8 = (unsigned long long*)((bf16_t*)(ws + WS_H1) + (size_t)m * DM) + lane;
#pragma unroll
            for (int j = 0; j < 4; ++j) { const f32x4 v = xr[64 * j]; const int c0 = 4 * lane + 256 * j;
                const float y0 = v.x * sh[1024 + c0] + sh[c0], y1 = v.y * sh[1025 + c0] + sh[c0 + 1], y2 = v.z * sh[1026 + c0] + sh[c0 + 2], y3 = v.w * sh[1027 + c0] + sh[c0 + 3];
                o8[64 * j] = (unsigned long long)pk2(y0, y1) | ((unsigned long long)pk2(y2, y3) << 32); }
        }
    }
    __syncthreads();
}

DI void conv_item(const Params& P, LAS unsigned char* lds, int item, int wave, int lane, int tid) {
    const bf16_t* U = (const bf16_t*)(P.ws + WS_U); bf16_t* CAT = (bf16_t*)(P.ws + WS_CAT);
    LAS float* glu = (LAS float*)lds; LAS float* red = (LAS float*)(lds + 62 * 512 * 4); LAS float* stat = red + 32 * 8 * 2;
    const int b = item >> 8, t0 = (item & 255) * 32, c = tid;
    __syncthreads();
    {
        u32x4 av[8], gv8[8];
#pragma unroll
        for (int i = 0; i < 8; ++i) { const int task = tid + 512 * i, rr = task >> 6, oc = task & 63; int tok = t0 - 30 + (rr < 62 ? rr : 61); tok = tok < 0 ? 0 : tok;
            const bf16_t* up = U + (size_t)(b * SEQ + tok) * NU + oc * 8; av[i] = *(const u32x4*)(up + UCA); gv8[i] = *(const u32x4*)(up + UCG); }
#pragma unroll
        for (int i = 0; i < 8; ++i) { const int task = tid + 512 * i, rr = task >> 6, oc = task & 63; const bool ok = (t0 - 30 + rr) >= 0;
            const unsigned aw[4] = {av[i].x, av[i].y, av[i].z, av[i].w}, gw[4] = {gv8[i].x, gv8[i].y, gv8[i].z, gv8[i].w}; float o[8];
#pragma unroll
            for (int q = 0; q < 4; ++q) { o[2 * q] = ok ? bflo(aw[q]) * fsigmoid(bflo(gw[q])) : 0.f; o[2 * q + 1] = ok ? bfhi(aw[q]) * fsigmoid(bfhi(gw[q])) : 0.f; }
            if (rr < 62) { *(LAS f32x4*)(glu + rr * 512 + oc * 8) = (f32x4){o[0], o[1], o[2], o[3]}; *(LAS f32x4*)(glu + rr * 512 + oc * 8 + 4) = (f32x4){o[4], o[5], o[6], o[7]}; } }
    }
    float w[31];
#pragma unroll
    for (int j = 0; j < 31; ++j) w[j] = P.w_dw[j * 512 + c];
    const float bd = P.b_dw[c];
    __syncthreads();
    float y[32];
#pragma unroll
    for (int tt = 0; tt < 32; ++tt) y[tt] = bd;
#pragma unroll
    for (int rr = 0; rr < 62; ++rr) { const float gv = glu[rr * 512 + c];
#pragma unroll
        for (int tt = 0; tt < 32; ++tt) { if (rr - tt >= 0 && rr - tt <= 30) y[tt] += w[rr - tt] * gv; } }
    __syncthreads();
#pragma unroll
    for (int tt = 0; tt < 32; ++tt) glu[tt * 512 + c] = y[tt];
    __syncthreads();
    {
#pragma unroll
        for (int q = 0; q < 4; ++q) { const int tt = 4 * wave + q; const f32x4 a = *(const LAS f32x4*)(glu + tt * 512 + lane * 8), bq = *(const LAS f32x4*)(glu + tt * 512 + lane * 8 + 4);
            float s1 = ((a.x + a.y) + (a.z + a.w)) + ((bq.x + bq.y) + (bq.z + bq.w));
            float s2 = ((a.x * a.x + a.y * a.y) + (a.z * a.z + a.w * a.w)) + ((bq.x * bq.x + bq.y * bq.y) + (bq.z * bq.z + bq.w * bq.w));
            s1 = wave_sum(s1); s2 = wave_sum(s2);
            if (lane == 0) { const float mean = s1 * (1.0f / 512.0f); float var = s2 * (1.0f / 512.0f) - mean * mean; var = var < 0.f ? 0.f : var;
                stat[tt * 2] = mean; stat[tt * 2 + 1] = 1.0f / sqrtf(var + LN_EPS); } }
    }
    __syncthreads();
    const float lg = P.conv_ln_g[c], lb = P.conv_ln_b[c];
#pragma unroll
    for (int tt = 0; tt < 32; ++tt) { const float v = (y[tt] - stat[tt * 2]) * stat[tt * 2 + 1] * lg + lb;
        CAT[(size_t)(b * SEQ + t0 + tt) * DM + 512 + c] = (bf16_t)(pk2(fsilu(v), 0.f) & 0xffffu); }
}

DI unsigned swap23(unsigned p) { return (p & ~12u) | ((p & 4u) << 1) | ((p & 8u) >> 1); }
DI void vt_copies(const Params& P, LAS unsigned char* lds, int gw, int NGW, int wave, int lane) {
    unsigned char* ws = P.ws;
    LAS bf16_t* tile = (LAS bf16_t*)(lds + wave * 8448);
    const bf16_t* U = (const bf16_t*)(ws + WS_U);
    for (int it = gw; it < 2 * 8 * 128; it += NGW) { const int which = it >> 10, bg = (it >> 7) & 7, blk = it & 127, b = bg >> 1, gg = bg & 1;
        const bf16_t* src = U + (size_t)(b * SEQ + blk * 64 + lane) * NU + (which ? UVW : UVS) + gg * 64;
#pragma unroll
        for (int q = 0; q < 8; ++q) { const u32x4 v = *(const u32x4*)(src + q * 8); LAS unsigned* tp = (LAS unsigned*)(tile + lane * 66 + q * 8); tp[0] = v.x; tp[1] = v.y; tp[2] = v.z; tp[3] = v.w; }
        LDS_WAIT(); asm volatile("" ::: "memory");
        bf16_t* dst = (bf16_t*)(ws + (which ? WS_VWT : WS_VST)) + ((size_t)(bg * 128 + blk) * 64 + lane) * 64;
#pragma unroll
        for (int q = 0; q < 8; ++q) { unsigned wv[4];
#pragma unroll
            for (int e2 = 0; e2 < 4; ++e2) { const int p0 = q * 8 + e2 * 2; const int k0 = (p0 & ~15) | (int)swap23((unsigned)p0 & 15u), k1 = ((p0 + 1) & ~15) | (int)swap23((unsigned)(p0 + 1) & 15u);
                wv[e2] = (unsigned)tile[k0 * 66 + lane] | ((unsigned)tile[k1 * 66 + lane] << 16); }
            *(u32x4*)(dst + q * 8) = (u32x4){wv[0], wv[1], wv[2], wv[3]}; }
        LDS_WAIT(); asm volatile("" ::: "memory");
    }
}

DI void cmp2_rows(const Params& P, LAS unsigned char* lds, int kv, int row0, int nblk64, int tid) {
    unsigned char* ws = P.ws;
    const float* w2 = kv ? P.w_cmp_v2 : P.w_cmp_k2; LAS float* w2s = (LAS float*)lds;
    __syncthreads();
    for (int i = tid; i < 256 * 64 / 4; i += 512) ((LAS f32x4*)w2s)[i] = ((const f32x4*)w2)[i];
    __syncthreads();
    for (int blk = 0; blk < nblk64; ++blk) {
        const int row = row0 + blk * 64 + (tid >> 3), oc = tid & 7;
        const bf16_t* hrow = (const bf16_t*)(ws + WS_HCMP) + ((size_t)kv * 4096 + row) * 256;
        float acc[8];
#pragma unroll
        for (int j = 0; j < 8; ++j) acc[j] = 0.f;
        for (int k8 = 0; k8 < 32; ++k8) { const u32x4 hv = *(const u32x4*)(hrow + k8 * 8); const unsigned hw[4] = {hv.x, hv.y, hv.z, hv.w};
#pragma unroll
            for (int q = 0; q < 4; ++q) {
#pragma unroll
                for (int hh = 0; hh < 2; ++hh) { const float hval = hh ? bfhi(hw[q]) : bflo(hw[q]); const int k = k8 * 8 + q * 2 + hh;
                    const f32x4 wa = *(const LAS f32x4*)(w2s + k * 64 + oc * 8), wb = *(const LAS f32x4*)(w2s + k * 64 + oc * 8 + 4);
                    acc[0] += hval * wa.x; acc[1] += hval * wa.y; acc[2] += hval * wa.z; acc[3] += hval * wa.w; acc[4] += hval * wb.x; acc[5] += hval * wb.y; acc[6] += hval * wb.z; acc[7] += hval * wb.w; } } }
        const int bg = row >> 9, n = row & 511;
        if (n == 511) {
#pragma unroll
            for (int j = 0; j < 8; ++j) acc[j] = 0.f; }
        if (kv == 0) { u32x4 o; o.x = pk2(acc[0], acc[1]); o.y = pk2(acc[2], acc[3]); o.z = pk2(acc[4], acc[5]); o.w = pk2(acc[6], acc[7]);
            *(u32x4*)((bf16_t*)(ws + WS_KC) + ((size_t)bg * 512 + n) * 64 + oc * 8) = o; }
        else { bf16_t* vt = (bf16_t*)(ws + WS_VCT) + (size_t)bg * 64 * 512; const int pos = (n & ~15) | (int)swap23((unsigned)n & 15u);
#pragma unroll
            for (int j = 0; j < 8; ++j) vt[(size_t)(oc * 8 + j) * 512 + pos] = (bf16_t)(pk2(acc[j], 0.f) & 0xffffu); }
    }
    __syncthreads();
}
DI void phase_cmp2(const Params& P, LAS unsigned char* lds, int vcu, int G, int wave, int lane, int tid) {
    for (int it = vcu; it < 128; it += G) cmp2_rows(P, lds, it >> 6, (it & 63) * 64, 1, tid);
    __syncthreads();
}
namespace attn {
constexpr int ROWB = 144;
constexpr int TROW = 128, TILEB = 64 * TROW;
constexpr int OFF_K = 0, OFF_V = 2 * TILEB, OFF_IMPG = 36864, OFF_IMPL = OFF_IMPG + 32768;
constexpr int OFF_SELM = LDS_TAB, OFF_MREF = LDS_TAB + 1024, OFF_LSUM = LDS_TAB + 2048, OFF_LIST = LDS_TAB + 4096, OFF_TM = LDS_TAB + 6144;
constexpr int OFF_QS = 0, OFF_PBUF = 36864, PSLOT = 32 * ROWB;
constexpr float NEG = -1e30f, MFLOOR = -1e20f;
#define MFMA32(a, b, c) __builtin_amdgcn_mfma_f32_32x32x16_bf16((a), (b), (c), 0, 0, 0)
DI float fexp2(float x) { return __builtin_amdgcn_exp2f(x); }
DI void dma_tile(const bf16_t* base, unsigned pitch, LAS unsigned char* buf, int wave, int lane) {
    const int row = 8 * wave + (lane >> 3), ch = (lane & 7) ^ ((row >> 1) & 7);
    __builtin_amdgcn_global_load_lds((const unsigned*)(base + (unsigned)(row * pitch + ch * 8)), (LAS unsigned*)(buf + wave * 1024), 16, 0, 0); }
DI bf16x8 pack8(const f32x16& p, int s2) { u32x4 w; w.x = pk2(p[8 * s2], p[8 * s2 + 1]); w.y = pk2(p[8 * s2 + 2], p[8 * s2 + 3]); w.z = pk2(p[8 * s2 + 4], p[8 * s2 + 5]); w.w = pk2(p[8 * s2 + 6], p[8 * s2 + 7]); return __builtin_bit_cast(bf16x8, w); }

constexpr int CV_PER_EXPERT = 1536, CV_TOTAL = NEXP * CV_PER_EXPERT;
struct CvState { int next, end, nfly; bool xafter; };
DI LAS unsigned char* cv_buf(LAS unsigned char* lds, int wave, int seq) { return lds + (wave < 4 ? 110592 + wave * 4096 : LDS_TAB + 8192 + (wave - 4) * 4096) + (seq & 1) * 2048; }
DI void cv_issue(const Params& P, CvState& c, LAS unsigned char* lds, int wave, int lane) {
    const int m = c.next, e = m / CV_PER_EXPERT, q = m % CV_PER_EXPERT, mat = q >> 9, w = q & 511;
    LAS unsigned* st = (LAS unsigned*)cv_buf(lds, wave, m);
    if (mat < 2) { const int nb = w >> 7, k0 = (w & 127) * 8;
        const float* src = (mat ? P.w_e_up : P.w_e_gate) + (size_t)e * 1024 * 256 + (size_t)k0 * 256 + nb * 64 + lane;
#pragma unroll
        for (int j = 0; j < 8; ++j) __builtin_amdgcn_global_load_lds((const unsigned*)(src + j * 256), st + j * 64, 4, 0, 0);
    } else { const int nb = w >> 5, k0 = (w & 31) * 8;
        const float* src = P.w_e_down + (size_t)e * 256 * 1024 + (size_t)k0 * 1024 + nb * 64 + lane;
#pragma unroll
        for (int j = 0; j < 8; ++j) __builtin_amdgcn_global_load_lds((const unsigned*)(src + j * 1024), st + j * 64, 4, 0, 0);
    }
    ++c.nfly; ++c.next; c.xafter = true;
}
DI void cv_finish(const Params& P, CvState& c, LAS unsigned char* lds, int wave, int lane) {
    const int m = c.next - c.nfly, e = m / CV_PER_EXPERT, q = m % CV_PER_EXPERT, mat = q >> 9, w = q & 511;
    const LAS float* st = (const LAS float*)cv_buf(lds, wave, m) + lane;
    u32x4 o; o.x = pk2(st[0], st[64]); o.y = pk2(st[128], st[192]); o.z = pk2(st[256], st[320]); o.w = pk2(st[384], st[448]);
    bf16_t* dst;
    if (mat < 2) { const int nb = w >> 7, k0 = (w & 127) * 8, n = nb * 64 + lane;
        dst = (bf16_t*)(P.ws + WS_WGU_T) + (size_t)e * 512 * 1024 + (size_t)((n >> 7) * 256 + mat * 128 + (n & 127)) * 1024 + k0;
    } else { const int nb = w >> 5, k0 = (w & 31) * 8, n = nb * 64 + lane;
        dst = (bf16_t*)(P.ws + WS_WDN_T) + (size_t)e * 1024 * 256 + (size_t)n * 256 + k0; }
    asm volatile("s_waitcnt lgkmcnt(0)" ::: "memory");
    *(u32x4*)dst = o; --c.nfly;
}
template <int MODE>
DI void tile_compute(const LAS unsigned char* Kb, const LAS unsigned char* Vb, const bf16x8 (&qf)[4], int r, int h, int lo, int hi, bool elem,
                     float& m, float& l, f32x16 (&O)[2], float meff_in, float linv, LAS float* impg, LAS float* impl, int sb0) {
    const bool rowfull = (lo <= 0 && hi >= 63);
    const int lo2 = lo - 4 * h, hi2 = hi - 4 * h, swz = (r >> 1) & 7;
#pragma unroll
    for (int kh = 0; kh < 2; ++kh) {
        f32x16 s;
#pragma unroll
        for (int i = 0; i < 16; ++i) s[i] = 0.f;
#pragma unroll
        for (int ks = 0; ks < 4; ++ks) { const bf16x8 a = *(const LAS bf16x8*)(Kb + (32 * kh + r) * TROW + (((2 * ks + h) ^ swz) << 4)); s = MFMA32(a, qf[ks], s); }
        if (elem) {
#pragma unroll
            for (int i = 0; i < 16; ++i) { const int k0 = (i & 3) + 8 * (i >> 2) + 32 * kh; s[i] = (k0 >= lo2 && k0 <= hi2) ? s[i] : NEG; }
        }
        float cref;
        if (MODE != 2) {
            float tm = s[0];
#pragma unroll
            for (int i = 1; i < 16; ++i) tm = fmaxf(tm, s[i]);
            tm = fmaxf(tm, __shfl_xor(tm, 32));
            if (!elem) tm = rowfull ? tm : NEG;
            const bool need = tm > m + 8.0f;
            if (__any(need)) {
                const float mnew = need ? tm : m;
                const float alpha = fexp2(fmaxf(m, MFLOOR) - fmaxf(mnew, MFLOOR));
                l *= alpha; m = mnew;
                if (MODE == 0) {
#pragma unroll
                    for (int i = 0; i < 16; ++i) { O[0][i] *= alpha; O[1][i] *= alpha; } }
            }
            cref = (elem || rowfull) ? fmaxf(m, MFLOOR) : 1e30f;
            float rs = 0.f;
#pragma unroll
            for (int i = 0; i < 16; ++i) { s[i] = fexp2(s[i] - cref); rs += s[i]; }
            rs += __shfl_xor(rs, 32);
            l += rs;
        } else {
            cref = (elem || rowfull) ? meff_in : 1e30f;
#pragma unroll
            for (int i = 0; i < 16; ++i) s[i] = fexp2(s[i] - cref);
        }
        if (MODE == 1) continue;
        if (MODE == 2) {
#pragma unroll
            for (int gq = 0; gq < 4; ++gq) {
                float Gs = ((s[4 * gq] + s[4 * gq + 1]) + (s[4 * gq + 2] + s[4 * gq + 3])) * linv, Ls = s[4 * gq + 3] * linv;
                Gs += __shfl_xor(Gs, 1); Gs += __shfl_xor(Gs, 2); Ls += __shfl_xor(Ls, 1); Ls += __shfl_xor(Ls, 2);
                if ((r & 3) == 0) { const int sb = sb0 + 8 * kh + 2 * gq + h; impg[sb] = Gs; impl[sb] = Ls; } }
        }
#pragma unroll
        for (int s2 = 0; s2 < 2; ++s2) { const bf16x8 pf = pack8(s, s2);
#pragma unroll
            for (int dt = 0; dt < 2; ++dt) { const bf16x8 a = *(const LAS bf16x8*)(Vb + (32 * dt + r) * TROW + (((4 * kh + 2 * s2 + h) ^ swz) << 4));
                O[dt] = MFMA32(a, pf, O[dt]); } }
    }
}

DI void attn_unit(const Params& P, LAS unsigned char* lds, int bg, int qt, int wave, int lane_in, int tid_in, int& it, CvState& cv) {
    int lane = lane_in; asm volatile("" : "+v"(lane));
    const int tid = wave * 64 + lane;
    unsigned char* ws = P.ws;
    const bf16_t* U = (const bf16_t*)(ws + WS_U);
    const int b = bg >> 1, gg = bg & 1, t0 = qt * 64, r = lane & 31, h = lane >> 5, tokl = 8 * wave + (r >> 2), hp = r & 3, t = t0 + tokl;
    LAS float* IMPG = (LAS float*)(lds + OFF_IMPG); LAS float* IMPL = (LAS float*)(lds + OFF_IMPL); LAS unsigned* SELM = (LAS unsigned*)(lds + OFF_SELM);
#define ATT_UROW(name) int lq_ = lane; asm volatile("" : "+v"(lq_)); const bf16_t* name = U + (size_t)(b * SEQ + t0 + 8 * wave + ((lq_ & 31) >> 2)) * NU; const int hq_ = lq_ & 3, hh_ = lq_ >> 5; (void)hq_; (void)hh_;
    bf16x8 qf[4];
#define ATT_LOADQ() do { ATT_UROW(urow_) _Pragma("unroll") for (int ks = 0; ks < 4; ++ks) qf[ks] = *(const bf16x8*)(urow_ + UQ + (4 * gg + hq_) * 64 + 16 * ks + 8 * hh_); } while (0)
    ATT_LOADQ();
    f32x16 OA[2];
#pragma unroll
    for (int i = 0; i < 16; ++i) { OA[0][i] = 0.f; OA[1][i] = 0.f; }
    __syncthreads();
#pragma unroll
    for (int j = 0; j < 4; ++j) { *(LAS f32x4*)(IMPG + 8 * wave * 128 + lane * 4 + 256 * j) = (f32x4){0.f, 0.f, 0.f, 0.f}; *(LAS f32x4*)(IMPL + 8 * wave * 128 + lane * 4 + 256 * j) = (f32x4){0.f, 0.f, 0.f, 0.f}; }
    f32x16 O[2]; float m, l;
#define ATT_RESET() do { m = NEG; l = 0.f; _Pragma("unroll") for (int i = 0; i < 16; ++i) { O[0][i] = 0.f; O[1][i] = 0.f; } } while (0)
#define ATT_FOLD(br) do { ATT_UROW(urow_) const float gate_ = fsigmoid(bf2f(urow_[UGT + gg * 12 + hq_ * 3 + (br)])); const float sc_ = (l > 0.f) ? gate_ / l : 0.f; _Pragma("unroll") for (int i = 0; i < 16; ++i) { OA[0][i] += sc_ * O[0][i]; OA[1][i] += sc_ * O[1][i]; } } while (0)

#define ATT_STEP(CUR, NXT, TI, KPTR, KPITCH, VPTR, VPITCH, USEV, ...) { \
            LAS unsigned char* Kb = lds + OFF_K + (CUR) * TILEB; LAS unsigned char* Vb = lds + OFF_V + (CUR) * TILEB; \
            int nfin_; if (cv.xafter) { asm volatile("s_waitcnt vmcnt(8)" ::: "memory"); nfin_ = cv.nfly - 1; } else { asm volatile("s_waitcnt vmcnt(0)" ::: "memory"); nfin_ = cv.nfly; } \
            for (int f_ = 0; f_ < nfin_; ++f_) cv_finish(P, cv, lds, wave, tz_); \
            asm volatile("s_waitcnt lgkmcnt(0)" ::: "memory"); __builtin_amdgcn_s_barrier(); asm volatile("" ::: "memory"); \
            if ((TI) + 1 < n_) { const int pi = (TI) + 1; dma_tile(KPTR, KPITCH, lds + OFF_K + (NXT) * TILEB, wave, tz_); if (USEV) dma_tile(VPTR, VPITCH, lds + OFF_V + (NXT) * TILEB, wave, tz_); cv.xafter = false; } \
            if (cv.next < cv.end && cv.nfly < 2) cv_issue(P, cv, lds, wave, tz_); \
            { const int ti = (TI); __VA_ARGS__ } ++it; }
#define ATT_LOOP(NTILES, KPTR, KPITCH, VPTR, VPITCH, USEV, ...) { const int n_ = (NTILES); int tz_ = lane; asm volatile("" : "+v"(tz_)); \
        asm volatile("s_waitcnt lgkmcnt(0)" ::: "memory"); __builtin_amdgcn_s_barrier(); asm volatile("" ::: "memory");     \
        if (n_ > 0) { const int pi = 0; dma_tile(KPTR, KPITCH, lds + OFF_K, wave, tz_); if (USEV) dma_tile(VPTR, VPITCH, lds + OFF_V, wave, tz_); cv.xafter = false; } \
        for (int i_ = 0; i_ < n_; i_ += 2) { \
            ATT_STEP(0, 1, i_, KPTR, KPITCH, VPTR, VPITCH, USEV, __VA_ARGS__) \
            if (i_ + 1 < n_) ATT_STEP(1, 0, i_ + 1, KPTR, KPITCH, VPTR, VPITCH, USEV, __VA_ARGS__) } }

    const bf16_t* KC = (const bf16_t*)(ws + WS_KC) + (size_t)bg * 512 * 64; const bf16_t* VCT = (const bf16_t*)(ws + WS_VCT) + (size_t)bg * 64 * 512;
    const int hin = (t - 31) >> 4;
    const int ntc = (((t0 + 32) >> 4) >> 6) + 1;
    ATT_RESET();
    ATT_LOOP(ntc, KC + (size_t)pi * 64 * 64, 64, KC, 64, false, {
        const int hi = hin - 64 * ti; const bool fe = (hi >= 63) || (hi < 0);
        if (!__all(hi < 0)) tile_compute<1>(Kb, Kb, qf, r, h, 0, hi, !__all(fe), m, l, O, 0.f, 0.f, nullptr, nullptr, 0); })
    {
        const float meff = fmaxf(m, MFLOOR), linv = (l > 0.f) ? 1.0f / l : 0.f;
        ATT_LOOP(ntc, KC + (size_t)pi * 64 * 64, 64, VCT + pi * 64, 512, true, {
            const int hi = hin - 64 * ti; const bool fe = (hi >= 63) || (hi < 0);
            float md = m, ld_ = l;
            if (!__all(hi < 0)) tile_compute<2>(Kb, Vb, qf, r, h, 0, hi, !__all(fe), md, ld_, O, meff, linv, IMPG + tokl * 128, IMPL + tokl * 128, 16 * ti); })
        ATT_FOLD(0);
    }
    for (int tk = 0; tk < 8; ++tk) { const int trow = 8 * wave + tk;
        const float ilo = IMPG[trow * 128 + lane] + (lane > 0 ? IMPL[trow * 128 + lane - 1] : 0.f), ihi = IMPG[trow * 128 + 64 + lane] + IMPL[trow * 128 + 63 + lane];
        const int slo = lane, shi = 64 + lane;
        const bool clo = slo <= qt, chi = shi <= qt, flo = (slo == 0) || (slo == qt) || (slo + 1 == qt), fhi = (shi == qt) || (shi + 1 == qt);
        const unsigned klo = clo ? ((flo ? 0xFFFFFF80u : (__float_as_uint(ilo) & 0xFFFFFF80u)) | (unsigned)(127 - slo)) : 0u;
        const unsigned khi = chi ? ((fhi ? 0xFFFFFF80u : (__float_as_uint(ihi) & 0xFFFFFF80u)) | (unsigned)(127 - shi)) : 0u;
        unsigned T = 0u;
        for (int bit = 31; bit >= 0; --bit) { const unsigned cand = T | (1u << bit);
            const int cnt = __popcll(__ballot(klo >= cand)) + __popcll(__ballot(khi >= cand)); if (cnt >= 16) T = cand; }
        const unsigned long long blo = __ballot(klo >= T && klo != 0u), bhi = __ballot(khi >= T && khi != 0u);
        if (lane == 0) { *(LAS u32x4*)(SELM + trow * 4) = (u32x4){(unsigned)blo, (unsigned)(blo >> 32), (unsigned)bhi, (unsigned)(bhi >> 32)}; }
    }
    { int lp_ = lane; asm volatile("" : "+v"(lp_)); float* oapark = (float*)(ws + WS_HIDM) + ((size_t)(blockIdx.x * 8 + wave) * 32) * 64 + lp_;
#pragma unroll
      for (int i = 0; i < 16; ++i) { oapark[i * 64] = OA[0][i]; oapark[(16 + i) * 64] = OA[1][i]; } }
    ATT_RESET();
    const bf16_t* KS = U + (size_t)(b * SEQ) * NU + UKS + gg * 64; const bf16_t* VST = (const bf16_t*)(ws + WS_VST) + (size_t)bg * 128 * 4096;
    constexpr int QT_COMPACT = 96;
    if (qt < QT_COMPACT) {
        const u32x4 selw = *(const LAS u32x4*)(SELM + tokl * 4);
        ATT_LOOP(qt + 1, KS + (size_t)pi * 64 * NU, NU, VST + (size_t)pi * 4096, 64, true, {
            const int j = ti;
            const unsigned wsel = (j < 32) ? selw.x : (j < 64) ? selw.y : (j < 96) ? selw.z : selw.w; const bool sel = (wsel >> (j & 31)) & 1u;
            const int hi = !sel ? -1 : (j == qt ? tokl : 63);
            if (!__all(!sel)) tile_compute<0>(Kb, Vb, qf, r, h, 0, hi, j == qt, m, l, O, 0.f, 0.f, nullptr, nullptr, 0); })
    } else {
        {
#define JMAP(i) ((i) == 0 ? 0 : qt - (2 - (i)))
            ATT_LOOP(3, KS + (size_t)JMAP(pi) * 64 * NU, NU, VST + (size_t)JMAP(pi) * 4096, 64, true, {
                const int j = JMAP(ti);
                tile_compute<0>(Kb, Vb, qf, r, h, 0, (j == qt ? tokl : 63), j == qt, m, l, O, 0.f, 0.f, nullptr, nullptr, 0); })
#undef JMAP
        }
        int lz = lane; asm volatile("" : "+v"(lz));
        const int r = lz & 31, h = lz >> 5, hp = r & 3, tokl = 8 * wave + (r >> 2), lane = lz, tid = wave * 64 + lz;
        LAS unsigned char* Qs = lds + OFF_QS; LAS float* MREF = (LAS float*)(lds + OFF_MREF); LAS float* LSUM = (LAS float*)(lds + OFF_LSUM); LAS int* LIST = (LAS int*)(lds + OFF_LIST) + wave * 64;
        LAS unsigned long long* TM = (LAS unsigned long long*)(lds + OFF_TM);
        if (h == 0) MREF[32 * wave + r] = fmaxf(m, MFLOOR);
        for (int j = wave; j < 128; j += 8) { const unsigned long long mk = __ballot((SELM[lane * 4 + (j >> 5)] >> (j & 31)) & 1u); if (lane == 0) TM[j] = mk; }
        __syncthreads();
#pragma unroll
        for (int q4 = 0; q4 < 4; ++q4) { const int ch = tid + 512 * q4, row = ch >> 3, c8 = ch & 7;
            *(LAS u32x4*)(Qs + row * ROWB + c8 * 16) = *(const u32x4*)(U + (size_t)(b * SEQ + t0 + (row >> 2)) * NU + UQ + (4 * gg + (row & 3)) * 64 + c8 * 8); }
        __syncthreads();
        const int jend = qt - 2; int jn = 1, rk = 0;
        const unsigned long long ltl = (1ull << tokl) - 1ull;
        int pjs = 0, pcnt = 0;
#define FAR_TM(dst, jj) { const unsigned long long tv_ = TM[(jj) <= jend ? (jj) : 0]; const unsigned lo_ = __builtin_amdgcn_readfirstlane((unsigned)tv_), hi_ = __builtin_amdgcn_readfirstlane((unsigned)(tv_ >> 32)); \
            dst = ((jj) <= jend) ? (((unsigned long long)hi_ << 32) | lo_) : 0ull; }
        for (;;) {
            int cnt = 0, used = 0, myj = -1, myc = 0; unsigned long long mymask = 0ull;
#pragma unroll
            for (int i = 0; i < 8; ++i) { const int jj = jn + i; unsigned long long mk; FAR_TM(mk, jj) const int nch = (__popcll(mk) + 7) >> 3;
                const bool take = (cnt == i) && (jj <= jend) && (used + nch <= 8);
                if (take) { if (wave >= used && wave < used + nch) { myj = jj; myc = wave - used; mymask = mk; } used += nch; ++cnt; } }
            if (cnt == 0 && pcnt == 0) break;
            const int cjs = jn; jn += cnt;
            bf16x8 kf[2][4], vf[2][4];
            if (myj >= 0) { const bf16_t* Kg = KS + (size_t)(myj * 64 + r) * NU + 8 * h; const bf16_t* Vg = VST + (size_t)myj * 4096 + r * 64 + 8 * h;
#pragma unroll
                for (int kh = 0; kh < 2; ++kh)
#pragma unroll
                    for (int ks = 0; ks < 4; ++ks) { kf[kh][ks] = *(const bf16x8*)(Kg + (size_t)(32 * kh) * NU + 16 * ks); vf[kh][ks] = *(const bf16x8*)(Vg + kh * 32 * 64 + ks * 16); } }
            if (pcnt > 0) { int base = 0;
#pragma unroll
                for (int i = 0; i < 8; ++i) { unsigned long long mk; FAR_TM(mk, pjs + i) if (i >= pcnt) mk = 0ull; const int nch = (__popcll(mk) + 7) >> 3;
                    const bool act = (mk >> tokl) & 1ull;
                    if (__any(act)) { const int rank = __popcll(mk & ltl), slot = base + (rank >> 3), prow = (rank & 7) * 4 + hp;
                        const LAS unsigned char* Pb = lds + OFF_PBUF + (((rk + 1) & 1) * 8 + slot) * PSLOT + prow * ROWB + h * 8;
#pragma unroll
                        for (int dt = 0; dt < 2; ++dt)
#pragma unroll
                            for (int gq = 0; gq < 4; ++gq) { u32x2 w = *(const LAS u32x2*)(Pb + (32 * dt + 8 * gq) * 2); if (!act) w = (u32x2){0u, 0u};
                                O[dt][4 * gq] += bflo(w.x); O[dt][4 * gq + 1] += bfhi(w.x); O[dt][4 * gq + 2] += bflo(w.y); O[dt][4 * gq + 3] += bfhi(w.y); }
                        l += act ? LSUM[(((rk + 1) & 1) * 8 + slot) * 32 + prow] : 0.f; }
                    base += nch; } }
            if (myj >= 0) {
                LAS unsigned char* Pw = lds + OFF_PBUF + ((rk & 1) * 8 + wave) * PSLOT;
                if ((mymask >> lane) & 1ull) LIST[__popcll(mymask & ((1ull << lane) - 1ull))] = lane;
                const int rank = 8 * myc + (r >> 2); const bool valid = rank < __popcll(mymask);
                const int tok = valid ? LIST[rank] : 0; const int qrow = tok * 4 + hp;
                bf16x8 qg[4];
#pragma unroll
                for (int ks = 0; ks < 4; ++ks) qg[ks] = *(const LAS bf16x8*)(Qs + qrow * ROWB + ks * 32 + h * 16);
                const float mr = MREF[qrow];
                float rs = 0.f; f32x16 Oc[2];
#pragma unroll
                for (int i = 0; i < 16; ++i) { Oc[0][i] = 0.f; Oc[1][i] = 0.f; }
#pragma unroll
                for (int kh = 0; kh < 2; ++kh) { f32x16 sv;
#pragma unroll
                    for (int i = 0; i < 16; ++i) sv[i] = 0.f;
#pragma unroll
                    for (int ks = 0; ks < 4; ++ks) sv = MFMA32(kf[kh][ks], qg[ks], sv);
#pragma unroll
                    for (int i = 0; i < 16; ++i) { sv[i] = valid ? fexp2(fminf(sv[i] - mr, 100.0f)) : 0.f; rs += sv[i]; }
#pragma unroll
                    for (int s2 = 0; s2 < 2; ++s2) { const bf16x8 pf = pack8(sv, s2);
                        Oc[0] = MFMA32(vf[0][kh * 2 + s2], pf, Oc[0]); Oc[1] = MFMA32(vf[1][kh * 2 + s2], pf, Oc[1]); } }
                rs += __shfl_xor(rs, 32);
                if (h == 0) LSUM[((rk & 1) * 8 + wave) * 32 + r] = rs;
#pragma unroll
                for (int dt = 0; dt < 2; ++dt)
#pragma unroll
                    for (int gq = 0; gq < 4; ++gq) { u32x2 w; w.x = pk2(Oc[dt][4 * gq], Oc[dt][4 * gq + 1]); w.y = pk2(Oc[dt][4 * gq + 2], Oc[dt][4 * gq + 3]);
                        *(LAS u32x2*)(Pw + r * ROWB + (32 * dt + 8 * gq + 4 * h) * 2) = w; }
            }
            __syncthreads();
            pjs = cjs; pcnt = cnt; ++rk;
        }
#undef FAR_TM
    }
    { int lp_ = lane; asm volatile("" : "+v"(lp_)); const float* oapark = (const float*)(ws + WS_HIDM) + ((size_t)(blockIdx.x * 8 + wave) * 32) * 64 + lp_;
#pragma unroll
      for (int i = 0; i < 16; ++i) { OA[0][i] = oapark[i * 64]; OA[1][i] = oapark[(16 + i) * 64]; } }
    ATT_FOLD(1);
    ATT_LOADQ();
    ATT_RESET();
    {
        int lw_ = lane; asm volatile("" : "+v"(lw_)); const int r = lw_ & 31, h = lw_ >> 5, tokl = 8 * wave + (r >> 2);
        const int jlo = qt >= 8 ? qt - 8 : 0;
        const bf16_t* KW = U + (size_t)(b * SEQ + jlo * 64) * NU + UKW + gg * 64; const bf16_t* VWT = (const bf16_t*)(ws + WS_VWT) + ((size_t)bg * 128 + jlo) * 4096;
        ATT_LOOP(qt - jlo + 1, KW + (size_t)pi * 64 * NU, NU, VWT + (size_t)pi * 4096, 64, true, {
            const int j = jlo + ti;
            const bool low = (j + 8 == qt), diag = (j == qt);
            const int lo = low ? tokl + 1 : 0, hi = diag ? tokl : 63;
            tile_compute<0>(Kb, Vb, qf, r, h, lo, hi, low || diag, m, l, O, 0.f, 0.f, nullptr, nullptr, 0); })
        ATT_FOLD(2);
    }
    int lo_ = lane; asm volatile("" : "+v"(lo_)); const int h_o = lo_ >> 5;
    bf16_t* orow = (bf16_t*)(ws + WS_CAT) + (size_t)(b * SEQ + t0 + 8 * wave + ((lo_ & 31) >> 2)) * DM + (4 * gg + (lo_ & 3)) * 64;
#pragma unroll
    for (int dt = 0; dt < 2; ++dt)
#pragma unroll
        for (int gq = 0; gq < 4; ++gq) { u32x2 w; w.x = pk2(OA[dt][4 * gq], OA[dt][4 * gq + 1]); w.y = pk2(OA[dt][4 * gq + 2], OA[dt][4 * gq + 3]);
            *(u32x2*)(orow + 32 * dt + 8 * gq + 4 * h_o) = w; }
#undef ATT_RESET
#undef ATT_FOLD
#undef ATT_LOADQ
#undef ATT_UROW
#undef ATT_LOOP
#undef ATT_STEP
}

DI void attn_phase(const Params& P, LAS unsigned char* lds, int vcu, int G, int wave, int lane, int tid) {
    int it = 0;
    CvState cv; { const int per = CV_TOTAL / (G * 8), gw = vcu * 8 + wave; cv.next = gw * per; cv.end = (gw == G * 8 - 1) ? CV_TOTAL : cv.next + per; cv.nfly = 0; cv.xafter = false; }
    static constexpr unsigned char QT_TAB[32][4] = {{14,37,91,127},{30,44,68,126},{31,35,77,100},{23,48,69,125},{27,40,76,99},{10,53,79,124},{17,38,85,123},{19,32,89,122},{20,33,87,121},{29,43,70,120},{21,54,66,107},{0,58,90,119},{25,42,75,118},{22,47,74,106},{18,34,88,117},{3,51,92,105},{15,56,71,116},{11,39,93,98},{9,49,82,115},{28,36,78,114},{24,52,64,113},{16,41,84,104},{5,46,95,97},{4,59,81,112},{26,50,65,103},{8,62,72,111},{6,45,94,102},{7,55,80,96},{2,61,83,110},{13,63,67,101},{1,60,86,109},{12,57,73,108}};
    if (G == 256) {
        const int bg = vcu >> 5, s = vcu & 31;
        for (int k = 3; k >= 0; --k) { const int qt = (k == 0) ? QT_TAB[s][0] : (k == 1) ? QT_TAB[s][1] : (k == 2) ? QT_TAB[s][2] : QT_TAB[s][3]; attn_unit(P, lds, bg, qt, wave, lane, tid, it, cv); }
    } else {
        for (int ui = vcu; ui < 1024; ui += G) { const int k = ui >> 8, v = ui & 255, bg = v >> 5, s = v & 31;
            const int qt = (k == 0) ? s : (k == 1) ? 63 - s : (k == 2) ? 64 + s : 127 - s;
            attn_unit(P, lds, bg, qt, wave, lane, tid, it, cv); }
    }
    for (;;) {
        if (cv.nfly > 0) { asm volatile("s_waitcnt vmcnt(0)" ::: "memory"); while (cv.nfly > 0) cv_finish(P, cv, lds, wave, lane); }
        if (cv.next >= cv.end) break;
        cv_issue(P, cv, lds, wave, lane); if (cv.next < cv.end) cv_issue(P, cv, lds, wave, lane); }
    __syncthreads();
}
}
#ifndef CHECK_ATTN
#define CHECK_ATTN 0
#endif
#if CHECK_ATTN
constexpr int CW_ERR = 8192;
namespace attnchk {
DI float wmax(float v) {
#pragma unroll
    for (int o = 1; o < 64; o <<= 1) v = fmaxf(v, __shfl_xor(v, o));
    return v; }
DI void item(const Params& P, LAS float* scr, int bg, int t, int lane, float& se, float& sr) {
    unsigned char* ws = P.ws; const bf16_t* U = (const bf16_t*)(ws + WS_U);
    const int b = bg >> 1, gg = bg & 1;
    LAS float* q = scr; LAS float* pc = scr + 256; LAS float* sc = scr + 768;
    const bf16_t* urow = U + (size_t)(b * SEQ + t) * NU;
    for (int i = lane; i < 256; i += 64) q[i] = bf2f(urow[UQ + gg * 256 + i]);
    const bf16_t* KC = (const bf16_t*)(ws + WS_KC) + (size_t)bg * 512 * 64; const bf16_t* VCT = (const bf16_t*)(ws + WS_VCT) + (size_t)bg * 64 * 512;
    const int nvalid = t >= 31 ? ((t - 31) >> 4) + 1 : 0, cur = t >> 6;
    float oc[4], os[4], ow[4], imp0 = 0.f, imp1 = 0.f;
    for (int p = 0; p < 4; ++p) {
        float sv[8], mx = -3e38f;
        for (int i = 0; i < 8; ++i) { const int n = lane + 64 * i; float a = 0.f;
            if (n < nvalid) { for (int d = 0; d < 64; ++d) a += q[p * 64 + d] * bf2f(KC[n * 64 + d]); mx = fmaxf(mx, a); }
            sv[i] = a; }
        mx = wmax(mx); float ls = 0.f;
        for (int i = 0; i < 8; ++i) { const int n = lane + 64 * i; const float e = (n < nvalid) ? exp2f(sv[i] - mx) : 0.f; sv[i] = e; ls += e; }
        ls = wave_sum(ls); const float inv = ls > 0.f ? 1.f / ls : 0.f;
        for (int i = 0; i < 8; ++i) pc[lane + 64 * i] = sv[i] * inv;
        float o = 0.f;
        for (int n = 0; n < nvalid; ++n) { const int pos = (n & ~15) | (int)swap23((unsigned)n & 15u); o += pc[n] * bf2f(VCT[lane * 512 + pos]); }
        oc[p] = o;
        for (int k = -1; k <= 3; ++k) { const int n0 = 4 * lane + k, n1 = 4 * (lane + 64) + k;
            if (n0 >= 0 && n0 < nvalid) imp0 += pc[n0]; if (n1 < nvalid) imp1 += pc[n1]; }
    }
    const float INF = __builtin_inff();
    const int s0 = lane, s1 = lane + 64;
    const float v0 = (s0 == 0 || s0 == cur || s0 == cur - 1) ? INF : (s0 <= cur ? imp0 : -INF);
    const float v1 = (s1 == cur || s1 == cur - 1) ? INF : (s1 <= cur ? imp1 : -INF);
    int r0 = 0, r1 = 0;
    for (int j = 0; j < 128; ++j) { const float vj = (j < 64) ? __shfl(v0, j) : __shfl(v1, j - 64);
        r0 += (vj > v0 || (vj == v0 && j < s0)) ? 1 : 0; r1 += (vj > v1 || (vj == v1 && j < s1)) ? 1 : 0; }
    const unsigned long long m0 = __ballot(r0 < 16 && v0 > -INF), m1 = __ballot(r1 < 16 && v1 > -INF);
    for (int br = 0; br < 2; ++br) {
        const bf16_t* Kp = U + (size_t)(b * SEQ) * NU + (br ? UKW : UKS) + gg * 64; const bf16_t* Vp = U + (size_t)(b * SEQ) * NU + (br ? UVW : UVS) + gg * 64;
        for (int p = 0; p < 4; ++p) {
            int nk = 0; float mx = -3e38f;
            if (br == 0) {
                for (int j = 0; j < 128; ++j) { const bool on = (j < 64) ? ((m0 >> j) & 1ull) : ((m1 >> (j - 64)) & 1ull); if (!on) continue;
                    const int key = 64 * j + lane; float a = -3e38f;
                    if (key <= t) { a = 0.f; for (int d = 0; d < 64; ++d) a += q[p * 64 + d] * bf2f(Kp[(size_t)key * NU + d]); mx = fmaxf(mx, a); }
                    sc[nk * 64 + lane] = a; ++nk; }
            } else {
                for (int i = 0; i < 8; ++i) { const int key = t - 511 + lane + 64 * i; float a = -3e38f;
                    if (key >= 0 && key <= t) { a = 0.f; for (int d = 0; d < 64; ++d) a += q[p * 64 + d] * bf2f(Kp[(size_t)key * NU + d]); mx = fmaxf(mx, a); }
                    sc[i * 64 + lane] = a; }
                nk = 8;
            }
            mx = wmax(mx); float ls = 0.f;
            for (int i = 0; i < nk; ++i) { const float a = sc[i * 64 + lane]; const float e = (a > -1e38f) ? exp2f(a - mx) : 0.f; sc[i * 64 + lane] = e; ls += e; }
            ls = wave_sum(ls); const float inv = ls > 0.f ? 1.f / ls : 0.f;
            float o = 0.f;
            if (br == 0) { int idx = 0;
                for (int j = 0; j < 128; ++j) { const bool on = (j < 64) ? ((m0 >> j) & 1ull) : ((m1 >> (j - 64)) & 1ull); if (!on) continue;
                    for (int kk = 0; kk < 64; ++kk) { const float pv = sc[idx * 64 + kk]; if (pv != 0.f) o += pv * bf2f(Vp[(size_t)(64 * j + kk) * NU + lane]); }
                    ++idx; }
                os[p] = o * inv;
            } else {
                for (int i = 0; i < 8; ++i) for (int kk = 0; kk < 64; ++kk) { const int key = t - 511 + kk + 64 * i; const float pv = sc[i * 64 + kk]; if (pv != 0.f) o += pv * bf2f(Vp[(size_t)key * NU + lane]); }
                ow[p] = o * inv;
            }
        }
    }
    const bf16_t* cat = (const bf16_t*)(ws + WS_CAT) + (size_t)(b * SEQ + t) * DM;
    for (int p = 0; p < 4; ++p) {
        const float g0 = fsigmoid(bf2f(urow[UGT + gg * 12 + p * 3 + 0])), g1 = fsigmoid(bf2f(urow[UGT + gg * 12 + p * 3 + 1])), g2 = fsigmoid(bf2f(urow[UGT + gg * 12 + p * 3 + 2]));
        const float ref = g0 * oc[p] + g1 * os[p] + g2 * ow[p], got = bf2f(cat[(4 * gg + p) * 64 + lane]);
        se += (ref - got) * (ref - got); sr += ref * ref; }
}
DI void phase(const Params& P, LAS unsigned char* lds, int vcu, int G, int wave, int lane) {
    LAS float* scr = (LAS float*)(lds + wave * 8192);
    float se = 0.f, sr = 0.f;
    for (int it = vcu * 8 + wave; it < 8 * SEQ; it += G * 8) { const int bg = it / SEQ, t = it % SEQ; item(P, scr, bg, t, lane, se, sr); }
    se = wave_sum(se); sr = wave_sum(sr);
    if (lane == 0) { atomicAdd((float*)(P.ws + WS_CTL) + CW_ERR, se); atomicAdd((float*)(P.ws + WS_CTL) + CW_ERR + 1, sr); }
}
}
#endif
DI void phase_ln1(const Params& P, int vcu, int G, int wave, int lane, bf16_t* x1base) {
    const float* mod = (const float*)(P.ws + WS_MOD);
    for (int mrow = vcu * 8 + wave; mrow < NT; mrow += G * 8) { const int b = mrow / SEQ;
        const u32x2* vr = (const u32x2*)((const bf16_t*)(P.ws + WS_V1) + (size_t)mrow * DM) + lane; f32x4 v[4]; float s = 0.f;
#pragma unroll
        for (int j = 0; j < 4; ++j) { const u32x2 q = vr[64 * j]; v[j] = (f32x4){bflo(q.x), bfhi(q.x), bflo(q.y), bfhi(q.y)}; s += (v[j].x + v[j].y) + (v[j].z + v[j].w); }
        const float mean = wave_sum(s) * (1.f / DM); float s2 = 0.f;
#pragma unroll
        for (int j = 0; j < 4; ++j) { v[j] = v[j] - mean; s2 += (v[j].x * v[j].x + v[j].y * v[j].y) + (v[j].z * v[j].z + v[j].w * v[j].w); }
        const float rstd = 1.f / sqrtf(wave_sum(s2) * (1.f / DM) + LN_EPS);
        unsigned long long* o8 = (unsigned long long*)((bf16_t*)(P.ws + WS_H2) + (size_t)mrow * DM) + lane;
        unsigned long long* x8 = (unsigned long long*)(x1base + (size_t)mrow * DM) + lane;
#pragma unroll
        for (int j = 0; j < 4; ++j) { const int c0 = 4 * lane + 256 * j;
            const f32x4 g = *(const f32x4*)(P.ln1_g + c0), bb = *(const f32x4*)(P.ln1_b + c0);
            const f32x4 sh = *(const f32x4*)(mod + b * 6144 + 3 * 1024 + c0), sc = *(const f32x4*)(mod + b * 6144 + 4 * 1024 + c0);
            const f32x4 x1 = v[j] * rstd * g + bb;
            x8[64 * j] = (unsigned long long)pk2(x1.x, x1.y) | ((unsigned long long)pk2(x1.z, x1.w) << 32);
            const f32x4 y = x1 * (sc + 1.0f) + sh;
            o8[64 * j] = (unsigned long long)pk2(y.x, y.y) | ((unsigned long long)pk2(y.z, y.w) << 32); }
    }
}

DI unsigned f2ord(float f) { const unsigned u = __float_as_uint(f); return (u & 0x80000000u) ? ~u : (u | 0x80000000u); }
DI void phase_route(const Params& P, LAS unsigned char* lds, int vcu, int G, int wave, int lane, int tid) {
    unsigned char* ws = P.ws;
    LAS int* hist = (LAS int*)lds;
    const float* logit = (const float*)(ws + WS_LOGIT);
    int* tok_e = (int*)(ws + WS_TOKE); float* tok_w = (float*)(ws + WS_TOKW); int* lrank = (int*)(ws + WS_LRANK);
    { int* rt = (int*)(ws + WS_ROWTOK); for (int i = vcu * 512 + tid; i < NPAD_MAX; i += G * 512) rt[i] = 0; }
    const int hh = lane >> 5;
    float bias[4];
#pragma unroll
    for (int k = 0; k < 4; ++k) bias[k] = P.router_bias[lane + 64 * k];
    const int tpw = NT / G;
    for (int base = vcu * tpw; base < NT; base += G * tpw) {
        __syncthreads();
        if (tid < 256) hist[tid] = 0;
        __syncthreads();
        for (int tq = wave; tq < tpw; tq += 8) { const int tkn = base + tq;
            float s[4], sel[4];
#pragma unroll
            for (int k = 0; k < 4; ++k) { s[k] = fsigmoid(logit[(size_t)tkn * 256 + lane + 64 * k]); sel[k] = s[k] + bias[k]; }
            float t1[4], t2[4];
#pragma unroll
            for (int k = 0; k < 4; ++k) { t1[k] = sel[k]; t2[k] = -3.0e38f; }
#pragma unroll
            for (int o = 1; o < 32; o <<= 1) {
#pragma unroll
                for (int k = 0; k < 4; ++k) { const float a1 = __shfl_xor(t1[k], o), a2 = __shfl_xor(t2[k], o);
                    const float n1 = fmaxf(t1[k], a1), n2 = fmaxf(fminf(t1[k], a1), fmaxf(t2[k], a2)); t1[k] = n1; t2[k] = n2; } }
            float gs[8];
#pragma unroll
            for (int k = 0; k < 4; ++k) { const float mine = t1[k] + t2[k], oth = __shfl_xor(mine, 32); gs[2 * k] = hh ? oth : mine; gs[2 * k + 1] = hh ? mine : oth; }
            bool gsel[8];
#pragma unroll
            for (int a = 0; a < 8; ++a) { int rk = 0;
#pragma unroll
                for (int c2 = 0; c2 < 8; ++c2) rk += (gs[c2] > gs[a] || (gs[c2] == gs[a] && c2 < a)) ? 1 : 0;
                gsel[a] = rk < 4; }
            unsigned key[4];
#pragma unroll
            for (int k = 0; k < 4; ++k) { const bool on = hh ? gsel[2 * k + 1] : gsel[2 * k]; key[k] = on ? f2ord(sel[k]) : 0u; }
            unsigned T = 0u;
            for (int bit = 31; bit >= 0; --bit) { const unsigned cand = T | (1u << bit); int cnt = 0;
#pragma unroll
                for (int k = 0; k < 4; ++k) cnt += __popcll(__ballot(key[k] >= cand));
                if (cnt >= 8) T = cand; }
            int ngt = 0;
#pragma unroll
            for (int k = 0; k < 4; ++k) ngt += __popcll(__ballot(key[k] > T));
            int need = 8 - ngt, npos = 0; const unsigned long long ltmask = (1ull << lane) - 1ull;
            bool chosen[4]; int pos[4];
#pragma unroll
            for (int k = 0; k < 4; ++k) { const unsigned long long eq = __ballot(key[k] == T), gt = __ballot(key[k] > T);
                const int myeq = __popcll(eq & ltmask); const bool ceq = (key[k] == T) && (myeq < need);
                chosen[k] = (key[k] > T) || ceq;
                const unsigned long long cm = __ballot(chosen[k]); pos[k] = npos + __popcll(cm & ltmask); npos += __popcll(cm);
                const int neq = __popcll(eq); need = need > neq ? need - neq : 0; (void)gt; }
            float ssum = 0.f;
#pragma unroll
            for (int k = 0; k < 4; ++k) ssum += chosen[k] ? s[k] : 0.f;
            ssum = wave_sum(ssum);
            const float wn = 2.5f / ssum;
#pragma unroll
            for (int k = 0; k < 4; ++k) if (chosen[k]) { const int e = lane + 64 * k; const int lr = __hip_atomic_fetch_add(hist + e, 1, __ATOMIC_RELAXED, __HIP_MEMORY_SCOPE_WORKGROUP);
                tok_e[tkn * 8 + pos[k]] = e; tok_w[tkn * 8 + pos[k]] = s[k] * wn; lrank[tkn * 8 + pos[k]] = lr; }
        }
        __syncthreads();
        if (tid < 256) ((int*)(ws + WS_HIST))[(base / tpw) * 256 + tid] = hist[tid];
    }
    __syncthreads();
}

DI void phase_scatter(const Params& P, LAS unsigned char* lds, int vcu, int G, int wave, int lane, int tid) {
    unsigned char* ws = P.ws;
    LAS int* sbase = (LAS int*)lds; LAS int* spad = sbase + 256; LAS int* sstart = spad + 256;
    const unsigned* hist = (const unsigned*)(ws + WS_HIST);
    const int* tok_e = (const int*)(ws + WS_TOKE); const int* lrank = (const int*)(ws + WS_LRANK);
    int* rowtok = (int*)(ws + WS_ROWTOK); int* pos_of = (int*)(ws + WS_POSOF); int* blk_e = (int*)(ws + WS_BLKE);
    const int tpw = NT / G, nslots = NT / tpw;
    for (int base = vcu * tpw; base < NT; base += G * tpw) { const int slot = base / tpw;
        __syncthreads();
        if (tid < 256) { int tot = 0, below = 0;
            for (int w2 = 0; w2 < nslots; ++w2) { const int hv = (int)hist[w2 * 256 + tid]; tot += hv; below += (w2 < slot) ? hv : 0; }
            spad[tid] = (tot + 255) & ~255; sbase[tid] = below; }
        __syncthreads();
        if (tid == 0) { int run = 0; for (int e = 0; e < 256; ++e) { sstart[e] = run; run += spad[e]; } sstart[256] = run; }
        __syncthreads();
        for (int i = tid; i < tpw * 8; i += 512) { const int a = base * 8 + i; const int e = tok_e[a]; const int pos = sstart[e] + sbase[e] + lrank[a];
            rowtok[pos] = a >> 3; pos_of[a] = pos; }
        if (slot == 0) {
            if (tid < 256) { const int b0 = sstart[tid] >> 8, b1 = (sstart[tid] + spad[tid]) >> 8; for (int bb = b0; bb < b1; ++bb) blk_e[bb] = tid; }
            if (tid == 0) blk_e[NBLK_MAX] = sstart[256] >> 8;
        }
    }
    __syncthreads();
}

DI void phase_final(const Params& P, int vcu, int G, int wave, int lane, float* dstbase) {
    unsigned char* ws = P.ws;
    const float* mod = (const float*)(ws + WS_MOD);
    const int* pos_of = (const int*)(ws + WS_POSOF); const float* tok_w = (const float*)(ws + WS_TOKW);
    const unsigned char* Y = (const unsigned char*)(ws + WS_YMOE);
    float dbg_scale = 1.0f;
#if CHECK_ATTN
    { const float se = __uint_as_float(ld_u32_agent((const unsigned*)(ws + WS_CTL) + CW_ERR)), sr = __uint_as_float(ld_u32_agent((const unsigned*)(ws + WS_CTL) + CW_ERR + 1)); const float err = sqrtf(se / fmaxf(sr, 1e-30f)); dbg_scale = 1.0f + (err < 0.005f ? 0.f : err < 0.02f ? 0.04f : err < 0.08f ? 0.055f : err < 0.3f ? 0.07f : 0.085f); }
#endif
    for (int mrow = vcu * 8 + wave; mrow < NT; mrow += G * 8) { const int b = mrow / SEQ;
        const u32x2* xr = (const u32x2*)((const bf16_t*)(ws + WS_X1) + (size_t)mrow * DM) + lane; const u32x2* sr = (const u32x2*)((const bf16_t*)(ws + WS_SH) + (size_t)mrow * DM) + lane; f32x4 v[4], ya[4];
#pragma unroll
        for (int j = 0; j < 4; ++j) { const u32x2 q = xr[64 * j], q2 = sr[64 * j]; v[j] = (f32x4){bflo(q.x), bfhi(q.x), bflo(q.y), bfhi(q.y)} * DN_ALPHA; ya[j] = (f32x4){bflo(q2.x), bfhi(q2.x), bflo(q2.y), bfhi(q2.y)}; }
        const int mypos = pos_of[(size_t)mrow * 8 + (lane & 7)]; const float myw = tok_w[(size_t)mrow * 8 + (lane & 7)];
#pragma unroll
        for (int k = 0; k < 8; ++k) { const int pos = __shfl(mypos, k); const float wk = __shfl(myw, k) * (1.0f / YMOE_SCALE);
            const unsigned* yr = (const unsigned*)(Y + (size_t)pos * DM) + lane;
#pragma unroll
            for (int j = 0; j < 4; ++j) { const int q = (int)yr[64 * j]; const f32x2 lo = __builtin_amdgcn_cvt_pk_f32_fp8(q, false), hi = __builtin_amdgcn_cvt_pk_f32_fp8(q, true);
                ya[j].x += wk * lo.x; ya[j].y += wk * lo.y; ya[j].z += wk * hi.x; ya[j].w += wk * hi.y; } }
        float s = 0.f;
#pragma unroll
        for (int j = 0; j < 4; ++j) { const f32x4 g2 = *(const f32x4*)(mod + b * 6144 + 5 * 1024 + 4 * lane + 256 * j); v[j] = v[j] + g2 * ya[j]; s += (v[j].x + v[j].y) + (v[j].z + v[j].w); }
        const float mean = wave_sum(s) * (1.f / DM); float s2 = 0.f;
#pragma unroll
        for (int j = 0; j < 4; ++j) { v[j] = v[j] - mean; s2 += (v[j].x * v[j].x + v[j].y * v[j].y) + (v[j].z * v[j].z + v[j].w * v[j].w); }
        const float rstd = 1.f / sqrtf(wave_sum(s2) * (1.f / DM) + LN_EPS);
#pragma unroll
        for (int j = 0; j < 4; ++j) { const int c0 = 4 * lane + 256 * j; const f32x4 g = *(const f32x4*)(P.ln2_g + c0), bb = *(const f32x4*)(P.ln2_b + c0);
            ((f32x4*)(dstbase + (size_t)mrow * DM) + lane)[64 * j] = (v[j] * rstd * g + bb) * dbg_scale; }
    }
}
#ifndef REP_PHASE
#define REP_PHASE -1
#endif
#ifndef MK_PER_PHASE
#define MK_PER_PHASE 0
#endif
DI void run_phase_0(const Params& P, LAS unsigned char* lds, int vcu, int G, int bx, int wave, int lane, int tid) {
    unsigned char* ws = P.ws; const float* mod = (const float*)(ws + WS_MOD); (void)mod; (void)ws;
 phase0a(P, lds, vcu, G, wave, lane, tid); }
DI void run_phase_1(const Params& P, LAS unsigned char* lds, int vcu, int G, int bx, int wave, int lane, int tid) {
    unsigned char* ws = P.ws; const float* mod = (const float*)(ws + WS_MOD); (void)mod; (void)ws;
 phase0b(P, lds, vcu, G, wave, lane, tid); }
DI void run_phase_2(const Params& P, LAS unsigned char* lds, int vcu, int G, int bx, int wave, int lane, int tid) {
    unsigned char* ws = P.ws; const float* mod = (const float*)(ws + WS_MOD); (void)mod; (void)ws;
        pg8::Gemm g{(const bf16_t*)(ws + WS_H1), (const bf16_t*)(ws + WS_WIN_T), DM, DM, DM, 128};
        pg8::DenseOrder S; S.init(g.A, DM, NT, NU, G, bx);
        pg8::EpiStoreBf16 E{(bf16_t*)(ws + WS_U), NU, 0.125f * 1.4426950408889634f, 2};
        pg8::gemm_phase<pg8::EpiStoreBf16, pg8::DenseOrder, true, false>(lds, g, S, E, nullptr);
    }
DI void run_phase_3(const Params& P, LAS unsigned char* lds, int vcu, int G, int bx, int wave, int lane, int tid) {
    unsigned char* ws = P.ws; const float* mod = (const float*)(ws + WS_MOD); (void)mod; (void)ws;
        if (bx < 32 && G > 32) {
            pg8::Gemm g{(const bf16_t*)(ws + WS_U), (const bf16_t*)(ws + WS_WC1_T), 16 * NU, 2048, 2048, NU * 2};
            pg8::CmpOrder S{G, bx, (const bf16_t*)(ws + WS_U)};
            pg8::EpiCmp E{(bf16_t*)(ws + WS_HCMP), (const float*)(ws + WS_PEB)};
            pg8::gemm_phase<pg8::EpiCmp, pg8::CmpOrder, true, false>(lds, g, S, E, nullptr);
        } else {
            const int nw = (G > 32) ? G - 32 : G, w0 = (G > 32) ? bx - 32 : bx;
            if (G <= 32) { pg8::Gemm g{(const bf16_t*)(ws + WS_U), (const bf16_t*)(ws + WS_WC1_T), 16 * NU, 2048, 2048, NU * 2};
                pg8::CmpOrder S{G, bx, (const bf16_t*)(ws + WS_U)}; pg8::EpiCmp E{(bf16_t*)(ws + WS_HCMP), (const float*)(ws + WS_PEB)};
                pg8::gemm_phase<pg8::EpiCmp, pg8::CmpOrder, true, false>(lds, g, S, E, nullptr); }
            for (int item = w0; item < 1024; item += nw) conv_item(P, lds, item, wave, lane, tid);
            if (REP_PHASE == 31) { for (int item = w0; item < 1024; item += nw) conv_item(P, lds, item, wave, lane, tid); }
            __syncthreads();
            vt_copies(P, lds, w0 * 8 + wave, nw * 8, wave, lane);
            __syncthreads();
        }
    }
DI void run_phase_4(const Params& P, LAS unsigned char* lds, int vcu, int G, int bx, int wave, int lane, int tid) {
    unsigned char* ws = P.ws; const float* mod = (const float*)(ws + WS_MOD); (void)mod; (void)ws;
 phase_cmp2(P, lds, vcu, G, wave, lane, tid); }
DI void run_phase_5(const Params& P, LAS unsigned char* lds, int vcu, int G, int bx, int wave, int lane, int tid) {
    unsigned char* ws = P.ws; const float* mod = (const float*)(ws + WS_MOD); (void)mod; (void)ws;
 attn::attn_phase(P, lds, vcu, G, wave, lane, tid); }
DI void run_phase_6(const Params& P, LAS unsigned char* lds, int vcu, int G, int bx, int wave, int lane, int tid) {
    unsigned char* ws = P.ws; const float* mod = (const float*)(ws + WS_MOD); (void)mod; (void)ws;
#if CHECK_ATTN
        attnchk::phase(P, lds, vcu, G, wave, lane); __syncthreads();
#endif
        pg8::Gemm g{(const bf16_t*)(ws + WS_CAT), (const bf16_t*)(ws + WS_WOUT_T), DM, DM, DM, 128};
        pg8::DenseOrder S; S.init(g.A, DM, NT, DM, G, bx);
        pg8::EpiResModBf16 E{P.x, (bf16_t*)(ws + WS_V1), mod + 2 * 1024, 6144};
        pg8::gemm_phase<pg8::EpiResModBf16, pg8::DenseOrder, true, false>(lds, g, S, E, nullptr);
    }
DI void run_phase_7(const Params& P, LAS unsigned char* lds, int vcu, int G, int bx, int wave, int lane, int tid) {
    unsigned char* ws = P.ws; const float* mod = (const float*)(ws + WS_MOD); (void)mod; (void)ws;
 if (REP_PHASE == 70) { phase_ln1(P, vcu, G, wave, lane, (bf16_t*)(ws + WS_HIDM)); phase_ln1(P, vcu, G, wave, lane, (bf16_t*)(ws + WS_HIDM)); }
    phase_ln1(P, vcu, G, wave, lane, (bf16_t*)(ws + WS_X1)); }
DI void run_phase_8(const Params& P, LAS unsigned char* lds, int vcu, int G, int bx, int wave, int lane, int tid) {
    unsigned char* ws = P.ws; const float* mod = (const float*)(ws + WS_MOD); (void)mod; (void)ws;
        { pg8::Gemm g{(const bf16_t*)(ws + WS_H2), (const bf16_t*)(ws + WS_WR_T), DM, DM, DM, 128};
          pg8::DenseOrder S; S.init(g.A, DM, NT, 256, G, bx);
          pg8::EpiF32 E{(float*)(ws + WS_LOGIT), 256};
          pg8::gemm_phase<pg8::EpiF32, pg8::DenseOrder, true, false>(lds, g, S, E, nullptr); }
        { pg8::Gemm g{(const bf16_t*)(ws + WS_H2), (const bf16_t*)(ws + WS_WSGU_T), DM, DM, DM, 128};
          pg8::DenseOrder S; S.init(g.A, DM, NT, 512, G, bx);
          pg8::EpiGlu E{(bf16_t*)(ws + WS_HIDS), 256};
          pg8::gemm_phase<pg8::EpiGlu, pg8::DenseOrder, true, false>(lds, g, S, E, nullptr); }
    }
DI void run_phase_9(const Params& P, LAS unsigned char* lds, int vcu, int G, int bx, int wave, int lane, int tid) {
    unsigned char* ws = P.ws; const float* mod = (const float*)(ws + WS_MOD); (void)mod; (void)ws;
        phase_route(P, lds, vcu, G, wave, lane, tid);
        if (REP_PHASE == 90) { phase_route(P, lds, vcu, G, wave, lane, tid); phase_route(P, lds, vcu, G, wave, lane, tid); }
        pg8::Gemm g{(const bf16_t*)(ws + WS_HIDS), (const bf16_t*)(ws + WS_WSD_T), 256, 256, 256, 128};
        pg8::DenseOrder S; S.init(g.A, 256, NT, DM, G, bx);
        pg8::EpiStoreBf16 E{(bf16_t*)(ws + WS_SH), DM, 1.0f, 0};
        pg8::gemm_phase<pg8::EpiStoreBf16, pg8::DenseOrder, true, false>(lds, g, S, E, nullptr);
    }
DI void run_phase_10(const Params& P, LAS unsigned char* lds, int vcu, int G, int bx, int wave, int lane, int tid) {
    unsigned char* ws = P.ws; const float* mod = (const float*)(ws + WS_MOD); (void)mod; (void)ws;
 phase_scatter(P, lds, vcu, G, wave, lane, tid); }
DI void run_phase_11(const Params& P, LAS unsigned char* lds, int vcu, int G, int bx, int wave, int lane, int tid) {
    unsigned char* ws = P.ws; const float* mod = (const float*)(ws + WS_MOD); (void)mod; (void)ws;
        const int nblk = (int)__builtin_amdgcn_readfirstlane((int)ld_u32_agent((const unsigned*)(ws + WS_BLKE) + NBLK_MAX));
        const int nunits = 2 * nblk; LAS int* tab = (LAS int*)(lds + LDS_TAB);
        { const int* rowtok = (const int*)(ws + WS_ROWTOK); int i = 0;
          for (int L = vcu; L < nunits && i < 28; L += G, ++i) { if (tid < 256) tab[i * 256 + tid] = rowtok[(L >> 1) * 256 + tid]; } }
        __syncthreads();
        pg8::Gemm g{(const bf16_t*)(ws + WS_H2), (const bf16_t*)(ws + WS_WGU_T), DM, DM, DM, 128};
        pg8::MoeOrder<2> S{G, vcu, nunits, (const int*)(ws + WS_BLKE), g.A, (size_t)0};
        pg8::EpiGlu E{(bf16_t*)(ws + WS_HIDM), 256};
        pg8::gemm_phase<pg8::EpiGlu, pg8::MoeOrder<2>, true, true>(lds, g, S, E, tab);
    }
DI void run_phase_12(const Params& P, LAS unsigned char* lds, int vcu, int G, int bx, int wave, int lane, int tid) {
    unsigned char* ws = P.ws; const float* mod = (const float*)(ws + WS_MOD); (void)mod; (void)ws;
        const int nblk = (int)__builtin_amdgcn_readfirstlane((int)ld_u32_agent((const unsigned*)(ws + WS_BLKE) + NBLK_MAX));
        pg8::Gemm g{(const bf16_t*)(ws + WS_HIDM), (const bf16_t*)(ws + WS_WDN_T), 256, 256, 256, 128};
        pg8::MoeOrder<4> S{G, vcu, 4 * nblk, (const int*)(ws + WS_BLKE), g.A, (size_t)256 * 256 * 2};
        pg8::EpiStoreFp8 E{(unsigned char*)(ws + WS_YMOE), DM, YMOE_SCALE};
        pg8::gemm_phase<pg8::EpiStoreFp8, pg8::MoeOrder<4>, true, false>(lds, g, S, E, nullptr);
    }
DI void run_phase_13(const Params& P, LAS unsigned char* lds, int vcu, int G, int bx, int wave, int lane, int tid) {
    unsigned char* ws = P.ws; const float* mod = (const float*)(ws + WS_MOD); (void)mod; (void)ws;
 if (REP_PHASE == 130) { phase_final(P, vcu, G, wave, lane, (float*)(ws + WS_HIDM)); phase_final(P, vcu, G, wave, lane, (float*)(ws + WS_HIDM)); }
    phase_final(P, vcu, G, wave, lane, P.out); }
constexpr int NPHASE = 14;
__global__ void __launch_bounds__(512, 2) nsa_conformer_moe_fwd(Params P) {
    extern __shared__ __attribute__((aligned(16))) unsigned char lds_raw[];
    LAS unsigned char* lds = (LAS unsigned char*)lds_raw;
    const int tid = threadIdx.x, lane = tid & 63, wave = __builtin_amdgcn_readfirstlane(tid >> 6);
    const int G = gridDim.x, bx = blockIdx.x, vcu = (G % 8 == 0) ? (bx % 8) * (G / 8) + bx / 8 : bx;
    unsigned char* ws = P.ws;
    volatile LAS unsigned* MISC = (volatile LAS unsigned*)(lds + LDS_MISC);
    if (tid < 64) MISC[tid] = 0u;
    __syncthreads();
    const int lo = P.ph_lo, hi = P.ph_hi;
    XcdBarrier bar; bar.bar = (unsigned*)(ws + WS_CTL) + CW_BAR; bar.x = 0; bar.st = MISC + 8;
    if (hi - lo > 1) bar = xcd_barrier_post((unsigned*)(ws + WS_CTL) + CW_BAR, MISC + 8);
#ifdef PH_ONLY
#define IN(k) ((k) == PH_ONLY && lo <= (k) && (k) < hi)
#else
#define IN(k) (lo <= (k) && (k) < hi)
#endif
#define SEAM(k) do { if (IN(k) && IN((k) + 1)) xcd_barrier(bar); } while (0)
    if (IN(0)) run_phase_0(P, lds, vcu, G, bx, wave, lane, tid);
    if (REP_PHASE == 0 && IN(0)) { run_phase_0(P, lds, vcu, G, bx, wave, lane, tid); run_phase_0(P, lds, vcu, G, bx, wave, lane, tid); }
    SEAM(0);
    if (REP_PHASE == 200 && IN(0) && IN(1)) { for (int q_ = 0; q_ < 20; ++q_) xcd_barrier(bar); }
    if (IN(1)) run_phase_1(P, lds, vcu, G, bx, wave, lane, tid);
    if (REP_PHASE == 1 && IN(1)) { run_phase_1(P, lds, vcu, G, bx, wave, lane, tid); run_phase_1(P, lds, vcu, G, bx, wave, lane, tid); }
    SEAM(1);
    if (IN(2)) run_phase_2(P, lds, vcu, G, bx, wave, lane, tid);
    if (REP_PHASE == 2 && IN(2)) { run_phase_2(P, lds, vcu, G, bx, wave, lane, tid); run_phase_2(P, lds, vcu, G, bx, wave, lane, tid); }
    SEAM(2);
    if (IN(3)) run_phase_3(P, lds, vcu, G, bx, wave, lane, tid);
    if (REP_PHASE == 3 && IN(3)) { run_phase_3(P, lds, vcu, G, bx, wave, lane, tid); run_phase_3(P, lds, vcu, G, bx, wave, lane, tid); }
    SEAM(3);
    if (IN(4)) run_phase_4(P, lds, vcu, G, bx, wave, lane, tid);
    if (REP_PHASE == 4 && IN(4)) { run_phase_4(P, lds, vcu, G, bx, wave, lane, tid); run_phase_4(P, lds, vcu, G, bx, wave, lane, tid); }
    SEAM(4);
    if (IN(5)) run_phase_5(P, lds, vcu, G, bx, wave, lane, tid);
    if (REP_PHASE == 5 && IN(5)) { run_phase_5(P, lds, vcu, G, bx, wave, lane, tid); run_phase_5(P, lds, vcu, G, bx, wave, lane, tid); }
    SEAM(5);
    if (IN(6)) run_phase_6(P, lds, vcu, G, bx, wave, lane, tid);
    if (REP_PHASE == 6 && IN(6)) { run_phase_6(P, lds, vcu, G, bx, wave, lane, tid); run_phase_6(P, lds, vcu, G, bx, wave, lane, tid); }
    SEAM(6);
    if (IN(7)) run_phase_7(P, lds, vcu, G, bx, wave, lane, tid);
    if (REP_PHASE == 7 && IN(7)) { run_phase_7(P, lds, vcu, G, bx, wave, lane, tid); run_phase_7(P, lds, vcu, G, bx, wave, lane, tid); }
    SEAM(7);
    if (IN(8)) run_phase_8(P, lds, vcu, G, bx, wave, lane, tid);
    if (REP_PHASE == 8 && IN(8)) { run_phase_8(P, lds, vcu, G, bx, wave, lane, tid); run_phase_8(P, lds, vcu, G, bx, wave, lane, tid); }
    SEAM(8);
    if (IN(9)) run_phase_9(P, lds, vcu, G, bx, wave, lane, tid);
    if (REP_PHASE == 9 && IN(9)) { run_phase_9(P, lds, vcu, G, bx, wave, lane, tid); run_phase_9(P, lds, vcu, G, bx, wave, lane, tid); }
    SEAM(9);
    if (IN(10)) run_phase_10(P, lds, vcu, G, bx, wave, lane, tid);
    if (REP_PHASE == 10 && IN(10)) { run_phase_10(P, lds, vcu, G, bx, wave, lane, tid); run_phase_10(P, lds, vcu, G, bx, wave, lane, tid); }
    SEAM(10);
    if (IN(11)) run_phase_11(P, lds, vcu, G, bx, wave, lane, tid);
    if (REP_PHASE == 11 && IN(11)) { run_phase_11(P, lds, vcu, G, bx, wave, lane, tid); run_phase_11(P, lds, vcu, G, bx, wave, lane, tid); }
    SEAM(11);
    if (IN(12)) run_phase_12(P, lds, vcu, G, bx, wave, lane, tid);
    if (REP_PHASE == 12 && IN(12)) { run_phase_12(P, lds, vcu, G, bx, wave, lane, tid); run_phase_12(P, lds, vcu, G, bx, wave, lane, tid); }
    SEAM(12);
    if (IN(13)) run_phase_13(P, lds, vcu, G, bx, wave, lane, tid);
    if (REP_PHASE == 13 && IN(13)) { run_phase_13(P, lds, vcu, G, bx, wave, lane, tid); run_phase_13(P, lds, vcu, G, bx, wave, lane, tid); }
#undef IN
#undef SEAM
}

extern "C" void kernel_launch(void* const* d_in, const int* in_sizes, int n_in, void* d_out, int out_size, void* d_ws, size_t ws_size, hipStream_t stream) {
    static int grid = 0;
    if (grid == 0) {
        if (n_in != 28 || out_size != NT * DM || ws_size < WS_END) { fprintf(stderr, "kernel_launch: unexpected arguments (n_in %d, out %d, ws %zu); nothing launched\n", n_in, out_size, ws_size); grid = -1; return; }
        int dev = 0, cus = 0, per_cu = 0;
        if (hipGetDevice(&dev) != hipSuccess || hipDeviceGetAttribute(&cus, hipDeviceAttributeMultiprocessorCount, dev) != hipSuccess) { grid = -1; return; }
        if (hipFuncSetAttribute((const void*)nsa_conformer_moe_fwd, hipFuncAttributeMaxDynamicSharedMemorySize, LDS_BYTES) != hipSuccess) { fprintf(stderr, "kernel_launch: hipFuncSetAttribute failed\n"); grid = -1; return; }
        if (hipOccupancyMaxActiveBlocksPerMultiprocessor(&per_cu, (const void*)nsa_conformer_moe_fwd, 512, LDS_BYTES) != hipSuccess || per_cu < 1) { fprintf(stderr, "kernel_launch: occupancy query says %d blocks per CU\n", per_cu); }
        (void)hipGetLastError();
        grid = cus;
    }
    if (grid < 0) return;
    (void)hipMemsetAsync((char*)d_ws + WS_CTL, 0, CTL_ZERO_BYTES, stream);
    Params p{};
    const float** pp = (const float**)&p;
    for (int i = 0; i < 28; ++i) pp[i] = (const float*)d_in[i];
    p.out = (float*)d_out; p.ws = (unsigned char*)d_ws;
#if MK_PER_PHASE
    for (int ph = 0; ph < NPHASE; ++ph) { p.ph_lo = ph; p.ph_hi = ph + 1; hipLaunchKernelGGL(nsa_conformer_moe_fwd, dim3(grid), dim3(512), LDS_BYTES, stream, p); }
#else
    p.ph_lo = 0; p.ph_hi = NPHASE;
    hipLaunchKernelGGL(nsa_conformer_moe_fwd, dim3(grid), dim3(512), LDS_BYTES, stream, p);
#endif
}
```

```cpp
#include <hip/hip_runtime.h>
#include <cstdio>
#include <cstdint>

#define DI __device__ __forceinline__
#define LAS __attribute__((address_space(3)))
#define GAS __attribute__((address_space(1)))
typedef unsigned short bf16_t;
typedef short bf16x8 __attribute__((ext_vector_type(8)));
typedef float f32x4 __attribute__((ext_vector_type(4)));
typedef float f32x16 __attribute__((ext_vector_type(16)));
typedef float f32x2 __attribute__((ext_vector_type(2)));
typedef unsigned u32x4 __attribute__((ext_vector_type(4)));
typedef unsigned u32x2 __attribute__((ext_vector_type(2)));
typedef __bf16 bf16x2_t __attribute__((ext_vector_type(2)));

constexpr int NB = 4, SEQ = 8192, DM = 1024, NT = NB * SEQ;
constexpr int NU = 2560;
constexpr int UQ = 0, UKC = 512, UVC = 640, UKS = 768, UVS = 896, UKW = 1024, UVW = 1152, UCA = 1280, UCG = 1792, UGT = 2304;
constexpr int DIN = 2328;
constexpr int NEXP = 256, DEXP = 256, TOPK = 8;
constexpr int NASSIGN = NT * TOPK;
constexpr int NPAD_MAX = NASSIGN + NEXP * 255 + 1;
constexpr int NBLK_MAX = NPAD_MAX / 256 + 1;
constexpr float LN_EPS = 1e-5f;
constexpr float YMOE_SCALE = 16.0f;
constexpr float DN_ALPHA = 1.189207115002721f;

DI unsigned pk2(float lo, float hi) { f32x2 v = {lo, hi}; bf16x2_t b = __builtin_convertvector(v, bf16x2_t); return __builtin_bit_cast(unsigned, b); }
DI float bflo(unsigned w) { return __uint_as_float(w << 16); }
DI float bfhi(unsigned w) { return __uint_as_float(w & 0xffff0000u); }
DI float bf2f(bf16_t b) { return __uint_as_float(((unsigned)b) << 16); }
DI float fsigmoid(float x) { return __builtin_amdgcn_rcpf(1.0f + __expf(-x)); }
DI float fsilu(float x) { return x * __builtin_amdgcn_rcpf(1.0f + __expf(-x)); }
DI float wave_sum(float v) {
#pragma unroll
    for (int o = 1; o < 64; o <<= 1) v += __shfl_xor(v, o);
    return v;
}
DI unsigned ld_u32_agent(const unsigned* p) { return __hip_atomic_load(p, __ATOMIC_RELAXED, __HIP_MEMORY_SCOPE_AGENT); }
#define LDS_WAIT() asm volatile("s_waitcnt lgkmcnt(0)" ::: "memory")
#define VM_WAIT() asm volatile("s_waitcnt vmcnt(0)" ::: "memory")

#define XB_TMO      128
#define XB_XCNT(j)  (256  + 64 * (j))
#define XB_XSUB(j)  (1280 + 64 * (j))
#define XB_XGEN(j)  (2304 + 64 * (j))
#define XB_TOP      3328
#define XB_TOPGEN   3392
#define XCD_BAR_WORDS 3456
#define XB_SPIN_CAP (1u << 18)
__device__ __forceinline__ unsigned xb_ld(unsigned* p)              { return __hip_atomic_load(p, __ATOMIC_RELAXED, __HIP_MEMORY_SCOPE_AGENT); }
__device__ __forceinline__ unsigned xb_add(unsigned* p, unsigned v) { return __hip_atomic_fetch_add(p, v, __ATOMIC_RELAXED, __HIP_MEMORY_SCOPE_AGENT); }
__device__ __forceinline__ unsigned xb_xcc_id() { return (unsigned)__builtin_amdgcn_s_getreg((3 << 11) | 20) & 0xFu; }
#define XB_SPIN(cond, bar) do { unsigned _sp = 0; while (cond) { __builtin_amdgcn_s_sleep(1); \
    if ((++_sp & 255u) == 0u) { if (xb_ld(&(bar)[XB_TMO])) break; if (_sp > XB_SPIN_CAP) { atomicAdd(&(bar)[XB_TMO], 1u); break; } } } } while (0)
struct XcdBarrier { unsigned* bar; unsigned x; volatile LAS unsigned* st; };
__device__ __forceinline__ XcdBarrier xcd_barrier_post(unsigned* bar, volatile LAS unsigned* st) {
    XcdBarrier b; b.bar = bar; b.x = xb_xcc_id(); b.st = st;
    if (threadIdx.x == 0) (void)xb_add(&bar[XB_XCNT(b.x)], 1u);
    return b;
}
__device__ __forceinline__ void xcd_barrier_complete(unsigned* bar, unsigned x, unsigned& nloc, unsigned& nx) {
    const unsigned G = gridDim.x * gridDim.y * gridDim.z;
    unsigned sum, cnt, mine, sp = 0u;
    for (;;) {
        sum = 0u; cnt = 0u; mine = 0u;
#pragma unroll
        for (unsigned j = 0; j < 16; ++j) { const unsigned c = xb_ld(&bar[XB_XCNT(j)]); sum += c; cnt += (c > 0u) ? 1u : 0u; mine = (j == x) ? c : mine; }
        if (sum == G) break;
        __builtin_amdgcn_s_sleep(1);
        if ((++sp & 255u) == 0u) { if (xb_ld(&bar[XB_TMO])) break; if (sp > XB_SPIN_CAP) { atomicAdd(&bar[XB_TMO], 1u); break; } }
    }
    nloc = mine > 0u ? mine : 1u; nx = cnt > 0u ? cnt : 1u;
}
__device__ __forceinline__ void xcd_barrier(const XcdBarrier& b) {
    asm volatile("s_waitcnt vmcnt(0)" ::: "memory");
    __syncthreads();
    if (threadIdx.x == 0) {
        unsigned* bar = b.bar;
        __builtin_amdgcn_s_waitcnt(0);
        unsigned nloc = b.st[0], nx = b.st[1];
        if (nloc == 0u) { xcd_barrier_complete(bar, b.x, nloc, nx); b.st[0] = nloc; b.st[1] = nx; }
        const unsigned old = xb_add(&bar[XB_XSUB(b.x)], 1u);
        const unsigned gen = old / nloc;
        if (old + 1u == (gen + 1u) * nloc) {
            __builtin_amdgcn_fence(__ATOMIC_RELEASE, "agent");
            asm volatile("s_waitcnt vmcnt(0)" ::: "memory");
            const unsigned og = xb_add(&bar[XB_TOP], 1u);
            const unsigned tg = og / nx;
            if (og + 1u == (tg + 1u) * nx) xb_add(&bar[XB_TOPGEN], 1u);
            else XB_SPIN(xb_ld(&bar[XB_TOPGEN]) == tg, bar);
            __builtin_amdgcn_fence(__ATOMIC_ACQUIRE, "agent");
            xb_add(&bar[XB_XGEN(b.x)], 1u);
            asm volatile("s_waitcnt vmcnt(0)" ::: "memory");
        } else {
            XB_SPIN(xb_ld(&bar[XB_XGEN(b.x)]) == gen, bar);
            __builtin_amdgcn_fence(__ATOMIC_ACQUIRE, "agent");
            asm volatile("s_waitcnt vmcnt(0)" ::: "memory");
        }
    }
    __syncthreads();
}

namespace pg8 {
constexpr int BM = 256, BK = 64, HALF = 128, HTB = HALF * BK * 2, STAGE_BYTES = 8 * HTB, NXCD = 8, WGM = 8;
__host__ __device__ __forceinline__ int lds_byte(int r, int c) { const int st = (r >> 4) * 2 + (c >> 5), rr = r & 15, cc = c & 31, ob = rr * 64 + cc * 2; return st * 1024 + (ob ^ (((ob >> 9) & 1) << 5)); }
__host__ __device__ __forceinline__ void stage_rc(int b, int& R, int& C) { const int st = b / 1024, sb = b % 1024, swz = sb ^ (((sb >> 9) & 1) << 5); R = (st >> 1) * 16 + swz / 64; C = (st & 1) * 32 + (swz % 64) / 2; }
__host__ __device__ __forceinline__ int perm32(int rho) { const int n = rho >> 4, i = rho & 15; return 8 * (i >> 2) + 4 * n + (i & 3); }

struct Unit { int pm, pn, po; };
struct Gemm { const bf16_t* A; const bf16_t* Bt; int lda, ldb, K, kstepA; };

struct DenseOrder {
    int nM, nN, nwg, G, c; const bf16_t* A; size_t tstepA;
    DI void init(const bf16_t* A_, int lda, int M, int N, int G_, int c_) { nM = M / BM; nN = N / BM; nwg = nM * nN; G = G_; c = c_; A = A_; tstepA = (size_t)BM * lda * 2; }
    DI bool next(int i, Unit& u) const {
        const long L = (long)i * G + c; if (L >= nwg) return false;
        int wgid = (int)L; { const int q = nwg / NXCD, r = nwg % NXCD, xcd = wgid % NXCD, off = wgid / NXCD; wgid = (xcd < r ? xcd * (q + 1) : r * (q + 1) + (xcd - r) * q) + off; }
        const int nig = WGM * nN, gid = wgid / nig, fm = gid * WGM, gsz = (nM - fm) < WGM ? (nM - fm) : WGM;
        u.pm = fm + ((wgid % nig) % gsz); u.pn = (wgid % nig) / gsz; u.po = u.pn; return true;
    }
    DI const char* abase(const Unit& u) const { return (const char*)A + (size_t)u.pm * tstepA; }
};

DI unsigned cvt_pk_bf16(float lo, float hi) { return pk2(lo, hi); }

template <class Epi, class Sched, bool ALIGN_EPI, bool GATHER>
__device__ __forceinline__ void gemm_phase(LAS unsigned char* lds, const Gemm g, const Sched& S, const Epi& E, const LAS int* rowidx  ) {
    const int tid = threadIdx.x, wid = __builtin_amdgcn_readfirstlane(tid >> 6), lane = tid & 63, wr = wid >> 2, wc = wid & 3, fr = lane & 15, fq = lane >> 4;
    const int K = g.K; int nt = K / BK; asm volatile("" : "+s"(nt));
    unsigned voffA[2], voffB[2]; int RA[2], CA[2];
#pragma unroll
    for (int i = 0; i < 2; ++i) { int R, C; stage_rc(tid * 16 + i * 8192, R, C); const int Rb = Epi::PERM ? ((R & ~31) + perm32(R & 31)) : R;
        RA[i] = R; CA[i] = C; voffA[i] = (unsigned)(R * g.lda + C) * 2u; voffB[i] = (unsigned)(Rb * g.ldb + C) * 2u; }
    const size_t kstepA = (size_t)g.kstepA, kstepB = (size_t)(BK * 2);
    const size_t hstepA = (size_t)HALF * g.lda * 2, hstepB = (size_t)HALF * g.ldb * 2;
    const size_t tstepB = 2 * hstepB;
    const unsigned ldsw = (unsigned)wid * 1024u;
    const int aoff = lds_byte(wr * 64 + fr, fq * 8), boff = lds_byte(wc * 32 + fr, fq * 8);
#define PG8_SA(b, h) (((b) * 2 + (h)) * HTB)
#define PG8_SB(b, h) ((4 + (b) * 2 + (h)) * HTB)
#define PG8_STAGE(bufoff, gbase, voff) do { _Pragma("unroll") for (int _i = 0; _i < 2; ++_i) \
        __builtin_amdgcn_global_load_lds((const unsigned*)((const char*)(gbase) + (voff)[_i]), (LAS unsigned*)(lds + (bufoff) + ldsw + _i * 8192), 16, 0, 0); } while (0)
#define PG8_LDA(dst, b, h) do { _Pragma("unroll") for (int m = 0; m < 4; ++m) _Pragma("unroll") for (int k = 0; k < 2; ++k) dst[m][k] = *(const LAS bf16x8*)(lds + PG8_SA(b, h) + aoff + m * 2048 + k * 1024); } while (0)
#define PG8_LDB(dst, b, h) do { _Pragma("unroll") for (int n = 0; n < 2; ++n) _Pragma("unroll") for (int k = 0; k < 2; ++k) dst[n][k] = *(const LAS bf16x8*)(lds + PG8_SB(b, h) + boff + n * 2048 + k * 1024); } while (0)
#define PG8_MMA(ai, bj, At, Bt) do { __builtin_amdgcn_s_setprio(1); _Pragma("unroll") for (int m = 0; m < 4; ++m) _Pragma("unroll") for (int n = 0; n < 2; ++n) _Pragma("unroll") for (int k = 0; k < 2; ++k) \
        acc[ai][bj][m][n] = __builtin_amdgcn_mfma_f32_16x16x32_bf16(Bt[n][k], At[m][k], acc[ai][bj][m][n], 0, 0, 0); __builtin_amdgcn_s_setprio(0); } while (0)
#define PG8_WAIT_V(n) asm volatile("s_waitcnt vmcnt(" #n ")" ::: "memory")
#define PG8_WAIT_L(n) asm volatile("s_waitcnt lgkmcnt(" #n ")" ::: "memory")
#define PG8_BAR __builtin_amdgcn_s_barrier()
#define PG8_SCHED __builtin_amdgcn_sched_barrier(0)
    Unit cur, nxt; int ui = 0;
    if (!S.next(0, cur)) return;
    f32x4 acc[2][2][4][2];
#pragma unroll
    for (int a = 0; a < 2; ++a)
#pragma unroll
        for (int b = 0; b < 2; ++b)
#pragma unroll
            for (int m = 0; m < 4; ++m)
#pragma unroll
                for (int n = 0; n < 2; ++n) acc[a][b][m][n] = (f32x4){0.f, 0.f, 0.f, 0.f};
    bf16x8 At[4][2], B0[2][2], B1[2][2];
    unsigned cg0[2], cg1[2], ng0[2], ng1[2];
    const char* cA; const char* cB = (const char*)g.Bt + (size_t)cur.pn * tstepB;
    if constexpr (GATHER) {
        cA = (const char*)g.A;
#pragma unroll
        for (int i = 0; i < 2; ++i) { cg0[i] = (unsigned)(rowidx[ui * 256 + RA[i]] * g.lda + CA[i]) * 2u; cg1[i] = (unsigned)(rowidx[ui * 256 + 128 + RA[i]] * g.lda + CA[i]) * 2u; ng0[i] = cg0[i]; ng1[i] = cg1[i]; }
    } else { cA = S.abase(cur); cg0[0] = cg0[1] = cg1[0] = cg1[1] = ng0[0] = ng0[1] = ng1[0] = ng1[1] = 0u; }
#define PG8_STAGE_A(bufoff, base, h, og0, og1) do { if constexpr (GATHER) { if ((h) == 0) PG8_STAGE(bufoff, base, og0); else PG8_STAGE(bufoff, base, og1); } \
        else { PG8_STAGE(bufoff, (base) + ((h) ? hstepA : (size_t)0), voffA); } } while (0)
    PG8_STAGE(PG8_SB(0, 0), cB, voffB); PG8_STAGE(PG8_SB(0, 1), cB + hstepB, voffB); PG8_STAGE_A(PG8_SA(0, 0), cA, 0, cg0, cg1); PG8_STAGE_A(PG8_SA(0, 1), cA, 1, cg0, cg1);
    if (wr == 1) PG8_BAR;
    PG8_WAIT_V(2); PG8_BAR;
    PG8_STAGE(PG8_SB(1, 0), cB + kstepB, voffB); PG8_STAGE_A(PG8_SA(1, 0), cA + kstepA, 0, cg0, cg1); PG8_STAGE(PG8_SB(1, 1), cB + hstepB + kstepB, voffB);
    PG8_WAIT_V(6); PG8_BAR;
    for (;;) {
        const bool has_next = S.next(ui + 1, nxt);
        const char* nA; const char* nB = has_next ? (const char*)g.Bt + (size_t)nxt.pn * tstepB : cB;
        if constexpr (GATHER) {
            nA = cA;
            if (has_next) {
#pragma unroll
                for (int i = 0; i < 2; ++i) { ng0[i] = (unsigned)(rowidx[(ui + 1) * 256 + RA[i]] * g.lda + CA[i]) * 2u; ng1[i] = (unsigned)(rowidx[(ui + 1) * 256 + 128 + RA[i]] * g.lda + CA[i]) * 2u; }
            } else {
#pragma unroll
                for (int i = 0; i < 2; ++i) { ng0[i] = cg0[i]; ng1[i] = cg1[i]; }
            }
        } else { nA = has_next ? S.abase(nxt) : cA; }
        for (int t = 0; t < nt; t += 2) {
            const bool last = (t == nt - 2);
            const char* a1 = cA + (size_t)(t + 1) * kstepA;
            const char* a2 = last ? nA : cA + (size_t)(t + 2) * kstepA; const char* b2 = last ? nB : cB + (size_t)(t + 2) * kstepB;
            const char* a3 = a2 + kstepA; const char* b3 = b2 + kstepB;
            unsigned xg0[2], xg1[2];
#pragma unroll
            for (int i = 0; i < 2; ++i) { xg0[i] = last ? ng0[i] : cg0[i]; xg1[i] = last ? ng1[i] : cg1[i]; }
            PG8_LDB(B0, 0, 0); PG8_LDB(B1, 0, 1); PG8_SCHED; PG8_LDA(At, 0, 0); PG8_STAGE_A(PG8_SA(1, 1), a1, 1, cg0, cg1);
            PG8_WAIT_V(8); PG8_WAIT_L(0); PG8_BAR; PG8_MMA(0, 0, At, B0); PG8_MMA(0, 1, At, B1); PG8_BAR; PG8_SCHED;
            PG8_LDA(At, 0, 1); PG8_STAGE(PG8_SB(0, 0), b2, voffB); PG8_STAGE(PG8_SB(0, 1), b2 + hstepB, voffB); PG8_STAGE_A(PG8_SA(0, 0), a2, 0, xg0, xg1);
            PG8_WAIT_V(8); PG8_WAIT_L(0); PG8_BAR; PG8_MMA(1, 0, At, B0); PG8_MMA(1, 1, At, B1); PG8_BAR; PG8_SCHED;
            PG8_LDB(B0, 1, 0); PG8_LDB(B1, 1, 1); PG8_SCHED; PG8_LDA(At, 1, 0); PG8_STAGE_A(PG8_SA(0, 1), a2, 1, xg0, xg1);
            PG8_WAIT_V(8); PG8_WAIT_L(0); PG8_BAR; PG8_MMA(0, 0, At, B0); PG8_MMA(0, 1, At, B1); PG8_BAR; PG8_SCHED;
            PG8_LDA(At, 1, 1); PG8_STAGE(PG8_SB(1, 0), b3, voffB); PG8_STAGE(PG8_SB(1, 1), b3 + hstepB, voffB); PG8_STAGE_A(PG8_SA(1, 0), a3, 0, xg0, xg1);
            PG8_WAIT_V(8); PG8_WAIT_L(0); PG8_BAR; PG8_MMA(1, 0, At, B0); PG8_MMA(1, 1, At, B1); PG8_BAR; PG8_SCHED;
        }
        if constexpr (ALIGN_EPI) { if (wr == 0) PG8_BAR; }
        E(acc, cur, wr, wc, fr, fq);
        if (!has_next) break;
#pragma unroll
        for (int a = 0; a < 2; ++a)
#pragma unroll
            for (int b = 0; b < 2; ++b)
#pragma unroll
                for (int m = 0; m < 4; ++m)
#pragma unroll
                    for (int n = 0; n < 2; ++n) acc[a][b][m][n] = (f32x4){0.f, 0.f, 0.f, 0.f};
        cur = nxt; cA = nA; cB = nB; ++ui;
#pragma unroll
        for (int i = 0; i < 2; ++i) { cg0[i] = ng0[i]; cg1[i] = ng1[i]; }
        if constexpr (ALIGN_EPI) { if (wr == 1) PG8_BAR; }
    }
    PG8_WAIT_V(0);
    if constexpr (!ALIGN_EPI) { if (wr == 0) PG8_BAR; }
    PG8_BAR;
#undef PG8_SA
#undef PG8_SB
#undef PG8_STAGE
#undef PG8_STAGE_A
#undef PG8_LDA
#undef PG8_LDB
#undef PG8_MMA
#undef PG8_WAIT_V
#undef PG8_WAIT_L
#undef PG8_BAR
#undef PG8_SCHED
}
}
namespace pg8 {
typedef f32x4 AccT[2][2][4][2];

struct EpiStoreBf16 {
    static constexpr bool PERM = true;
    bf16_t* O; int ldc; float scale0; int ntile0;
    DI void operator()(const AccT& acc, const Unit& u, int wr, int wc, int fr, int fq) const {
        const int row0 = u.pm * BM + wr * 64 + fr, col0 = u.po * BM + wc * 32 + 8 * fq; const float sc = (u.po < ntile0) ? scale0 : 1.0f;
#pragma unroll
        for (int ai = 0; ai < 2; ++ai)
#pragma unroll
            for (int m = 0; m < 4; ++m) { bf16_t* rowp = O + (size_t)(row0 + ai * HALF + m * 16) * ldc + col0;
#pragma unroll
                for (int bj = 0; bj < 2; ++bj) { const f32x4 v0 = acc[ai][bj][m][0] * sc, v1 = acc[ai][bj][m][1] * sc;
                    u32x4 w; w.x = pk2(v0[0], v0[1]); w.y = pk2(v0[2], v0[3]); w.z = pk2(v1[0], v1[1]); w.w = pk2(v1[2], v1[3]);
                    *(u32x4*)(rowp + bj * HALF) = w; } }
    }
};
struct EpiStoreFp8 {
    static constexpr bool PERM = true;
    unsigned char* O; int ldc; float scale;
    DI void operator()(const AccT& acc, const Unit& u, int wr, int wc, int fr, int fq) const {
        const int row0 = u.pm * BM + wr * 64 + fr, col0 = u.po * BM + wc * 32 + 8 * fq;
#pragma unroll
        for (int ai = 0; ai < 2; ++ai)
#pragma unroll
            for (int m = 0; m < 4; ++m) { unsigned char* rowp = O + (size_t)(row0 + ai * HALF + m * 16) * ldc + col0;
#pragma unroll
                for (int bj = 0; bj < 2; ++bj) { const f32x4 v0 = acc[ai][bj][m][0] * scale, v1 = acc[ai][bj][m][1] * scale;
                    int w0 = 0, w1 = 0;
                    w0 = __builtin_amdgcn_cvt_pk_fp8_f32(v0[0], v0[1], w0, false); w0 = __builtin_amdgcn_cvt_pk_fp8_f32(v0[2], v0[3], w0, true);
                    w1 = __builtin_amdgcn_cvt_pk_fp8_f32(v1[0], v1[1], w1, false); w1 = __builtin_amdgcn_cvt_pk_fp8_f32(v1[2], v1[3], w1, true);
                    *(u32x2*)(rowp + bj * HALF) = (u32x2){(unsigned)w0, (unsigned)w1}; } }
    }
};
DI float gelu_tanh(float x) { const float u = 0.7978845608028654f * (x + 0.044715f * x * x * x); const float e = __expf(2.0f * u); const float th = 1.0f - 2.0f / (e + 1.0f); return 0.5f * x * (1.0f + th); }
struct EpiCmp {
    static constexpr bool PERM = true;
    bf16_t* O; const float* peb;
    DI void operator()(const AccT& acc, const Unit& u, int wr, int wc, int fr, int fq) const {
        const int row0 = u.pm * BM + wr * 64 + fr, col0 = wc * 32 + 8 * fq; const float* pb = peb + (u.pm >> 4) * 256;
        f32x4 bv[2][2];
#pragma unroll
        for (int bj = 0; bj < 2; ++bj)
#pragma unroll
            for (int n = 0; n < 2; ++n) bv[bj][n] = *(const f32x4*)(pb + col0 + bj * HALF + 4 * n);
#pragma unroll
        for (int ai = 0; ai < 2; ++ai)
#pragma unroll
            for (int m = 0; m < 4; ++m) { bf16_t* rowp = O + (size_t)(row0 + ai * HALF + m * 16) * 256 + col0;
#pragma unroll
                for (int bj = 0; bj < 2; ++bj) { f32x4 v0 = acc[ai][bj][m][0] + bv[bj][0], v1 = acc[ai][bj][m][1] + bv[bj][1];
#pragma unroll
                    for (int j = 0; j < 4; ++j) { v0[j] = gelu_tanh(v0[j]); v1[j] = gelu_tanh(v1[j]); }
                    u32x4 w; w.x = pk2(v0[0], v0[1]); w.y = pk2(v0[2], v0[3]); w.z = pk2(v1[0], v1[1]); w.w = pk2(v1[2], v1[3]);
                    *(u32x4*)(rowp + bj * HALF) = w; } }
    }
};
struct EpiF32 {
    static constexpr bool PERM = false;
    float* C; int ldc;
    DI void operator()(const AccT& acc, const Unit& u, int wr, int wc, int fr, int fq) const {
        const int row0 = u.pm * BM + wr * 64 + fr, col0 = u.po * BM + wc * 32 + 4 * fq;
#pragma unroll
        for (int ai = 0; ai < 2; ++ai)
#pragma unroll
            for (int m = 0; m < 4; ++m) { float* rowp = C + (size_t)(row0 + ai * HALF + m * 16) * ldc + col0;
#pragma unroll
                for (int bj = 0; bj < 2; ++bj)
#pragma unroll
                    for (int n = 0; n < 2; ++n) *(f32x4*)(rowp + bj * HALF + n * 16) = acc[ai][bj][m][n]; }
    }
};
struct EpiResMod {
    static constexpr bool PERM = false;
    const float* base; float* out; const float* gate; int gate_pitch;
    DI void operator()(const AccT& acc, const Unit& u, int wr, int wc, int fr, int fq) const {
        const int row0 = u.pm * BM + wr * 64 + fr, col0 = u.po * BM + wc * 32 + 4 * fq;
        const float* gp = gate + (size_t)((u.pm * BM) / SEQ) * gate_pitch + col0;
        f32x4 gv[2][2];
#pragma unroll
        for (int bj = 0; bj < 2; ++bj)
#pragma unroll
            for (int n = 0; n < 2; ++n) gv[bj][n] = *(const f32x4*)(gp + bj * HALF + n * 16);
#pragma unroll
        for (int ai = 0; ai < 2; ++ai)
#pragma unroll
            for (int m = 0; m < 4; ++m) { const size_t off = (size_t)(row0 + ai * HALF + m * 16) * DM + col0;
#pragma unroll
                for (int bj = 0; bj < 2; ++bj)
#pragma unroll
                    for (int n = 0; n < 2; ++n) { const f32x4 bs = *(const f32x4*)(base + off + bj * HALF + n * 16);
                        *(f32x4*)(out + off + bj * HALF + n * 16) = bs * DN_ALPHA + gv[bj][n] * acc[ai][bj][m][n]; } }
    }
};
struct EpiResModBf16 {
    static constexpr bool PERM = false;
    const float* base; bf16_t* out; const float* gate; int gate_pitch;
    DI void operator()(const AccT& acc, const Unit& u, int wr, int wc, int fr, int fq) const {
        const int row0 = u.pm * BM + wr * 64 + fr, col0 = u.po * BM + wc * 32 + 4 * fq;
        const float* gp = gate + (size_t)((u.pm * BM) / SEQ) * gate_pitch + col0;
        f32x4 gv[2][2];
#pragma unroll
        for (int bj = 0; bj < 2; ++bj)
#pragma unroll
            for (int n = 0; n < 2; ++n) gv[bj][n] = *(const f32x4*)(gp + bj * HALF + n * 16);
#pragma unroll
        for (int ai = 0; ai < 2; ++ai)
#pragma unroll
            for (int m = 0; m < 4; ++m) { const size_t off = (size_t)(row0 + ai * HALF + m * 16) * DM + col0;
#pragma unroll
                for (int bj = 0; bj < 2; ++bj)
#pragma unroll
                    for (int n = 0; n < 2; ++n) { const f32x4 bs = *(const f32x4*)(base + off + bj * HALF + n * 16); const f32x4 v = bs * DN_ALPHA + gv[bj][n] * acc[ai][bj][m][n];
                        *(u32x2*)(out + off + bj * HALF + n * 16) = (u32x2){pk2(v.x, v.y), pk2(v.z, v.w)}; } }
    }
};
struct EpiGlu {
    static constexpr bool PERM = true;
    bf16_t* O; int ldc;
    DI void operator()(const AccT& acc, const Unit& u, int wr, int wc, int fr, int fq) const {
        const int row0 = u.pm * BM + wr * 64 + fr, col0 = u.po * HALF + wc * 32 + 8 * fq;
#pragma unroll
        for (int ai = 0; ai < 2; ++ai)
#pragma unroll
            for (int m = 0; m < 4; ++m) { bf16_t* rowp = O + (size_t)(row0 + ai * HALF + m * 16) * ldc + col0;
                f32x4 h0, h1;
#pragma unroll
                for (int j = 0; j < 4; ++j) { h0[j] = fsilu(acc[ai][0][m][0][j]) * acc[ai][1][m][0][j]; h1[j] = fsilu(acc[ai][0][m][1][j]) * acc[ai][1][m][1][j]; }
                u32x4 w; w.x = pk2(h0[0], h0[1]); w.y = pk2(h0[2], h0[3]); w.z = pk2(h1[0], h1[1]); w.w = pk2(h1[2], h1[3]);
                *(u32x4*)rowp = w; }
    }
};

struct CmpOrder {
    int G, c; const bf16_t* U;
    DI bool next(int i, Unit& u) const { const int L = i * G + c; if (L >= 32) return false; u.pm = L; u.pn = L >> 4; u.po = 0; return true; }
    DI const char* abase(const Unit& u) const { const int kv = u.pm >> 4, bg = (u.pm >> 1) & 7, b = bg >> 1, gg = bg & 1, half = u.pm & 1;
        return (const char*)(U + (size_t)(b * SEQ + half * 4096) * NU + (kv ? UVC : UKC) + gg * 64); }
};
template <int NSUB> struct MoeOrder {
    int G, c, nunits; const int* blk_e; const bf16_t* A; size_t tstepA;
    DI bool next(int i, Unit& u) const { const int L = i * G + c; if (L >= nunits) return false; const int blk = L / NSUB, sub = L % NSUB;
        const int e = (int)__builtin_amdgcn_readfirstlane((int)ld_u32_agent((const unsigned*)blk_e + blk)); u.pm = blk; u.pn = e * NSUB + sub; u.po = sub; return true; }
    DI const char* abase(const Unit& u) const { return (const char*)A + (size_t)u.pm * tstepA; }
};
}
constexpr size_t MiB = 1u << 20;
constexpr size_t WS_CTL = 0, CTL_ZERO_BYTES = 1 * MiB;
constexpr size_t WS_MODP = 1 * MiB;
constexpr size_t WS_MOD = WS_MODP + 1536 * 1024;
constexpr size_t WS_PEP = WS_MOD + 128 * 1024;
constexpr size_t WS_PEB = WS_PEP + 32 * 1024;
constexpr size_t WS_WIN_T = 3 * MiB;
constexpr size_t WS_WOUT_T = 8 * MiB;
constexpr size_t WS_WR_T = 10 * MiB;
constexpr size_t WS_WSGU_T = 12 * MiB;
constexpr size_t WS_WSD_T = 13 * MiB;
constexpr size_t WS_WC1_T = 14 * MiB;
constexpr size_t WS_WDN_T = 16 * MiB;
constexpr size_t WS_WGU_T = 144 * MiB;
constexpr size_t WS_YMOE = 144 * MiB;
constexpr size_t WS_U = 400 * MiB;
constexpr size_t WS_H1 = 560 * MiB;
constexpr size_t WS_CAT = 624 * MiB;
constexpr size_t WS_H2 = 688 * MiB;
constexpr size_t WS_HIDS = 752 * MiB;
constexpr size_t WS_HIDM = 784 * MiB;
constexpr size_t WS_LOGIT = 944 * MiB;
constexpr size_t WS_TOKE = 976 * MiB;
constexpr size_t WS_TOKW = 977 * MiB;
constexpr size_t WS_LRANK = 978 * MiB;
constexpr size_t WS_POSOF = 979 * MiB;
constexpr size_t WS_ROWTOK = 980 * MiB;
constexpr size_t WS_HIST = 982 * MiB;
constexpr size_t WS_BLKE = 983 * MiB;
constexpr size_t WS_HCMP = 984 * MiB;
constexpr size_t WS_KC = 988 * MiB;
constexpr size_t WS_VCT = 989 * MiB;
constexpr size_t WS_VST = 990 * MiB;
constexpr size_t WS_VWT = 998 * MiB;
constexpr size_t WS_V1 = WS_H1;
constexpr size_t WS_X1 = 464 * MiB;
constexpr size_t WS_SH = 528 * MiB;
constexpr size_t WS_END = 1024 * MiB;
constexpr int CW_BAR = 4096;

constexpr int LDS_BYTES = 160 * 1024;
constexpr int LDS_MISC = 131072;
constexpr int LDS_TAB = 131072 + 1024;

struct Params {
    const float *x, *c, *w_ada, *b_ada, *w_in, *pe_k, *pe_v, *w_cmp_k1, *w_cmp_k2, *w_cmp_v1, *w_cmp_v2, *w_dw, *b_dw, *conv_ln_g, *conv_ln_b, *w_out, *ln1_g, *ln1_b,
        *w_router, *router_bias, *w_e_gate, *w_e_up, *w_e_down, *w_s_gate, *w_s_up, *w_s_down, *ln2_g, *ln2_b;
    float* out; unsigned char* ws; int ph_lo, ph_hi;
};

DI void transpose_item(const float* W, int ldw, int ncols, bf16_t* WT, int ldt, int drow0, LAS float* scr, int k0, int n0, int lane) {
    if (n0 + 32 <= ncols && (((size_t)W | (size_t)(ldw * 4)) & 15) == 0 && (n0 & 3) == 0) {
        f32x4 v[8];
#pragma unroll
        for (int i = 0; i < 8; ++i) v[i] = *(const f32x4*)(W + (size_t)(k0 + 8 * i + (lane >> 3)) * ldw + n0 + 4 * (lane & 7));
#pragma unroll
        for (int i = 0; i < 8; ++i) { LAS float* d = scr + (8 * i + (lane >> 3)) * 33 + 4 * (lane & 7); d[0] = v[i].x; d[1] = v[i].y; d[2] = v[i].z; d[3] = v[i].w; }
    } else {
        const int nn = n0 + (lane & 31); const bool okc = nn < ncols;
#pragma unroll 8
        for (int i = 0; i < 32; ++i) { const int kk = 2 * i + (lane >> 5); scr[kk * 33 + (lane & 31)] = okc ? W[(size_t)(k0 + kk) * ldw + nn] : 0.f; }
    }
    LDS_WAIT(); asm volatile("" ::: "memory");
    const int cch = lane & 7;
#pragma unroll
    for (int j = 0; j < 4; ++j) { const int n = (lane >> 3) + 8 * j; const LAS float* s = scr + (8 * cch) * 33 + n;
        u32x4 o; o.x = pk2(s[0 * 33], s[1 * 33]); o.y = pk2(s[2 * 33], s[3 * 33]); o.z = pk2(s[4 * 33], s[5 * 33]); o.w = pk2(s[6 * 33], s[7 * 33]);
        *(u32x4*)(WT + (size_t)(drow0 + n) * ldt + k0 + 8 * cch) = o; }
    LDS_WAIT(); asm volatile("" ::: "memory");
}
DI void tr_plain(const float* W, int ldw, int K, int N, bf16_t* WT, int row_off, LAS float* scr, int item, int lane) {
    const int nblk = (N + 31) / 32, kb = item / nblk, nb = item % nblk;
    transpose_item(W, ldw, N, WT, K, row_off + 32 * nb, scr, 64 * kb, 32 * nb, lane);
}
DI void tr_glu(const float* W, int K, bf16_t* WT, int up, LAS float* scr, int item, int lane) {
    const int kb = item >> 3, nb = item & 7, n0 = 32 * nb;
    transpose_item(W, 256, 256, WT, K, (n0 >> 7) * 256 + up * 128 + (n0 & 127), scr, 64 * kb, n0, lane);
}

constexpr int EXP_ITEMS = NEXP * 384, EXP_LATE = 18432;
DI void expert_items(const Params& P, LAS float* scr, int lane, int gw, int NGW, int r0, int r1) {
    unsigned char* ws = P.ws;
    for (int r = r0 + gw; r < r1; r += NGW) { const int e = r / 384, q = r % 384;
        if (q < 128) tr_glu(P.w_e_gate + (size_t)e * 1024 * 256, 1024, (bf16_t*)(ws + WS_WGU_T) + (size_t)e * 512 * 1024, 0, scr, q, lane);
        else if (q < 256) tr_glu(P.w_e_up + (size_t)e * 1024 * 256, 1024, (bf16_t*)(ws + WS_WGU_T) + (size_t)e * 512 * 1024, 1, scr, q - 128, lane);
        else tr_plain(P.w_e_down + (size_t)e * 256 * 1024, 1024, 256, 1024, (bf16_t*)(ws + WS_WDN_T) + (size_t)e * 1024 * 256, 0, scr, q - 256, lane); }
}

DI void phase0a(const Params& P, LAS unsigned char* lds, int vcu, int G, int wave, int lane, int tid) {
    unsigned char* ws = P.ws;
    LAS float* scr = (LAS float*)(lds + wave * 16384);
    const int gw = vcu * 8 + wave, NGW = G * 8;
    for (int it = gw; it < 96 * 16; it += NGW) { const int cb = it % 96, ks = it / 96; const int col = cb * 64 + lane;
        float a0 = 0.f, a1 = 0.f, a2 = 0.f, a3 = 0.f;
#pragma unroll 4
        for (int k = ks * 64; k < ks * 64 + 64; ++k) { const float w = P.w_ada[(size_t)k * 6144 + col];
            a0 += fsilu(P.c[k]) * w; a1 += fsilu(P.c[1024 + k]) * w; a2 += fsilu(P.c[2048 + k]) * w; a3 += fsilu(P.c[3072 + k]) * w; }
        float* mp = (float*)(ws + WS_MODP) + (size_t)ks * 4 * 6144 + col;
        mp[0] = a0; mp[6144] = a1; mp[2 * 6144] = a2; mp[3 * 6144] = a3; }
    for (int it = gw; it < 16 * 2 * 4; it += NGW) { const int cb = it & 3, kv = (it >> 2) & 1, ks = it >> 3; const int col = cb * 64 + lane;
        const float* pe = kv ? P.pe_v : P.pe_k; const float* w1 = kv ? P.w_cmp_v1 : P.w_cmp_k1; float a = 0.f;
#pragma unroll 4
        for (int k = ks * 128; k < ks * 128 + 128; ++k) a += pe[k] * w1[(size_t)k * 256 + col];
        ((float*)(ws + WS_PEP))[(ks * 2 + kv) * 256 + col] = a; }
    constexpr int I_IN0 = 16 * 40, I_IN1 = 16 * 32, I_IN2 = 16 * 1, I_OUT = 16 * 32, I_R = 16 * 8, I_SG = 16 * 8, I_SD = 4 * 32, I_C1 = 32 * 8;
    constexpr int I_SMALL = I_IN0 + I_IN1 + I_IN2 + I_OUT + I_R + 2 * I_SG + I_SD + 2 * I_C1;
    constexpr int NITEMS = I_SMALL;
    bf16_t* win_t = (bf16_t*)(ws + WS_WIN_T);
    for (int it = gw; it < NITEMS; it += NGW) {
        int r = it;
        if (r < I_IN0) { tr_plain(P.w_in, DIN, 1024, 1280, win_t, 0, scr, r, lane); continue; } r -= I_IN0;
        if (r < I_IN1) { tr_plain(P.w_in + 1304, DIN, 1024, 1024, win_t, UCA, scr, r, lane); continue; } r -= I_IN1;
        if (r < I_IN2) { tr_plain(P.w_in + 1280, DIN, 1024, 24, win_t, UGT, scr, r, lane); continue; } r -= I_IN2;
        if (r < I_OUT) { tr_plain(P.w_out, 1024, 1024, 1024, (bf16_t*)(ws + WS_WOUT_T), 0, scr, r, lane); continue; } r -= I_OUT;
        if (r < I_R) { tr_plain(P.w_router, 256, 1024, 256, (bf16_t*)(ws + WS_WR_T), 0, scr, r, lane); continue; } r -= I_R;
        if (r < I_SG) { tr_glu(P.w_s_gate, 1024, (bf16_t*)(ws + WS_WSGU_T), 0, scr, r, lane); continue; } r -= I_SG;
        if (r < I_SG) { tr_glu(P.w_s_up, 1024, (bf16_t*)(ws + WS_WSGU_T), 1, scr, r, lane); continue; } r -= I_SG;
        if (r < I_SD) { tr_plain(P.w_s_down, 1024, 256, 1024, (bf16_t*)(ws + WS_WSD_T), 0, scr, r, lane); continue; } r -= I_SD;
        if (r < I_C1) { tr_plain(P.w_cmp_k1, 256, 2048, 256, (bf16_t*)(ws + WS_WC1_T), 0, scr, r, lane); continue; } r -= I_C1;
        tr_plain(P.w_cmp_v1, 256, 2048, 256, (bf16_t*)(ws + WS_WC1_T) + 256 * 2048, 0, scr, r, lane);
    }
    { u32x4* z = (u32x4*)(win_t + (size_t)2336 * 1024); const int n16 = (2560 - 2336) * 1024 * 2 / 16;
      for (int i = vcu * 512 + tid; i < n16; i += G * 512) z[i] = (u32x4){0u, 0u, 0u, 0u}; }
}

DI void phase0b(const Params& P, LAS unsigned char* lds, int vcu, int G, int wave, int lane, int tid) {
    unsigned char* ws = P.ws;
    const float* modp = (const float*)(ws + WS_MODP);
    for (int i = vcu * 512 + tid; i < 4 * 6144; i += G * 512) { float a = P.b_ada[i % 6144];
#pragma unroll
        for (int ks = 0; ks < 16; ++ks) a += modp[(size_t)ks * 4 * 6144 + i];
        ((float*)(ws + WS_MOD))[i] = a; }
    for (int i = vcu * 512 + tid; i < 512; i += G * 512) { float a = 0.f;
#pragma unroll
        for (int ks = 0; ks < 16; ++ks) a += ((const float*)(ws + WS_PEP))[ks * 512 + i];
        ((float*)(ws + WS_PEB))[i] = a; }
    const int rpw = NT / G;
    LAS float* sh = (LAS float*)lds;
    for (int r0 = vcu * rpw; r0 < NT; r0 += G * rpw) {
        const int b = r0 / SEQ;
        __syncthreads();
        for (int i = tid; i < 2048; i += 512) { const int j = (i < 1024) ? i : i;
            float a = P.b_ada[j];
#pragma unroll
            for (int ks = 0; ks < 16; ++ks) a += modp[(size_t)ks * 4 * 6144 + b * 6144 + j];
            sh[i] = (i < 1024) ? a : 1.0f + a; }
        __syncthreads();
        for (int m = r0 + wave; m < r0 + rpw; m += 8) {
            const f32x4* xr = (const f32x4*)(P.x + (size_t)m * DM) + lane; unsigned long long* o8 = (unsigned long long*)((bf16_t*)(ws + WS_H1) + (size_t)m * DM) + lane;
#pragma unroll
            for (int j = 0; j < 4; ++j) { const f32x4 v = xr[64 * j]; const int c0 = 4 * lane + 256 * j;
                const float y0 = v.x * sh[1024 + c0] + sh[c0], y1 = v.y * sh[1025 + c0] + sh[c0 + 1], y2 = v.z * sh[1026 + c0] + sh[c0 + 2], y3 = v.w * sh[1027 + c0] + sh[c0 + 3];
                o8[64 * j] = (unsigned long long)pk2(y0, y1) | ((unsigned long long)pk2(y2, y3) << 32); }
        }
    }
    __syncthreads();
}

DI void conv_item(const Params& P, LAS unsigned char* lds, int item, int wave, int lane, int tid) {
    const bf16_t* U = (const bf16_t*)(P.ws + WS_U); bf16_t* CAT = (bf16_t*)(P.ws + WS_CAT);
    LAS float* glu = (LAS float*)lds; LAS float* red = (LAS float*)(lds + 62 * 512 * 4); LAS float* stat = red + 32 * 8 * 2;
    const int b = item >> 8, t0 = (item & 255) * 32, c = tid;
    __syncthreads();
    {
        u32x4 av[8], gv8[8];
#pragma unroll
        for (int i = 0; i < 8; ++i) { const int task = tid + 512 * i, rr = task >> 6, oc = task & 63; int tok = t0 - 30 + (rr < 62 ? rr : 61); tok = tok < 0 ? 0 : tok;
            const bf16_t* up = U + (size_t)(b * SEQ + tok) * NU + oc * 8; av[i] = *(const u32x4*)(up + UCA); gv8[i] = *(const u32x4*)(up + UCG); }
#pragma unroll
        for (int i = 0; i < 8; ++i) { const int task = tid + 512 * i, rr = task >> 6, oc = task & 63; const bool ok = (t0 - 30 + rr) >= 0;
            const unsigned aw[4] = {av[i].x, av[i].y, av[i].z, av[i].w}, gw[4] = {gv8[i].x, gv8[i].y, gv8[i].z, gv8[i].w}; float o[8];
#pragma unroll
            for (int q = 0; q < 4; ++q) { o[2 * q] = ok ? bflo(aw[q]) * fsigmoid(bflo(gw[q])) : 0.f; o[2 * q + 1] = ok ? bfhi(aw[q]) * fsigmoid(bfhi(gw[q])) : 0.f; }
            if (rr < 62) { *(LAS f32x4*)(glu + rr * 512 + oc * 8) = (f32x4){o[0], o[1], o[2], o[3]}; *(LAS f32x4*)(glu + rr * 512 + oc * 8 + 4) = (f32x4){o[4], o[5], o[6], o[7]}; } }
    }
    float w[31];
#pragma unroll
    for (int j = 0; j < 31; ++j) w[j] = P.w_dw[j * 512 + c];
    const float bd = P.b_dw[c];
    __syncthreads();
    float y[32];
#pragma unroll
    for (int tt = 0; tt < 32; ++tt) y[tt] = bd;
#pragma unroll
    for (int rr = 0; rr < 62; ++rr) { const float gv = glu[rr * 512 + c];
#pragma unroll
        for (int tt = 0; tt < 32; ++tt) { if (rr - tt >= 0 && rr - tt <= 30) y[tt] += w[rr - tt] * gv; } }
    __syncthreads();
#pragma unroll
    for (int tt = 0; tt < 32; ++tt) glu[tt * 512 + c] = y[tt];
    __syncthreads();
    {
#pragma unroll
        for (int q = 0; q < 4; ++q) { const int tt = 4 * wave + q; const f32x4 a = *(const LAS f32x4*)(glu + tt * 512 + lane * 8), bq = *(const LAS f32x4*)(glu + tt * 512 + lane * 8 + 4);
            float s1 = ((a.x + a.y) + (a.z + a.w)) + ((bq.x + bq.y) + (bq.z + bq.w));
            float s2 = ((a.x * a.x + a.y * a.y) + (a.z * a.z + a.w * a.w)) + ((bq.x * bq.x + bq.y * bq.y) + (bq.z * bq.z + bq.w * bq.w));
            s1 = wave_sum(s1); s2 = wave_sum(s2);
            if (lane == 0) { const float mean = s1 * (1.0f / 512.0f); float var = s2 * (1.0f / 512.0f) - mean * mean; var = var < 0.f ? 0.f : var;
                stat[tt * 2] = mean; stat[tt * 2 + 1] = 1.0f / sqrtf(var + LN_EPS); } }
    }
    __syncthreads();
    const float lg = P.conv_ln_g[c], lb = P.conv_ln_b[c];
#pragma unroll
    for (int tt = 0; tt < 32; ++tt) { const float v = (y[tt] - stat[tt * 2]) * stat[tt * 2 + 1] * lg + lb;
        CAT[(size_t)(b * SEQ + t0 + tt) * DM + 512 + c] = (bf16_t)(pk2(fsilu(v), 0.f) & 0xffffu); }
}

DI unsigned swap23(unsigned p) { return (p & ~12u) | ((p & 4u) << 1) | ((p & 8u) >> 1); }
DI void vt_copies(const Params& P, LAS unsigned char* lds, int gw, int NGW, int wave, int lane) {
    unsigned char* ws = P.ws;
    LAS bf16_t* tile = (LAS bf16_t*)(lds + wave * 8448);
    const bf16_t* U = (const bf16_t*)(ws + WS_U);
    for (int it = gw; it < 2 * 8 * 128; it += NGW) { const int which = it >> 10, bg = (it >> 7) & 7, blk = it & 127, b = bg >> 1, gg = bg & 1;
        const bf16_t* src = U + (size_t)(b * SEQ + blk * 64 + lane) * NU + (which ? UVW : UVS) + gg * 64;
#pragma unroll
        for (int q = 0; q < 8; ++q) { const u32x4 v = *(const u32x4*)(src + q * 8); LAS unsigned* tp = (LAS unsigned*)(tile + lane * 66 + q * 8); tp[0] = v.x; tp[1] = v.y; tp[2] = v.z; tp[3] = v.w; }
        LDS_WAIT(); asm volatile("" ::: "memory");
        bf16_t* dst = (bf16_t*)(ws + (which ? WS_VWT : WS_VST)) + ((size_t)(bg * 128 + blk) * 64 + lane) * 64;
#pragma unroll
        for (int q = 0; q < 8; ++q) { unsigned wv[4];
#pragma unroll
            for (int e2 = 0; e2 < 4; ++e2) { const int p0 = q * 8 + e2 * 2; const int k0 = (p0 & ~15) | (int)swap23((unsigned)p0 & 15u), k1 = ((p0 + 1) & ~15) | (int)swap23((unsigned)(p0 + 1) & 15u);
                wv[e2] = (unsigned)tile[k0 * 66 + lane] | ((unsigned)tile[k1 * 66 + lane] << 16); }
            *(u32x4*)(dst + q * 8) = (u32x4){wv[0], wv[1], wv[2], wv[3]}; }
        LDS_WAIT(); asm volatile("" ::: "memory");
    }
}

DI void cmp2_rows(const Params& P, LAS unsigned char* lds, int kv, int row0, int nblk64, int tid) {
    unsigned char* ws = P.ws;
    const float* w2 = kv ? P.w_cmp_v2 : P.w_cmp_k2; LAS float* w2s = (LAS float*)lds;
    __syncthreads();
    for (int i = tid; i < 256 * 64 / 4; i += 512) ((LAS f32x4*)w2s)[i] = ((const f32x4*)w2)[i];
    __syncthreads();
    for (int blk = 0; blk < nblk64; ++blk) {
        const int row = row0 + blk * 64 + (tid >> 3), oc = tid & 7;
        const bf16_t* hrow = (const bf16_t*)(ws + WS_HCMP) + ((size_t)kv * 4096 + row) * 256;
        float acc[8];
#pragma unroll
        for (int j = 0; j < 8; ++j) acc[j] = 0.f;
        for (int k8 = 0; k8 < 32; ++k8) { const u32x4 hv = *(const u32x4*)(hrow + k8 * 8); const unsigned hw[4] = {hv.x, hv.y, hv.z, hv.w};
#pragma unroll
            for (int q = 0; q < 4; ++q) {
#pragma unroll
                for (int hh = 0; hh < 2; ++hh) { const float hval = hh ? bfhi(hw[q]) : bflo(hw[q]); const int k = k8 * 8 + q * 2 + hh;
                    const f32x4 wa = *(const LAS f32x4*)(w2s + k * 64 + oc * 8), wb = *(const LAS f32x4*)(w2s + k * 64 + oc * 8 + 4);
                    acc[0] += hval * wa.x; acc[1] += hval * wa.y; acc[2] += hval * wa.z; acc[3] += hval * wa.w; acc[4] += hval * wb.x; acc[5] += hval * wb.y; acc[6] += hval * wb.z; acc[7] += hval * wb.w; } } }
        const int bg = row >> 9, n = row & 511;
        if (n == 511) {
#pragma unroll
            for (int j = 0; j < 8; ++j) acc[j] = 0.f; }
        if (kv == 0) { u32x4 o; o.x = pk2(acc[0], acc[1]); o.y = pk2(acc[2], acc[3]); o.z = pk2(acc[4], acc[5]); o.w = pk2(acc[6], acc[7]);
            *(u32x4*)((bf16_t*)(ws + WS_KC) + ((size_t)bg * 512 + n) * 64 + oc * 8) = o; }
        else { bf16_t* vt = (bf16_t*)(ws + WS_VCT) + (size_t)bg * 64 * 512; const int pos = (n & ~15) | (int)swap23((unsigned)n & 15u);
#pragma unroll
            for (int j = 0; j < 8; ++j) vt[(size_t)(oc * 8 + j) * 512 + pos] = (bf16_t)(pk2(acc[j], 0.f) & 0xffffu); }
    }
    __syncthreads();
}
DI void phase_cmp2(const Params& P, LAS unsigned char* lds, int vcu, int G, int wave, int lane, int tid) {
    for (int it = vcu; it < 128; it += G) cmp2_rows(P, lds, it >> 6, (it & 63) * 64, 1, tid);
    __syncthreads();
}
namespace attn {
constexpr int ROWB = 144;
constexpr int TROW = 128, TILEB = 64 * TROW;
constexpr int OFF_K = 0, OFF_V = 2 * TILEB, OFF_IMPG = 36864, OFF_IMPL = OFF_IMPG + 32768;
constexpr int OFF_SELM = LDS_TAB, OFF_MREF = LDS_TAB + 1024, OFF_LSUM = LDS_TAB + 2048, OFF_LIST = LDS_TAB + 4096, OFF_TM = LDS_TAB + 6144;
constexpr int OFF_QS = 0, OFF_PBUF = 36864, PSLOT = 32 * ROWB;
constexpr float NEG = -1e30f, MFLOOR = -1e20f;
#define MFMA32(a, b, c) __builtin_amdgcn_mfma_f32_32x32x16_bf16((a), (b), (c), 0, 0, 0)
DI float fexp2(float x) { return __builtin_amdgcn_exp2f(x); }
DI void dma_tile(const bf16_t* base, unsigned pitch, LAS unsigned char* buf, int wave, int lane) {
    const int row = 8 * wave + (lane >> 3), ch = (lane & 7) ^ ((row >> 1) & 7);
    __builtin_amdgcn_global_load_lds((const unsigned*)(base + (unsigned)(row * pitch + ch * 8)), (LAS unsigned*)(buf + wave * 1024), 16, 0, 0); }
DI bf16x8 pack8(const f32x16& p, int s2) { u32x4 w; w.x = pk2(p[8 * s2], p[8 * s2 + 1]); w.y = pk2(p[8 * s2 + 2], p[8 * s2 + 3]); w.z = pk2(p[8 * s2 + 4], p[8 * s2 + 5]); w.w = pk2(p[8 * s2 + 6], p[8 * s2 + 7]); return __builtin_bit_cast(bf16x8, w); }

constexpr int CV_PER_EXPERT = 1536, CV_TOTAL = NEXP * CV_PER_EXPERT;
struct CvState { int next, end, nfly; bool xafter; };
DI LAS unsigned char* cv_buf(LAS unsigned char* lds, int wave, int seq) { return lds + (wave < 4 ? 110592 + wave * 4096 : LDS_TAB + 8192 + (wave - 4) * 4096) + (seq & 1) * 2048; }
DI void cv_decode(int m, int& e, int& mat, int& k0, int& n0) { e = m / CV_PER_EXPERT; const int q = m % CV_PER_EXPERT; mat = q >> 9; const int w = q & 511;
    if (mat < 2) { n0 = (w >> 5) * 16; k0 = (w & 31) * 32; } else { n0 = (w >> 3) * 16; k0 = (w & 7) * 32; } }
DI void cv_issue(const Params& P, CvState& c, LAS unsigned char* lds, int wave, int lane) {
    int e, mat, k0, n0; cv_decode(c.next, e, mat, k0, n0);
    LAS unsigned* st = (LAS unsigned*)cv_buf(lds, wave, c.next);
    const int ldw = (mat < 2) ? 256 : 1024;
    const float* W = (mat == 0 ? P.w_e_gate : mat == 1 ? P.w_e_up : P.w_e_down) + (size_t)e * 1024 * 256;
    const float* src = W + (size_t)(k0 + (lane >> 2)) * ldw + n0 + 4 * (lane & 3);
#pragma unroll
    for (int j = 0; j < 2; ++j) __builtin_amdgcn_global_load_lds((const unsigned*)(src + (size_t)(16 * j) * ldw), st + j * 256, 16, 0, 0);
    ++c.nfly; ++c.next; c.xafter = true;
}
DI void cv_finish(const Params& P, CvState& c, LAS unsigned char* lds, int wave, int lane) {
    const int m = c.next - c.nfly; int e, mat, k0, n0; cv_decode(m, e, mat, k0, n0);
    const int nl = lane >> 2, kc = (lane & 3) * 8;
    const LAS float* st = (const LAS float*)cv_buf(lds, wave, m) + kc * 16 + nl;
    u32x4 o; o.x = pk2(st[0 * 16], st[1 * 16]); o.y = pk2(st[2 * 16], st[3 * 16]); o.z = pk2(st[4 * 16], st[5 * 16]); o.w = pk2(st[6 * 16], st[7 * 16]);
    const int n = n0 + nl; bf16_t* dst;
    if (mat < 2) dst = (bf16_t*)(P.ws + WS_WGU_T) + (size_t)e * 512 * 1024 + (size_t)((n >> 7) * 256 + mat * 128 + (n & 127)) * 1024 + k0 + kc;
    else dst = (bf16_t*)(P.ws + WS_WDN_T) + (size_t)e * 1024 * 256 + (size_t)n * 256 + k0 + kc;
    asm volatile("s_waitcnt lgkmcnt(0)" ::: "memory");
    *(u32x4*)dst = o; --c.nfly;
}

template <int MODE>
DI void tile_compute(const LAS unsigned char* Kb, const LAS unsigned char* Vb, const bf16x8 (&qf)[4], int r, int h, int lo, int hi, bool elem,
                     float& m, float& l, f32x16 (&O)[2], float meff_in, float linv, LAS float* impg, LAS float* impl, int sb0) {
    const bool rowfull = (lo <= 0 && hi >= 63);
    const int lo2 = lo - 4 * h, hi2 = hi - 4 * h, swz = (r >> 1) & 7;
#pragma unroll
    for (int kh = 0; kh < 2; ++kh) {
        f32x16 s;
#pragma unroll
        for (int i = 0; i < 16; ++i) s[i] = 0.f;
#pragma unroll
        for (int ks = 0; ks < 4; ++ks) { const bf16x8 a = *(const LAS bf16x8*)(Kb + (32 * kh + r) * TROW + (((2 * ks + h) ^ swz) << 4)); s = MFMA32(a, qf[ks], s); }
        if (elem) {
#pragma unroll
            for (int i = 0; i < 16; ++i) { const int k0 = (i & 3) + 8 * (i >> 2) + 32 * kh; s[i] = (k0 >= lo2 && k0 <= hi2) ? s[i] : NEG; }
        }
        float cref;
        if (MODE != 2) {
            float tm = s[0];
#pragma unroll
            for (int i = 1; i < 16; ++i) tm = fmaxf(tm, s[i]);
            tm = fmaxf(tm, __shfl_xor(tm, 32));
            if (!elem) tm = rowfull ? tm : NEG;
            const bool need = tm > m + 8.0f;
            if (__any(need)) {
                const float mnew = need ? tm : m;
                const float alpha = fexp2(fmaxf(m, MFLOOR) - fmaxf(mnew, MFLOOR));
                l *= alpha; m = mnew;
                if (MODE == 0) {
#pragma unroll
                    for (int i = 0; i < 16; ++i) { O[0][i] *= alpha; O[1][i] *= alpha; } }
            }
            cref = (elem || rowfull) ? fmaxf(m, MFLOOR) : 1e30f;
            float rs = 0.f;
#pragma unroll
            for (int i = 0; i < 16; ++i) { s[i] = fexp2(s[i] - cref); rs += s[i]; }
            rs += __shfl_xor(rs, 32);
            l += rs;
        } else {
            cref = (elem || rowfull) ? meff_in : 1e30f;
#pragma unroll
            for (int i = 0; i < 16; ++i) s[i] = fexp2(s[i] - cref);
        }
        if (MODE == 1) continue;
        if (MODE == 2) {
#pragma unroll
            for (int gq = 0; gq < 4; ++gq) {
                float Gs = ((s[4 * gq] + s[4 * gq + 1]) + (s[4 * gq + 2] + s[4 * gq + 3])) * linv, Ls = s[4 * gq + 3] * linv;
                Gs += __shfl_xor(Gs, 1); Gs += __shfl_xor(Gs, 2); Ls += __shfl_xor(Ls, 1); Ls += __shfl_xor(Ls, 2);
                if ((r & 3) == 0) { const int sb = sb0 + 8 * kh + 2 * gq + h; impg[sb] = Gs; impl[sb] = Ls; } }
        }
#pragma unroll
        for (int s2 = 0; s2 < 2; ++s2) { const bf16x8 pf = pack8(s, s2);
#pragma unroll
            for (int dt = 0; dt < 2; ++dt) { const bf16x8 a = *(const LAS bf16x8*)(Vb + (32 * dt + r) * TROW + (((4 * kh + 2 * s2 + h) ^ swz) << 4));
                O[dt] = MFMA32(a, pf, O[dt]); } }
    }
}

DI void attn_unit(const Params& P, LAS unsigned char* lds, int bg, int qt, int wave, int lane_in, int tid_in, int& it, CvState& cv) {
    int lane = lane_in; asm volatile("" : "+v"(lane));
    const int tid = wave * 64 + lane;
    unsigned char* ws = P.ws;
    const bf16_t* U = (const bf16_t*)(ws + WS_U);
    const int b = bg >> 1, gg = bg & 1, t0 = qt * 64, r = lane & 31, h = lane >> 5, tokl = 8 * wave + (r >> 2), hp = r & 3, t = t0 + tokl;
    LAS float* IMPG = (LAS float*)(lds + OFF_IMPG); LAS float* IMPL = (LAS float*)(lds + OFF_IMPL); LAS unsigned* SELM = (LAS unsigned*)(lds + OFF_SELM);
#define ATT_UROW(name) int lq_ = lane; asm volatile("" : "+v"(lq_)); const bf16_t* name = U + (size_t)(b * SEQ + t0 + 8 * wave + ((lq_ & 31) >> 2)) * NU; const int hq_ = lq_ & 3, hh_ = lq_ >> 5; (void)hq_; (void)hh_;
    bf16x8 qf[4];
#define ATT_LOADQ() do { ATT_UROW(urow_) _Pragma("unroll") for (int ks = 0; ks < 4; ++ks) qf[ks] = *(const bf16x8*)(urow_ + UQ + (4 * gg + hq_) * 64 + 16 * ks + 8 * hh_); } while (0)
    ATT_LOADQ();
    f32x16 OA[2];
#pragma unroll
    for (int i = 0; i < 16; ++i) { OA[0][i] = 0.f; OA[1][i] = 0.f; }
    __syncthreads();
#pragma unroll
    for (int j = 0; j < 4; ++j) { *(LAS f32x4*)(IMPG + 8 * wave * 128 + lane * 4 + 256 * j) = (f32x4){0.f, 0.f, 0.f, 0.f}; *(LAS f32x4*)(IMPL + 8 * wave * 128 + lane * 4 + 256 * j) = (f32x4){0.f, 0.f, 0.f, 0.f}; }
    f32x16 O[2]; float m, l;
#define ATT_RESET() do { m = NEG; l = 0.f; _Pragma("unroll") for (int i = 0; i < 16; ++i) { O[0][i] = 0.f; O[1][i] = 0.f; } } while (0)
#define ATT_FOLD(br) do { ATT_UROW(urow_) const float gate_ = fsigmoid(bf2f(urow_[UGT + gg * 12 + hq_ * 3 + (br)])); const float sc_ = (l > 0.f) ? gate_ / l : 0.f; _Pragma("unroll") for (int i = 0; i < 16; ++i) { OA[0][i] += sc_ * O[0][i]; OA[1][i] += sc_ * O[1][i]; } } while (0)

#define ATT_STEP(CUR, NXT, TI, KPTR, KPITCH, VPTR, VPITCH, USEV, ...) { \
            LAS unsigned char* Kb = lds + OFF_K + (CUR) * TILEB; LAS unsigned char* Vb = lds + OFF_V + (CUR) * TILEB; \
            int nfin_; if (cv.xafter) { asm volatile("s_waitcnt vmcnt(2)" ::: "memory"); nfin_ = cv.nfly - 1; } else { asm volatile("s_waitcnt vmcnt(0)" ::: "memory"); nfin_ = cv.nfly; } \
            for (int f_ = 0; f_ < nfin_; ++f_) cv_finish(P, cv, lds, wave, tz_); \
            asm volatile("s_waitcnt lgkmcnt(0)" ::: "memory"); __builtin_amdgcn_s_barrier(); asm volatile("" ::: "memory"); \
            if ((TI) + 1 < n_) { const int pi = (TI) + 1; dma_tile(KPTR, KPITCH, lds + OFF_K + (NXT) * TILEB, wave, tz_); if (USEV) dma_tile(VPTR, VPITCH, lds + OFF_V + (NXT) * TILEB, wave, tz_); cv.xafter = false; } \
            if (cv.next < cv.end && cv.nfly < 2) cv_issue(P, cv, lds, wave, tz_); \
            { const int ti = (TI); __VA_ARGS__ } ++it; }
#define ATT_LOOP(NTILES, KPTR, KPITCH, VPTR, VPITCH, USEV, ...) { const int n_ = (NTILES); int tz_ = lane; asm volatile("" : "+v"(tz_)); \
        asm volatile("s_waitcnt lgkmcnt(0)" ::: "memory"); __builtin_amdgcn_s_barrier(); asm volatile("" ::: "memory");     \
        if (n_ > 0) { const int pi = 0; dma_tile(KPTR, KPITCH, lds + OFF_K, wave, tz_); if (USEV) dma_tile(VPTR, VPITCH, lds + OFF_V, wave, tz_); cv.xafter = false; } \
        for (int i_ = 0; i_ < n_; i_ += 2) { \
            ATT_STEP(0, 1, i_, KPTR, KPITCH, VPTR, VPITCH, USEV, __VA_ARGS__) \
            if (i_ + 1 < n_) ATT_STEP(1, 0, i_ + 1, KPTR, KPITCH, VPTR, VPITCH, USEV, __VA_ARGS__) } }

    const bf16_t* KC = (const bf16_t*)(ws + WS_KC) + (size_t)bg * 512 * 64; const bf16_t* VCT = (const bf16_t*)(ws + WS_VCT) + (size_t)bg * 64 * 512;
    const int hin = (t - 31) >> 4;
    const int ntc = (((t0 + 32) >> 4) >> 6) + 1;
    ATT_RESET();
    ATT_LOOP(ntc, KC + (size_t)pi * 64 * 64, 64, KC, 64, false, {
        const int hi = hin - 64 * ti; const bool fe = (hi >= 63) || (hi < 0);
        if (!__all(hi < 0)) tile_compute<1>(Kb, Kb, qf, r, h, 0, hi, !__all(fe), m, l, O, 0.f, 0.f, nullptr, nullptr, 0); })
    {
        const float meff = fmaxf(m, MFLOOR), linv = (l > 0.f) ? 1.0f / l : 0.f;
        ATT_LOOP(ntc, KC + (size_t)pi * 64 * 64, 64, VCT + pi * 64, 512, true, {
            const int hi = hin - 64 * ti; const bool fe = (hi >= 63) || (hi < 0);
            float md = m, ld_ = l;
            if (!__all(hi < 0)) tile_compute<2>(Kb, Vb, qf, r, h, 0, hi, !__all(fe), md, ld_, O, meff, linv, IMPG + tokl * 128, IMPL + tokl * 128, 16 * ti); })
        ATT_FOLD(0);
    }
    for (int tk = 0; tk < 8; ++tk) { const int trow = 8 * wave + tk;
        const float ilo = IMPG[trow * 128 + lane] + (lane > 0 ? IMPL[trow * 128 + lane - 1] : 0.f), ihi = IMPG[trow * 128 + 64 + lane] + IMPL[trow * 128 + 63 + lane];
        const int slo = lane, shi = 64 + lane;
        const bool clo = slo <= qt, chi = shi <= qt, flo = (slo == 0) || (slo == qt) || (slo + 1 == qt), fhi = (shi == qt) || (shi + 1 == qt);
        const unsigned klo = clo ? ((flo ? 0xFFFFFF80u : (__float_as_uint(ilo) & 0xFFFFFF80u)) | (unsigned)(127 - slo)) : 0u;
        const unsigned khi = chi ? ((fhi ? 0xFFFFFF80u : (__float_as_uint(ihi) & 0xFFFFFF80u)) | (unsigned)(127 - shi)) : 0u;
        unsigned T = 0u;
        for (int bit = 31; bit >= 0; --bit) { const unsigned cand = T | (1u << bit);
            const int cnt = __popcll(__ballot(klo >= cand)) + __popcll(__ballot(khi >= cand)); if (cnt >= 16) T = cand; }
        const unsigned long long blo = __ballot(klo >= T && klo != 0u), bhi = __ballot(khi >= T && khi != 0u);
        if (lane == 0) { *(LAS u32x4*)(SELM + trow * 4) = (u32x4){(unsigned)blo, (unsigned)(blo >> 32), (unsigned)bhi, (unsigned)(bhi >> 32)}; }
    }
    { int lp_ = lane; asm volatile("" : "+v"(lp_)); float* oapark = (float*)(ws + WS_HIDM) + ((size_t)(blockIdx.x * 8 + wave) * 32) * 64 + lp_;
#pragma unroll
      for (int i = 0; i < 16; ++i) { oapark[i * 64] = OA[0][i]; oapark[(16 + i) * 64] = OA[1][i]; } }
    ATT_RESET();
    const bf16_t* KS = U + (size_t)(b * SEQ) * NU + UKS + gg * 64; const bf16_t* VST = (const bf16_t*)(ws + WS_VST) + (size_t)bg * 128 * 4096;
    constexpr int QT_COMPACT = 96;
    if (qt < QT_COMPACT) {
        const u32x4 selw = *(const LAS u32x4*)(SELM + tokl * 4);
        ATT_LOOP(qt + 1, KS + (size_t)pi * 64 * NU, NU, VST + (size_t)pi * 4096, 64, true, {
            const int j = ti;
            const unsigned wsel = (j < 32) ? selw.x : (j < 64) ? selw.y : (j < 96) ? selw.z : selw.w; const bool sel = (wsel >> (j & 31)) & 1u;
            const int hi = !sel ? -1 : (j == qt ? tokl : 63);
            if (!__all(!sel)) tile_compute<0>(Kb, Vb, qf, r, h, 0, hi, j == qt, m, l, O, 0.f, 0.f, nullptr, nullptr, 0); })
    } else {
        {
#define JMAP(i) ((i) == 0 ? 0 : qt - (2 - (i)))
            ATT_LOOP(3, KS + (size_t)JMAP(pi) * 64 * NU, NU, VST + (size_t)JMAP(pi) * 4096, 64, true, {
                const int j = JMAP(ti);
                tile_compute<0>(Kb, Vb, qf, r, h, 0, (j == qt ? tokl : 63), j == qt, m, l, O, 0.f, 0.f, nullptr, nullptr, 0); })
#undef JMAP
        }
        int lz = lane; asm volatile("" : "+v"(lz));
        const int r = lz & 31, h = lz >> 5, hp = r & 3, tokl = 8 * wave + (r >> 2), lane = lz, tid = wave * 64 + lz;
        LAS unsigned char* Qs = lds + OFF_QS; LAS float* MREF = (LAS float*)(lds + OFF_MREF); LAS float* LSUM = (LAS float*)(lds + OFF_LSUM); LAS int* LIST = (LAS int*)(lds + OFF_LIST) + wave * 64;
        LAS unsigned long long* TM = (LAS unsigned long long*)(lds + OFF_TM);
        if (h == 0) MREF[32 * wave + r] = fmaxf(m, MFLOOR);
        for (int j = wave; j < 128; j += 8) { const unsigned long long mk = __ballot((SELM[lane * 4 + (j >> 5)] >> (j & 31)) & 1u); if (lane == 0) TM[j] = mk; }
        __syncthreads();
#pragma unroll
        for (int q4 = 0; q4 < 4; ++q4) { const int ch = tid + 512 * q4, row = ch >> 3, c8 = ch & 7;
            *(LAS u32x4*)(Qs + row * ROWB + c8 * 16) = *(const u32x4*)(U + (size_t)(b * SEQ + t0 + (row >> 2)) * NU + UQ + (4 * gg + (row & 3)) * 64 + c8 * 8); }
        __syncthreads();
        const int jend = qt - 2; int jn = 1, rk = 0;
        const unsigned long long ltl = (1ull << tokl) - 1ull;
        int pjs = 0, pcnt = 0;
#define FAR_TM(dst, jj) { const unsigned long long tv_ = TM[(jj) <= jend ? (jj) : 0]; const unsigned lo_ = __builtin_amdgcn_readfirstlane((unsigned)tv_), hi_ = __builtin_amdgcn_readfirstlane((unsigned)(tv_ >> 32)); \
            dst = ((jj) <= jend) ? (((unsigned long long)hi_ << 32) | lo_) : 0ull; }
        for (;;) {
            int cnt = 0, used = 0, myj = -1, myc = 0; unsigned long long mymask = 0ull;
#pragma unroll
            for (int i = 0; i < 8; ++i) { const int jj = jn + i; unsigned long long mk; FAR_TM(mk, jj) const int nch = (__popcll(mk) + 7) >> 3;
                const bool take = (cnt == i) && (jj <= jend) && (used + nch <= 8);
                if (take) { if (wave >= used && wave < used + nch) { myj = jj; myc = wave - used; mymask = mk; } used += nch; ++cnt; } }
            if (cnt == 0 && pcnt == 0) break;
            const int cjs = jn; jn += cnt;
            bf16x8 kf[2][4], vf[2][4];
            if (myj >= 0) { const bf16_t* Kg = KS + (size_t)(myj * 64 + r) * NU + 8 * h; const bf16_t* Vg = VST + (size_t)myj * 4096 + r * 64 + 8 * h;
#pragma unroll
                for (int kh = 0; kh < 2; ++kh)
#pragma unroll
                    for (int ks = 0; ks < 4; ++ks) { kf[kh][ks] = *(const bf16x8*)(Kg + (size_t)(32 * kh) * NU + 16 * ks); vf[kh][ks] = *(const bf16x8*)(Vg + kh * 32 * 64 + ks * 16); } }
            if (pcnt > 0) { int base = 0;
#pragma unroll
                for (int i = 0; i < 8; ++i) { unsigned long long mk; FAR_TM(mk, pjs + i) if (i >= pcnt) mk = 0ull; const int nch = (__popcll(mk) + 7) >> 3;
                    const bool act = (mk >> tokl) & 1ull;
                    if (__any(act)) { const int rank = __popcll(mk & ltl), slot = base + (rank >> 3), prow = (rank & 7) * 4 + hp;
                        const LAS unsigned char* Pb = lds + OFF_PBUF + (((rk + 1) & 1) * 8 + slot) * PSLOT + prow * ROWB + h * 8;
#pragma unroll
                        for (int dt = 0; dt < 2; ++dt)
#pragma unroll
                            for (int gq = 0; gq < 4; ++gq) { u32x2 w = *(const LAS u32x2*)(Pb + (32 * dt + 8 * gq) * 2); if (!act) w = (u32x2){0u, 0u};
                                O[dt][4 * gq] += bflo(w.x); O[dt][4 * gq + 1] += bfhi(w.x); O[dt][4 * gq + 2] += bflo(w.y); O[dt][4 * gq + 3] += bfhi(w.y); }
                        l += act ? LSUM[(((rk + 1) & 1) * 8 + slot) * 32 + prow] : 0.f; }
                    base += nch; } }
            if (myj >= 0) {
                LAS unsigned char* Pw = lds + OFF_PBUF + ((rk & 1) * 8 + wave) * PSLOT;
                if ((mymask >> lane) & 1ull) LIST[__popcll(mymask & ((1ull << lane) - 1ull))] = lane;
                const int rank = 8 * myc + (r >> 2); const bool valid = rank < __popcll(mymask);
                const int tok = valid ? LIST[rank] : 0; const int qrow = tok * 4 + hp;
                bf16x8 qg[4];
#pragma unroll
                for (int ks = 0; ks < 4; ++ks) qg[ks] = *(const LAS bf16x8*)(Qs + qrow * ROWB + ks * 32 + h * 16);
                const float mr = MREF[qrow];
                float rs = 0.f; f32x16 Oc[2];
#pragma unroll
                for (int i = 0; i < 16; ++i) { Oc[0][i] = 0.f; Oc[1][i] = 0.f; }
#pragma unroll
                for (int kh = 0; kh < 2; ++kh) { f32x16 sv;
#pragma unroll
                    for (int i = 0; i < 16; ++i) sv[i] = 0.f;
#pragma unroll
                    for (int ks = 0; ks < 4; ++ks) sv = MFMA32(kf[kh][ks], qg[ks], sv);
#pragma unroll
                    for (int i = 0; i < 16; ++i) { sv[i] = valid ? fexp2(fminf(sv[i] - mr, 100.0f)) : 0.f; rs += sv[i]; }
#pragma unroll
                    for (int s2 = 0; s2 < 2; ++s2) { const bf16x8 pf = pack8(sv, s2);
                        Oc[0] = MFMA32(vf[0][kh * 2 + s2], pf, Oc[0]); Oc[1] = MFMA32(vf[1][kh * 2 + s2], pf, Oc[1]); } }
                rs += __shfl_xor(rs, 32);
                if (h == 0) LSUM[((rk & 1) * 8 + wave) * 32 + r] = rs;
#pragma unroll
                for (int dt = 0; dt < 2; ++dt)
#pragma unroll
                    for (int gq = 0; gq < 4; ++gq) { u32x2 w; w.x = pk2(Oc[dt][4 * gq], Oc[dt][4 * gq + 1]); w.y = pk2(Oc[dt][4 * gq + 2], Oc[dt][4 * gq + 3]);
                        *(LAS u32x2*)(Pw + r * ROWB + (32 * dt + 8 * gq + 4 * h) * 2) = w; }
            }
            __syncthreads();
            pjs = cjs; pcnt = cnt; ++rk;
        }
#undef FAR_TM
    }
    { int lp_ = lane; asm volatile("" : "+v"(lp_)); const float* oapark = (const float*)(ws + WS_HIDM) + ((size_t)(blockIdx.x * 8 + wave) * 32) * 64 + lp_;
#pragma unroll
      for (int i = 0; i < 16; ++i) { OA[0][i] = oapark[i * 64]; OA[1][i] = oapark[(16 + i) * 64]; } }
    ATT_FOLD(1);
    ATT_LOADQ();
    ATT_RESET();
    {
        int lw_ = lane; asm volatile("" : "+v"(lw_)); const int r = lw_ & 31, h = lw_ >> 5, tokl = 8 * wave + (r >> 2);
        const int jlo = qt >= 8 ? qt - 8 : 0;
        const bf16_t* KW = U + (size_t)(b * SEQ + jlo * 64) * NU + UKW + gg * 64; const bf16_t* VWT = (const bf16_t*)(ws + WS_VWT) + ((size_t)bg * 128 + jlo) * 4096;
        ATT_LOOP(qt - jlo + 1, KW + (size_t)pi * 64 * NU, NU, VWT + (size_t)pi * 4096, 64, true, {
            const int j = jlo + ti;
            const bool low = (j + 8 == qt), diag = (j == qt);
            const int lo = low ? tokl + 1 : 0, hi = diag ? tokl : 63;
            tile_compute<0>(Kb, Vb, qf, r, h, lo, hi, low || diag, m, l, O, 0.f, 0.f, nullptr, nullptr, 0); })
        ATT_FOLD(2);
    }
    int lo_ = lane; asm volatile("" : "+v"(lo_)); const int h_o = lo_ >> 5;
    bf16_t* orow = (bf16_t*)(ws + WS_CAT) + (size_t)(b * SEQ + t0 + 8 * wave + ((lo_ & 31) >> 2)) * DM + (4 * gg + (lo_ & 3)) * 64;
#pragma unroll
    for (int dt = 0; dt < 2; ++dt)
#pragma unroll
        for (int gq = 0; gq < 4; ++gq) { u32x2 w; w.x = pk2(OA[dt][4 * gq], OA[dt][4 * gq + 1]); w.y = pk2(OA[dt][4 * gq + 2], OA[dt][4 * gq + 3]);
            *(u32x2*)(orow + 32 * dt + 8 * gq + 4 * h_o) = w; }
#undef ATT_RESET
#undef ATT_FOLD
#undef ATT_LOADQ
#undef ATT_UROW
#undef ATT_LOOP
#undef ATT_STEP
}

DI void attn_phase(const Params& P, LAS unsigned char* lds, int vcu, int G, int wave, int lane, int tid) {
    int it = 0;
    CvState cv; { const int per = CV_TOTAL / (G * 8), gw = vcu * 8 + wave; cv.next = gw * per; cv.end = (gw == G * 8 - 1) ? CV_TOTAL : cv.next + per; cv.nfly = 0; cv.xafter = false; }
    static constexpr unsigned char QT_TAB[32][4] = {{14,37,91,127},{30,44,68,126},{31,35,77,100},{23,48,69,125},{27,40,76,99},{10,53,79,124},{17,38,85,123},{19,32,89,122},{20,33,87,121},{29,43,70,120},{21,54,66,107},{0,58,90,119},{25,42,75,118},{22,47,74,106},{18,34,88,117},{3,51,92,105},{15,56,71,116},{11,39,93,98},{9,49,82,115},{28,36,78,114},{24,52,64,113},{16,41,84,104},{5,46,95,97},{4,59,81,112},{26,50,65,103},{8,62,72,111},{6,45,94,102},{7,55,80,96},{2,61,83,110},{13,63,67,101},{1,60,86,109},{12,57,73,108}};
    if (G == 256) {
        const int bg = vcu >> 5, s = vcu & 31;
        for (int k = 3; k >= 0; --k) { const int qt = (k == 0) ? QT_TAB[s][0] : (k == 1) ? QT_TAB[s][1] : (k == 2) ? QT_TAB[s][2] : QT_TAB[s][3]; attn_unit(P, lds, bg, qt, wave, lane, tid, it, cv); }
    } else {
        for (int ui = vcu; ui < 1024; ui += G) { const int k = ui >> 8, v = ui & 255, bg = v >> 5, s = v & 31;
            const int qt = (k == 0) ? s : (k == 1) ? 63 - s : (k == 2) ? 64 + s : 127 - s;
            attn_unit(P, lds, bg, qt, wave, lane, tid, it, cv); }
    }
    for (;;) {
        if (cv.nfly > 0) { asm volatile("s_waitcnt vmcnt(0)" ::: "memory"); while (cv.nfly > 0) cv_finish(P, cv, lds, wave, lane); }
        if (cv.next >= cv.end) break;
        cv_issue(P, cv, lds, wave, lane); if (cv.next < cv.end) cv_issue(P, cv, lds, wave, lane); }
    __syncthreads();
}
}
#ifndef CHECK_ATTN
#define CHECK_ATTN 0
#endif
#if CHECK_ATTN
constexpr int CW_ERR = 8192;
namespace attnchk {
DI float wmax(float v) {
#pragma unroll
    for (int o = 1; o < 64; o <<= 1) v = fmaxf(v, __shfl_xor(v, o));
    return v; }
DI void item(const Params& P, LAS float* scr, int bg, int t, int lane, float& se, float& sr) {
    unsigned char* ws = P.ws; const bf16_t* U = (const bf16_t*)(ws + WS_U);
    const int b = bg >> 1, gg = bg & 1;
    LAS float* q = scr; LAS float* pc = scr + 256; LAS float* sc = scr + 768;
    const bf16_t* urow = U + (size_t)(b * SEQ + t) * NU;
    for (int i = lane; i < 256; i += 64) q[i] = bf2f(urow[UQ + gg * 256 + i]);
    const bf16_t* KC = (const bf16_t*)(ws + WS_KC) + (size_t)bg * 512 * 64; const bf16_t* VCT = (const bf16_t*)(ws + WS_VCT) + (size_t)bg * 64 * 512;
    const int nvalid = t >= 31 ? ((t - 31) >> 4) + 1 : 0, cur = t >> 6;
    float oc[4], os[4], ow[4], imp0 = 0.f, imp1 = 0.f;
    for (int p = 0; p < 4; ++p) {
        float sv[8], mx = -3e38f;
        for (int i = 0; i < 8; ++i) { const int n = lane + 64 * i; float a = 0.f;
            if (n < nvalid) { for (int d = 0; d < 64; ++d) a += q[p * 64 + d] * bf2f(KC[n * 64 + d]); mx = fmaxf(mx, a); }
            sv[i] = a; }
        mx = wmax(mx); float ls = 0.f;
        for (int i = 0; i < 8; ++i) { const int n = lane + 64 * i; const float e = (n < nvalid) ? exp2f(sv[i] - mx) : 0.f; sv[i] = e; ls += e; }
        ls = wave_sum(ls); const float inv = ls > 0.f ? 1.f / ls : 0.f;
        for (int i = 0; i < 8; ++i) pc[lane + 64 * i] = sv[i] * inv;
        float o = 0.f;
        for (int n = 0; n < nvalid; ++n) { const int pos = (n & ~15) | (int)swap23((unsigned)n & 15u); o += pc[n] * bf2f(VCT[lane * 512 + pos]); }
        oc[p] = o;
        for (int k = -1; k <= 3; ++k) { const int n0 = 4 * lane + k, n1 = 4 * (lane + 64) + k;
            if (n0 >= 0 && n0 < nvalid) imp0 += pc[n0]; if (n1 < nvalid) imp1 += pc[n1]; }
    }
    const float INF = __builtin_inff();
    const int s0 = lane, s1 = lane + 64;
    const float v0 = (s0 == 0 || s0 == cur || s0 == cur - 1) ? INF : (s0 <= cur ? imp0 : -INF);
    const float v1 = (s1 == cur || s1 == cur - 1) ? INF : (s1 <= cur ? imp1 : -INF);
    int r0 = 0, r1 = 0;
    for (int j = 0; j < 128; ++j) { const float vj = (j < 64) ? __shfl(v0, j) : __shfl(v1, j - 64);
        r0 += (vj > v0 || (vj == v0 && j < s0)) ? 1 : 0; r1 += (vj > v1 || (vj == v1 && j < s1)) ? 1 : 0; }
    const unsigned long long m0 = __ballot(r0 < 16 && v0 > -INF), m1 = __ballot(r1 < 16 && v1 > -INF);
    for (int br = 0; br < 2; ++br) {
        const bf16_t* Kp = U + (size_t)(b * SEQ) * NU + (br ? UKW : UKS) + gg * 64; const bf16_t* Vp = U + (size_t)(b * SEQ) * NU + (br ? UVW : UVS) + gg * 64;
        for (int p = 0; p < 4; ++p) {
            int nk = 0; float mx = -3e38f;
            if (br == 0) {
                for (int j = 0; j < 128; ++j) { const bool on = (j < 64) ? ((m0 >> j) & 1ull) : ((m1 >> (j - 64)) & 1ull); if (!on) continue;
                    const int key = 64 * j + lane; float a = -3e38f;
                    if (key <= t) { a = 0.f; for (int d = 0; d < 64; ++d) a += q[p * 64 + d] * bf2f(Kp[(size_t)key * NU + d]); mx = fmaxf(mx, a); }
                    sc[nk * 64 + lane] = a; ++nk; }
            } else {
                for (int i = 0; i < 8; ++i) { const int key = t - 511 + lane + 64 * i; float a = -3e38f;
                    if (key >= 0 && key <= t) { a = 0.f; for (int d = 0; d < 64; ++d) a += q[p * 64 + d] * bf2f(Kp[(size_t)key * NU + d]); mx = fmaxf(mx, a); }
                    sc[i * 64 + lane] = a; }
                nk = 8;
            }
            mx = wmax(mx); float ls = 0.f;
            for (int i = 0; i < nk; ++i) { const float a = sc[i * 64 + lane]; const float e = (a > -1e38f) ? exp2f(a - mx) : 0.f; sc[i * 64 + lane] = e; ls += e; }
            ls = wave_sum(ls); const float inv = ls > 0.f ? 1.f / ls : 0.f;
            float o = 0.f;
            if (br == 0) { int idx = 0;
                for (int j = 0; j < 128; ++j) { const bool on = (j < 64) ? ((m0 >> j) & 1ull) : ((m1 >> (j - 64)) & 1ull); if (!on) continue;
                    for (int kk = 0; kk < 64; ++kk) { const float pv = sc[idx * 64 + kk]; if (pv != 0.f) o += pv * bf2f(Vp[(size_t)(64 * j + kk) * NU + lane]); }
                    ++idx; }
                os[p] = o * inv;
            } else {
                for (int i = 0; i < 8; ++i) for (int kk = 0; kk < 64; ++kk) { const int key = t - 511 + kk + 64 * i; const float pv = sc[i * 64 + kk]; if (pv != 0.f) o += pv * bf2f(Vp[(size_t)key * NU + lane]); }
                ow[p] = o * inv;
            }
        }
    }
    const bf16_t* cat = (const bf16_t*)(ws + WS_CAT) + (size_t)(b * SEQ + t) * DM;
    for (int p = 0; p < 4; ++p) {
        const float g0 = fsigmoid(bf2f(urow[UGT + gg * 12 + p * 3 + 0])), g1 = fsigmoid(bf2f(urow[UGT + gg * 12 + p * 3 + 1])), g2 = fsigmoid(bf2f(urow[UGT + gg * 12 + p * 3 + 2]));
        const float ref = g0 * oc[p] + g1 * os[p] + g2 * ow[p], got = bf2f(cat[(4 * gg + p) * 64 + lane]);
        se += (ref - got) * (ref - got); sr += ref * ref; }
}
DI void phase(const Params& P, LAS unsigned char* lds, int vcu, int G, int wave, int lane) {
    LAS float* scr = (LAS float*)(lds + wave * 8192);
    float se = 0.f, sr = 0.f;
    for (int it = vcu * 8 + wave; it < 8 * SEQ; it += G * 8) { const int bg = it / SEQ, t = it % SEQ; item(P, scr, bg, t, lane, se, sr); }
    se = wave_sum(se); sr = wave_sum(sr);
    if (lane == 0) { atomicAdd((float*)(P.ws + WS_CTL) + CW_ERR, se); atomicAdd((float*)(P.ws + WS_CTL) + CW_ERR + 1, sr); }
}
}
#endif
DI void phase_ln1(const Params& P, int vcu, int G, int wave, int lane, bf16_t* x1base) {
    const float* mod = (const float*)(P.ws + WS_MOD);
    for (int mrow = vcu * 8 + wave; mrow < NT; mrow += G * 8) { const int b = mrow / SEQ;
        const u32x2* vr = (const u32x2*)((const bf16_t*)(P.ws + WS_V1) + (size_t)mrow * DM) + lane; f32x4 v[4]; float s = 0.f;
#pragma unroll
        for (int j = 0; j < 4; ++j) { const u32x2 q = vr[64 * j]; v[j] = (f32x4){bflo(q.x), bfhi(q.x), bflo(q.y), bfhi(q.y)}; s += (v[j].x + v[j].y) + (v[j].z + v[j].w); }
        const float mean = wave_sum(s) * (1.f / DM); float s2 = 0.f;
#pragma unroll
        for (int j = 0; j < 4; ++j) { v[j] = v[j] - mean; s2 += (v[j].x * v[j].x + v[j].y * v[j].y) + (v[j].z * v[j].z + v[j].w * v[j].w); }
        const float rstd = 1.f / sqrtf(wave_sum(s2) * (1.f / DM) + LN_EPS);
        unsigned long long* o8 = (unsigned long long*)((bf16_t*)(P.ws + WS_H2) + (size_t)mrow * DM) + lane;
        unsigned long long* x8 = (unsigned long long*)(x1base + (size_t)mrow * DM) + lane;
#pragma unroll
        for (int j = 0; j < 4; ++j) { const int c0 = 4 * lane + 256 * j;
            const f32x4 g = *(const f32x4*)(P.ln1_g + c0), bb = *(const f32x4*)(P.ln1_b + c0);
            const f32x4 sh = *(const f32x4*)(mod + b * 6144 + 3 * 1024 + c0), sc = *(const f32x4*)(mod + b * 6144 + 4 * 1024 + c0);
            const f32x4 x1 = v[j] * rstd * g + bb;
            x8[64 * j] = (unsigned long long)pk2(x1.x, x1.y) | ((unsigned long long)pk2(x1.z, x1.w) << 32);
            const f32x4 y = x1 * (sc + 1.0f) + sh;
            o8[64 * j] = (unsigned long long)pk2(y.x, y.y) | ((unsigned long long)pk2(y.z, y.w) << 32); }
    }
}

DI unsigned f2ord(float f) { const unsigned u = __float_as_uint(f); return (u & 0x80000000u) ? ~u : (u | 0x80000000u); }
DI void phase_route(const Params& P, LAS unsigned char* lds, int vcu, int G, int wave, int lane, int tid) {
    unsigned char* ws = P.ws;
    LAS int* hist = (LAS int*)lds;
    const float* logit = (const float*)(ws + WS_LOGIT);
    int* tok_e = (int*)(ws + WS_TOKE); float* tok_w = (float*)(ws + WS_TOKW); int* lrank = (int*)(ws + WS_LRANK);
    { int* rt = (int*)(ws + WS_ROWTOK); for (int i = vcu * 512 + tid; i < NPAD_MAX; i += G * 512) rt[i] = 0; }
    const int hh = lane >> 5;
    float bias[4];
#pragma unroll
    for (int k = 0; k < 4; ++k) bias[k] = P.router_bias[lane + 64 * k];
    const int tpw = NT / G;
    for (int base = vcu * tpw; base < NT; base += G * tpw) {
        __syncthreads();
        if (tid < 256) hist[tid] = 0;
        __syncthreads();
        for (int tq = wave; tq < tpw; tq += 8) { const int tkn = base + tq;
            float s[4], sel[4];
#pragma unroll
            for (int k = 0; k < 4; ++k) { s[k] = fsigmoid(logit[(size_t)tkn * 256 + lane + 64 * k]); sel[k] = s[k] + bias[k]; }
            float t1[4], t2[4];
#pragma unroll
            for (int k = 0; k < 4; ++k) { t1[k] = sel[k]; t2[k] = -3.0e38f; }
#pragma unroll
            for (int o = 1; o < 32; o <<= 1) {
#pragma unroll
                for (int k = 0; k < 4; ++k) { const float a1 = __shfl_xor(t1[k], o), a2 = __shfl_xor(t2[k], o);
                    const float n1 = fmaxf(t1[k], a1), n2 = fmaxf(fminf(t1[k], a1), fmaxf(t2[k], a2)); t1[k] = n1; t2[k] = n2; } }
            float gs[8];
#pragma unroll
            for (int k = 0; k < 4; ++k) { const float mine = t1[k] + t2[k], oth = __shfl_xor(mine, 32); gs[2 * k] = hh ? oth : mine; gs[2 * k + 1] = hh ? mine : oth; }
            bool gsel[8];
#pragma unroll
            for (int a = 0; a < 8; ++a) { int rk = 0;
#pragma unroll
                for (int c2 = 0; c2 < 8; ++c2) rk += (gs[c2] > gs[a] || (gs[c2] == gs[a] && c2 < a)) ? 1 : 0;
                gsel[a] = rk < 4; }
            unsigned key[4];
#pragma unroll
            for (int k = 0; k < 4; ++k) { const bool on = hh ? gsel[2 * k + 1] : gsel[2 * k]; key[k] = on ? f2ord(sel[k]) : 0u; }
            unsigned T = 0u;
            for (int bit = 31; bit >= 0; --bit) { const unsigned cand = T | (1u << bit); int cnt = 0;
#pragma unroll
                for (int k = 0; k < 4; ++k) cnt += __popcll(__ballot(key[k] >= cand));
                if (cnt >= 8) T = cand; }
            int ngt = 0;
#pragma unroll
            for (int k = 0; k < 4; ++k) ngt += __popcll(__ballot(key[k] > T));
            int need = 8 - ngt, npos = 0; const unsigned long long ltmask = (1ull << lane) - 1ull;
            bool chosen[4]; int pos[4];
#pragma unroll
            for (int k = 0; k < 4; ++k) { const unsigned long long eq = __ballot(key[k] == T), gt = __ballot(key[k] > T);
                const int myeq = __popcll(eq & ltmask); const bool ceq = (key[k] == T) && (myeq < need);
                chosen[k] = (key[k] > T) || ceq;
                const unsigned long long cm = __ballot(chosen[k]); pos[k] = npos + __popcll(cm & ltmask); npos += __popcll(cm);
                const int neq = __popcll(eq); need = need > neq ? need - neq : 0; (void)gt; }
            float ssum = 0.f;
#pragma unroll
            for (int k = 0; k < 4; ++k) ssum += chosen[k] ? s[k] : 0.f;
            ssum = wave_sum(ssum);
            const float wn = 2.5f / ssum;
#pragma unroll
            for (int k = 0; k < 4; ++k) if (chosen[k]) { const int e = lane + 64 * k; const int lr = __hip_atomic_fetch_add(hist + e, 1, __ATOMIC_RELAXED, __HIP_MEMORY_SCOPE_WORKGROUP);
                tok_e[tkn * 8 + pos[k]] = e; tok_w[tkn * 8 + pos[k]] = s[k] * wn; lrank[tkn * 8 + pos[k]] = lr; }
        }
        __syncthreads();
        if (tid < 256) ((int*)(ws + WS_HIST))[(base / tpw) * 256 + tid] = hist[tid];
    }
    __syncthreads();
}

DI void phase_scatter(const Params& P, LAS unsigned char* lds, int vcu, int G, int wave, int lane, int tid) {
    unsigned char* ws = P.ws;
    LAS int* sbase = (LAS int*)lds; LAS int* spad = sbase + 256; LAS int* sstart = spad + 256;
    const unsigned* hist = (const unsigned*)(ws + WS_HIST);
    const int* tok_e = (const int*)(ws + WS_TOKE); const int* lrank = (const int*)(ws + WS_LRANK);
    int* rowtok = (int*)(ws + WS_ROWTOK); int* pos_of = (int*)(ws + WS_POSOF); int* blk_e = (int*)(ws + WS_BLKE);
    const int tpw = NT / G, nslots = NT / tpw;
    for (int base = vcu * tpw; base < NT; base += G * tpw) { const int slot = base / tpw;
        __syncthreads();
        if (tid < 256) { int tot = 0, below = 0;
            for (int w2 = 0; w2 < nslots; ++w2) { const int hv = (int)hist[w2 * 256 + tid]; tot += hv; below += (w2 < slot) ? hv : 0; }
            spad[tid] = (tot + 255) & ~255; sbase[tid] = below; }
        __syncthreads();
        if (tid == 0) { int run = 0; for (int e = 0; e < 256; ++e) { sstart[e] = run; run += spad[e]; } sstart[256] = run; }
        __syncthreads();
        for (int i = tid; i < tpw * 8; i += 512) { const int a = base * 8 + i; const int e = tok_e[a]; const int pos = sstart[e] + sbase[e] + lrank[a];
            rowtok[pos] = a >> 3; pos_of[a] = pos; }
        if (slot == 0) {
            if (tid < 256) { const int b0 = sstart[tid] >> 8, b1 = (sstart[tid] + spad[tid]) >> 8; for (int bb = b0; bb < b1; ++bb) blk_e[bb] = tid; }
            if (tid == 0) blk_e[NBLK_MAX] = sstart[256] >> 8;
        }
    }
    __syncthreads();
}

DI void phase_final(const Params& P, int vcu, int G, int wave, int lane, float* dstbase) {
    unsigned char* ws = P.ws;
    const float* mod = (const float*)(ws + WS_MOD);
    const int* pos_of = (const int*)(ws + WS_POSOF); const float* tok_w = (const float*)(ws + WS_TOKW);
    const unsigned char* Y = (const unsigned char*)(ws + WS_YMOE);
    float dbg_scale = 1.0f;
#if CHECK_ATTN
    { const float se = __uint_as_float(ld_u32_agent((const unsigned*)(ws + WS_CTL) + CW_ERR)), sr = __uint_as_float(ld_u32_agent((const unsigned*)(ws + WS_CTL) + CW_ERR + 1)); const float err = sqrtf(se / fmaxf(sr, 1e-30f)); dbg_scale = 1.0f + (err < 0.005f ? 0.f : err < 0.02f ? 0.04f : err < 0.08f ? 0.055f : err < 0.3f ? 0.07f : 0.085f); }
#endif
    for (int mrow = vcu * 8 + wave; mrow < NT; mrow += G * 8) { const int b = mrow / SEQ;
        const u32x2* xr = (const u32x2*)((const bf16_t*)(ws + WS_X1) + (size_t)mrow * DM) + lane; const u32x2* sr = (const u32x2*)((const bf16_t*)(ws + WS_SH) + (size_t)mrow * DM) + lane; f32x4 v[4], ya[4];
#pragma unroll
        for (int j = 0; j < 4; ++j) { const u32x2 q = xr[64 * j], q2 = sr[64 * j]; v[j] = (f32x4){bflo(q.x), bfhi(q.x), bflo(q.y), bfhi(q.y)} * DN_ALPHA; ya[j] = (f32x4){bflo(q2.x), bfhi(q2.x), bflo(q2.y), bfhi(q2.y)}; }
        const int mypos = pos_of[(size_t)mrow * 8 + (lane & 7)]; const float myw = tok_w[(size_t)mrow * 8 + (lane & 7)];
#pragma unroll
        for (int k = 0; k < 8; ++k) { const int pos = __shfl(mypos, k); const float wk = __shfl(myw, k) * (1.0f / YMOE_SCALE);
            const unsigned* yr = (const unsigned*)(Y + (size_t)pos * DM) + lane;
#pragma unroll
            for (int j = 0; j < 4; ++j) { const int q = (int)yr[64 * j]; const f32x2 lo = __builtin_amdgcn_cvt_pk_f32_fp8(q, false), hi = __builtin_amdgcn_cvt_pk_f32_fp8(q, true);
                ya[j].x += wk * lo.x; ya[j].y += wk * lo.y; ya[j].z += wk * hi.x; ya[j].w += wk * hi.y; } }
        float s = 0.f;
#pragma unroll
        for (int j = 0; j < 4; ++j) { const f32x4 g2 = *(const f32x4*)(mod + b * 6144 + 5 * 1024 + 4 * lane + 256 * j); v[j] = v[j] + g2 * ya[j]; s += (v[j].x + v[j].y) + (v[j].z + v[j].w); }
        const float mean = wave_sum(s) * (1.f / DM); float s2 = 0.f;
#pragma unroll
        for (int j = 0; j < 4; ++j) { v[j] = v[j] - mean; s2 += (v[j].x * v[j].x + v[j].y * v[j].y) + (v[j].z * v[j].z + v[j].w * v[j].w); }
        const float rstd = 1.f / sqrtf(wave_sum(s2) * (1.f / DM) + LN_EPS);
#pragma unroll
        for (int j = 0; j < 4; ++j) { const int c0 = 4 * lane + 256 * j; const f32x4 g = *(const f32x4*)(P.ln2_g + c0), bb = *(const f32x4*)(P.ln2_b + c0);
            ((f32x4*)(dstbase + (size_t)mrow * DM) + lane)[64 * j] = (v[j] * rstd * g + bb) * dbg_scale; }
    }
}
#ifndef REP_PHASE
#define REP_PHASE -1
#endif
#ifndef MK_PER_PHASE
#define MK_PER_PHASE 0
#endif
DI void run_phase_0(const Params& P, LAS unsigned char* lds, int vcu, int G, int bx, int wave, int lane, int tid) {
    unsigned char* ws = P.ws; const float* mod = (const float*)(ws + WS_MOD); (void)mod; (void)ws;
 phase0a(P, lds, vcu, G, wave, lane, tid); }
DI void run_phase_1(const Params& P, LAS unsigned char* lds, int vcu, int G, int bx, int wave, int lane, int tid) {
    unsigned char* ws = P.ws; const float* mod = (const float*)(ws + WS_MOD); (void)mod; (void)ws;
 phase0b(P, lds, vcu, G, wave, lane, tid); }
DI void run_phase_2(const Params& P, LAS unsigned char* lds, int vcu, int G, int bx, int wave, int lane, int tid) {
    unsigned char* ws = P.ws; const float* mod = (const float*)(ws + WS_MOD); (void)mod; (void)ws;
        pg8::Gemm g{(const bf16_t*)(ws + WS_H1), (const bf16_t*)(ws + WS_WIN_T), DM, DM, DM, 128};
        pg8::DenseOrder S; S.init(g.A, DM, NT, NU, G, bx);
        pg8::EpiStoreBf16 E{(bf16_t*)(ws + WS_U), NU, 0.125f * 1.4426950408889634f, 2};
        pg8::gemm_phase<pg8::EpiStoreBf16, pg8::DenseOrder, true, false>(lds, g, S, E, nullptr);
    }
DI void run_phase_3(const Params& P, LAS unsigned char* lds, int vcu, int G, int bx, int wave, int lane, int tid) {
    unsigned char* ws = P.ws; const float* mod = (const float*)(ws + WS_MOD); (void)mod; (void)ws;
        if (bx < 32 && G > 32) {
            pg8::Gemm g{(const bf16_t*)(ws + WS_U), (const bf16_t*)(ws + WS_WC1_T), 16 * NU, 2048, 2048, NU * 2};
            pg8::CmpOrder S{G, bx, (const bf16_t*)(ws + WS_U)};
            pg8::EpiCmp E{(bf16_t*)(ws + WS_HCMP), (const float*)(ws + WS_PEB)};
            pg8::gemm_phase<pg8::EpiCmp, pg8::CmpOrder, true, false>(lds, g, S, E, nullptr);
        } else {
            const int nw = (G > 32) ? G - 32 : G, w0 = (G > 32) ? bx - 32 : bx;
            if (G <= 32) { pg8::Gemm g{(const bf16_t*)(ws + WS_U), (const bf16_t*)(ws + WS_WC1_T), 16 * NU, 2048, 2048, NU * 2};
                pg8::CmpOrder S{G, bx, (const bf16_t*)(ws + WS_U)}; pg8::EpiCmp E{(bf16_t*)(ws + WS_HCMP), (const float*)(ws + WS_PEB)};
                pg8::gemm_phase<pg8::EpiCmp, pg8::CmpOrder, true, false>(lds, g, S, E, nullptr); }
            for (int item = w0; item < 1024; item += nw) conv_item(P, lds, item, wave, lane, tid);
            if (REP_PHASE == 31) { for (int item = w0; item < 1024; item += nw) conv_item(P, lds, item, wave, lane, tid); }
            __syncthreads();
            vt_copies(P, lds, w0 * 8 + wave, nw * 8, wave, lane);
            __syncthreads();
        }
    }
DI void run_phase_4(const Params& P, LAS unsigned char* lds, int vcu, int G, int bx, int wave, int lane, int tid) {
    unsigned char* ws = P.ws; const float* mod = (const float*)(ws + WS_MOD); (void)mod; (void)ws;
 phase_cmp2(P, lds, vcu, G, wave, lane, tid); }
DI void run_phase_5(const Params& P, LAS unsigned char* lds, int vcu, int G, int bx, int wave, int lane, int tid) {
    unsigned char* ws = P.ws; const float* mod = (const float*)(ws + WS_MOD); (void)mod; (void)ws;
 attn::attn_phase(P, lds, vcu, G, wave, lane, tid); }
DI void run_phase_6(const Params& P, LAS unsigned char* lds, int vcu, int G, int bx, int wave, int lane, int tid) {
    unsigned char* ws = P.ws; const float* mod = (const float*)(ws + WS_MOD); (void)mod; (void)ws;
#if CHECK_ATTN
        attnchk::phase(P, lds, vcu, G, wave, lane); __syncthreads();
#endif
        pg8::Gemm g{(const bf16_t*)(ws + WS_CAT), (const bf16_t*)(ws + WS_WOUT_T), DM, DM, DM, 128};
        pg8::DenseOrder S; S.init(g.A, DM, NT, DM, G, bx);
        pg8::EpiResModBf16 E{P.x, (bf16_t*)(ws + WS_V1), mod + 2 * 1024, 6144};
        pg8::gemm_phase<pg8::EpiResModBf16, pg8::DenseOrder, true, false>(lds, g, S, E, nullptr);
    }
DI void run_phase_7(const Params& P, LAS unsigned char* lds, int vcu, int G, int bx, int wave, int lane, int tid) {
    unsigned char* ws = P.ws; const float* mod = (const float*)(ws + WS_MOD); (void)mod; (void)ws;
 if (REP_PHASE == 70) { phase_ln1(P, vcu, G, wave, lane, (bf16_t*)(ws + WS_HIDM)); phase_ln1(P, vcu, G, wave, lane, (bf16_t*)(ws + WS_HIDM)); }
    phase_ln1(P, vcu, G, wave, lane, (bf16_t*)(ws + WS_X1)); }
DI void run_phase_8(const Params& P, LAS unsigned char* lds, int vcu, int G, int bx, int wave, int lane, int tid) {
    unsigned char* ws = P.ws; const float* mod = (const float*)(ws + WS_MOD); (void)mod; (void)ws;
        { pg8::Gemm g{(const bf16_t*)(ws + WS_H2), (const bf16_t*)(ws + WS_WR_T), DM, DM, DM, 128};
          pg8::DenseOrder S; S.init(g.A, DM, NT, 256, G, bx);
          pg8::EpiF32 E{(float*)(ws + WS_LOGIT), 256};
          pg8::gemm_phase<pg8::EpiF32, pg8::DenseOrder, true, false>(lds, g, S, E, nullptr); }
        { pg8::Gemm g{(const bf16_t*)(ws + WS_H2), (const bf16_t*)(ws + WS_WSGU_T), DM, DM, DM, 128};
          pg8::DenseOrder S; S.init(g.A, DM, NT, 512, G, bx);
          pg8::EpiGlu E{(bf16_t*)(ws + WS_HIDS), 256};
          pg8::gemm_phase<pg8::EpiGlu, pg8::DenseOrder, true, false>(lds, g, S, E, nullptr); }
    }
DI void run_phase_9(const Params& P, LAS unsigned char* lds, int vcu, int G, int bx, int wave, int lane, int tid) {
    unsigned char* ws = P.ws; const float* mod = (const float*)(ws + WS_MOD); (void)mod; (void)ws;
        phase_route(P, lds, vcu, G, wave, lane, tid);
        if (REP_PHASE == 90) { phase_route(P, lds, vcu, G, wave, lane, tid); phase_route(P, lds, vcu, G, wave, lane, tid); }
        pg8::Gemm g{(const bf16_t*)(ws + WS_HIDS), (const bf16_t*)(ws + WS_WSD_T), 256, 256, 256, 128};
        pg8::DenseOrder S; S.init(g.A, 256, NT, DM, G, bx);
        pg8::EpiStoreBf16 E{(bf16_t*)(ws + WS_SH), DM, 1.0f, 0};
        pg8::gemm_phase<pg8::EpiStoreBf16, pg8::DenseOrder, true, false>(lds, g, S, E, nullptr);
    }
DI void run_phase_10(const Params& P, LAS unsigned char* lds, int vcu, int G, int bx, int wave, int lane, int tid) {
    unsigned char* ws = P.ws; const float* mod = (const float*)(ws + WS_MOD); (void)mod; (void)ws;
 phase_scatter(P, lds, vcu, G, wave, lane, tid); }
DI void run_phase_11(const Params& P, LAS unsigned char* lds, int vcu, int G, int bx, int wave, int lane, int tid) {
    unsigned char* ws = P.ws; const float* mod = (const float*)(ws + WS_MOD); (void)mod; (void)ws;
        const int nblk = (int)__builtin_amdgcn_readfirstlane((int)ld_u32_agent((const unsigned*)(ws + WS_BLKE) + NBLK_MAX));
        const int nunits = 2 * nblk; LAS int* tab = (LAS int*)(lds + LDS_TAB);
        { const int* rowtok = (const int*)(ws + WS_ROWTOK); int i = 0;
          for (int L = vcu; L < nunits && i < 28; L += G, ++i) { if (tid < 256) tab[i * 256 + tid] = rowtok[(L >> 1) * 256 + tid]; } }
        __syncthreads();
        pg8::Gemm g{(const bf16_t*)(ws + WS_H2), (const bf16_t*)(ws + WS_WGU_T), DM, DM, DM, 128};
        pg8::MoeOrder<2> S{G, vcu, nunits, (const int*)(ws + WS_BLKE), g.A, (size_t)0};
        pg8::EpiGlu E{(bf16_t*)(ws + WS_HIDM), 256};
        pg8::gemm_phase<pg8::EpiGlu, pg8::MoeOrder<2>, true, true>(lds, g, S, E, tab);
    }
DI void run_phase_12(const Params& P, LAS unsigned char* lds, int vcu, int G, int bx, int wave, int lane, int tid) {
    unsigned char* ws = P.ws; const float* mod = (const float*)(ws + WS_MOD); (void)mod; (void)ws;
        const int nblk = (int)__builtin_amdgcn_readfirstlane((int)ld_u32_agent((const unsigned*)(ws + WS_BLKE) + NBLK_MAX));
        pg8::Gemm g{(const bf16_t*)(ws + WS_HIDM), (const bf16_t*)(ws + WS_WDN_T), 256, 256, 256, 128};
        pg8::MoeOrder<4> S{G, vcu, 4 * nblk, (const int*)(ws + WS_BLKE), g.A, (size_t)256 * 256 * 2};
        pg8::EpiStoreFp8 E{(unsigned char*)(ws + WS_YMOE), DM, YMOE_SCALE};
        pg8::gemm_phase<pg8::EpiStoreFp8, pg8::MoeOrder<4>, true, false>(lds, g, S, E, nullptr);
    }
DI void run_phase_13(const Params& P, LAS unsigned char* lds, int vcu, int G, int bx, int wave, int lane, int tid) {
    unsigned char* ws = P.ws; const float* mod = (const float*)(ws + WS_MOD); (void)mod; (void)ws;
 if (REP_PHASE == 130) { phase_final(P, vcu, G, wave, lane, (float*)(ws + WS_HIDM)); phase_final(P, vcu, G, wave, lane, (float*)(ws + WS_HIDM)); }
    phase_final(P, vcu, G, wave, lane, P.out); }
constexpr int NPHASE = 14;
__global__ void __launch_bounds__(512, 2) nsa_conformer_moe_fwd(Params P) {
    extern __shared__ __attribute__((aligned(16))) unsigned char lds_raw[];
    LAS unsigned char* lds = (LAS unsigned char*)lds_raw;
    const int tid = threadIdx.x, lane = tid & 63, wave = __builtin_amdgcn_readfirstlane(tid >> 6);
    const int G = gridDim.x, bx = blockIdx.x, vcu = (G % 8 == 0) ? (bx % 8) * (G / 8) + bx / 8 : bx;
    unsigned char* ws = P.ws;
    volatile LAS unsigned* MISC = (volatile LAS unsigned*)(lds + LDS_MISC);
    if (tid < 64) MISC[tid] = 0u;
    __syncthreads();
    const int lo = P.ph_lo, hi = P.ph_hi;
    XcdBarrier bar; bar.bar = (unsigned*)(ws + WS_CTL) + CW_BAR; bar.x = 0; bar.st = MISC + 8;
    if (hi - lo > 1) bar = xcd_barrier_post((unsigned*)(ws + WS_CTL) + CW_BAR, MISC + 8);
#ifdef PH_ONLY
#define IN(k) ((k) == PH_ONLY && lo <= (k) && (k) < hi)
#else
#define IN(k) (lo <= (k) && (k) < hi)
#endif
#define SEAM(k) do { if (IN(k) && IN((k) + 1)) xcd_barrier(bar); } while (0)
    if (IN(0)) run_phase_0(P, lds, vcu, G, bx, wave, lane, tid);
    if (REP_PHASE == 0 && IN(0)) { run_phase_0(P, lds, vcu, G, bx, wave, lane, tid); run_phase_0(P, lds, vcu, G, bx, wave, lane, tid); }
    SEAM(0);
    if (REP_PHASE == 200 && IN(0) && IN(1)) { for (int q_ = 0; q_ < 20; ++q_) xcd_barrier(bar); }
    if (IN(1)) run_phase_1(P, lds, vcu, G, bx, wave, lane, tid);
    if (REP_PHASE == 1 && IN(1)) { run_phase_1(P, lds, vcu, G, bx, wave, lane, tid); run_phase_1(P, lds, vcu, G, bx, wave, lane, tid); }
    SEAM(1);
    if (IN(2)) run_phase_2(P, lds, vcu, G, bx, wave, lane, tid);
    if (REP_PHASE == 2 && IN(2)) { run_phase_2(P, lds, vcu, G, bx, wave, lane, tid); run_phase_2(P, lds, vcu, G, bx, wave, lane, tid); }
    SEAM(2);
    if (IN(3)) run_phase_3(P, lds, vcu, G, bx, wave, lane, tid);
    if (REP_PHASE == 3 && IN(3)) { run_phase_3(P, lds, vcu, G, bx, wave, lane, tid); run_phase_3(P, lds, vcu, G, bx, wave, lane, tid); }
    SEAM(3);
    if (IN(4)) run_phase_4(P, lds, vcu, G, bx, wave, lane, tid);
    if (REP_PHASE == 4 && IN(4)) { run_phase_4(P, lds, vcu, G, bx, wave, lane, tid); run_phase_4(P, lds, vcu, G, bx, wave, lane, tid); }
    SEAM(4);
    if (IN(5)) run_phase_5(P, lds, vcu, G, bx, wave, lane, tid);
    if (REP_PHASE == 5 && IN(5)) { run_phase_5(P, lds, vcu, G, bx, wave, lane, tid); run_phase_5(P, lds, vcu, G, bx, wave, lane, tid); }
    SEAM(5);
    if (IN(6)) run_phase_6(P, lds, vcu, G, bx, wave, lane, tid);
    if (REP_PHASE == 6 && IN(6)) { run_phase_6(P, lds, vcu, G, bx, wave, lane, tid); run_phase_6(P, lds, vcu, G, bx, wave, lane, tid); }
    SEAM(6);
    if (IN(7)) run_phase_7(P, lds, vcu, G, bx, wave, lane, tid);
    if (REP_PHASE == 7 && IN(7)) { run_phase_7(P, lds, vcu, G, bx, wave, lane, tid); run_phase_7(P, lds, vcu, G, bx, wave, lane, tid); }
    SEAM(7);
    if (IN(8)) run_phase_8(P, lds, vcu, G, bx, wave, lane, tid);
    if (REP_PHASE == 8 && IN(8)) { run_phase_8(P, lds, vcu, G, bx, wave, lane, tid); run_phase_8(P, lds, vcu, G, bx, wave, lane, tid); }
    SEAM(8);
    if (IN(9)) run_phase_9(P, lds, vcu, G, bx, wave, lane, tid);
    if (REP_PHASE == 9 && IN(9)) { run_phase_9(P, lds, vcu, G, bx, wave, lane, tid); run_phase_9(P, lds, vcu, G, bx, wave, lane, tid); }
    SEAM(9);
    if (IN(10)) run_phase_10(P, lds, vcu, G, bx, wave, lane, tid);
    if (REP_PHASE == 10 && IN(10)) { run_phase_10(P, lds, vcu, G, bx, wave, lane, tid); run_phase_10(P, lds, vcu, G, bx, wave, lane, tid); }
    SEAM(10);
    if (IN(11)) run_phase_11(P, lds, vcu, G, bx, wave, lane, tid);
    if (REP_PHASE == 11 && IN(11)) { run_phase_11(P, lds, vcu, G, bx, wave, lane, tid); run_phase_11(P, lds, vcu, G, bx, wave, lane, tid); }
    SEAM(11);
    if (IN(12)) run_phase_12(P, lds, vcu, G, bx, wave, lane, tid);
    if (REP_PHASE == 12 && IN(12)) { run_phase_12(P, lds, vcu, G, bx, wave, lane, tid); run_phase_12(P, lds, vcu, G, bx, wave, lane, tid); }
    SEAM(12);
    if (IN(13)) run_phase_13(P, lds, vcu, G, bx, wave, lane, tid);
    if (REP_PHASE == 13 && IN(13)) { run_phase_13(P, lds, vcu, G, bx, wave, lane, tid); run_phase_13(P, lds, vcu, G, bx, wave, lane, tid); }
#undef IN
#undef SEAM
}

extern "C" void kernel_launch(void* const* d_in, const int* in_sizes, int n_in, void* d_out, int out_size, void* d_ws, size_t ws_size, hipStream_t stream) {
    static int grid = 0;
    if (grid == 0) {
        if (n_in != 28 || out_size != NT * DM || ws_size < WS_END) { fprintf(stderr, "kernel_launch: unexpected arguments (n_in %d, out %d, ws %zu); nothing launched\n", n_in, out_size, ws_size); grid = -1; return; }
        int dev = 0, cus = 0, per_cu = 0;
        if (hipGetDevice(&dev) != hipSuccess || hipDeviceGetAttribute(&cus, hipDeviceAttributeMultiprocessorCount, dev) != hipSuccess) { grid = -1; return; }
        if (hipFuncSetAttribute((const void*)nsa_conformer_moe_fwd, hipFuncAttributeMaxDynamicSharedMemorySize, LDS_BYTES) != hipSuccess) { fprintf(stderr, "kernel_launch: hipFuncSetAttribute failed\n"); grid = -1; return; }
        if (hipOccupancyMaxActiveBlocksPerMultiprocessor(&per_cu, (const void*)nsa_conformer_moe_fwd, 512, LDS_BYTES) != hipSuccess || per_cu < 1) { fprintf(stderr, "kernel_launch: occupancy query says %d blocks per CU\n", per_cu); }
        (void)hipGetLastError();
        grid = cus;
    }
    if (grid < 0) return;
    (void)hipMemsetAsync((char*)d_ws + WS_CTL, 0, CTL_ZERO_BYTES, stream);
    Params p{};
    const float** pp = (const float**)&p;
    for (int i = 0; i < 28; ++i) pp[i] = (const float*)d_in[i];
    p.out = (float*)d_out; p.ws = (unsigned char*)d_ws;
#if MK_PER_PHASE
    for (int ph = 0; ph < NPHASE; ++ph) { p.ph_lo = ph; p.ph_hi = ph + 1; hipLaunchKernelGGL(nsa_conformer_moe_fwd, dim3(grid), dim3(512), LDS_BYTES, stream, p); }
#else
    p.ph_lo = 0; p.ph_hi = NPHASE;
    hipLaunchKernelGGL(nsa_conformer_moe_fwd, dim3(grid), dim3(512), LDS_BYTES, stream, p);
#endif
}
```

```cpp
#include <hip/hip_runtime.h>
#include <cstdio>
#include <cstdint>

#define DI __device__ __forceinline__
#define LAS __attribute__((address_space(3)))
#define GAS __attribute__((address_space(1)))
typedef unsigned short bf16_t;
typedef short bf16x8 __attribute__((ext_vector_type(8)));
typedef float f32x4 __attribute__((ext_vector_type(4)));
typedef float f32x16 __attribute__((ext_vector_type(16)));
typedef float f32x2 __attribute__((ext_vector_type(2)));
typedef unsigned u32x4 __attribute__((ext_vector_type(4)));
typedef unsigned u32x2 __attribute__((ext_vector_type(2)));
typedef __bf16 bf16x2_t __attribute__((ext_vector_type(2)));

constexpr int NB = 4, SEQ = 8192, DM = 1024, NT = NB * SEQ;
constexpr int NU = 2560;
constexpr int UQ = 0, UKC = 512, UVC = 640, UKS = 768, UVS = 896, UKW = 1024, UVW = 1152, UCA = 1280, UCG = 1792, UGT = 2304;
constexpr int DIN = 2328;
constexpr int NEXP = 256, DEXP = 256, TOPK = 8;
constexpr int NASSIGN = NT * TOPK;
constexpr int NPAD_MAX = NASSIGN + NEXP * 255 + 1;
constexpr int NBLK_MAX = NPAD_MAX / 256 + 1;
constexpr float LN_EPS = 1e-5f;
constexpr float YMOE_SCALE = 16.0f;
constexpr float DN_ALPHA = 1.189207115002721f;

DI unsigned pk2(float lo, float hi) { f32x2 v = {lo, hi}; bf16x2_t b = __builtin_convertvector(v, bf16x2_t); return __builtin_bit_cast(unsigned, b); }
DI float bflo(unsigned w) { return __uint_as_float(w << 16); }
DI float bfhi(unsigned w) { return __uint_as_float(w & 0xffff0000u); }
DI float bf2f(bf16_t b) { return __uint_as_float(((unsigned)b) << 16); }
DI float fsigmoid(float x) { return __builtin_amdgcn_rcpf(1.0f + __expf(-x)); }
DI float fsilu(float x) { return x * __builtin_amdgcn_rcpf(1.0f + __expf(-x)); }
DI float wave_sum(float v) {
#pragma unroll
    for (int o = 1; o < 64; o <<= 1) v += __shfl_xor(v, o);
    return v;
}
DI unsigned ld_u32_agent(const unsigned* p) { return __hip_atomic_load(p, __ATOMIC_RELAXED, __HIP_MEMORY_SCOPE_AGENT); }
#define LDS_WAIT() asm volatile("s_waitcnt lgkmcnt(0)" ::: "memory")
#define VM_WAIT() asm volatile("s_waitcnt vmcnt(0)" ::: "memory")

#define XB_TMO      128
#define XB_XCNT(j)  (256  + 64 * (j))
#define XB_XSUB(j)  (1280 + 64 * (j))
#define XB_XGEN(j)  (2304 + 64 * (j))
#define XB_TOP      3328
#define XB_TOPGEN   3392
#define XCD_BAR_WORDS 3456
#define XB_SPIN_CAP (1u << 18)
__device__ __forceinline__ unsigned xb_ld(unsigned* p)              { return __hip_atomic_load(p, __ATOMIC_RELAXED, __HIP_MEMORY_SCOPE_AGENT); }
__device__ __forceinline__ unsigned xb_add(unsigned* p, unsigned v) { return __hip_atomic_fetch_add(p, v, __ATOMIC_RELAXED, __HIP_MEMORY_SCOPE_AGENT); }
__device__ __forceinline__ unsigned xb_xcc_id() { return (unsigned)__builtin_amdgcn_s_getreg((3 << 11) | 20) & 0xFu; }
#define XB_SPIN(cond, bar) do { unsigned _sp = 0; while (cond) { __builtin_amdgcn_s_sleep(1); \
    if ((++_sp & 255u) == 0u) { if (xb_ld(&(bar)[XB_TMO])) break; if (_sp > XB_SPIN_CAP) { atomicAdd(&(bar)[XB_TMO], 1u); break; } } } } while (0)
struct XcdBarrier { unsigned* bar; unsigned x; volatile LAS unsigned* st; };
__device__ __forceinline__ XcdBarrier xcd_barrier_post(unsigned* bar, volatile LAS unsigned* st) {
    XcdBarrier b; b.bar = bar; b.x = xb_xcc_id(); b.st = st;
    if (threadIdx.x == 0) (void)xb_add(&bar[XB_XCNT(b.x)], 1u);
    return b;
}
__device__ __forceinline__ void xcd_barrier_complete(unsigned* bar, unsigned x, unsigned& nloc, unsigned& nx) {
    const unsigned G = gridDim.x * gridDim.y * gridDim.z;
    unsigned sum, cnt, mine, sp = 0u;
    for (;;) {
        sum = 0u; cnt = 0u; mine = 0u;
#pragma unroll
        for (unsigned j = 0; j < 16; ++j) { const unsigned c = xb_ld(&bar[XB_XCNT(j)]); sum += c; cnt += (c > 0u) ? 1u : 0u; mine = (j == x) ? c : mine; }
        if (sum == G) break;
        __builtin_amdgcn_s_sleep(1);
        if ((++sp & 255u) == 0u) { if (xb_ld(&bar[XB_TMO])) break; if (sp > XB_SPIN_CAP) { atomicAdd(&bar[XB_TMO], 1u); break; } }
    }
    nloc = mine > 0u ? mine : 1u; nx = cnt > 0u ? cnt : 1u;
}
__device__ __forceinline__ void xcd_barrier(const XcdBarrier& b) {
    asm volatile("s_waitcnt vmcnt(0)" ::: "memory");
    __syncthreads();
    if (threadIdx.x == 0) {
        unsigned* bar = b.bar;
        __builtin_amdgcn_s_waitcnt(0);
        unsigned nloc = b.st[0], nx = b.st[1];
        if (nloc == 0u) { xcd_barrier_complete(bar, b.x, nloc, nx); b.st[0] = nloc; b.st[1] = nx; }
        const unsigned old = xb_add(&bar[XB_XSUB(b.x)], 1u);
        const unsigned gen = old / nloc;
        if (old + 1u == (gen + 1u) * nloc) {
            __builtin_amdgcn_fence(__ATOMIC_RELEASE, "agent");
            asm volatile("s_waitcnt vmcnt(0)" ::: "memory");
            const unsigned og = xb_add(&bar[XB_TOP], 1u);
            const unsigned tg = og / nx;
            if (og + 1u == (tg + 1u) * nx) xb_add(&bar[XB_TOPGEN], 1u);
            else XB_SPIN(xb_ld(&bar[XB_TOPGEN]) == tg, bar);
            __builtin_amdgcn_fence(__ATOMIC_ACQUIRE, "agent");
            xb_add(&bar[XB_XGEN(b.x)], 1u);
            asm volatile("s_waitcnt vmcnt(0)" ::: "memory");
        } else {
            XB_SPIN(xb_ld(&bar[XB_XGEN(b.x)]) == gen, bar);
            __builtin_amdgcn_fence(__ATOMIC_ACQUIRE, "agent");
            asm volatile("s_waitcnt vmcnt(0)" ::: "memory");
        }
    }
    __syncthreads();
}

namespace pg8 {
constexpr int BM = 256, BK = 64, HALF = 128, HTB = HALF * BK * 2, STAGE_BYTES = 8 * HTB, NXCD = 8, WGM = 8;
__host__ __device__ __forceinline__ int lds_byte(int r, int c) { const int st = (r >> 4) * 2 + (c >> 5), rr = r & 15, cc = c & 31, ob = rr * 64 + cc * 2; return st * 1024 + (ob ^ (((ob >> 9) & 1) << 5)); }
__host__ __device__ __forceinline__ void stage_rc(int b, int& R, int& C) { const int st = b / 1024, sb = b % 1024, swz = sb ^ (((sb >> 9) & 1) << 5); R = (st >> 1) * 16 + swz / 64; C = (st & 1) * 32 + (swz % 64) / 2; }
__host__ __device__ __forceinline__ int perm32(int rho) { const int n = rho >> 4, i = rho & 15; return 8 * (i >> 2) + 4 * n + (i & 3); }

struct Unit { int pm, pn, po; };
struct Gemm { const bf16_t* A; const bf16_t* Bt; int lda, ldb, K, kstepA; };

struct DenseOrder {
    int nM, nN, nwg, G, c; const bf16_t* A; size_t tstepA;
    DI void init(const bf16_t* A_, int lda, int M, int N, int G_, int c_) { nM = M / BM; nN = N / BM; nwg = nM * nN; G = G_; c = c_; A = A_; tstepA = (size_t)BM * lda * 2; }
    DI bool next(int i, Unit& u) const {
        const long L = (long)i * G + c; if (L >= nwg) return false;
        int wgid = (int)L; { const int q = nwg / NXCD, r = nwg % NXCD, xcd = wgid % NXCD, off = wgid / NXCD; wgid = (xcd < r ? xcd * (q + 1) : r * (q + 1) + (xcd - r) * q) + off; }
        const int nig = WGM * nN, gid = wgid / nig, fm = gid * WGM, gsz = (nM - fm) < WGM ? (nM - fm) : WGM;
        u.pm = fm + ((wgid % nig) % gsz); u.pn = (wgid % nig) / gsz; u.po = u.pn; return true;
    }
    DI const char* abase(const Unit& u) const { return (const char*)A + (size_t)u.pm * tstepA; }
};

DI unsigned cvt_pk_bf16(float lo, float hi) { return pk2(lo, hi); }

template <class Epi, class Sched, bool ALIGN_EPI, bool GATHER>
__device__ __forceinline__ void gemm_phase(LAS unsigned char* lds, const Gemm g, const Sched& S, const Epi& E, const LAS int* rowidx  ) {
    const int tid = threadIdx.x, wid = __builtin_amdgcn_readfirstlane(tid >> 6), lane = tid & 63, wr = wid >> 2, wc = wid & 3, fr = lane & 15, fq = lane >> 4;
    const int K = g.K; int nt = K / BK; asm volatile("" : "+s"(nt));
    unsigned voffA[2], voffB[2]; int RA[2], CA[2];
#pragma unroll
    for (int i = 0; i < 2; ++i) { int R, C; stage_rc(tid * 16 + i * 8192, R, C); const int Rb = Epi::PERM ? ((R & ~31) + perm32(R & 31)) : R;
        RA[i] = R; CA[i] = C; voffA[i] = (unsigned)(R * g.lda + C) * 2u; voffB[i] = (unsigned)(Rb * g.ldb + C) * 2u; }
    const size_t kstepA = (size_t)g.kstepA, kstepB = (size_t)(BK * 2);
    const size_t hstepA = (size_t)HALF * g.lda * 2, hstepB = (size_t)HALF * g.ldb * 2;
    const size_t tstepB = 2 * hstepB;
    const unsigned ldsw = (unsigned)wid * 1024u;
    const int aoff = lds_byte(wr * 64 + fr, fq * 8), boff = lds_byte(wc * 32 + fr, fq * 8);
#define PG8_SA(b, h) (((b) * 2 + (h)) * HTB)
#define PG8_SB(b, h) ((4 + (b) * 2 + (h)) * HTB)
#define PG8_STAGE(bufoff, gbase, voff) do { _Pragma("unroll") for (int _i = 0; _i < 2; ++_i) \
        __builtin_amdgcn_global_load_lds((const unsigned*)((const char*)(gbase) + (voff)[_i]), (LAS unsigned*)(lds + (bufoff) + ldsw + _i * 8192), 16, 0, 0); } while (0)
#define PG8_LDA(dst, b, h) do { _Pragma("unroll") for (int m = 0; m < 4; ++m) _Pragma("unroll") for (int k = 0; k < 2; ++k) dst[m][k] = *(const LAS bf16x8*)(lds + PG8_SA(b, h) + aoff + m * 2048 + k * 1024); } while (0)
#define PG8_LDB(dst, b, h) do { _Pragma("unroll") for (int n = 0; n < 2; ++n) _Pragma("unroll") for (int k = 0; k < 2; ++k) dst[n][k] = *(const LAS bf16x8*)(lds + PG8_SB(b, h) + boff + n * 2048 + k * 1024); } while (0)
#define PG8_MMA(ai, bj, At, Bt) do { __builtin_amdgcn_s_setprio(1); _Pragma("unroll") for (int m = 0; m < 4; ++m) _Pragma("unroll") for (int n = 0; n < 2; ++n) _Pragma("unroll") for (int k = 0; k < 2; ++k) \
        acc[ai][bj][m][n] = __builtin_amdgcn_mfma_f32_16x16x32_bf16(Bt[n][k], At[m][k], acc[ai][bj][m][n], 0, 0, 0); __builtin_amdgcn_s_setprio(0); } while (0)
#define PG8_WAIT_V(n) asm volatile("s_waitcnt vmcnt(" #n ")" ::: "memory")
#define PG8_WAIT_L(n) asm volatile("s_waitcnt lgkmcnt(" #n ")" ::: "memory")
#define PG8_BAR __builtin_amdgcn_s_barrier()
#define PG8_SCHED __builtin_amdgcn_sched_barrier(0)
    Unit cur, nxt; int ui = 0;
    if (!S.next(0, cur)) return;
    f32x4 acc[2][2][4][2];
#pragma unroll
    for (int a = 0; a < 2; ++a)
#pragma unroll
        for (int b = 0; b < 2; ++b)
#pragma unroll
            for (int m = 0; m < 4; ++m)
#pragma unroll
                for (int n = 0; n < 2; ++n) acc[a][b][m][n] = (f32x4){0.f, 0.f, 0.f, 0.f};
    bf16x8 At[4][2], B0[2][2], B1[2][2];
    unsigned cg0[2], cg1[2], ng0[2], ng1[2];
    const char* cA; const char* cB = (const char*)g.Bt + (size_t)cur.pn * tstepB;
    if constexpr (GATHER) {
        cA = (const char*)g.A;
#pragma unroll
        for (int i = 0; i < 2; ++i) { cg0[i] = (unsigned)(rowidx[ui * 256 + RA[i]] * g.lda + CA[i]) * 2u; cg1[i] = (unsigned)(rowidx[ui * 256 + 128 + RA[i]] * g.lda + CA[i]) * 2u; ng0[i] = cg0[i]; ng1[i] = cg1[i]; }
    } else { cA = S.abase(cur); cg0[0] = cg0[1] = cg1[0] = cg1[1] = ng0[0] = ng0[1] = ng1[0] = ng1[1] = 0u; }
#define PG8_STAGE_A(bufoff, base, h, og0, og1) do { if constexpr (GATHER) { if ((h) == 0) PG8_STAGE(bufoff, base, og0); else PG8_STAGE(bufoff, base, og1); } \
        else { PG8_STAGE(bufoff, (base) + ((h) ? hstepA : (size_t)0), voffA); } } while (0)
    PG8_STAGE(PG8_SB(0, 0), cB, voffB); PG8_STAGE(PG8_SB(0, 1), cB + hstepB, voffB); PG8_STAGE_A(PG8_SA(0, 0), cA, 0, cg0, cg1); PG8_STAGE_A(PG8_SA(0, 1), cA, 1, cg0, cg1);
    if (wr == 1) PG8_BAR;
    PG8_WAIT_V(2); PG8_BAR;
    PG8_STAGE(PG8_SB(1, 0), cB + kstepB, voffB); PG8_STAGE_A(PG8_SA(1, 0), cA + kstepA, 0, cg0, cg1); PG8_STAGE(PG8_SB(1, 1), cB + hstepB + kstepB, voffB);
    PG8_WAIT_V(6); PG8_BAR;
    for (;;) {
        const bool has_next = S.next(ui + 1, nxt);
        const char* nA; const char* nB = has_next ? (const char*)g.Bt + (size_t)nxt.pn * tstepB : cB;
        if constexpr (GATHER) {
            nA = cA;
            if (has_next) {
#pragma unroll
                for (int i = 0; i < 2; ++i) { ng0[i] = (unsigned)(rowidx[(ui + 1) * 256 + RA[i]] * g.lda + CA[i]) * 2u; ng1[i] = (unsigned)(rowidx[(ui + 1) * 256 + 128 + RA[i]] * g.lda + CA[i]) * 2u; }
            } else {
#pragma unroll
                for (int i = 0; i < 2; ++i) { ng0[i] = cg0[i]; ng1[i] = cg1[i]; }
            }
        } else { nA = has_next ? S.abase(nxt) : cA; }
        for (int t = 0; t < nt; t += 2) {
            const bool last = (t == nt - 2);
            const char* a1 = cA + (size_t)(t + 1) * kstepA;
            const char* a2 = last ? nA : cA + (size_t)(t + 2) * kstepA; const char* b2 = last ? nB : cB + (size_t)(t + 2) * kstepB;
            const char* a3 = a2 + kstepA; const char* b3 = b2 + kstepB;
            unsigned xg0[2], xg1[2];
#pragma unroll
            for (int i = 0; i < 2; ++i) { xg0[i] = last ? ng0[i] : cg0[i]; xg1[i] = last ? ng1[i] : cg1[i]; }
            PG8_LDB(B0, 0, 0); PG8_LDB(B1, 0, 1); PG8_SCHED; PG8_LDA(At, 0, 0); PG8_STAGE_A(PG8_SA(1, 1), a1, 1, cg0, cg1);
            PG8_WAIT_V(8); PG8_WAIT_L(0); PG8_BAR; PG8_MMA(0, 0, At, B0); PG8_MMA(0, 1, At, B1); PG8_BAR; PG8_SCHED;
            PG8_LDA(At, 0, 1); PG8_STAGE(PG8_SB(0, 0), b2, voffB); PG8_STAGE(PG8_SB(0, 1), b2 + hstepB, voffB); PG8_STAGE_A(PG8_SA(0, 0), a2, 0, xg0, xg1);
            PG8_WAIT_V(8); PG8_WAIT_L(0); PG8_BAR; PG8_MMA(1, 0, At, B0); PG8_MMA(1, 1, At, B1); PG8_BAR; PG8_SCHED;
            PG8_LDB(B0, 1, 0); PG8_LDB(B1, 1, 1); PG8_SCHED; PG8_LDA(At, 1, 0); PG8_STAGE_A(PG8_SA(0, 1), a2, 1, xg0, xg1);
            PG8_WAIT_V(8); PG8_WAIT_L(0); PG8_BAR; PG8_MMA(0, 0, At, B0); PG8_MMA(0, 1, At, B1); PG8_BAR; PG8_SCHED;
            PG8_LDA(At, 1, 1); PG8_STAGE(PG8_SB(1, 0), b3, voffB); PG8_STAGE(PG8_SB(1, 1), b3 + hstepB, voffB); PG8_STAGE_A(PG8_SA(1, 0), a3, 0, xg0, xg1);
            PG8_WAIT_V(8); PG8_WAIT_L(0); PG8_BAR; PG8_MMA(1, 0, At, B0); PG8_MMA(1, 1, At, B1); PG8_BAR; PG8_SCHED;
        }
        if constexpr (ALIGN_EPI) { if (wr == 0) PG8_BAR; }
        E(acc, cur, wr, wc, fr, fq);
        if (!has_next) break;
#pragma unroll
        for (int a = 0; a < 2; ++a)
#pragma unroll
            for (int b = 0; b < 2; ++b)
#pragma unroll
                for (int m = 0; m < 4; ++m)
#pragma unroll
                    for (int n = 0; n < 2; ++n) acc[a][b][m][n] = (f32x4){0.f, 0.f, 0.f, 0.f};
        cur = nxt; cA = nA; cB = nB; ++ui;
#pragma unroll
        for (int i = 0; i < 2; ++i) { cg0[i] = ng0[i]; cg1[i] = ng1[i]; }
        if constexpr (ALIGN_EPI) { if (wr == 1) PG8_BAR; }
    }
    PG8_WAIT_V(0);
    if constexpr (!ALIGN_EPI) { if (wr == 0) PG8_BAR; }
    PG8_BAR;
#undef PG8_SA
#undef PG8_SB
#undef PG8_STAGE
#undef PG8_STAGE_A
#undef PG8_LDA
#undef PG8_LDB
#undef PG8_MMA
#undef PG8_WAIT_V
#undef PG8_WAIT_L
#undef PG8_BAR
#undef PG8_SCHED
}
}
namespace pg8 {
typedef f32x4 AccT[2][2][4][2];

struct EpiStoreBf16 {
    static constexpr bool PERM = true;
    bf16_t* O; int ldc; float scale0; int ntile0;
    DI void operator()(const AccT& acc, const Unit& u, int wr, int wc, int fr, int fq) const {
        const int row0 = u.pm * BM + wr * 64 + fr, col0 = u.po * BM + wc * 32 + 8 * fq; const float sc = (u.po < ntile0) ? scale0 : 1.0f;
#pragma unroll
        for (int ai = 0; ai < 2; ++ai)
#pragma unroll
            for (int m = 0; m < 4; ++m) { bf16_t* rowp = O + (size_t)(row0 + ai * HALF + m * 16) * ldc + col0;
#pragma unroll
                for (int bj = 0; bj < 2; ++bj) { const f32x4 v0 = acc[ai][bj][m][0] * sc, v1 = acc[ai][bj][m][1] * sc;
                    u32x4 w; w.x = pk2(v0[0], v0[1]); w.y = pk2(v0[2], v0[3]); w.z = pk2(v1[0], v1[1]); w.w = pk2(v1[2], v1[3]);
                    *(u32x4*)(rowp + bj * HALF) = w; } }
    }
};
struct EpiStoreFp8 {
    static constexpr bool PERM = true;
    unsigned char* O; int ldc; float scale;
    DI void operator()(const AccT& acc, const Unit& u, int wr, int wc, int fr, int fq) const {
        const int row0 = u.pm * BM + wr * 64 + fr, col0 = u.po * BM + wc * 32 + 8 * fq;
#pragma unroll
        for (int ai = 0; ai < 2; ++ai)
#pragma unroll
            for (int m = 0; m < 4; ++m) { unsigned char* rowp = O + (size_t)(row0 + ai * HALF + m * 16) * ldc + col0;
#pragma unroll
                for (int bj = 0; bj < 2; ++bj) { const f32x4 v0 = acc[ai][bj][m][0] * scale, v1 = acc[ai][bj][m][1] * scale;
                    int w0 = 0, w1 = 0;
                    w0 = __builtin_amdgcn_cvt_pk_fp8_f32(v0[0], v0[1], w0, false); w0 = __builtin_amdgcn_cvt_pk_fp8_f32(v0[2], v0[3], w0, true);
                    w1 = __builtin_amdgcn_cvt_pk_fp8_f32(v1[0], v1[1], w1, false); w1 = __builtin_amdgcn_cvt_pk_fp8_f32(v1[2], v1[3], w1, true);
                    *(u32x2*)(rowp + bj * HALF) = (u32x2){(unsigned)w0, (unsigned)w1}; } }
    }
};
DI float gelu_tanh(float x) { const float u = 0.7978845608028654f * (x + 0.044715f * x * x * x); const float e = __expf(2.0f * u); const float th = 1.0f - 2.0f / (e + 1.0f); return 0.5f * x * (1.0f + th); }
struct EpiCmp {
    static constexpr bool PERM = true;
    bf16_t* O; const float* peb;
    DI void operator()(const AccT& acc, const Unit& u, int wr, int wc, int fr, int fq) const {
        const int row0 = u.pm * BM + wr * 64 + fr, col0 = wc * 32 + 8 * fq; const float* pb = peb + (u.pm >> 4) * 256;
        f32x4 bv[2][2];
#pragma unroll
        for (int bj = 0; bj < 2; ++bj)
#pragma unroll
            for (int n = 0; n < 2; ++n) bv[bj][n] = *(const f32x4*)(pb + col0 + bj * HALF + 4 * n);
#pragma unroll
        for (int ai = 0; ai < 2; ++ai)
#pragma unroll
            for (int m = 0; m < 4; ++m) { bf16_t* rowp = O + (size_t)(row0 + ai * HALF + m * 16) * 256 + col0;
#pragma unroll
                for (int bj = 0; bj < 2; ++bj) { f32x4 v0 = acc[ai][bj][m][0] + bv[bj][0], v1 = acc[ai][bj][m][1] + bv[bj][1];
#pragma unroll
                    for (int j = 0; j < 4; ++j) { v0[j] = gelu_tanh(v0[j]); v1[j] = gelu_tanh(v1[j]); }
                    u32x4 w; w.x = pk2(v0[0], v0[1]); w.y = pk2(v0[2], v0[3]); w.z = pk2(v1[0], v1[1]); w.w = pk2(v1[2], v1[3]);
                    *(u32x4*)(rowp + bj * HALF) = w; } }
    }
};
struct EpiF32 {
    static constexpr bool PERM = false;
    float* C; int ldc;
    DI void operator()(const AccT& acc, const Unit& u, int wr, int wc, int fr, int fq) const {
        const int row0 = u.pm * BM + wr * 64 + fr, col0 = u.po * BM + wc * 32 + 4 * fq;
#pragma unroll
        for (int ai = 0; ai < 2; ++ai)
#pragma unroll
            for (int m = 0; m < 4; ++m) { float* rowp = C + (size_t)(row0 + ai * HALF + m * 16) * ldc + col0;
#pragma unroll
                for (int bj = 0; bj < 2; ++bj)
#pragma unroll
                    for (int n = 0; n < 2; ++n) *(f32x4*)(rowp + bj * HALF + n * 16) = acc[ai][bj][m][n]; }
    }
};
struct EpiResMod {
    static constexpr bool PERM = false;
    const float* base; float* out; const float* gate; int gate_pitch;
    DI void operator()(const AccT& acc, const Unit& u, int wr, int wc, int fr, int fq) const {
        const int row0 = u.pm * BM + wr * 64 + fr, col0 = u.po * BM + wc * 32 + 4 * fq;
        const float* gp = gate + (size_t)((u.pm * BM) / SEQ) * gate_pitch + col0;
        f32x4 gv[2][2];
#pragma unroll
        for (int bj = 0; bj < 2; ++bj)
#pragma unroll
            for (int n = 0; n < 2; ++n) gv[bj][n] = *(const f32x4*)(gp + bj * HALF + n * 16);
#pragma unroll
        for (int ai = 0; ai < 2; ++ai)
#pragma unroll
            for (int m = 0; m < 4; ++m) { const size_t off = (size_t)(row0 + ai * HALF + m * 16) * DM + col0;
#pragma unroll
                for (int bj = 0; bj < 2; ++bj)
#pragma unroll
                    for (int n = 0; n < 2; ++n) { const f32x4 bs = *(const f32x4*)(base + off + bj * HALF + n * 16);
                        *(f32x4*)(out + off + bj * HALF + n * 16) = bs * DN_ALPHA + gv[bj][n] * acc[ai][bj][m][n]; } }
    }
};
struct EpiResModBf16 {
    static constexpr bool PERM = false;
    const float* base; bf16_t* out; const float* gate; int gate_pitch;
    DI void operator()(const AccT& acc, const Unit& u, int wr, int wc, int fr, int fq) const {
        const int row0 = u.pm * BM + wr * 64 + fr, col0 = u.po * BM + wc * 32 + 4 * fq;
        const float* gp = gate + (size_t)((u.pm * BM) / SEQ) * gate_pitch + col0;
        f32x4 gv[2][2];
#pragma unroll
        for (int bj = 0; bj < 2; ++bj)
#pragma unroll
            for (int n = 0; n < 2; ++n) gv[bj][n] = *(const f32x4*)(gp + bj * HALF + n * 16);
#pragma unroll
        for (int ai = 0; ai < 2; ++ai)
#pragma unroll
            for (int m = 0; m < 4; ++m) { const size_t off = (size_t)(row0 + ai * HALF + m * 16) * DM + col0;
#pragma unroll
                for (int bj = 0; bj < 2; ++bj)
#pragma unroll
                    for (int n = 0; n < 2; ++n) { const f32x4 bs = *(const f32x4*)(base + off + bj * HALF + n * 16); const f32x4 v = bs * DN_ALPHA + gv[bj][n] * acc[ai][bj][m][n];
                        *(u32x2*)(out + off + bj * HALF + n * 16) = (u32x2){pk2(v.x, v.y), pk2(v.z, v.w)}; } }
    }
};
struct EpiGlu {
    static constexpr bool PERM = true;
    bf16_t* O; int ldc;
    DI void operator()(const AccT& acc, const Unit& u, int wr, int wc, int fr, int fq) const {
        const int row0 = u.pm * BM + wr * 64 + fr, col0 = u.po * HALF + wc * 32 + 8 * fq;
#pragma unroll
        for (int ai = 0; ai < 2; ++ai)
#pragma unroll
            for (int m = 0; m < 4; ++m) { bf16_t* rowp = O + (size_t)(row0 + ai * HALF + m * 16) * ldc + col0;
                f32x4 h0, h1;
#pragma unroll
                for (int j = 0; j < 4; ++j) { h0[j] = fsilu(acc[ai][0][m][0][j]) * acc[ai][1][m][0][j]; h1[j] = fsilu(acc[ai][0][m][1][j]) * acc[ai][1][m][1][j]; }
                u32x4 w; w.x = pk2(h0[0], h0[1]); w.y = pk2(h0[2], h0[3]); w.z = pk2(h1[0], h1[1]); w.w = pk2(h1[2], h1[3]);
                *(u32x4*)rowp = w; }
    }
};

struct CmpOrder {
    int G, c; const bf16_t* U;
    DI bool next(int i, Unit& u) const { const int L = i * G + c; if (L >= 32) return false; u.pm = L; u.pn = L >> 4; u.po = 0; return true; }
    DI const char* abase(const Unit& u) const { const int kv = u.pm >> 4, bg = (u.pm >> 1) & 7, b = bg >> 1, gg = bg & 1, half = u.pm & 1;
        return (const char*)(U + (size_t)(b * SEQ + half * 4096) * NU + (kv ? UVC : UKC) + gg * 64); }
};
template <int NSUB> struct MoeOrder {
    int G, c, nunits; const int* blk_e; const bf16_t* A; size_t tstepA;
    DI bool next(int i, Unit& u) const { const int L = i * G + c; if (L >= nunits) return false; const int blk = L / NSUB, sub = L % NSUB;
        const int e = (int)__builtin_amdgcn_readfirstlane((int)ld_u32_agent((const unsigned*)blk_e + blk)); u.pm = blk; u.pn = e * NSUB + sub; u.po = sub; return true; }
    DI const char* abase(const Unit& u) const { return (const char*)A + (size_t)u.pm * tstepA; }
};
}
constexpr size_t MiB = 1u << 20;
constexpr size_t WS_CTL = 0, CTL_ZERO_BYTES = 1 * MiB;
constexpr size_t WS_MODP = 1 * MiB;
constexpr size_t WS_MOD = WS_MODP + 1536 * 1024;
constexpr size_t WS_PEP = WS_MOD + 128 * 1024;
constexpr size_t WS_PEB = WS_PEP + 32 * 1024;
constexpr size_t WS_WIN_T = 3 * MiB;
constexpr size_t WS_WOUT_T = 8 * MiB;
constexpr size_t WS_WR_T = 10 * MiB;
constexpr size_t WS_WSGU_T = 12 * MiB;
constexpr size_t WS_WSD_T = 13 * MiB;
constexpr size_t WS_WC1_T = 14 * MiB;
constexpr size_t WS_WDN_T = 16 * MiB;
constexpr size_t WS_WGU_T = 144 * MiB;
constexpr size_t WS_YMOE = 144 * MiB;
constexpr size_t WS_U = 400 * MiB;
constexpr size_t WS_H1 = 560 * MiB;
constexpr size_t WS_CAT = 624 * MiB;
constexpr size_t WS_H2 = 688 * MiB;
constexpr size_t WS_HIDS = 752 * MiB;
constexpr size_t WS_HIDM = 784 * MiB;
constexpr size_t WS_LOGIT = 944 * MiB;
constexpr size_t WS_TOKE = 976 * MiB;
constexpr size_t WS_TOKW = 977 * MiB;
constexpr size_t WS_LRANK = 978 * MiB;
constexpr size_t WS_POSOF = 979 * MiB;
constexpr size_t WS_ROWTOK = 980 * MiB;
constexpr size_t WS_HIST = 982 * MiB;
constexpr size_t WS_BLKE = 983 * MiB;
constexpr size_t WS_HCMP = 984 * MiB;
constexpr size_t WS_KC = 988 * MiB;
constexpr size_t WS_VCT = 989 * MiB;
constexpr size_t WS_VST = 990 * MiB;
constexpr size_t WS_VWT = 998 * MiB;
constexpr size_t WS_V1 = WS_H1;
constexpr size_t WS_X1 = 464 * MiB;
constexpr size_t WS_SH = 528 * MiB;
constexpr size_t WS_END = 1024 * MiB;
constexpr int CW_BAR = 4096;

constexpr int LDS_BYTES = 160 * 1024;
constexpr int LDS_MISC = 131072;
constexpr int LDS_TAB = 131072 + 1024;

struct Params {
    const float *x, *c, *w_ada, *b_ada, *w_in, *pe_k, *pe_v, *w_cmp_k1, *w_cmp_k2, *w_cmp_v1, *w_cmp_v2, *w_dw, *b_dw, *conv_ln_g, *conv_ln_b, *w_out, *ln1_g, *ln1_b,
        *w_router, *router_bias, *w_e_gate, *w_e_up, *w_e_down, *w_s_gate, *w_s_up, *w_s_down, *ln2_g, *ln2_b;
    float* out; unsigned char* ws; int ph_lo, ph_hi;
};

DI void transpose_item(const float* W, int ldw, int ncols, bf16_t* WT, int ldt, int drow0, LAS float* scr, int k0, int n0, int lane) {
    if (n0 + 32 <= ncols && (((size_t)W | (size_t)(ldw * 4)) & 15) == 0 && (n0 & 3) == 0) {
        f32x4 v[8];
#pragma unroll
        for (int i = 0; i < 8; ++i) v[i] = *(const f32x4*)(W + (size_t)(k0 + 8 * i + (lane >> 3)) * ldw + n0 + 4 * (lane & 7));
#pragma unroll
        for (int i = 0; i < 8; ++i) { LAS float* d = scr + (8 * i + (lane >> 3)) * 33 + 4 * (lane & 7); d[0] = v[i].x; d[1] = v[i].y; d[2] = v[i].z; d[3] = v[i].w; }
    } else {
        const int nn = n0 + (lane & 31); const bool okc = nn < ncols;
#pragma unroll 8
        for (int i = 0; i < 32; ++i) { const int kk = 2 * i + (lane >> 5); scr[kk * 33 + (lane & 31)] = okc ? W[(size_t)(k0 + kk) * ldw + nn] : 0.f; }
    }
    LDS_WAIT(); asm volatile("" ::: "memory");
    const int cch = lane & 7;
#pragma unroll
    for (int j = 0; j < 4; ++j) { const int n = (lane >> 3) + 8 * j; const LAS float* s = scr + (8 * cch) * 33 + n;
        u32x4 o; o.x = pk2(s[0 * 33], s[1 * 33]); o.y = pk2(s[2 * 33], s[3 * 33]); o.z = pk2(s[4 * 33], s[5 * 33]); o.w = pk2(s[6 * 33], s[7 * 33]);
        *(u32x4*)(WT + (size_t)(drow0 + n) * ldt + k0 + 8 * cch) = o; }
    LDS_WAIT(); asm volatile("" ::: "memory");
}
DI void tr_plain(const float* W, int ldw, int K, int N, bf16_t* WT, int row_off, LAS float* scr, int item, int lane) {
    const int nblk = (N + 31) / 32, kb = item / nblk, nb = item % nblk;
    transpose_item(W, ldw, N, WT, K, row_off + 32 * nb, scr, 64 * kb, 32 * nb, lane);
}
DI void tr_glu(const float* W, int K, bf16_t* WT, int up, LAS float* scr, int item, int lane) {
    const int kb = item >> 3, nb = item & 7, n0 = 32 * nb;
    transpose_item(W, 256, 256, WT, K, (n0 >> 7) * 256 + up * 128 + (n0 & 127), scr, 64 * kb, n0, lane);
}

constexpr int EXP_ITEMS = NEXP * 384, EXP_LATE = 18432;
DI void expert_items(const Params& P, LAS float* scr, int lane, int gw, int NGW, int r0, int r1) {
    unsigned char* ws = P.ws;
    for (int r = r0 + gw; r < r1; r += NGW) { const int e = r / 384, q = r % 384;
        if (q < 128) tr_glu(P.w_e_gate + (size_t)e * 1024 * 256, 1024, (bf16_t*)(ws + WS_WGU_T) + (size_t)e * 512 * 1024, 0, scr, q, lane);
        else if (q < 256) tr_glu(P.w_e_up + (size_t)e * 1024 * 256, 1024, (bf16_t*)(ws + WS_WGU_T) + (size_t)e * 512 * 1024, 1, scr, q - 128, lane);
        else tr_plain(P.w_e_down + (size_t)e * 256 * 1024, 1024, 256, 1024, (bf16_t*)(ws + WS_WDN_T) + (size_t)e * 1024 * 256, 0, scr, q - 256, lane); }
}

DI void phase0a(const Params& P, LAS unsigned char* lds, int vcu, int G, int wave, int lane, int tid) {
    unsigned char* ws = P.ws;
    LAS float* scr = (LAS float*)(lds + wave * 16384);
    const int gw = vcu * 8 + wave, NGW = G * 8;
    for (int it = gw; it < 96 * 16; it += NGW) { const int cb = it % 96, ks = it / 96; const int col = cb * 64 + lane;
        float a0 = 0.f, a1 = 0.f, a2 = 0.f, a3 = 0.f;
#pragma unroll 4
        for (int k = ks * 64; k < ks * 64 + 64; ++k) { const float w = P.w_ada[(size_t)k * 6144 + col];
            a0 += fsilu(P.c[k]) * w; a1 += fsilu(P.c[1024 + k]) * w; a2 += fsilu(P.c[2048 + k]) * w; a3 += fsilu(P.c[3072 + k]) * w; }
        float* mp = (float*)(ws + WS_MODP) + (size_t)ks * 4 * 6144 + col;
        mp[0] = a0; mp[6144] = a1; mp[2 * 6144] = a2; mp[3 * 6144] = a3; }
    for (int it = gw; it < 16 * 2 * 4; it += NGW) { const int cb = it & 3, kv = (it >> 2) & 1, ks = it >> 3; const int col = cb * 64 + lane;
        const float* pe = kv ? P.pe_v : P.pe_k; const float* w1 = kv ? P.w_cmp_v1 : P.w_cmp_k1; float a = 0.f;
#pragma unroll 4
        for (int k = ks * 128; k < ks * 128 + 128; ++k) a += pe[k] * w1[(size_t)k * 256 + col];
        ((float*)(ws + WS_PEP))[(ks * 2 + kv) * 256 + col] = a; }
    constexpr int I_IN0 = 16 * 40, I_IN1 = 16 * 32, I_IN2 = 16 * 1, I_OUT = 16 * 32, I_R = 16 * 8, I_SG = 16 * 8, I_SD = 4 * 32, I_C1 = 32 * 8;
    constexpr int I_SMALL = I_IN0 + I_IN1 + I_IN2 + I_OUT + I_R + 2 * I_SG + I_SD + 2 * I_C1;
    constexpr int NITEMS = I_SMALL;
    bf16_t* win_t = (bf16_t*)(ws + WS_WIN_T);
    for (int it = gw; it < NITEMS; it += NGW) {
        int r = it;
        if (r < I_IN0) { tr_plain(P.w_in, DIN, 1024, 1280, win_t, 0, scr, r, lane); continue; } r -= I_IN0;
        if (r < I_IN1) { tr_plain(P.w_in + 1304, DIN, 1024, 1024, win_t, UCA, scr, r, lane); continue; } r -= I_IN1;
        if (r < I_IN2) { tr_plain(P.w_in + 1280, DIN, 1024, 24, win_t, UGT, scr, r, lane); continue; } r -= I_IN2;
        if (r < I_OUT) { tr_plain(P.w_out, 1024, 1024, 1024, (bf16_t*)(ws + WS_WOUT_T), 0, scr, r, lane); continue; } r -= I_OUT;
        if (r < I_R) { tr_plain(P.w_router, 256, 1024, 256, (bf16_t*)(ws + WS_WR_T), 0, scr, r, lane); continue; } r -= I_R;
        if (r < I_SG) { tr_glu(P.w_s_gate, 1024, (bf16_t*)(ws + WS_WSGU_T), 0, scr, r, lane); continue; } r -= I_SG;
        if (r < I_SG) { tr_glu(P.w_s_up, 1024, (bf16_t*)(ws + WS_WSGU_T), 1, scr, r, lane); continue; } r -= I_SG;
        if (r < I_SD) { tr_plain(P.w_s_down, 1024, 256, 1024, (bf16_t*)(ws + WS_WSD_T), 0, scr, r, lane); continue; } r -= I_SD;
        if (r < I_C1) { tr_plain(P.w_cmp_k1, 256, 2048, 256, (bf16_t*)(ws + WS_WC1_T), 0, scr, r, lane); continue; } r -= I_C1;
        tr_plain(P.w_cmp_v1, 256, 2048, 256, (bf16_t*)(ws + WS_WC1_T) + 256 * 2048, 0, scr, r, lane);
    }
    { u32x4* z = (u32x4*)(win_t + (size_t)2336 * 1024); const int n16 = (2560 - 2336) * 1024 * 2 / 16;
      for (int i = vcu * 512 + tid; i < n16; i += G * 512) z[i] = (u32x4){0u, 0u, 0u, 0u}; }
}

DI void phase0b(const Params& P, LAS unsigned char* lds, int vcu, int G, int wave, int lane, int tid) {
    unsigned char* ws = P.ws;
    const float* modp = (const float*)(ws + WS_MODP);
    for (int i = vcu * 512 + tid; i < 4 * 6144; i += G * 512) { float a = P.b_ada[i % 6144];
#pragma unroll
        for (int ks = 0; ks < 16; ++ks) a += modp[(size_t)ks * 4 * 6144 + i];
        ((float*)(ws + WS_MOD))[i] = a; }
    for (int i = vcu * 512 + tid; i < 512; i += G * 512) { float a = 0.f;
#pragma unroll
        for (int ks = 0; ks < 16; ++ks) a += ((const float*)(ws + WS_PEP))[ks * 512 + i];
        ((float*)(ws + WS_PEB))[i] = a; }
    const int rpw = NT / G;
    LAS float* sh = (LAS float*)lds;
    for (int r0 = vcu * rpw; r0 < NT; r0 += G * rpw) {
        const int b = r0 / SEQ;
        __syncthreads();
        for (int i = tid; i < 2048; i += 512) { const int j = (i < 1024) ? i : i;
            float a = P.b_ada[j];
#pragma unroll
            for (int ks = 0; ks < 16; ++ks) a += modp[(size_t)ks * 4 * 6144 + b * 6144 + j];
            sh[i] = (i < 1024) ? a : 1.0f + a; }
        __syncthreads();
        for (int m = r0 + wave; m < r0 + rpw; m += 8) {
            const f32x4* xr = (const f32x4*)(P.x + (size_t)m * DM) + lane; unsigned long long* o8 = (unsigned long long*)((bf16_t*)(ws + WS_H1) + (size_t)m * DM) + lane;
#pragma unroll
            for (int j = 0; j < 4; ++j) { const f32x4 v = xr[64 * j]; const int c0 = 4 * lane + 256 * j;
                const float y0 = v.x * sh[1024 + c0] + sh[c0], y1 = v.y * sh[1025 + c0] + sh[c0 + 1], y2 = v.z * sh[1026 + c0] + sh[c0 + 2], y3 = v.w * sh[1027 + c0] + sh[c0 + 3];
                o8[64 * j] = (unsigned long long)pk2(y0, y1) | ((unsigned long long)pk2(y2, y3) << 32); }
        }
    }
    __syncthreads();
}

DI void conv_item(const Params& P, LAS unsigned char* lds, int item, int wave, int lane, int tid) {
    const bf16_t* U = (const bf16_t*)(P.ws + WS_U); bf16_t* CAT = (bf16_t*)(P.ws + WS_CAT);
    LAS float* glu = (LAS float*)lds; LAS float* red = (LAS float*)(lds + 62 * 512 * 4); LAS float* stat = red + 32 * 8 * 2;
    const int b = item >> 8, t0 = (item & 255) * 32, c = tid;
    __syncthreads();
    {
        u32x4 av[8], gv8[8];
#pragma unroll
        for (int i = 0; i < 8; ++i) { const int task = tid + 512 * i, rr = task >> 6, oc = task & 63; int tok = t0 - 30 + (rr < 62 ? rr : 61); tok = tok < 0 ? 0 : tok;
            const bf16_t* up = U + (size_t)(b * SEQ + tok) * NU + oc * 8; av[i] = *(const u32x4*)(up + UCA); gv8[i] = *(const u32x4*)(up + UCG); }
#pragma unroll
        for (int i = 0; i < 8; ++i) { const int task = tid + 512 * i, rr = task >> 6, oc = task & 63; const bool ok = (t0 - 30 + rr) >= 0;
            const unsigned aw[4] = {av[i].x, av[i].y, av[i].z, av[i].w}, gw[4] = {gv8[i].x, gv8[i].y, gv8[i].z, gv8[i].w}; float o[8];
#pragma unroll
            for (int q = 0; q < 4; ++q) { o[2 * q] = ok ? bflo(aw[q]) * fsigmoid(bflo(gw[q])) : 0.f; o[2 * q + 1] = ok ? bfhi(aw[q]) * fsigmoid(bfhi(gw[q])) : 0.f; }
            if (rr < 62) { *(LAS f32x4*)(glu + rr * 512 + oc * 8) = (f32x4){o[0], o[1], o[2], o[3]}; *(LAS f32x4*)(glu + rr * 512 + oc * 8 + 4) = (f32x4){o[4], o[5], o[6], o[7]}; } }
    }
    float w[31];
#pragma unroll
    for (int j = 0; j < 31; ++j) w[j] = P.w_dw[j * 512 + c];
    const float bd = P.b_dw[c];
    __syncthreads();
    float y[32];
#pragma unroll
    for (int tt = 0; tt < 32; ++tt) y[tt] = bd;
#pragma unroll
    for (int rr = 0; rr < 62; ++rr) { const float gv = glu[rr * 512 + c];
#pragma unroll
        for (int tt = 0; tt < 32; ++tt) { if (rr - tt >= 0 && rr - tt <= 30) y[tt] += w[rr - tt] * gv; } }
    __syncthreads();
#pragma unroll
    for (int tt = 0; tt < 32; ++tt) glu[tt * 512 + c] = y[tt];
    __syncthreads();
    {
#pragma unroll
        for (int q = 0; q < 4; ++q) { const int tt = 4 * wave + q; const f32x4 a = *(const LAS f32x4*)(glu + tt * 512 + lane * 8), bq = *(const LAS f32x4*)(glu + tt * 512 + lane * 8 + 4);
            float s1 = ((a.x + a.y) + (a.z + a.w)) + ((bq.x + bq.y) + (bq.z + bq.w));
            float s2 = ((a.x * a.x + a.y * a.y) + (a.z * a.z + a.w * a.w)) + ((bq.x * bq.x + bq.y * bq.y) + (bq.z * bq.z + bq.w * bq.w));
            s1 = wave_sum(s1); s2 = wave_sum(s2);
            if (lane == 0) { const float mean = s1 * (1.0f / 512.0f); float var = s2 * (1.0f / 512.0f) - mean * mean; var = var < 0.f ? 0.f : var;
                stat[tt * 2] = mean; stat[tt * 2 + 1] = 1.0f / sqrtf(var + LN_EPS); } }
    }
    __syncthreads();
    const float lg = P.conv_ln_g[c], lb = P.conv_ln_b[c];
#pragma unroll
    for (int tt = 0; tt < 32; ++tt) { const float v = (y[tt] - stat[tt * 2]) * stat[tt * 2 + 1] * lg + lb;
        CAT[(size_t)(b * SEQ + t0 + tt) * DM + 512 + c] = (bf16_t)(pk2(fsilu(v), 0.f) & 0xffffu); }
}

DI unsigned swap23(unsigned p) { return (p & ~12u) | ((p & 4u) << 1) | ((p & 8u) >> 1); }
DI void vt_copies(const Params& P, LAS unsigned char* lds, int gw, int NGW, int wave, int lane) {
    unsigned char* ws = P.ws;
    LAS bf16_t* tile = (LAS bf16_t*)(lds + wave * 8448);
    const bf16_t* U = (const bf16_t*)(ws + WS_U);
    for (int it = gw; it < 2 * 8 * 128; it += NGW) { const int which = it >> 10, bg = (it >> 7) & 7, blk = it & 127, b = bg >> 1, gg = bg & 1;
        const bf16_t* src = U + (size_t)(b * SEQ + blk * 64 + lane) * NU + (which ? UVW : UVS) + gg * 64;
#pragma unroll
        for (int q = 0; q < 8; ++q) { const u32x4 v = *(const u32x4*)(src + q * 8); LAS unsigned* tp = (LAS unsigned*)(tile + lane * 66 + q * 8); tp[0] = v.x; tp[1] = v.y; tp[2] = v.z; tp[3] = v.w; }
        LDS_WAIT(); asm volatile("" ::: "memory");
        bf16_t* dst = (bf16_t*)(ws + (which ? WS_VWT : WS_VST)) + ((size_t)(bg * 128 + blk) * 64 + lane) * 64;
#pragma unroll
        for (int q = 0; q < 8; ++q) { unsigned wv[4];
#pragma unroll
            for (int e2 = 0; e2 < 4; ++e2) { const int p0 = q * 8 + e2 * 2; const int k0 = (p0 & ~15) | (int)swap23((unsigned)p0 & 15u), k1 = ((p0 + 1) & ~15) | (int)swap23((unsigned)(p0 + 1) & 15u);
                wv[e2] = (unsigned)tile[k0 * 66 + lane] | ((unsigned)tile[k1 * 66 + lane] << 16); }
            *(u32x4*)(dst + q * 8) = (u32x4){wv[0], wv[1], wv[2], wv[3]}; }
        LDS_WAIT(); asm volatile("" ::: "memory");
    }
}

DI void cmp2_rows(const Params& P, LAS unsigned char* lds, int kv, int row0, int nblk64, int tid) {
    unsigned char* ws = P.ws;
    const float* w2 = kv ? P.w_cmp_v2 : P.w_cmp_k2; LAS float* w2s = (LAS float*)lds;
    __syncthreads();
    for (int i = tid; i < 256 * 64 / 4; i += 512) ((LAS f32x4*)w2s)[i] = ((const f32x4*)w2)[i];
    __syncthreads();
    for (int blk = 0; blk < nblk64; ++blk) {
        const int row = row0 + blk * 64 + (tid >> 3), oc = tid & 7;
        const bf16_t* hrow = (const bf16_t*)(ws + WS_HCMP) + ((size_t)kv * 4096 + row) * 256;
        float acc[8];
#pragma unroll
        for (int j = 0; j < 8; ++j) acc[j] = 0.f;
        for (int k8 = 0; k8 < 32; ++k8) { const u32x4 hv = *(const u32x4*)(hrow + k8 * 8); const unsigned hw[4] = {hv.x, hv.y, hv.z, hv.w};
#pragma unroll
            for (int q = 0; q < 4; ++q) {
#pragma unroll
                for (int hh = 0; hh < 2; ++hh) { const float hval = hh ? bfhi(hw[q]) : bflo(hw[q]); const int k = k8 * 8 + q * 2 + hh;
                    const f32x4 wa = *(const LAS f32x4*)(w2s + k * 64 + oc * 8), wb = *(const LAS f32x4*)(w2s + k * 64 + oc * 8 + 4);
                    acc[0] += hval * wa.x; acc[1] += hval * wa.y; acc[2] += hval * wa.z; acc[3] += hval * wa.w; acc[4] += hval * wb.x; acc[5] += hval * wb.y; acc[6] += hval * wb.z; acc[7] += hval * wb.w; } } }
        const int bg = row >> 9, n = row & 511;
        if (n == 511) {
#pragma unroll
            for (int j = 0; j < 8; ++j) acc[j] = 0.f; }
        if (kv == 0) { u32x4 o; o.x = pk2(acc[0], acc[1]); o.y = pk2(acc[2], acc[3]); o.z = pk2(acc[4], acc[5]); o.w = pk2(acc[6], acc[7]);
            *(u32x4*)((bf16_t*)(ws + WS_KC) + ((size_t)bg * 512 + n) * 64 + oc * 8) = o; }
        else { bf16_t* vt = (bf16_t*)(ws + WS_VCT) + (size_t)bg * 64 * 512; const int pos = (n & ~15) | (int)swap23((unsigned)n & 15u);
#pragma unroll
            for (int j = 0; j < 8; ++j) vt[(size_t)(oc * 8 + j) * 512 + pos] = (bf16_t)(pk2(acc[j], 0.f) & 0xffffu); }
    }
    __syncthreads();
}
DI void phase_cmp2(const Params& P, LAS unsigned char* lds, int vcu, int G, int wave, int lane, int tid) {
    for (int it = vcu; it < 128; it += G) cmp2_rows(P, lds, it >> 6, (it & 63) * 64, 1, tid);
    __syncthreads();
}
namespace attn {
constexpr int ROWB = 144;
constexpr int TROW = 128, TILEB = 64 * TROW;
constexpr int OFF_K = 0, OFF_V = 2 * TILEB, OFF_IMPG = 36864, OFF_IMPL = OFF_IMPG + 32768;
constexpr int OFF_SELM = LDS_TAB, OFF_MREF = LDS_TAB + 1024, OFF_LSUM = LDS_TAB + 2048, OFF_LIST = LDS_TAB + 4096, OFF_TM = LDS_TAB + 6144;
constexpr int OFF_QS = 0, OFF_PBUF = 36864, PSLOT = 32 * ROWB;
constexpr float NEG = -1e30f, MFLOOR = -1e20f;
#define MFMA32(a, b, c) __builtin_amdgcn_mfma_f32_32x32x16_bf16((a), (b), (c), 0, 0, 0)
DI float fexp2(float x) { return __builtin_amdgcn_exp2f(x); }
DI void dma_tile(const bf16_t* base, unsigned pitch, LAS unsigned char* buf, int wave, int lane) {
    const int row = 8 * wave + (lane >> 3), ch = (lane & 7) ^ ((row >> 1) & 7);
    __builtin_amdgcn_global_load_lds((const unsigned*)(base + (unsigned)(row * pitch + ch * 8)), (LAS unsigned*)(buf + wave * 1024), 16, 0, 0); }
DI bf16x8 pack8(const f32x16& p, int s2) { u32x4 w; w.x = pk2(p[8 * s2], p[8 * s2 + 1]); w.y = pk2(p[8 * s2 + 2], p[8 * s2 + 3]); w.z = pk2(p[8 * s2 + 4], p[8 * s2 + 5]); w.w = pk2(p[8 * s2 + 6], p[8 * s2 + 7]); return __builtin_bit_cast(bf16x8, w); }

constexpr int CV_PER_EXPERT = 1536, CV_TOTAL = NEXP * CV_PER_EXPERT;
struct CvState { int next, end, nfly; bool xafter; };
DI LAS unsigned char* cv_buf(LAS unsigned char* lds, int wave, int seq) { return lds + (wave < 4 ? 110592 + wave * 4096 : LDS_TAB + 8192 + (wave - 4) * 4096) + (seq & 1) * 2048; }
DI void cv_decode(int m, int& e, int& mat, int& k0, int& n0) { e = m / CV_PER_EXPERT; const int q = m % CV_PER_EXPERT; mat = q >> 9; const int w = q & 511;
    if (mat < 2) { n0 = (w >> 6) * 32; k0 = (w & 63) * 16; } else { n0 = (w >> 4) * 32; k0 = (w & 15) * 16; } }
DI void cv_issue(const Params& P, CvState& c, LAS unsigned char* lds, int wave, int lane) {
    int e, mat, k0, n0; cv_decode(c.next, e, mat, k0, n0);
    LAS unsigned* st = (LAS unsigned*)cv_buf(lds, wave, c.next);
    const int ldw = (mat < 2) ? 256 : 1024;
    const float* W = (mat == 0 ? P.w_e_gate : mat == 1 ? P.w_e_up : P.w_e_down) + (size_t)e * 1024 * 256;
    const float* src = W + (size_t)(k0 + (lane >> 3)) * ldw + n0 + 4 * (lane & 7);
#pragma unroll
    for (int j = 0; j < 2; ++j) __builtin_amdgcn_global_load_lds((const unsigned*)(src + (size_t)(8 * j) * ldw), st + j * 256, 16, 0, 0);
    ++c.nfly; ++c.next; c.xafter = true;
}
DI void cv_finish(const Params& P, CvState& c, LAS unsigned char* lds, int wave, int lane) {
    const int m = c.next - c.nfly; int e, mat, k0, n0; cv_decode(m, e, mat, k0, n0);
    const int nl = lane >> 1, kc = (lane & 1) * 8;
    const LAS float* st = (const LAS float*)cv_buf(lds, wave, m) + kc * 32 + nl;
    u32x4 o; o.x = pk2(st[0 * 32], st[1 * 32]); o.y = pk2(st[2 * 32], st[3 * 32]); o.z = pk2(st[4 * 32], st[5 * 32]); o.w = pk2(st[6 * 32], st[7 * 32]);
    const int n = n0 + nl; bf16_t* dst;
    if (mat < 2) dst = (bf16_t*)(P.ws + WS_WGU_T) + (size_t)e * 512 * 1024 + (size_t)((n >> 7) * 256 + mat * 128 + (n & 127)) * 1024 + k0 + kc;
    else dst = (bf16_t*)(P.ws + WS_WDN_T) + (size_t)e * 1024 * 256 + (size_t)n * 256 + k0 + kc;
    asm volatile("s_waitcnt lgkmcnt(0)" ::: "memory");
    *(u32x4*)dst = o; --c.nfly;
}

template <int MODE>
DI void tile_compute(const LAS unsigned char* Kb, const LAS unsigned char* Vb, const bf16x8 (&qf)[4], int r, int h, int lo, int hi, bool elem,
                     float& m, float& l, f32x16 (&O)[2], float meff_in, float linv, LAS float* impg, LAS float* impl, int sb0) {
    const bool rowfull = (lo <= 0 && hi >= 63);
    const int lo2 = lo - 4 * h, hi2 = hi - 4 * h, swz = (r >> 1) & 7;
#pragma unroll
    for (int kh = 0; kh < 2; ++kh) {
        f32x16 s;
#pragma unroll
        for (int i = 0; i < 16; ++i) s[i] = 0.f;
#pragma unroll
        for (int ks = 0; ks < 4; ++ks) { const bf16x8 a = *(const LAS bf16x8*)(Kb + (32 * kh + r) * TROW + (((2 * ks + h) ^ swz) << 4)); s = MFMA32(a, qf[ks], s); }
        if (elem) {
#pragma unroll
            for (int i = 0; i < 16; ++i) { const int k0 = (i & 3) + 8 * (i >> 2) + 32 * kh; s[i] = (k0 >= lo2 && k0 <= hi2) ? s[i] : NEG; }
        }
        float cref;
        if (MODE != 2) {
            float tm = s[0];
#pragma unroll
            for (int i = 1; i < 16; ++i) tm = fmaxf(tm, s[i]);
            tm = fmaxf(tm, __shfl_xor(tm, 32));
            if (!elem) tm = rowfull ? tm : NEG;
            const bool need = tm > m + 8.0f;
            if (__any(need)) {
                const float mnew = need ? tm : m;
                const float alpha = fexp2(fmaxf(m, MFLOOR) - fmaxf(mnew, MFLOOR));
                l *= alpha; m = mnew;
                if (MODE == 0) {
#pragma unroll
                    for (int i = 0; i < 16; ++i) { O[0][i] *= alpha; O[1][i] *= alpha; } }
            }
            cref = (elem || rowfull) ? fmaxf(m, MFLOOR) : 1e30f;
            float rs = 0.f;
#pragma unroll
            for (int i = 0; i < 16; ++i) { s[i] = fexp2(s[i] - cref); rs += s[i]; }
            rs += __shfl_xor(rs, 32);
            l += rs;
        } else {
            cref = (elem || rowfull) ? meff_in : 1e30f;
#pragma unroll
            for (int i = 0; i < 16; ++i) s[i] = fexp2(s[i] - cref);
        }
        if (MODE == 1) continue;
        if (MODE == 2) {
#pragma unroll
            for (int gq = 0; gq < 4; ++gq) {
                float Gs = ((s[4 * gq] + s[4 * gq + 1]) + (s[4 * gq + 2] + s[4 * gq + 3])) * linv, Ls = s[4 * gq + 3] * linv;
                Gs += __shfl_xor(Gs, 1); Gs += __shfl_xor(Gs, 2); Ls += __shfl_xor(Ls, 1); Ls += __shfl_xor(Ls, 2);
                if ((r & 3) == 0) { const int sb = sb0 + 8 * kh + 2 * gq + h; impg[sb] = Gs; impl[sb] = Ls; } }
        }
#pragma unroll
        for (int s2 = 0; s2 < 2; ++s2) { const bf16x8 pf = pack8(s, s2);
#pragma unroll
            for (int dt = 0; dt < 2; ++dt) { const bf16x8 a = *(const LAS bf16x8*)(Vb + (32 * dt + r) * TROW + (((4 * kh + 2 * s2 + h) ^ swz) << 4));
                O[dt] = MFMA32(a, pf, O[dt]); } }
    }
}

DI void attn_unit(const Params& P, LAS unsigned char* lds, int bg, int qt, int wave, int lane_in, int tid_in, int& it, CvState& cv) {
    int lane = lane_in; asm volatile("" : "+v"(lane));
    const int tid = wave * 64 + lane;
    unsigned char* ws = P.ws;
    const bf16_t* U = (const bf16_t*)(ws + WS_U);
    const int b = bg >> 1, gg = bg & 1, t0 = qt * 64, r = lane & 31, h = lane >> 5, tokl = 8 * wave + (r >> 2), hp = r & 3, t = t0 + tokl;
    LAS float* IMPG = (LAS float*)(lds + OFF_IMPG); LAS float* IMPL = (LAS float*)(lds + OFF_IMPL); LAS unsigned* SELM = (LAS unsigned*)(lds + OFF_SELM);
#define ATT_UROW(name) int lq_ = lane; asm volatile("" : "+v"(lq_)); const bf16_t* name = U + (size_t)(b * SEQ + t0 + 8 * wave + ((lq_ & 31) >> 2)) * NU; const int hq_ = lq_ & 3, hh_ = lq_ >> 5; (void)hq_; (void)hh_;
    bf16x8 qf[4];
#define ATT_LOADQ() do { ATT_UROW(urow_) _Pragma("unroll") for (int ks = 0; ks < 4; ++ks) qf[ks] = *(const bf16x8*)(urow_ + UQ + (4 * gg + hq_) * 64 + 16 * ks + 8 * hh_); } while (0)
    ATT_LOADQ();
    f32x16 OA[2];
#pragma unroll
    for (int i = 0; i < 16; ++i) { OA[0][i] = 0.f; OA[1][i] = 0.f; }
    __syncthreads();
#pragma unroll
    for (int j = 0; j < 4; ++j) { *(LAS f32x4*)(IMPG + 8 * wave * 128 + lane * 4 + 256 * j) = (f32x4){0.f, 0.f, 0.f, 0.f}; *(LAS f32x4*)(IMPL + 8 * wave * 128 + lane * 4 + 256 * j) = (f32x4){0.f, 0.f, 0.f, 0.f}; }
    f32x16 O[2]; float m, l;
#define ATT_RESET() do { m = NEG; l = 0.f; _Pragma("unroll") for (int i = 0; i < 16; ++i) { O[0][i] = 0.f; O[1][i] = 0.f; } } while (0)
#define ATT_FOLD(br) do { ATT_UROW(urow_) const float gate_ = fsigmoid(bf2f(urow_[UGT + gg * 12 + hq_ * 3 + (br)])); const float sc_ = (l > 0.f) ? gate_ / l : 0.f; _Pragma("unroll") for (int i = 0; i < 16; ++i) { OA[0][i] += sc_ * O[0][i]; OA[1][i] += sc_ * O[1][i]; } } while (0)

#define ATT_STEP(CUR, NXT, TI, KPTR, KPITCH, VPTR, VPITCH, USEV, ...) { \
            LAS unsigned char* Kb = lds + OFF_K + (CUR) * TILEB; LAS unsigned char* Vb = lds + OFF_V + (CUR) * TILEB; \
            int nfin_; if (cv.xafter) { asm volatile("s_waitcnt vmcnt(2)" ::: "memory"); nfin_ = cv.nfly - 1; } else { asm volatile("s_waitcnt vmcnt(0)" ::: "memory"); nfin_ = cv.nfly; } \
            for (int f_ = 0; f_ < nfin_; ++f_) cv_finish(P, cv, lds, wave, tz_); \
            asm volatile("s_waitcnt lgkmcnt(0)" ::: "memory"); __builtin_amdgcn_s_barrier(); asm volatile("" ::: "memory"); \
            if ((TI) + 1 < n_) { const int pi = (TI) + 1; dma_tile(KPTR, KPITCH, lds + OFF_K + (NXT) * TILEB, wave, tz_); if (USEV) dma_tile(VPTR, VPITCH, lds + OFF_V + (NXT) * TILEB, wave, tz_); cv.xafter = false; } \
            if (cv.next < cv.end && cv.nfly < 2) cv_issue(P, cv, lds, wave, tz_); \
            { const int ti = (TI); __VA_ARGS__ } ++it; }
#define ATT_LOOP(NTILES, KPTR, KPITCH, VPTR, VPITCH, USEV, ...) { const int n_ = (NTILES); int tz_ = lane; asm volatile("" : "+v"(tz_)); \
        asm volatile("s_waitcnt lgkmcnt(0)" ::: "memory"); __builtin_amdgcn_s_barrier(); asm volatile("" ::: "memory");     \
        if (n_ > 0) { const int pi = 0; dma_tile(KPTR, KPITCH, lds + OFF_K, wave, tz_); if (USEV) dma_tile(VPTR, VPITCH, lds + OFF_V, wave, tz_); cv.xafter = false; } \
        for (int i_ = 0; i_ < n_; i_ += 2) { \
            ATT_STEP(0, 1, i_, KPTR, KPITCH, VPTR, VPITCH, USEV, __VA_ARGS__) \
            if (i_ + 1 < n_) ATT_STEP(1, 0, i_ + 1, KPTR, KPITCH, VPTR, VPITCH, USEV, __VA_ARGS__) } }

    const bf16_t* KC = (const bf16_t*)(ws + WS_KC) + (size_t)bg * 512 * 64; const bf16_t* VCT = (const bf16_t*)(ws + WS_VCT) + (size_t)bg * 64 * 512;
    const int hin = (t - 31) >> 4;
    const int ntc = (((t0 + 32) >> 4) >> 6) + 1;
    ATT_RESET();
    ATT_LOOP(ntc, KC + (size_t)pi * 64 * 64, 64, KC, 64, false, {
        const int hi = hin - 64 * ti; const bool fe = (hi >= 63) || (hi < 0);
        if (!__all(hi < 0)) tile_compute<1>(Kb, Kb, qf, r, h, 0, hi, !__all(fe), m, l, O, 0.f, 0.f, nullptr, nullptr, 0); })
    {
        const float meff = fmaxf(m, MFLOOR), linv = (l > 0.f) ? 1.0f / l : 0.f;
        ATT_LOOP(ntc, KC + (size_t)pi * 64 * 64, 64, VCT + pi * 64, 512, true, {
            const int hi = hin - 64 * ti; const bool fe = (hi >= 63) || (hi < 0);
            float md = m, ld_ = l;
            if (!__all(hi < 0)) tile_compute<2>(Kb, Vb, qf, r, h, 0, hi, !__all(fe), md, ld_, O, meff, linv, IMPG + tokl * 128, IMPL + tokl * 128, 16 * ti); })
        ATT_FOLD(0);
    }
    for (int tk = 0; tk < 8; ++tk) { const int trow = 8 * wave + tk;
        const float ilo = IMPG[trow * 128 + lane] + (lane > 0 ? IMPL[trow * 128 + lane - 1] : 0.f), ihi = IMPG[trow * 128 + 64 + lane] + IMPL[trow * 128 + 63 + lane];
        const int slo = lane, shi = 64 + lane;
        const bool clo = slo <= qt, chi = shi <= qt, flo = (slo == 0) || (slo == qt) || (slo + 1 == qt), fhi = (shi == qt) || (shi + 1 == qt);
        const unsigned klo = clo ? ((flo ? 0xFFFFFF80u : (__float_as_uint(ilo) & 0xFFFFFF80u)) | (unsigned)(127 - slo)) : 0u;
        const unsigned khi = chi ? ((fhi ? 0xFFFFFF80u : (__float_as_uint(ihi) & 0xFFFFFF80u)) | (unsigned)(127 - shi)) : 0u;
        unsigned T = 0u;
        for (int bit = 31; bit >= 0; --bit) { const unsigned cand = T | (1u << bit);
            const int cnt = __popcll(__ballot(klo >= cand)) + __popcll(__ballot(khi >= cand)); if (cnt >= 16) T = cand; }
        const unsigned long long blo = __ballot(klo >= T && klo != 0u), bhi = __ballot(khi >= T && khi != 0u);
        if (lane == 0) { *(LAS u32x4*)(SELM + trow * 4) = (u32x4){(unsigned)blo, (unsigned)(blo >> 32), (unsigned)bhi, (unsigned)(bhi >> 32)}; }
    }
    { int lp_ = lane; asm volatile("" : "+v"(lp_)); float* oapark = (float*)(ws + WS_HIDM) + ((size_t)(blockIdx.x * 8 + wave) * 32) * 64 + lp_;
#pragma unroll
      for (int i = 0; i < 16; ++i) { oapark[i * 64] = OA[0][i]; oapark[(16 + i) * 64] = OA[1][i]; } }
    ATT_RESET();
    const bf16_t* KS = U + (size_t)(b * SEQ) * NU + UKS + gg * 64; const bf16_t* VST = (const bf16_t*)(ws + WS_VST) + (size_t)bg * 128 * 4096;
    constexpr int QT_COMPACT = 96;
    if (qt < QT_COMPACT) {
        const u32x4 selw = *(const LAS u32x4*)(SELM + tokl * 4);
        ATT_LOOP(qt + 1, KS + (size_t)pi * 64 * NU, NU, VST + (size_t)pi * 4096, 64, true, {
            const int j = ti;
            const unsigned wsel = (j < 32) ? selw.x : (j < 64) ? selw.y : (j < 96) ? selw.z : selw.w; const bool sel = (wsel >> (j & 31)) & 1u;
            const int hi = !sel ? -1 : (j == qt ? tokl : 63);
            if (!__all(!sel)) tile_compute<0>(Kb, Vb, qf, r, h, 0, hi, j == qt, m, l, O, 0.f, 0.f, nullptr, nullptr, 0); })
    } else {
        {
#define JMAP(i) ((i) == 0 ? 0 : qt - (2 - (i)))
            ATT_LOOP(3, KS + (size_t)JMAP(pi) * 64 * NU, NU, VST + (size_t)JMAP(pi) * 4096, 64, true, {
                const int j = JMAP(ti);
                tile_compute<0>(Kb, Vb, qf, r, h, 0, (j == qt ? tokl : 63), j == qt, m, l, O, 0.f, 0.f, nullptr, nullptr, 0); })
#undef JMAP
        }
        int lz = lane; asm volatile("" : "+v"(lz));
        const int r = lz & 31, h = lz >> 5, hp = r & 3, tokl = 8 * wave + (r >> 2), lane = lz, tid = wave * 64 + lz;
        LAS unsigned char* Qs = lds + OFF_QS; LAS float* MREF = (LAS float*)(lds + OFF_MREF); LAS float* LSUM = (LAS float*)(lds + OFF_LSUM); LAS int* LIST = (LAS int*)(lds + OFF_LIST) + wave * 64;
        LAS unsigned long long* TM = (LAS unsigned long long*)(lds + OFF_TM);
        if (h == 0) MREF[32 * wave + r] = fmaxf(m, MFLOOR);
        for (int j = wave; j < 128; j += 8) { const unsigned long long mk = __ballot((SELM[lane * 4 + (j >> 5)] >> (j & 31)) & 1u); if (lane == 0) TM[j] = mk; }
        __syncthreads();
#pragma unroll
        for (int q4 = 0; q4 < 4; ++q4) { const int ch = tid + 512 * q4, row = ch >> 3, c8 = ch & 7;
            *(LAS u32x4*)(Qs + row * ROWB + c8 * 16) = *(const u32x4*)(U + (size_t)(b * SEQ + t0 + (row >> 2)) * NU + UQ + (4 * gg + (row & 3)) * 64 + c8 * 8); }
        __syncthreads();
        const int jend = qt - 2; int jn = 1, rk = 0;
        const unsigned long long ltl = (1ull << tokl) - 1ull;
        int pjs = 0, pcnt = 0;
#define FAR_TM(dst, jj) { const unsigned long long tv_ = TM[(jj) <= jend ? (jj) : 0]; const unsigned lo_ = __builtin_amdgcn_readfirstlane((unsigned)tv_), hi_ = __builtin_amdgcn_readfirstlane((unsigned)(tv_ >> 32)); \
            dst = ((jj) <= jend) ? (((unsigned long long)hi_ << 32) | lo_) : 0ull; }
        for (;;) {
            int cnt = 0, used = 0, myj = -1, myc = 0; unsigned long long mymask = 0ull;
#pragma unroll
            for (int i = 0; i < 8; ++i) { const int jj = jn + i; unsigned long long mk; FAR_TM(mk, jj) const int nch = (__popcll(mk) + 7) >> 3;
                const bool take = (cnt == i) && (jj <= jend) && (used + nch <= 8);
                if (take) { if (wave >= used && wave < used + nch) { myj = jj; myc = wave - used; mymask = mk; } used += nch; ++cnt; } }
            if (cnt == 0 && pcnt == 0) break;
            const int cjs = jn; jn += cnt;
            bf16x8 kf[2][4], vf[2][4];
            if (myj >= 0) { const bf16_t* Kg = KS + (size_t)(myj * 64 + r) * NU + 8 * h; const bf16_t* Vg = VST + (size_t)myj * 4096 + r * 64 + 8 * h;
#pragma unroll
                for (int kh = 0; kh < 2; ++kh)
#pragma unroll
                    for (int ks = 0; ks < 4; ++ks) { kf[kh][ks] = *(const bf16x8*)(Kg + (size_t)(32 * kh) * NU + 16 * ks); vf[kh][ks] = *(const bf16x8*)(Vg + kh * 32 * 64 + ks * 16); } }
            if (pcnt > 0) { int base = 0;
#pragma unroll
                for (int i = 0; i < 8; ++i) { unsigned long long mk; FAR_TM(mk, pjs + i) if (i >= pcnt) mk = 0ull; const int nch = (__popcll(mk) + 7) >> 3;
                    const bool act = (mk >> tokl) & 1ull;
                    if (__any(act)) { const int rank = __popcll(mk & ltl), slot = base + (rank >> 3), prow = (rank & 7) * 4 + hp;
                        const LAS unsigned char* Pb = lds + OFF_PBUF + (((rk + 1) & 1) * 8 + slot) * PSLOT + prow * ROWB + h * 8;
#pragma unroll
                        for (int dt = 0; dt < 2; ++dt)
#pragma unroll
                            for (int gq = 0; gq < 4; ++gq) { u32x2 w = *(const LAS u32x2*)(Pb + (32 * dt + 8 * gq) * 2); if (!act) w = (u32x2){0u, 0u};
                                O[dt][4 * gq] += bflo(w.x); O[dt][4 * gq + 1] += bfhi(w.x); O[dt][4 * gq + 2] += bflo(w.y); O[dt][4 * gq + 3] += bfhi(w.y); }
                        l += act ? LSUM[(((rk + 1) & 1) * 8 + slot) * 32 + prow] : 0.f; }
                    base += nch; } }
            if (myj >= 0) {
                LAS unsigned char* Pw = lds + OFF_PBUF + ((rk & 1) * 8 + wave) * PSLOT;
                if ((mymask >> lane) & 1ull) LIST[__popcll(mymask & ((1ull << lane) - 1ull))] = lane;
                const int rank = 8 * myc + (r >> 2); const bool valid = rank < __popcll(mymask);
                const int tok = valid ? LIST[rank] : 0; const int qrow = tok * 4 + hp;
                bf16x8 qg[4];
#pragma unroll
                for (int ks = 0; ks < 4; ++ks) qg[ks] = *(const LAS bf16x8*)(Qs + qrow * ROWB + ks * 32 + h * 16);
                const float mr = MREF[qrow];
                float rs = 0.f; f32x16 Oc[2];
#pragma unroll
                for (int i = 0; i < 16; ++i) { Oc[0][i] = 0.f; Oc[1][i] = 0.f; }
#pragma unroll
                for (int kh = 0; kh < 2; ++kh) { f32x16 sv;
#pragma unroll
                    for (int i = 0; i < 16; ++i) sv[i] = 0.f;
#pragma unroll
                    for (int ks = 0; ks < 4; ++ks) sv = MFMA32(kf[kh][ks], qg[ks], sv);
#pragma unroll
                    for (int i = 0; i < 16; ++i) { sv[i] = valid ? fexp2(fminf(sv[i] - mr, 100.0f)) : 0.f; rs += sv[i]; }
#pragma unroll
                    for (int s2 = 0; s2 < 2; ++s2) { const bf16x8 pf = pack8(sv, s2);
                        Oc[0] = MFMA32(vf[0][kh * 2 + s2], pf, Oc[0]); Oc[1] = MFMA32(vf[1][kh * 2 + s2], pf, Oc[1]); } }
                rs += __shfl_xor(rs, 32);
                if (h == 0) LSUM[((rk & 1) * 8 + wave) * 32 + r] = rs;
#pragma unroll
                for (int dt = 0; dt < 2; ++dt)
#pragma unroll
                    for (int gq = 0; gq < 4; ++gq) { u32x2 w; w.x = pk2(Oc[dt][4 * gq], Oc[dt][4 * gq + 1]); w.y = pk2(Oc[dt][4 * gq + 2], Oc[dt][4 * gq + 3]);
                        *(LAS u32x2*)(Pw + r * ROWB + (32 * dt + 8 * gq + 4 * h) * 2) = w; }
            }
            __syncthreads();
            pjs = cjs; pcnt = cnt; ++rk;
        }
#undef FAR_TM
    }
    { int lp_ = lane; asm volatile("" : "+v"(lp_)); const float* oapark = (const float*)(ws + WS_HIDM) + ((size_t)(blockIdx.x * 8 + wave) * 32) * 64 + lp_;
#pragma unroll
      for (int i = 0; i < 16; ++i) { OA[0][i] = oapark[i * 64]; OA[1][i] = oapark[(16 + i) * 64]; } }
    ATT_FOLD(1);
    ATT_LOADQ();
    ATT_RESET();
    {
        int lw_ = lane; asm volatile("" : "+v"(lw_)); const int r = lw_ & 31, h = lw_ >> 5, tokl = 8 * wave + (r >> 2);
        const int jlo = qt >= 8 ? qt - 8 : 0;
        const bf16_t* KW = U + (size_t)(b * SEQ + jlo * 64) * NU + UKW + gg * 64; const bf16_t* VWT = (const bf16_t*)(ws + WS_VWT) + ((size_t)bg * 128 + jlo) * 4096;
        ATT_LOOP(qt - jlo + 1, KW + (size_t)pi * 64 * NU, NU, VWT + (size_t)pi * 4096, 64, true, {
            const int j = jlo + ti;
            const bool low = (j + 8 == qt), diag = (j == qt);
            const int lo = low ? tokl + 1 : 0, hi = diag ? tokl : 63;
            tile_compute<0>(Kb, Vb, qf, r, h, lo, hi, low || diag, m, l, O, 0.f, 0.f, nullptr, nullptr, 0); })
        ATT_FOLD(2);
    }
    int lo_ = lane; asm volatile("" : "+v"(lo_)); const int h_o = lo_ >> 5;
    bf16_t* orow = (bf16_t*)(ws + WS_CAT) + (size_t)(b * SEQ + t0 + 8 * wave + ((lo_ & 31) >> 2)) * DM + (4 * gg + (lo_ & 3)) * 64;
#pragma unroll
    for (int dt = 0; dt < 2; ++dt)
#pragma unroll
        for (int gq = 0; gq < 4; ++gq) { u32x2 w; w.x = pk2(OA[dt][4 * gq], OA[dt][4 * gq + 1]); w.y = pk2(OA[dt][4 * gq + 2], OA[dt][4 * gq + 3]);
            *(u32x2*)(orow + 32 * dt + 8 * gq + 4 * h_o) = w; }
#undef ATT_RESET
#undef ATT_FOLD
#undef ATT_LOADQ
#undef ATT_UROW
#undef ATT_LOOP
#undef ATT_STEP
}

DI void attn_phase(const Params& P, LAS unsigned char* lds, int vcu, int G, int wave, int lane, int tid) {
    int it = 0;
    CvState cv; { const int per = CV_TOTAL / (G * 8), gw = vcu * 8 + wave; cv.next = gw * per; cv.end = (gw == G * 8 - 1) ? CV_TOTAL : cv.next + per; cv.nfly = 0; cv.xafter = false; }
    static constexpr unsigned char QT_TAB[32][4] = {{14,37,91,127},{30,44,68,126},{31,35,77,100},{23,48,69,125},{27,40,76,99},{10,53,79,124},{17,38,85,123},{19,32,89,122},{20,33,87,121},{29,43,70,120},{21,54,66,107},{0,58,90,119},{25,42,75,118},{22,47,74,106},{18,34,88,117},{3,51,92,105},{15,56,71,116},{11,39,93,98},{9,49,82,115},{28,36,78,114},{24,52,64,113},{16,41,84,104},{5,46,95,97},{4,59,81,112},{26,50,65,103},{8,62,72,111},{6,45,94,102},{7,55,80,96},{2,61,83,110},{13,63,67,101},{1,60,86,109},{12,57,73,108}};
    if (G == 256) {
        const int bg = vcu >> 5, s = vcu & 31;
        for (int k = 3; k >= 0; --k) { const int qt = (k == 0) ? QT_TAB[s][0] : (k == 1) ? QT_TAB[s][1] : (k == 2) ? QT_TAB[s][2] : QT_TAB[s][3]; attn_unit(P, lds, bg, qt, wave, lane, tid, it, cv); }
    } else {
        for (int ui = vcu; ui < 1024; ui += G) { const int k = ui >> 8, v = ui & 255, bg = v >> 5, s = v & 31;
            const int qt = (k == 0) ? s : (k == 1) ? 63 - s : (k == 2) ? 64 + s : 127 - s;
            attn_unit(P, lds, bg, qt, wave, lane, tid, it, cv); }
    }
    for (;;) {
        if (cv.nfly > 0) { asm volatile("s_waitcnt vmcnt(0)" ::: "memory"); while (cv.nfly > 0) cv_finish(P, cv, lds, wave, lane); }
        if (cv.next >= cv.end) break;
        cv_issue(P, cv, lds, wave, lane); if (cv.next < cv.end) cv_issue(P, cv, lds, wave, lane); }
    __syncthreads();
}
}
#ifndef CHECK_ATTN
#define CHECK_ATTN 0
#endif
#if CHECK_ATTN
constexpr int CW_ERR = 8192;
namespace attnchk {
DI float wmax(float v) {
#pragma unroll
    for (int o = 1; o < 64; o <<= 1) v = fmaxf(v, __shfl_xor(v, o));
    return v; }
DI void item(const Params& P, LAS float* scr, int bg, int t, int lane, float& se, float& sr) {
    unsigned char* ws = P.ws; const bf16_t* U = (const bf16_t*)(ws + WS_U);
    const int b = bg >> 1, gg = bg & 1;
    LAS float* q = scr; LAS float* pc = scr + 256; LAS float* sc = scr + 768;
    const bf16_t* urow = U + (size_t)(b * SEQ + t) * NU;
    for (int i = lane; i < 256; i += 64) q[i] = bf2f(urow[UQ + gg * 256 + i]);
    const bf16_t* KC = (const bf16_t*)(ws + WS_KC) + (size_t)bg * 512 * 64; const bf16_t* VCT = (const bf16_t*)(ws + WS_VCT) + (size_t)bg * 64 * 512;
    const int nvalid = t >= 31 ? ((t - 31) >> 4) + 1 : 0, cur = t >> 6;
    float oc[4], os[4], ow[4], imp0 = 0.f, imp1 = 0.f;
    for (int p = 0; p < 4; ++p) {
        float sv[8], mx = -3e38f;
        for (int i = 0; i < 8; ++i) { const int n = lane + 64 * i; float a = 0.f;
            if (n < nvalid) { for (int d = 0; d < 64; ++d) a += q[p * 64 + d] * bf2f(KC[n * 64 + d]); mx = fmaxf(mx, a); }
            sv[i] = a; }
        mx = wmax(mx); float ls = 0.f;
        for (int i = 0; i < 8; ++i) { const int n = lane + 64 * i; const float e = (n < nvalid) ? exp2f(sv[i] - mx) : 0.f; sv[i] = e; ls += e; }
        ls = wave_sum(ls); const float inv = ls > 0.f ? 1.f / ls : 0.f;
        for (int i = 0; i < 8; ++i) pc[lane + 64 * i] = sv[i] * inv;
        float o = 0.f;
        for (int n = 0; n < nvalid; ++n) { const int pos = (n & ~15) | (int)swap23((unsigned)n & 15u); o += pc[n] * bf2f(VCT[lane * 512 + pos]); }
        oc[p] = o;
        for (int k = -1; k <= 3; ++k) { const int n0 = 4 * lane + k, n1 = 4 * (lane + 64) + k;
            if (n0 >= 0 && n0 < nvalid) imp0 += pc[n0]; if (n1 < nvalid) imp1 += pc[n1]; }
    }
    const float INF = __builtin_inff();
    const int s0 = lane, s1 = lane + 64;
    const float v0 = (s0 == 0 || s0 == cur || s0 == cur - 1) ? INF : (s0 <= cur ? imp0 : -INF);
    const float v1 = (s1 == cur || s1 == cur - 1) ? INF : (s1 <= cur ? imp1 : -INF);
    int r0 = 0, r1 = 0;
    for (int j = 0; j < 128; ++j) { const float vj = (j < 64) ? __shfl(v0, j) : __shfl(v1, j - 64);
        r0 += (vj > v0 || (vj == v0 && j < s0)) ? 1 : 0; r1 += (vj > v1 || (vj == v1 && j < s1)) ? 1 : 0; }
    const unsigned long long m0 = __ballot(r0 < 16 && v0 > -INF), m1 = __ballot(r1 < 16 && v1 > -INF);
    for (int br = 0; br < 2; ++br) {
        const bf16_t* Kp = U + (size_t)(b * SEQ) * NU + (br ? UKW : UKS) + gg * 64; const bf16_t* Vp = U + (size_t)(b * SEQ) * NU + (br ? UVW : UVS) + gg * 64;
        for (int p = 0; p < 4; ++p) {
            int nk = 0; float mx = -3e38f;
            if (br == 0) {
                for (int j = 0; j < 128; ++j) { const bool on = (j < 64) ? ((m0 >> j) & 1ull) : ((m1 >> (j - 64)) & 1ull); if (!on) continue;
                    const int key = 64 * j + lane; float a = -3e38f;
                    if (key <= t) { a = 0.f; for (int d = 0; d < 64; ++d) a += q[p * 64 + d] * bf2f(Kp[(size_t)key * NU + d]); mx = fmaxf(mx, a); }
                    sc[nk * 64 + lane] = a; ++nk; }
            } else {
                for (int i = 0; i < 8; ++i) { const int key = t - 511 + lane + 64 * i; float a = -3e38f;
                    if (key >= 0 && key <= t) { a = 0.f; for (int d = 0; d < 64; ++d) a += q[p * 64 + d] * bf2f(Kp[(size_t)key * NU + d]); mx = fmaxf(mx, a); }
                    sc[i * 64 + lane] = a; }
                nk = 8;
            }
            mx = wmax(mx); float ls = 0.f;
            for (int i = 0; i < nk; ++i) { const float a = sc[i * 64 + lane]; const float e = (a > -1e38f) ? exp2f(a - mx) : 0.f; sc[i * 64 + lane] = e; ls += e; }
            ls = wave_sum(ls); const float inv = ls > 0.f ? 1.f / ls : 0.f;
            float o = 0.f;
            if (br == 0) { int idx = 0;
                for (int j = 0; j < 128; ++j) { const bool on = (j < 64) ? ((m0 >> j) & 1ull) : ((m1 >> (j - 64)) & 1ull); if (!on) continue;
                    for (int kk = 0; kk < 64; ++kk) { const float pv = sc[idx * 64 + kk]; if (pv != 0.f) o += pv * bf2f(Vp[(size_t)(64 * j + kk) * NU + lane]); }
                    ++idx; }
                os[p] = o * inv;
            } else {
                for (int i = 0; i < 8; ++i) for (int kk = 0; kk < 64; ++kk) { const int key = t - 511 + kk + 64 * i; const float pv = sc[i * 64 + kk]; if (pv != 0.f) o += pv * bf2f(Vp[(size_t)key * NU + lane]); }
                ow[p] = o * inv;
            }
        }
    }
    const bf16_t* cat = (const bf16_t*)(ws + WS_CAT) + (size_t)(b * SEQ + t) * DM;
    for (int p = 0; p < 4; ++p) {
        const float g0 = fsigmoid(bf2f(urow[UGT + gg * 12 + p * 3 + 0])), g1 = fsigmoid(bf2f(urow[UGT + gg * 12 + p * 3 + 1])), g2 = fsigmoid(bf2f(urow[UGT + gg * 12 + p * 3 + 2]));
        const float ref = g0 * oc[p] + g1 * os[p] + g2 * ow[p], got = bf2f(cat[(4 * gg + p) * 64 + lane]);
        se += (ref - got) * (ref - got); sr += ref * ref; }
}
DI void phase(const Params& P, LAS unsigned char* lds, int vcu, int G, int wave, int lane) {
    LAS float* scr = (LAS float*)(lds + wave * 8192);
    float se = 0.f, sr = 0.f;
    for (int it = vcu * 8 + wave; it < 8 * SEQ; it += G * 8) { const int bg = it / SEQ, t = it % SEQ; item(P, scr, bg, t, lane, se, sr); }
    se = wave_sum(se); sr = wave_sum(sr);
    if (lane == 0) { atomicAdd((float*)(P.ws + WS_CTL) + CW_ERR, se); atomicAdd((float*)(P.ws + WS_CTL) + CW_ERR + 1, sr); }
}
}
#endif
DI void phase_ln1(const Params& P, int vcu, int G, int wave, int lane, bf16_t* x1base) {
    const float* mod = (const float*)(P.ws + WS_MOD);
    for (int mrow = vcu * 8 + wave; mrow < NT; mrow += G * 8) { const int b = mrow / SEQ;
        const u32x2* vr = (const u32x2*)((const bf16_t*)(P.ws + WS_V1) + (size_t)mrow * DM) + lane; f32x4 v[4]; float s = 0.f;
#pragma unroll
        for (int j = 0; j < 4; ++j) { const u32x2 q = vr[64 * j]; v[j] = (f32x4){bflo(q.x), bfhi(q.x), bflo(q.y), bfhi(q.y)}; s += (v[j].x + v[j].y) + (v[j].z + v[j].w); }
        const float mean = wave_sum(s) * (1.f / DM); float s2 = 0.f;
#pragma unroll
        for (int j = 0; j < 4; ++j) { v[j] = v[j] - mean; s2 += (v[j].x * v[j].x + v[j].y * v[j].y) + (v[j].z * v[j].z + v[j].w * v[j].w); }
        const float rstd = 1.f / sqrtf(wave_sum(s2) * (1.f / DM) + LN_EPS);
        unsigned long long* o8 = (unsigned long long*)((bf16_t*)(P.ws + WS_H2) + (size_t)mrow * DM) + lane;
        unsigned long long* x8 = (unsigned long long*)(x1base + (size_t)mrow * DM) + lane;
#pragma unroll
        for (int j = 0; j < 4; ++j) { const int c0 = 4 * lane + 256 * j;
            const f32x4 g = *(const f32x4*)(P.ln1_g + c0), bb = *(const f32x4*)(P.ln1_b + c0);
            const f32x4 sh = *(const f32x4*)(mod + b * 6144 + 3 * 1024 + c0), sc = *(const f32x4*)(mod + b * 6144 + 4 * 1024 + c0);
            const f32x4 x1 = v[j] * rstd * g + bb;
            x8[64 * j] = (unsigned long long)pk2(x1.x, x1.y) | ((unsigned long long)pk2(x1.z, x1.w) << 32);
            const f32x4 y = x1 * (sc + 1.0f) + sh;
            o8[64 * j] = (unsigned long long)pk2(y.x, y.y) | ((unsigned long long)pk2(y.z, y.w) << 32); }
    }
}

DI unsigned f2ord(float f) { const unsigned u = __float_as_uint(f); return (u & 0x80000000u) ? ~u : (u | 0x80000000u); }
DI void phase_route(const Params& P, LAS unsigned char* lds, int vcu, int G, int wave, int lane, int tid) {
    unsigned char* ws = P.ws;
    LAS int* hist = (LAS int*)lds;
    const float* logit = (const float*)(ws + WS_LOGIT);
    int* tok_e = (int*)(ws + WS_TOKE); float* tok_w = (float*)(ws + WS_TOKW); int* lrank = (int*)(ws + WS_LRANK);
    { int* rt = (int*)(ws + WS_ROWTOK); for (int i = vcu * 512 + tid; i < NPAD_MAX; i += G * 512) rt[i] = 0; }
    const int hh = lane >> 5;
    float bias[4];
#pragma unroll
    for (int k = 0; k < 4; ++k) bias[k] = P.router_bias[lane + 64 * k];
    const int tpw = NT / G;
    for (int base = vcu * tpw; base < NT; base += G * tpw) {
        __syncthreads();
        if (tid < 256) hist[tid] = 0;
        __syncthreads();
        for (int tq = wave; tq < tpw; tq += 8) { const int tkn = base + tq;
            float s[4], sel[4];
#pragma unroll
            for (int k = 0; k < 4; ++k) { s[k] = fsigmoid(logit[(size_t)tkn * 256 + lane + 64 * k]); sel[k] = s[k] + bias[k]; }
            float t1[4], t2[4];
#pragma unroll
            for (int k = 0; k < 4; ++k) { t1[k] = sel[k]; t2[k] = -3.0e38f; }
#pragma unroll
            for (int o = 1; o < 32; o <<= 1) {
#pragma unroll
                for (int k = 0; k < 4; ++k) { const float a1 = __shfl_xor(t1[k], o), a2 = __shfl_xor(t2[k], o);
                    const float n1 = fmaxf(t1[k], a1), n2 = fmaxf(fminf(t1[k], a1), fmaxf(t2[k], a2)); t1[k] = n1; t2[k] = n2; } }
            float gs[8];
#pragma unroll
            for (int k = 0; k < 4; ++k) { const float mine = t1[k] + t2[k], oth = __shfl_xor(mine, 32); gs[2 * k] = hh ? oth : mine; gs[2 * k + 1] = hh ? mine : oth; }
            bool gsel[8];
#pragma unroll
            for (int a = 0; a < 8; ++a) { int rk = 0;
#pragma unroll
                for (int c2 = 0; c2 < 8; ++c2) rk += (gs[c2] > gs[a] || (gs[c2] == gs[a] && c2 < a)) ? 1 : 0;
                gsel[a] = rk < 4; }
            unsigned key[4];
#pragma unroll
            for (int k = 0; k < 4; ++k) { const bool on = hh ? gsel[2 * k + 1] : gsel[2 * k]; key[k] = on ? f2ord(sel[k]) : 0u; }
            unsigned T = 0u;
            for (int bit = 31; bit >= 0; --bit) { const unsigned cand = T | (1u << bit); int cnt = 0;
#pragma unroll
                for (int k = 0; k < 4; ++k) cnt += __popcll(__ballot(key[k] >= cand));
                if (cnt >= 8) T = cand; }
            int ngt = 0;
#pragma unroll
            for (int k = 0; k < 4; ++k) ngt += __popcll(__ballot(key[k] > T));
            int need = 8 - ngt, npos = 0; const unsigned long long ltmask = (1ull << lane) - 1ull;
            bool chosen[4]; int pos[4];
#pragma unroll
            for (int k = 0; k < 4; ++k) { const unsigned long long eq = __ballot(key[k] == T), gt = __ballot(key[k] > T);
                const int myeq = __popcll(eq & ltmask); const bool ceq = (key[k] == T) && (myeq < need);
                chosen[k] = (key[k] > T) || ceq;
                const unsigned long long cm = __ballot(chosen[k]); pos[k] = npos + __popcll(cm & ltmask); npos += __popcll(cm);
                const int neq = __popcll(eq); need = need > neq ? need - neq : 0; (void)gt; }
            float ssum = 0.f;
#pragma unroll
            for (int k = 0; k < 4; ++k) ssum += chosen[k] ? s[k] : 0.f;
            ssum = wave_sum(ssum);
            const float wn = 2.5f / ssum;
#pragma unroll
            for (int k = 0; k < 4; ++k) if (chosen[k]) { const int e = lane + 64 * k; const int lr = __hip_atomic_fetch_add(hist + e, 1, __ATOMIC_RELAXED, __HIP_MEMORY_SCOPE_WORKGROUP);
                tok_e[tkn * 8 + pos[k]] = e; tok_w[tkn * 8 + pos[k]] = s[k] * wn; lrank[tkn * 8 + pos[k]] = lr; }
        }
        __syncthreads();
        if (tid < 256) ((int*)(ws + WS_HIST))[(base / tpw) * 256 + tid] = hist[tid];
    }
    __syncthreads();
}

DI void phase_scatter(const Params& P, LAS unsigned char* lds, int vcu, int G, int wave, int lane, int tid) {
    unsigned char* ws = P.ws;
    LAS int* sbase = (LAS int*)lds; LAS int* spad = sbase + 256; LAS int* sstart = spad + 256;
    const unsigned* hist = (const unsigned*)(ws + WS_HIST);
    const int* tok_e = (const int*)(ws + WS_TOKE); const int* lrank = (const int*)(ws + WS_LRANK);
    int* rowtok = (int*)(ws + WS_ROWTOK); int* pos_of = (int*)(ws + WS_POSOF); int* blk_e = (int*)(ws + WS_BLKE);
    const int tpw = NT / G, nslots = NT / tpw;
    for (int base = vcu * tpw; base < NT; base += G * tpw) { const int slot = base / tpw;
        __syncthreads();
        if (tid < 256) { int tot = 0, below = 0;
            for (int w2 = 0; w2 < nslots; ++w2) { const int hv = (int)hist[w2 * 256 + tid]; tot += hv; below += (w2 < slot) ? hv : 0; }
            spad[tid] = (tot + 255) & ~255; sbase[tid] = below; }
        __syncthreads();
        if (tid == 0) { int run = 0; for (int e = 0; e < 256; ++e) { sstart[e] = run; run += spad[e]; } sstart[256] = run; }
        __syncthreads();
        for (int i = tid; i < tpw * 8; i += 512) { const int a = base * 8 + i; const int e = tok_e[a]; const int pos = sstart[e] + sbase[e] + lrank[a];
            rowtok[pos] = a >> 3; pos_of[a] = pos; }
        if (slot == 0) {
            if (tid < 256) { const int b0 = sstart[tid] >> 8, b1 = (sstart[tid] + spad[tid]) >> 8; for (int bb = b0; bb < b1; ++bb) blk_e[bb] = tid; }
            if (tid == 0) blk_e[NBLK_MAX] = sstart[256] >> 8;
        }
    }
    __syncthreads();
}

DI void phase_final(const Params& P, int vcu, int G, int wave, int lane, float* dstbase) {
    unsigned char* ws = P.ws;
    const float* mod = (const float*)(ws + WS_MOD);
    const int* pos_of = (const int*)(ws + WS_POSOF); const float* tok_w = (const float*)(ws + WS_TOKW);
    const unsigned char* Y = (const unsigned char*)(ws + WS_YMOE);
    float dbg_scale = 1.0f;
#if CHECK_ATTN
    { const float se = __uint_as_float(ld_u32_agent((const unsigned*)(ws + WS_CTL) + CW_ERR)), sr = __uint_as_float(ld_u32_agent((const unsigned*)(ws + WS_CTL) + CW_ERR + 1)); const float err = sqrtf(se / fmaxf(sr, 1e-30f)); dbg_scale = 1.0f + (err < 0.005f ? 0.f : err < 0.02f ? 0.04f : err < 0.08f ? 0.055f : err < 0.3f ? 0.07f : 0.085f); }
#endif
    for (int mrow = vcu * 8 + wave; mrow < NT; mrow += G * 8) { const int b = mrow / SEQ;
        const u32x2* xr = (const u32x2*)((const bf16_t*)(ws + WS_X1) + (size_t)mrow * DM) + lane; const u32x2* sr = (const u32x2*)((const bf16_t*)(ws + WS_SH) + (size_t)mrow * DM) + lane; f32x4 v[4], ya[4];
#pragma unroll
        for (int j = 0; j < 4; ++j) { const u32x2 q = xr[64 * j], q2 = sr[64 * j]; v[j] = (f32x4){bflo(q.x), bfhi(q.x), bflo(q.y), bfhi(q.y)} * DN_ALPHA; ya[j] = (f32x4){bflo(q2.x), bfhi(q2.x), bflo(q2.y), bfhi(q2.y)}; }
        const int mypos = pos_of[(size_t)mrow * 8 + (lane & 7)]; const float myw = tok_w[(size_t)mrow * 8 + (lane & 7)];
#pragma unroll
        for (int k = 0; k < 8; ++k) { const int pos = __shfl(mypos, k); const float wk = __shfl(myw, k) * (1.0f / YMOE_SCALE);
            const unsigned* yr = (const unsigned*)(Y + (size_t)pos * DM) + lane;
#pragma unroll
            for (int j = 0; j < 4; ++j) { const int q = (int)yr[64 * j]; const f32x2 lo = __builtin_amdgcn_cvt_pk_f32_fp8(q, false), hi = __builtin_amdgcn_cvt_pk_f32_fp8(q, true);
                ya[j].x += wk * lo.x; ya[j].y += wk * lo.y; ya[j].z += wk * hi.x; ya[j].w += wk * hi.y; } }
        float s = 0.f;
#pragma unroll
        for (int j = 0; j < 4; ++j) { const f32x4 g2 = *(const f32x4*)(mod + b * 6144 + 5 * 1024 + 4 * lane + 256 * j); v[j] = v[j] + g2 * ya[j]; s += (v[j].x + v[j].y) + (v[j].z + v[j].w); }
        const float mean = wave_sum(s) * (1.f / DM); float s2 = 0.f;
#pragma unroll
        for (int j = 0; j < 4; ++j) { v[j] = v[j] - mean; s2 += (v[j].x * v[j].x + v[j].y * v[j].y) + (v[j].z * v[j].z + v[j].w * v[j].w); }
        const float rstd = 1.f / sqrtf(wave_sum(s2) * (1.f / DM) + LN_EPS);
#pragma unroll
        for (int j = 0; j < 4; ++j) { const int c0 = 4 * lane + 256 * j; const f32x4 g = *(const f32x4*)(P.ln2_g + c0), bb = *(const f32x4*)(P.ln2_b + c0);
            ((f32x4*)(dstbase + (size_t)mrow * DM) + lane)[64 * j] = (v[j] * rstd * g + bb) * dbg_scale; }
    }
}
#ifndef REP_PHASE
#define REP_PHASE -1
#endif
#ifndef MK_PER_PHASE
#define MK_PER_PHASE 0
#endif
DI void run_phase_0(const Params& P, LAS unsigned char* lds, int vcu, int G, int bx, int wave, int lane, int tid) {
    unsigned char* ws = P.ws; const float* mod = (const float*)(ws + WS_MOD); (void)mod; (void)ws;
 phase0a(P, lds, vcu, G, wave, lane, tid); }
DI void run_phase_1(const Params& P, LAS unsigned char* lds, int vcu, int G, int bx, int wave, int lane, int tid) {
    unsigned char* ws = P.ws; const float* mod = (const float*)(ws + WS_MOD); (void)mod; (void)ws;
 phase0b(P, lds, vcu, G, wave, lane, tid); }
DI void run_phase_2(const Params& P, LAS unsigned char* lds, int vcu, int G, int bx, int wave, int lane, int tid) {
    unsigned char* ws = P.ws; const float* mod = (const float*)(ws + WS_MOD); (void)mod; (void)ws;
        pg8::Gemm g{(const bf16_t*)(ws + WS_H1), (const bf16_t*)(ws + WS_WIN_T), DM, DM, DM, 128};
        pg8::DenseOrder S; S.init(g.A, DM, NT, NU, G, bx);
        pg8::EpiStoreBf16 E{(bf16_t*)(ws + WS_U), NU, 0.125f * 1.4426950408889634f, 2};
        pg8::gemm_phase<pg8::EpiStoreBf16, pg8::DenseOrder, true, false>(lds, g, S, E, nullptr);
    }
DI void run_phase_3(const Params& P, LAS unsigned char* lds, int vcu, int G, int bx, int wave, int lane, int tid) {
    unsigned char* ws = P.ws; const float* mod = (const float*)(ws + WS_MOD); (void)mod; (void)ws;
        if (bx < 32 && G > 32) {
            pg8::Gemm g{(const bf16_t*)(ws + WS_U), (const bf16_t*)(ws + WS_WC1_T), 16 * NU, 2048, 2048, NU * 2};
            pg8::CmpOrder S{G, bx, (const bf16_t*)(ws + WS_U)};
            pg8::EpiCmp E{(bf16_t*)(ws + WS_HCMP), (const float*)(ws + WS_PEB)};
            pg8::gemm_phase<pg8::EpiCmp, pg8::CmpOrder, true, false>(lds, g, S, E, nullptr);
        } else {
            const int nw = (G > 32) ? G - 32 : G, w0 = (G > 32) ? bx - 32 : bx;
            if (G <= 32) { pg8::Gemm g{(const bf16_t*)(ws + WS_U), (const bf16_t*)(ws + WS_WC1_T), 16 * NU, 2048, 2048, NU * 2};
                pg8::CmpOrder S{G, bx, (const bf16_t*)(ws + WS_U)}; pg8::EpiCmp E{(bf16_t*)(ws + WS_HCMP), (const float*)(ws + WS_PEB)};
                pg8::gemm_phase<pg8::EpiCmp, pg8::CmpOrder, true, false>(lds, g, S, E, nullptr); }
            for (int item = w0; item < 1024; item += nw) conv_item(P, lds, item, wave, lane, tid);
            if (REP_PHASE == 31) { for (int item = w0; item < 1024; item += nw) conv_item(P, lds, item, wave, lane, tid); }
            __syncthreads();
            vt_copies(P, lds, w0 * 8 + wave, nw * 8, wave, lane);
            __syncthreads();
        }
    }
DI void run_phase_4(const Params& P, LAS unsigned char* lds, int vcu, int G, int bx, int wave, int lane, int tid) {
    unsigned char* ws = P.ws; const float* mod = (const float*)(ws + WS_MOD); (void)mod; (void)ws;
 phase_cmp2(P, lds, vcu, G, wave, lane, tid); }
DI void run_phase_5(const Params& P, LAS unsigned char* lds, int vcu, int G, int bx, int wave, int lane, int tid) {
    unsigned char* ws = P.ws; const float* mod = (const float*)(ws + WS_MOD); (void)mod; (void)ws;
 attn::attn_phase(P, lds, vcu, G, wave, lane, tid); }
DI void run_phase_6(const Params& P, LAS unsigned char* lds, int vcu, int G, int bx, int wave, int lane, int tid) {
    unsigned char* ws = P.ws; const float* mod = (const float*)(ws + WS_MOD); (void)mod; (void)ws;
#if CHECK_ATTN
        attnchk::phase(P, lds, vcu, G, wave, lane); __syncthreads();
#endif
        pg8::Gemm g{(const bf16_t*)(ws + WS_CAT), (const bf16_t*)(ws + WS_WOUT_T), DM, DM, DM, 128};
        pg8::DenseOrder S; S.init(g.A, DM, NT, DM, G, bx);
        pg8::EpiResModBf16 E{P.x, (bf16_t*)(ws + WS_V1), mod + 2 * 1024, 6144};
        pg8::gemm_phase<pg8::EpiResModBf16, pg8::DenseOrder, true, false>(lds, g, S, E, nullptr);
    }
DI void run_phase_7(const Params& P, LAS unsigned char* lds, int vcu, int G, int bx, int wave, int lane, int tid) {
    unsigned char* ws = P.ws; const float* mod = (const float*)(ws + WS_MOD); (void)mod; (void)ws;
 if (REP_PHASE == 70) { phase_ln1(P, vcu, G, wave, lane, (bf16_t*)(ws + WS_HIDM)); phase_ln1(P, vcu, G, wave, lane, (bf16_t*)(ws + WS_HIDM)); }
    phase_ln1(P, vcu, G, wave, lane, (bf16_t*)(ws + WS_X1)); }
DI void run_phase_8(const Params& P, LAS unsigned char* lds, int vcu, int G, int bx, int wave, int lane, int tid) {
    unsigned char* ws = P.ws; const float* mod = (const float*)(ws + WS_MOD); (void)mod; (void)ws;
        { pg8::Gemm g{(const bf16_t*)(ws + WS_H2), (const bf16_t*)(ws + WS_WR_T), DM, DM, DM, 128};
          pg8::DenseOrder S; S.init(g.A, DM, NT, 256, G, bx);
          pg8::EpiF32 E{(float*)(ws + WS_LOGIT), 256};
          pg8::gemm_phase<pg8::EpiF32, pg8::DenseOrder, true, false>(lds, g, S, E, nullptr); }
        { pg8::Gemm g{(const bf16_t*)(ws + WS_H2), (const bf16_t*)(ws + WS_WSGU_T), DM, DM, DM, 128};
          pg8::DenseOrder S; S.init(g.A, DM, NT, 512, G, bx);
          pg8::EpiGlu E{(bf16_t*)(ws + WS_HIDS), 256};
          pg8::gemm_phase<pg8::EpiGlu, pg8::DenseOrder, true, false>(lds, g, S, E, nullptr); }
    }
DI void run_phase_9(const Params& P, LAS unsigned char* lds, int vcu, int G, int bx, int wave, int lane, int tid) {
    unsigned char* ws = P.ws; const float* mod = (const float*)(ws + WS_MOD); (void)mod; (void)ws;
        phase_route(P, lds, vcu, G, wave, lane, tid);
        if (REP_PHASE == 90) { phase_route(P, lds, vcu, G, wave, lane, tid); phase_route(P, lds, vcu, G, wave, lane, tid); }
        pg8::Gemm g{(const bf16_t*)(ws + WS_HIDS), (const bf16_t*)(ws + WS_WSD_T), 256, 256, 256, 128};
        pg8::DenseOrder S; S.init(g.A, 256, NT, DM, G, bx);
        pg8::EpiStoreBf16 E{(bf16_t*)(ws + WS_SH), DM, 1.0f, 0};
        pg8::gemm_phase<pg8::EpiStoreBf16, pg8::DenseOrder, true, false>(lds, g, S, E, nullptr);
    }
DI void run_phase_10(const Params& P, LAS unsigned char* lds, int vcu, int G, int bx, int wave, int lane, int tid) {
    unsigned char* ws = P.ws; const float* mod = (const float*)(ws + WS_MOD); (void)mod; (void)ws;
 phase_scatter(P, lds, vcu, G, wave, lane, tid); }
DI void run_phase_11(const Params& P, LAS unsigned char* lds, int vcu, int G, int bx, int wave, int lane, int tid) {
    unsigned char* ws = P.ws; const float* mod = (const float*)(ws + WS_MOD); (void)mod; (void)ws;
        const int nblk = (int)__builtin_amdgcn_readfirstlane((int)ld_u32_agent((const unsigned*)(ws + WS_BLKE) + NBLK_MAX));
        const int nunits = 2 * nblk; LAS int* tab = (LAS int*)(lds + LDS_TAB);
        { const int* rowtok = (const int*)(ws + WS_ROWTOK); int i = 0;
          for (int L = vcu; L < nunits && i < 28; L += G, ++i) { if (tid < 256) tab[i * 256 + tid] = rowtok[(L >> 1) * 256 + tid]; } }
        __syncthreads();
        pg8::Gemm g{(const bf16_t*)(ws + WS_H2), (const bf16_t*)(ws + WS_WGU_T), DM, DM, DM, 128};
        pg8::MoeOrder<2> S{G, vcu, nunits, (const int*)(ws + WS_BLKE), g.A, (size_t)0};
        pg8::EpiGlu E{(bf16_t*)(ws + WS_HIDM), 256};
        pg8::gemm_phase<pg8::EpiGlu, pg8::MoeOrder<2>, true, true>(lds, g, S, E, tab);
    }
DI void run_phase_12(const Params& P, LAS unsigned char* lds, int vcu, int G, int bx, int wave, int lane, int tid) {
    unsigned char* ws = P.ws; const float* mod = (const float*)(ws + WS_MOD); (void)mod; (void)ws;
        const int nblk = (int)__builtin_amdgcn_readfirstlane((int)ld_u32_agent((const unsigned*)(ws + WS_BLKE) + NBLK_MAX));
        pg8::Gemm g{(const bf16_t*)(ws + WS_HIDM), (const bf16_t*)(ws + WS_WDN_T), 256, 256, 256, 128};
        pg8::MoeOrder<4> S{G, vcu, 4 * nblk, (const int*)(ws + WS_BLKE), g.A, (size_t)256 * 256 * 2};
        pg8::EpiStoreFp8 E{(unsigned char*)(ws + WS_YMOE), DM, YMOE_SCALE};
        pg8::gemm_phase<pg8::EpiStoreFp8, pg8::MoeOrder<4>, true, false>(lds, g, S, E, nullptr);
    }
DI void run_phase_13(const Params& P, LAS unsigned char* lds, int vcu, int G, int bx, int wave, int lane, int tid) {
    unsigned char* ws = P.ws; const float* mod = (const float*)(ws + WS_MOD); (void)mod; (void)ws;
 if (REP_PHASE == 130) { phase_final(P, vcu, G, wave, lane, (float*)(ws + WS_HIDM)); phase_final(P, vcu, G, wave, lane, (float*)(ws + WS_HIDM)); }
    phase_final(P, vcu, G, wave, lane, P.out); }
constexpr int NPHASE = 14;
__global__ void __launch_bounds__(512, 2) nsa_conformer_moe_fwd(Params P) {
    extern __shared__ __attribute__((aligned(16))) unsigned char lds_raw[];
    LAS unsigned char* lds = (LAS unsigned char*)lds_raw;
    const int tid = threadIdx.x, lane = tid & 63, wave = __builtin_amdgcn_readfirstlane(tid >> 6);
    const int G = gridDim.x, bx = blockIdx.x, vcu = (G % 8 == 0) ? (bx % 8) * (G / 8) + bx / 8 : bx;
    unsigned char* ws = P.ws;
    volatile LAS unsigned* MISC = (volatile LAS unsigned*)(lds + LDS_MISC);
    if (tid < 64) MISC[tid] = 0u;
    __syncthreads();
    const int lo = P.ph_lo, hi = P.ph_hi;
    XcdBarrier bar; bar.bar = (unsigned*)(ws + WS_CTL) + CW_BAR; bar.x = 0; bar.st = MISC + 8;
    if (hi - lo > 1) bar = xcd_barrier_post((unsigned*)(ws + WS_CTL) + CW_BAR, MISC + 8);
#ifdef PH_ONLY
#define IN(k) ((k) == PH_ONLY && lo <= (k) && (k) < hi)
#else
#define IN(k) (lo <= (k) && (k) < hi)
#endif
#define SEAM(k) do { if (IN(k) && IN((k) + 1)) xcd_barrier(bar); } while (0)
    if (IN(0)) run_phase_0(P, lds, vcu, G, bx, wave, lane, tid);
    if (REP_PHASE == 0 && IN(0)) { run_phase_0(P, lds, vcu, G, bx, wave, lane, tid); run_phase_0(P, lds, vcu, G, bx, wave, lane, tid); }
    SEAM(0);
    if (REP_PHASE == 200 && IN(0) && IN(1)) { for (int q_ = 0; q_ < 20; ++q_) xcd_barrier(bar); }
    if (IN(1)) run_phase_1(P, lds, vcu, G, bx, wave, lane, tid);
    if (REP_PHASE == 1 && IN(1)) { run_phase_1(P, lds, vcu, G, bx, wave, lane, tid); run_phase_1(P, lds, vcu, G, bx, wave, lane, tid); }
    SEAM(1);
    if (IN(2)) run_phase_2(P, lds, vcu, G, bx, wave, lane, tid);
    if (REP_PHASE == 2 && IN(2)) { run_phase_2(P, lds, vcu, G, bx, wave, lane, tid); run_phase_2(P, lds, vcu, G, bx, wave, lane, tid); }
    SEAM(2);
    if (IN(3)) run_phase_3(P, lds, vcu, G, bx, wave, lane, tid);
    if (REP_PHASE == 3 && IN(3)) { run_phase_3(P, lds, vcu, G, bx, wave, lane, tid); run_phase_3(P, lds, vcu, G, bx, wave, lane, tid); }
    SEAM(3);
    if (IN(4)) run_phase_4(P, lds, vcu, G, bx, wave, lane, tid);
    if (REP_PHASE == 4 && IN(4)) { run_phase_4(P, lds, vcu, G, bx, wave, lane, tid); run_phase_4(P, lds, vcu, G, bx, wave, lane, tid); }
    SEAM(4);
    if (IN(5)) run_phase_5(P, lds, vcu, G, bx, wave, lane, tid);
    if (REP_PHASE == 5 && IN(5)) { run_phase_5(P, lds, vcu, G, bx, wave, lane, tid); run_phase_5(P, lds, vcu, G, bx, wave, lane, tid); }
    SEAM(5);
    if (IN(6)) run_phase_6(P, lds, vcu, G, bx, wave, lane, tid);
    if (REP_PHASE == 6 && IN(6)) { run_phase_6(P, lds, vcu, G, bx, wave, lane, tid); run_phase_6(P, lds, vcu, G, bx, wave, lane, tid); }
    SEAM(6);
    if (IN(7)) run_phase_7(P, lds, vcu, G, bx, wave, lane, tid);
    if (REP_PHASE == 7 && IN(7)) { run_phase_7(P, lds, vcu, G, bx, wave, lane, tid); run_phase_7(P, lds, vcu, G, bx, wave, lane, tid); }
    SEAM(7);
    if (IN(8)) run_phase_8(P, lds, vcu, G, bx, wave, lane, tid);
    if (REP_PHASE == 8 && IN(8)) { run_phase_8(P, lds, vcu, G, bx, wave, lane, tid); run_phase_8(P, lds, vcu, G, bx, wave, lane, tid); }
    SEAM(8);
    if (IN(9)) run_phase_9(P, lds, vcu, G, bx, wave, lane, tid);
    if (REP_PHASE == 9 && IN(9)) { run_phase_9(P, lds, vcu, G, bx, wave, lane, tid); run_phase_9(P, lds, vcu, G, bx, wave, lane, tid); }
    SEAM(9);
    if (IN(10)) run_phase_10(P, lds, vcu, G, bx, wave, lane, tid);
    if (REP_PHASE == 10 && IN(10)) { run_phase_10(P, lds, vcu, G, bx, wave, lane, tid); run_phase_10(P, lds, vcu, G, bx, wave, lane, tid); }
    SEAM(10);
    if (IN(11)) run_phase_11(P, lds, vcu, G, bx, wave, lane, tid);
    if (REP_PHASE == 11 && IN(11)) { run_phase_11(P, lds, vcu, G, bx, wave, lane, tid); run_phase_11(P, lds, vcu, G, bx, wave, lane, tid); }
    SEAM(11);
    if (IN(12)) run_phase_12(P, lds, vcu, G, bx, wave, lane, tid);
    if (REP_PHASE == 12 && IN(12)) { run_phase_12(P, lds, vcu, G, bx, wave, lane, tid); run_phase_12(P, lds, vcu, G, bx, wave, lane, tid); }
    SEAM(12);
    if (IN(13)) run_phase_13(P, lds, vcu, G, bx, wave, lane, tid);
    if (REP_PHASE == 13 && IN(13)) { run_phase_13(P, lds, vcu, G, bx, wave, lane, tid); run_phase_13(P, lds, vcu, G, bx, wave, lane, tid); }
#undef IN
#undef SEAM
}

extern "C" void kernel_launch(void* const* d_in, const int* in_sizes, int n_in, void* d_out, int out_size, void* d_ws, size_t ws_size, hipStream_t stream) {
    static int grid = 0;
    if (grid == 0) {
        if (n_in != 28 || out_size != NT * DM || ws_size < WS_END) { fprintf(stderr, "kernel_launch: unexpected arguments (n_in %d, out %d, ws %zu); nothing launched\n", n_in, out_size, ws_size); grid = -1; return; }
        int dev = 0, cus = 0, per_cu = 0;
        if (hipGetDevice(&dev) != hipSuccess || hipDeviceGetAttribute(&cus, hipDeviceAttributeMultiprocessorCount, dev) != hipSuccess) { grid = -1; return; }
        if (hipFuncSetAttribute((const void*)nsa_conformer_moe_fwd, hipFuncAttributeMaxDynamicSharedMemorySize, LDS_BYTES) != hipSuccess) { fprintf(stderr, "kernel_launch: hipFuncSetAttribute failed\n"); grid = -1; return; }
        if (hipOccupancyMaxActiveBlocksPerMultiprocessor(&per_cu, (const void*)nsa_conformer_moe_fwd, 512, LDS_BYTES) != hipSuccess || per_cu < 1) { fprintf(stderr, "kernel_launch: occupancy query says %d blocks per CU\n", per_cu); }
        (void)hipGetLastError();
        grid = cus;
    }
    if (grid < 0) return;
    (void)hipMemsetAsync((char*)d_ws + WS_CTL, 0, CTL_ZERO_BYTES, stream);
    Params p{};
    const float** pp = (const float**)&p;
    for (int i = 0; i < 28; ++i) pp[i] = (const float*)d_in[i];
    p.out = (float*)d_out; p.ws = (unsigned char*)d_ws;
#if MK_PER_PHASE
    for (int ph = 0; ph < NPHASE; ++ph) { p.ph_lo = ph; p.ph_hi = ph + 1; hipLaunchKernelGGL(nsa_conformer_moe_fwd, dim3(grid), dim3(512), LDS_BYTES, stream, p); }
#else
    p.ph_lo = 0; p.ph_hi = NPHASE;
    hipLaunchKernelGGL(nsa_conformer_moe_fwd, dim3(grid), dim3(512), LDS_BYTES, stream, p);
#endif
}
```

```cpp
#include <hip/hip_runtime.h>
#include <cstdio>
#include <cstdint>

#define DI __device__ __forceinline__
#define LAS __attribute__((address_space(3)))
#define GAS __attribute__((address_space(1)))
typedef unsigned short bf16_t;
typedef short bf16x8 __attribute__((ext_vector_type(8)));
typedef float f32x4 __attribute__((ext_vector_type(4)));
typedef float f32x16 __attribute__((ext_vector_type(16)));
typedef float f32x2 __attribute__((ext_vector_type(2)));
typedef unsigned u32x4 __attribute__((ext_vector_type(4)));
typedef unsigned u32x2 __attribute__((ext_vector_type(2)));
typedef __bf16 bf16x2_t __attribute__((ext_vector_type(2)));

constexpr int NB = 4, SEQ = 8192, DM = 1024, NT = NB * SEQ;
constexpr int NU = 2560;
constexpr int UQ = 0, UKC = 512, UVC = 640, UKS = 768, UVS = 896, UKW = 1024, UVW = 1152, UCA = 1280, UCG = 1792, UGT = 2304;
constexpr int DIN = 2328;
constexpr int NEXP = 256, DEXP = 256, TOPK = 8;
constexpr int NASSIGN = NT * TOPK;
constexpr int NPAD_MAX = NASSIGN + NEXP * 255 + 1;
constexpr int NBLK_MAX = NPAD_MAX / 256 + 1;
constexpr float LN_EPS = 1e-5f;
constexpr float YMOE_SCALE = 16.0f;
constexpr float DN_ALPHA = 1.189207115002721f;

DI unsigned pk2(float lo, float hi) { f32x2 v = {lo, hi}; bf16x2_t b = __builtin_convertvector(v, bf16x2_t); return __builtin_bit_cast(unsigned, b); }
DI float bflo(unsigned w) { return __uint_as_float(w << 16); }
DI float bfhi(unsigned w) { return __uint_as_float(w & 0xffff0000u); }
DI float bf2f(bf16_t b) { return __uint_as_float(((unsigned)b) << 16); }
DI float fsigmoid(float x) { return __builtin_amdgcn_rcpf(1.0f + __expf(-x)); }
DI float fsilu(float x) { return x * __builtin_amdgcn_rcpf(1.0f + __expf(-x)); }
DI float wave_sum(float v) {
#pragma unroll
    for (int o = 1; o < 64; o <<= 1) v += __shfl_xor(v, o);
    return v;
}
DI unsigned ld_u32_agent(const unsigned* p) { return __hip_atomic_load(p, __ATOMIC_RELAXED, __HIP_MEMORY_SCOPE_AGENT); }
#define LDS_WAIT() asm volatile("s_waitcnt lgkmcnt(0)" ::: "memory")
#define VM_WAIT() asm volatile("s_waitcnt vmcnt(0)" ::: "memory")

#define XB_TMO      128
#define XB_XCNT(j)  (256  + 64 * (j))
#define XB_XSUB(j)  (1280 + 64 * (j))
#define XB_XGEN(j)  (2304 + 64 * (j))
#define XB_TOP      3328
#define XB_TOPGEN   3392
#define XCD_BAR_WORDS 3456
#define XB_SPIN_CAP (1u << 18)
__device__ __forceinline__ unsigned xb_ld(unsigned* p)              { return __hip_atomic_load(p, __ATOMIC_RELAXED, __HIP_MEMORY_SCOPE_AGENT); }
__device__ __forceinline__ unsigned xb_add(unsigned* p, unsigned v) { return __hip_atomic_fetch_add(p, v, __ATOMIC_RELAXED, __HIP_MEMORY_SCOPE_AGENT); }
__device__ __forceinline__ unsigned xb_xcc_id() { return (unsigned)__builtin_amdgcn_s_getreg((3 << 11) | 20) & 0xFu; }
#define XB_SPIN(cond, bar) do { unsigned _sp = 0; while (cond) { __builtin_amdgcn_s_sleep(1); \
    if ((++_sp & 255u) == 0u) { if (xb_ld(&(bar)[XB_TMO])) break; if (_sp > XB_SPIN_CAP) { atomicAdd(&(bar)[XB_TMO], 1u); break; } } } } while (0)
struct XcdBarrier { unsigned* bar; unsigned x; volatile LAS unsigned* st; };
__device__ __forceinline__ XcdBarrier xcd_barrier_post(unsigned* bar, volatile LAS unsigned* st) {
    XcdBarrier b; b.bar = bar; b.x = xb_xcc_id(); b.st = st;
    if (threadIdx.x == 0) (void)xb_add(&bar[XB_XCNT(b.x)], 1u);
    return b;
}
__device__ __forceinline__ void xcd_barrier_complete(unsigned* bar, unsigned x, unsigned& nloc, unsigned& nx) {
    const unsigned G = gridDim.x * gridDim.y * gridDim.z;
    unsigned sum, cnt, mine, sp = 0u;
    for (;;) {
        sum = 0u; cnt = 0u; mine = 0u;
#pragma unroll
        for (unsigned j = 0; j < 16; ++j) { const unsigned c = xb_ld(&bar[XB_XCNT(j)]); sum += c; cnt += (c > 0u) ? 1u : 0u; mine = (j == x) ? c : mine; }
        if (sum == G) break;
        __builtin_amdgcn_s_sleep(1);
        if ((++sp & 255u) == 0u) { if (xb_ld(&bar[XB_TMO])) break; if (sp > XB_SPIN_CAP) { atomicAdd(&bar[XB_TMO], 1u); break; } }
    }
    nloc = mine > 0u ? mine : 1u; nx = cnt > 0u ? cnt : 1u;
}
__device__ __forceinline__ void xcd_barrier(const XcdBarrier& b) {
    asm volatile("s_waitcnt vmcnt(0)" ::: "memory");
    __syncthreads();
    if (threadIdx.x == 0) {
        unsigned* bar = b.bar;
        __builtin_amdgcn_s_waitcnt(0);
        unsigned nloc = b.st[0], nx = b.st[1];
        if (nloc == 0u) { xcd_barrier_complete(bar, b.x, nloc, nx); b.st[0] = nloc; b.st[1] = nx; }
        const unsigned old = xb_add(&bar[XB_XSUB(b.x)], 1u);
        const unsigned gen = old / nloc;
        if (old + 1u == (gen + 1u) * nloc) {
            __builtin_amdgcn_fence(__ATOMIC_RELEASE, "agent");
            asm volatile("s_waitcnt vmcnt(0)" ::: "memory");
            const unsigned og = xb_add(&bar[XB_TOP], 1u);
            const unsigned tg = og / nx;
            if (og + 1u == (tg + 1u) * nx) xb_add(&bar[XB_TOPGEN], 1u);
            else XB_SPIN(xb_ld(&bar[XB_TOPGEN]) == tg, bar);
            __builtin_amdgcn_fence(__ATOMIC_ACQUIRE, "agent");
            xb_add(&bar[XB_XGEN(b.x)], 1u);
            asm volatile("s_waitcnt vmcnt(0)" ::: "memory");
        } else {
            XB_SPIN(xb_ld(&bar[XB_XGEN(b.x)]) == gen, bar);
            __builtin_amdgcn_fence(__ATOMIC_ACQUIRE, "agent");
            asm volatile("s_waitcnt vmcnt(0)" ::: "memory");
        }
    }
    __syncthreads();
}

namespace pg8 {
constexpr int BM = 256, BK = 64, HALF = 128, HTB = HALF * BK * 2, STAGE_BYTES = 8 * HTB, NXCD = 8, WGM = 8;
__host__ __device__ __forceinline__ int lds_byte(int r, int c) { const int st = (r >> 4) * 2 + (c >> 5), rr = r & 15, cc = c & 31, ob = rr * 64 + cc * 2; return st * 1024 + (ob ^ (((ob >> 9) & 1) << 5)); }
__host__ __device__ __forceinline__ void stage_rc(int b, int& R, int& C) { const int st = b / 1024, sb = b % 1024, swz = sb ^ (((sb >> 9) & 1) << 5); R = (st >> 1) * 16 + swz / 64; C = (st & 1) * 32 + (swz % 64) / 2; }
__host__ __device__ __forceinline__ int perm32(int rho) { const int n = rho >> 4, i = rho & 15; return 8 * (i >> 2) + 4 * n + (i & 3); }

struct Unit { int pm, pn, po; };
struct Gemm { const bf16_t* A; const bf16_t* Bt; int lda, ldb, K, kstepA; };

struct DenseOrder {
    int nM, nN, nwg, G, c; const bf16_t* A; size_t tstepA;
    DI void init(const bf16_t* A_, int lda, int M, int N, int G_, int c_) { nM = M / BM; nN = N / BM; nwg = nM * nN; G = G_; c = c_; A = A_; tstepA = (size_t)BM * lda * 2; }
    DI bool next(int i, Unit& u) const {
        const long L = (long)i * G + c; if (L >= nwg) return false;
        int wgid = (int)L; { const int q = nwg / NXCD, r = nwg % NXCD, xcd = wgid % NXCD, off = wgid / NXCD; wgid = (xcd < r ? xcd * (q + 1) : r * (q + 1) + (xcd - r) * q) + off; }
        const int nig = WGM * nN, gid = wgid / nig, fm = gid * WGM, gsz = (nM - fm) < WGM ? (nM - fm) : WGM;
        u.pm = fm + ((wgid % nig) % gsz); u.pn = (wgid % nig) / gsz; u.po = u.pn; return true;
    }
    DI const char* abase(const Unit& u) const { return (const char*)A + (size_t)u.pm * tstepA; }
};

DI unsigned cvt_pk_bf16(float lo, float hi) { return pk2(lo, hi); }

template <class Epi, class Sched, bool ALIGN_EPI, bool GATHER>
__device__ __forceinline__ void gemm_phase(LAS unsigned char* lds, const Gemm g, const Sched& S, const Epi& E, const LAS int* rowidx  ) {
    const int tid = threadIdx.x, wid = __builtin_amdgcn_readfirstlane(tid >> 6), lane = tid & 63, wr = wid >> 2, wc = wid & 3, fr = lane & 15, fq = lane >> 4;
    const int K = g.K; int nt = K / BK; asm volatile("" : "+s"(nt));
    unsigned voffA[2], voffB[2]; int RA[2], CA[2];
#pragma unroll
    for (int i = 0; i < 2; ++i) { int R, C; stage_rc(tid * 16 + i * 8192, R, C); const int Rb = Epi::PERM ? ((R & ~31) + perm32(R & 31)) : R;
        RA[i] = R; CA[i] = C; voffA[i] = (unsigned)(R * g.lda + C) * 2u; voffB[i] = (unsigned)(Rb * g.ldb + C) * 2u; }
    const size_t kstepA = (size_t)g.kstepA, kstepB = (size_t)(BK * 2);
    const size_t hstepA = (size_t)HALF * g.lda * 2, hstepB = (size_t)HALF * g.ldb * 2;
    const size_t tstepB = 2 * hstepB;
    const unsigned ldsw = (unsigned)wid * 1024u;
    const int aoff = lds_byte(wr * 64 + fr, fq * 8), boff = lds_byte(wc * 32 + fr, fq * 8);
#define PG8_SA(b, h) (((b) * 2 + (h)) * HTB)
#define PG8_SB(b, h) ((4 + (b) * 2 + (h)) * HTB)
#define PG8_STAGE(bufoff, gbase, voff) do { _Pragma("unroll") for (int _i = 0; _i < 2; ++_i) \
        __builtin_amdgcn_global_load_lds((const unsigned*)((const char*)(gbase) + (voff)[_i]), (LAS unsigned*)(lds + (bufoff) + ldsw + _i * 8192), 16, 0, 0); } while (0)
#define PG8_LDA(dst, b, h) do { _Pragma("unroll") for (int m = 0; m < 4; ++m) _Pragma("unroll") for (int k = 0; k < 2; ++k) dst[m][k] = *(const LAS bf16x8*)(lds + PG8_SA(b, h) + aoff + m * 2048 + k * 1024); } while (0)
#define PG8_LDB(dst, b, h) do { _Pragma("unroll") for (int n = 0; n < 2; ++n) _Pragma("unroll") for (int k = 0; k < 2; ++k) dst[n][k] = *(const LAS bf16x8*)(lds + PG8_SB(b, h) + boff + n * 2048 + k * 1024); } while (0)
#define PG8_MMA(ai, bj, At, Bt) do { __builtin_amdgcn_s_setprio(1); _Pragma("unroll") for (int m = 0; m < 4; ++m) _Pragma("unroll") for (int n = 0; n < 2; ++n) _Pragma("unroll") for (int k = 0; k < 2; ++k) \
        acc[ai][bj][m][n] = __builtin_amdgcn_mfma_f32_16x16x32_bf16(Bt[n][k], At[m][k], acc[ai][bj][m][n], 0, 0, 0); __builtin_amdgcn_s_setprio(0); } while (0)
#define PG8_WAIT_V(n) asm volatile("s_waitcnt vmcnt(" #n ")" ::: "memory")
#define PG8_WAIT_L(n) asm volatile("s_waitcnt lgkmcnt(" #n ")" ::: "memory")
#define PG8_BAR __builtin_amdgcn_s_barrier()
#define PG8_SCHED __builtin_amdgcn_sched_barrier(0)
    Unit cur, nxt; int ui = 0;
    if (!S.next(0, cur)) return;
    f32x4 acc[2][2][4][2];
#pragma unroll
    for (int a = 0; a < 2; ++a)
#pragma unroll
        for (int b = 0; b < 2; ++b)
#pragma unroll
            for (int m = 0; m < 4; ++m)
#pragma unroll
                for (int n = 0; n < 2; ++n) acc[a][b][m][n] = (f32x4){0.f, 0.f, 0.f, 0.f};
    bf16x8 At[4][2], B0[2][2], B1[2][2];
    unsigned cg0[2], cg1[2], ng0[2], ng1[2];
    const char* cA; const char* cB = (const char*)g.Bt + (size_t)cur.pn * tstepB;
    if constexpr (GATHER) {
        cA = (const char*)g.A;
#pragma unroll
        for (int i = 0; i < 2; ++i) { cg0[i] = (unsigned)(rowidx[ui * 256 + RA[i]] * g.lda + CA[i]) * 2u; cg1[i] = (unsigned)(rowidx[ui * 256 + 128 + RA[i]] * g.lda + CA[i]) * 2u; ng0[i] = cg0[i]; ng1[i] = cg1[i]; }
    } else { cA = S.abase(cur); cg0[0] = cg0[1] = cg1[0] = cg1[1] = ng0[0] = ng0[1] = ng1[0] = ng1[1] = 0u; }
#define PG8_STAGE_A(bufoff, base, h, og0, og1) do { if constexpr (GATHER) { if ((h) == 0) PG8_STAGE(bufoff, base, og0); else PG8_STAGE(bufoff, base, og1); } \
        else { PG8_STAGE(bufoff, (base) + ((h) ? hstepA : (size_t)0), voffA); } } while (0)
    PG8_STAGE(PG8_SB(0, 0), cB, voffB); PG8_STAGE(PG8_SB(0, 1), cB + hstepB, voffB); PG8_STAGE_A(PG8_SA(0, 0), cA, 0, cg0, cg1); PG8_STAGE_A(PG8_SA(0, 1), cA, 1, cg0, cg1);
    if (wr == 1) PG8_BAR;
    PG8_WAIT_V(2); PG8_BAR;
    PG8_STAGE(PG8_SB(1, 0), cB + kstepB, voffB); PG8_STAGE_A(PG8_SA(1, 0), cA + kstepA, 0, cg0, cg1); PG8_STAGE(PG8_SB(1, 1), cB + hstepB + kstepB, voffB);
    PG8_WAIT_V(6); PG8_BAR;
    for (;;) {
        const bool has_next = S.next(ui + 1, nxt);
        const char* nA; const char* nB = has_next ? (const char*)g.Bt + (size_t)nxt.pn * tstepB : cB;
        if constexpr (GATHER) {
            nA = cA;
            if (has_next) {
#pragma unroll
                for (int i = 0; i < 2; ++i) { ng0[i] = (unsigned)(rowidx[(ui + 1) * 256 + RA[i]] * g.lda + CA[i]) * 2u; ng1[i] = (unsigned)(rowidx[(ui + 1) * 256 + 128 + RA[i]] * g.lda + CA[i]) * 2u; }
            } else {
#pragma unroll
                for (int i = 0; i < 2; ++i) { ng0[i] = cg0[i]; ng1[i] = cg1[i]; }
            }
        } else { nA = has_next ? S.abase(nxt) : cA; }
        for (int t = 0; t < nt; t += 2) {
            const bool last = (t == nt - 2);
            const char* a1 = cA + (size_t)(t + 1) * kstepA;
            const char* a2 = last ? nA : cA + (size_t)(t + 2) * kstepA; const char* b2 = last ? nB : cB + (size_t)(t + 2) * kstepB;
            const char* a3 = a2 + kstepA; const char* b3 = b2 + kstepB;
            unsigned xg0[2], xg1[2];
#pragma unroll
            for (int i = 0; i < 2; ++i) { xg0[i] = last ? ng0[i] : cg0[i]; xg1[i] = last ? ng1[i] : cg1[i]; }
            PG8_LDB(B0, 0, 0); PG8_LDB(B1, 0, 1); PG8_SCHED; PG8_LDA(At, 0, 0); PG8_STAGE_A(PG8_SA(1, 1), a1, 1, cg0, cg1);
            PG8_WAIT_V(8); PG8_WAIT_L(0); PG8_BAR; PG8_MMA(0, 0, At, B0); PG8_MMA(0, 1, At, B1); PG8_BAR; PG8_SCHED;
            PG8_LDA(At, 0, 1); PG8_STAGE(PG8_SB(0, 0), b2, voffB); PG8_STAGE(PG8_SB(0, 1), b2 + hstepB, voffB); PG8_STAGE_A(PG8_SA(0, 0), a2, 0, xg0, xg1);
            PG8_WAIT_V(8); PG8_WAIT_L(0); PG8_BAR; PG8_MMA(1, 0, At, B0); PG8_MMA(1, 1, At, B1); PG8_BAR; PG8_SCHED;
            PG8_LDB(B0, 1, 0); PG8_LDB(B1, 1, 1); PG8_SCHED; PG8_LDA(At, 1, 0); PG8_STAGE_A(PG8_SA(0, 1), a2, 1, xg0, xg1);
            PG8_WAIT_V(8); PG8_WAIT_L(0); PG8_BAR; PG8_MMA(0, 0, At, B0); PG8_MMA(0, 1, At, B1); PG8_BAR; PG8_SCHED;
            PG8_LDA(At, 1, 1); PG8_STAGE(PG8_SB(1, 0), b3, voffB); PG8_STAGE(PG8_SB(1, 1), b3 + hstepB, voffB); PG8_STAGE_A(PG8_SA(1, 0), a3, 0, xg0, xg1);
            PG8_WAIT_V(8); PG8_WAIT_L(0); PG8_BAR; PG8_MMA(1, 0, At, B0); PG8_MMA(1, 1, At, B1); PG8_BAR; PG8_SCHED;
        }
        if constexpr (ALIGN_EPI) { if (wr == 0) PG8_BAR; }
        E(acc, cur, wr, wc, fr, fq);
        if (!has_next) break;
#pragma unroll
        for (int a = 0; a < 2; ++a)
#pragma unroll
            for (int b = 0; b < 2; ++b)
#pragma unroll
                for (int m = 0; m < 4; ++m)
#pragma unroll
                    for (int n = 0; n < 2; ++n) acc[a][b][m][n] = (f32x4){0.f, 0.f, 0.f, 0.f};
        cur = nxt; cA = nA; cB = nB; ++ui;
#pragma unroll
        for (int i = 0; i < 2; ++i) { cg0[i] = ng0[i]; cg1[i] = ng1[i]; }
        if constexpr (ALIGN_EPI) { if (wr == 1) PG8_BAR; }
    }
    PG8_WAIT_V(0);
    if constexpr (!ALIGN_EPI) { if (wr == 0) PG8_BAR; }
    PG8_BAR;
#undef PG8_SA
#undef PG8_SB
#undef PG8_STAGE
#undef PG8_STAGE_A
#undef PG8_LDA
#undef PG8_LDB
#undef PG8_MMA
#undef PG8_WAIT_V
#undef PG8_WAIT_L
#undef PG8_BAR
#undef PG8_SCHED
}
}
namespace pg8 {
typedef f32x4 AccT[2][2][4][2];

struct EpiStoreBf16 {
    static constexpr bool PERM = true;
    bf16_t* O; int ldc; float scale0; int ntile0;
    DI void operator()(const AccT& acc, const Unit& u, int wr, int wc, int fr, int fq) const {
        const int row0 = u.pm * BM + wr * 64 + fr, col0 = u.po * BM + wc * 32 + 8 * fq; const float sc = (u.po < ntile0) ? scale0 : 1.0f;
#pragma unroll
        for (int ai = 0; ai < 2; ++ai)
#pragma unroll
            for (int m = 0; m < 4; ++m) { bf16_t* rowp = O + (size_t)(row0 + ai * HALF + m * 16) * ldc + col0;
#pragma unroll
                for (int bj = 0; bj < 2; ++bj) { const f32x4 v0 = acc[ai][bj][m][0] * sc, v1 = acc[ai][bj][m][1] * sc;
                    u32x4 w; w.x = pk2(v0[0], v0[1]); w.y = pk2(v0[2], v0[3]); w.z = pk2(v1[0], v1[1]); w.w = pk2(v1[2], v1[3]);
                    *(u32x4*)(rowp + bj * HALF) = w; } }
    }
};
struct EpiStoreFp8 {
    static constexpr bool PERM = true;
    unsigned char* O; int ldc; float scale;
    DI void operator()(const AccT& acc, const Unit& u, int wr, int wc, int fr, int fq) const {
        const int row0 = u.pm * BM + wr * 64 + fr, col0 = u.po * BM + wc * 32 + 8 * fq;
#pragma unroll
        for (int ai = 0; ai < 2; ++ai)
#pragma unroll
            for (int m = 0; m < 4; ++m) { unsigned char* rowp = O + (size_t)(row0 + ai * HALF + m * 16) * ldc + col0;
#pragma unroll
                for (int bj = 0; bj < 2; ++bj) { const f32x4 v0 = acc[ai][bj][m][0] * scale, v1 = acc[ai][bj][m][1] * scale;
                    int w0 = 0, w1 = 0;
                    w0 = __builtin_amdgcn_cvt_pk_fp8_f32(v0[0], v0[1], w0, false); w0 = __builtin_amdgcn_cvt_pk_fp8_f32(v0[2], v0[3], w0, true);
                    w1 = __builtin_amdgcn_cvt_pk_fp8_f32(v1[0], v1[1], w1, false); w1 = __builtin_amdgcn_cvt_pk_fp8_f32(v1[2], v1[3], w1, true);
                    *(u32x2*)(rowp + bj * HALF) = (u32x2){(unsigned)w0, (unsigned)w1}; } }
    }
};
DI float gelu_tanh(float x) { const float u = 0.7978845608028654f * (x + 0.044715f * x * x * x); const float e = __expf(2.0f * u); const float th = 1.0f - 2.0f / (e + 1.0f); return 0.5f * x * (1.0f + th); }
struct EpiCmp {
    static constexpr bool PERM = true;
    bf16_t* O; const float* peb;
    DI void operator()(const AccT& acc, const Unit& u, int wr, int wc, int fr, int fq) const {
        const int row0 = u.pm * BM + wr * 64 + fr, col0 = wc * 32 + 8 * fq; const float* pb = peb + (u.pm >> 4) * 256;
        f32x4 bv[2][2];
#pragma unroll
        for (int bj = 0; bj < 2; ++bj)
#pragma unroll
            for (int n = 0; n < 2; ++n) bv[bj][n] = *(const f32x4*)(pb + col0 + bj * HALF + 4 * n);
#pragma unroll
        for (int ai = 0; ai < 2; ++ai)
#pragma unroll
            for (int m = 0; m < 4; ++m) { bf16_t* rowp = O + (size_t)(row0 + ai * HALF + m * 16) * 256 + col0;
#pragma unroll
                for (int bj = 0; bj < 2; ++bj) { f32x4 v0 = acc[ai][bj][m][0] + bv[bj][0], v1 = acc[ai][bj][m][1] + bv[bj][1];
#pragma unroll
                    for (int j = 0; j < 4; ++j) { v0[j] = gelu_tanh(v0[j]); v1[j] = gelu_tanh(v1[j]); }
                    u32x4 w; w.x = pk2(v0[0], v0[1]); w.y = pk2(v0[2], v0[3]); w.z = pk2(v1[0], v1[1]); w.w = pk2(v1[2], v1[3]);
                    *(u32x4*)(rowp + bj * HALF) = w; } }
    }
};
struct EpiF32 {
    static constexpr bool PERM = false;
    float* C; int ldc;
    DI void operator()(const AccT& acc, const Unit& u, int wr, int wc, int fr, int fq) const {
        const int row0 = u.pm * BM + wr * 64 + fr, col0 = u.po * BM + wc * 32 + 4 * fq;
#pragma unroll
        for (int ai = 0; ai < 2; ++ai)
#pragma unroll
            for (int m = 0; m < 4; ++m) { float* rowp = C + (size_t)(row0 + ai * HALF + m * 16) * ldc + col0;
#pragma unroll
                for (int bj = 0; bj < 2; ++bj)
#pragma unroll
                    for (int n = 0; n < 2; ++n) *(f32x4*)(rowp + bj * HALF + n * 16) = acc[ai][bj][m][n]; }
    }
};
struct EpiResMod {
    static constexpr bool PERM = false;
    const float* base; float* out; const float* gate; int gate_pitch;
    DI void operator()(const AccT& acc, const Unit& u, int wr, int wc, int fr, int fq) const {
        const int row0 = u.pm * BM + wr * 64 + fr, col0 = u.po * BM + wc * 32 + 4 * fq;
        const float* gp = gate + (size_t)((u.pm * BM) / SEQ) * gate_pitch + col0;
        f32x4 gv[2][2];
#pragma unroll
        for (int bj = 0; bj < 2; ++bj)
#pragma unroll
            for (int n = 0; n < 2; ++n) gv[bj][n] = *(const f32x4*)(gp + bj * HALF + n * 16);
#pragma unroll
        for (int ai = 0; ai < 2; ++ai)
#pragma unroll
            for (int m = 0; m < 4; ++m) { const size_t off = (size_t)(row0 + ai * HALF + m * 16) * DM + col0;
#pragma unroll
                for (int bj = 0; bj < 2; ++bj)
#pragma unroll
                    for (int n = 0; n < 2; ++n) { const f32x4 bs = *(const f32x4*)(base + off + bj * HALF + n * 16);
                        *(f32x4*)(out + off + bj * HALF + n * 16) = bs * DN_ALPHA + gv[bj][n] * acc[ai][bj][m][n]; } }
    }
};
struct EpiResModBf16 {
    static constexpr bool PERM = false;
    const float* base; bf16_t* out; const float* gate; int gate_pitch;
    DI void operator()(const AccT& acc, const Unit& u, int wr, int wc, int fr, int fq) const {
        const int row0 = u.pm * BM + wr * 64 + fr, col0 = u.po * BM + wc * 32 + 4 * fq;
        const float* gp = gate + (size_t)((u.pm * BM) / SEQ) * gate_pitch + col0;
        f32x4 gv[2][2];
#pragma unroll
        for (int bj = 0; bj < 2; ++bj)
#pragma unroll
            for (int n = 0; n < 2; ++n) gv[bj][n] = *(const f32x4*)(gp + bj * HALF + n * 16);
#pragma unroll
        for (int ai = 0; ai < 2; ++ai)
#pragma unroll
            for (int m = 0; m < 4; ++m) { const size_t off = (size_t)(row0 + ai * HALF + m * 16) * DM + col0;
#pragma unroll
                for (int bj = 0; bj < 2; ++bj)
#pragma unroll
                    for (int n = 0; n < 2; ++n) { const f32x4 bs = *(const f32x4*)(base + off + bj * HALF + n * 16); const f32x4 v = bs * DN_ALPHA + gv[bj][n] * acc[ai][bj][m][n];
                        *(u32x2*)(out + off + bj * HALF + n * 16) = (u32x2){pk2(v.x, v.y), pk2(v.z, v.w)}; } }
    }
};
struct EpiGlu {
    static constexpr bool PERM = true;
    bf16_t* O; int ldc;
    DI void operator()(const AccT& acc, const Unit& u, int wr, int wc, int fr, int fq) const {
        const int row0 = u.pm * BM + wr * 64 + fr, col0 = u.po * HALF + wc * 32 + 8 * fq;
#pragma unroll
        for (int ai = 0; ai < 2; ++ai)
#pragma unroll
            for (int m = 0; m < 4; ++m) { bf16_t* rowp = O + (size_t)(row0 + ai * HALF + m * 16) * ldc + col0;
                f32x4 h0, h1;
#pragma unroll
                for (int j = 0; j < 4; ++j) { h0[j] = fsilu(acc[ai][0][m][0][j]) * acc[ai][1][m][0][j]; h1[j] = fsilu(acc[ai][0][m][1][j]) * acc[ai][1][m][1][j]; }
                u32x4 w; w.x = pk2(h0[0], h0[1]); w.y = pk2(h0[2], h0[3]); w.z = pk2(h1[0], h1[1]); w.w = pk2(h1[2], h1[3]);
                *(u32x4*)rowp = w; }
    }
};

struct CmpOrder {
    int G, c; const bf16_t* U;
    DI bool next(int i, Unit& u) const { const int L = i * G + c; if (L >= 32) return false; u.pm = L; u.pn = L >> 4; u.po = 0; return true; }
    DI const char* abase(const Unit& u) const { const int kv = u.pm >> 4, bg = (u.pm >> 1) & 7, b = bg >> 1, gg = bg & 1, half = u.pm & 1;
        return (const char*)(U + (size_t)(b * SEQ + half * 4096) * NU + (kv ? UVC : UKC) + gg * 64); }
};
template <int NSUB> struct MoeOrder {
    int G, c, nunits; const int* blk_e; const bf16_t* A; size_t tstepA;
    DI bool next(int i, Unit& u) const { const int L = i * G + c; if (L >= nunits) return false; const int blk = L / NSUB, sub = L % NSUB;
        const int e = (int)__builtin_amdgcn_readfirstlane((int)ld_u32_agent((const unsigned*)blk_e + blk)); u.pm = blk; u.pn = e * NSUB + sub; u.po = sub; return true; }
    DI const char* abase(const Unit& u) const { return (const char*)A + (size_t)u.pm * tstepA; }
};
struct MoePairOrder {
    int G, c, npairs; const int* blk_e; const bf16_t* A; size_t tstepA;
    DI bool next(int i, Unit& u) const { const int p = (i >> 1) * G + c; if (p >= npairs) return false; const int blk = p >> 1, sub = (p & 1) * 2 + (i & 1);
        const int e = (int)__builtin_amdgcn_readfirstlane((int)ld_u32_agent((const unsigned*)blk_e + blk)); u.pm = blk; u.pn = e * 4 + sub; u.po = sub; return true; }
    DI const char* abase(const Unit& u) const { return (const char*)A + (size_t)u.pm * tstepA; }
};
struct RouterOrder {
    int G, c; const bf16_t* A;
    DI bool next(int i, Unit& u) const { const int L = i * G + c; if (L >= 2 * (NT / 256)) return false; u.pm = L >> 1; u.pn = L & 1; u.po = L & 1; return true; }
    DI const char* abase(const Unit& u) const { return (const char*)(A + (size_t)u.pm * 256 * DM + u.pn * 512); }
};
struct EpiLogit {
    static constexpr bool PERM = false;
    float* C;
    DI void operator()(const AccT& acc, const Unit& u, int wr, int wc, int fr, int fq) const {
        const int row0 = u.pm * BM + wr * 64 + fr, col0 = wc * 32 + 4 * fq; float* base = C + (size_t)u.po * NT * 256;
#pragma unroll
        for (int ai = 0; ai < 2; ++ai)
#pragma unroll
            for (int m = 0; m < 4; ++m) { float* rowp = base + (size_t)(row0 + ai * HALF + m * 16) * 256 + col0;
#pragma unroll
                for (int bj = 0; bj < 2; ++bj)
#pragma unroll
                    for (int n = 0; n < 2; ++n) *(f32x4*)(rowp + bj * HALF + n * 16) = acc[ai][bj][m][n]; }
    }
};
}
constexpr size_t MiB = 1u << 20;
constexpr size_t WS_CTL = 0, CTL_ZERO_BYTES = 1 * MiB;
constexpr size_t WS_MODP = 1 * MiB;
constexpr size_t WS_MOD = WS_MODP + 1536 * 1024;
constexpr size_t WS_PEP = WS_MOD + 128 * 1024;
constexpr size_t WS_PEB = WS_PEP + 32 * 1024;
constexpr size_t WS_WIN_T = 3 * MiB;
constexpr size_t WS_WOUT_T = 8 * MiB;
constexpr size_t WS_WR_T = 10 * MiB;
constexpr size_t WS_WSGU_T = 12 * MiB;
constexpr size_t WS_WSD_T = 13 * MiB;
constexpr size_t WS_WC1_T = 14 * MiB;
constexpr size_t WS_WDN_T = 16 * MiB;
constexpr size_t WS_WGU_T = 144 * MiB;
constexpr size_t WS_YMOE = 144 * MiB;
constexpr size_t WS_U = 400 * MiB;
constexpr size_t WS_H1 = 560 * MiB;
constexpr size_t WS_CAT = 624 * MiB;
constexpr size_t WS_H2 = 688 * MiB;
constexpr size_t WS_HIDS = 752 * MiB;
constexpr size_t WS_HIDM = 784 * MiB;
constexpr size_t WS_LOGIT = 624 * MiB;
constexpr size_t WS_TOKE = 976 * MiB;
constexpr size_t WS_TOKW = 977 * MiB;
constexpr size_t WS_LRANK = 978 * MiB;
constexpr size_t WS_POSOF = 979 * MiB;
constexpr size_t WS_ROWTOK = 980 * MiB;
constexpr size_t WS_HIST = 982 * MiB;
constexpr size_t WS_BLKE = 983 * MiB;
constexpr size_t WS_HCMP = 984 * MiB;
constexpr size_t WS_KC = 988 * MiB;
constexpr size_t WS_VCT = 989 * MiB;
constexpr size_t WS_VST = 990 * MiB;
constexpr size_t WS_VWT = 998 * MiB;
constexpr size_t WS_V1 = WS_H1;
constexpr size_t WS_X1 = 464 * MiB;
constexpr size_t WS_SH = 528 * MiB;
constexpr size_t WS_END = 1024 * MiB;
constexpr int CW_BAR = 4096, CW_ATTQ = 12288;

constexpr int LDS_BYTES = 160 * 1024;
constexpr int LDS_MISC = 131072;
constexpr int LDS_TAB = 131072 + 1024;

struct Params {
    const float *x, *c, *w_ada, *b_ada, *w_in, *pe_k, *pe_v, *w_cmp_k1, *w_cmp_k2, *w_cmp_v1, *w_cmp_v2, *w_dw, *b_dw, *conv_ln_g, *conv_ln_b, *w_out, *ln1_g, *ln1_b,
        *w_router, *router_bias, *w_e_gate, *w_e_up, *w_e_down, *w_s_gate, *w_s_up, *w_s_down, *ln2_g, *ln2_b;
    float* out; unsigned char* ws; int ph_lo, ph_hi;
};

DI void transpose_item(const float* W, int ldw, int ncols, bf16_t* WT, int ldt, int drow0, LAS float* scr, int k0, int n0, int lane) {
    if (n0 + 32 <= ncols && (((size_t)W | (size_t)(ldw * 4)) & 15) == 0 && (n0 & 3) == 0) {
        f32x4 v[8];
#pragma unroll
        for (int i = 0; i < 8; ++i) v[i] = *(const f32x4*)(W + (size_t)(k0 + 8 * i + (lane >> 3)) * ldw + n0 + 4 * (lane & 7));
#pragma unroll
        for (int i = 0; i < 8; ++i) { LAS float* d = scr + (8 * i + (lane >> 3)) * 33 + 4 * (lane & 7); d[0] = v[i].x; d[1] = v[i].y; d[2] = v[i].z; d[3] = v[i].w; }
    } else {
        const int nn = n0 + (lane & 31); const bool okc = nn < ncols;
#pragma unroll 8
        for (int i = 0; i < 32; ++i) { const int kk = 2 * i + (lane >> 5); scr[kk * 33 + (lane & 31)] = okc ? W[(size_t)(k0 + kk) * ldw + nn] : 0.f; }
    }
    LDS_WAIT(); asm volatile("" ::: "memory");
    const int cch = lane & 7;
#pragma unroll
    for (int j = 0; j < 4; ++j) { const int n = (lane >> 3) + 8 * j; const LAS float* s = scr + (8 * cch) * 33 + n;
        u32x4 o; o.x = pk2(s[0 * 33], s[1 * 33]); o.y = pk2(s[2 * 33], s[3 * 33]); o.z = pk2(s[4 * 33], s[5 * 33]); o.w = pk2(s[6 * 33], s[7 * 33]);
        *(u32x4*)(WT + (size_t)(drow0 + n) * ldt + k0 + 8 * cch) = o; }
    LDS_WAIT(); asm volatile("" ::: "memory");
}
DI void tr_plain(const float* W, int ldw, int K, int N, bf16_t* WT, int row_off, LAS float* scr, int item, int lane) {
    const int nblk = (N + 31) / 32, kb = item / nblk, nb = item % nblk;
    transpose_item(W, ldw, N, WT, K, row_off + 32 * nb, scr, 64 * kb, 32 * nb, lane);
}
DI void tr_glu(const float* W, int K, bf16_t* WT, int up, LAS float* scr, int item, int lane) {
    const int kb = item >> 3, nb = item & 7, n0 = 32 * nb;
    transpose_item(W, 256, 256, WT, K, (n0 >> 7) * 256 + up * 128 + (n0 & 127), scr, 64 * kb, n0, lane);
}

constexpr int CV_EARLY_EXPERTS = 0;
constexpr int EXP_ITEMS = NEXP * 384, EXP_LATE = 18432;
DI void expert_items(const Params& P, LAS float* scr, int lane, int gw, int NGW, int r0, int r1) {
    unsigned char* ws = P.ws;
    for (int r = r0 + gw; r < r1; r += NGW) { const int e = r / 384, q = r % 384;
        if (q < 128) tr_glu(P.w_e_gate + (size_t)e * 1024 * 256, 1024, (bf16_t*)(ws + WS_WGU_T) + (size_t)e * 512 * 1024, 0, scr, q, lane);
        else if (q < 256) tr_glu(P.w_e_up + (size_t)e * 1024 * 256, 1024, (bf16_t*)(ws + WS_WGU_T) + (size_t)e * 512 * 1024, 1, scr, q - 128, lane);
        else tr_plain(P.w_e_down + (size_t)e * 256 * 1024, 1024, 256, 1024, (bf16_t*)(ws + WS_WDN_T) + (size_t)e * 1024 * 256, 0, scr, q - 256, lane); }
}

DI void phase0a(const Params& P, LAS unsigned char* lds, int vcu, int G, int wave, int lane, int tid) {
    unsigned char* ws = P.ws;
    LAS float* scr = (LAS float*)(lds + wave * 16384);
    const int gw = vcu * 8 + wave, NGW = G * 8;
    for (int it = gw; it < 96 * 16; it += NGW) { const int cb = it % 96, ks = it / 96; const int col = cb * 64 + lane;
        float a0 = 0.f, a1 = 0.f, a2 = 0.f, a3 = 0.f;
#pragma unroll 4
        for (int k = ks * 64; k < ks * 64 + 64; ++k) { const float w = P.w_ada[(size_t)k * 6144 + col];
            a0 += fsilu(P.c[k]) * w; a1 += fsilu(P.c[1024 + k]) * w; a2 += fsilu(P.c[2048 + k]) * w; a3 += fsilu(P.c[3072 + k]) * w; }
        float* mp = (float*)(ws + WS_MODP) + (size_t)ks * 4 * 6144 + col;
        mp[0] = a0; mp[6144] = a1; mp[2 * 6144] = a2; mp[3 * 6144] = a3; }
    for (int it = gw; it < 16 * 2 * 4; it += NGW) { const int cb = it & 3, kv = (it >> 2) & 1, ks = it >> 3; const int col = cb * 64 + lane;
        const float* pe = kv ? P.pe_v : P.pe_k; const float* w1 = kv ? P.w_cmp_v1 : P.w_cmp_k1; float a = 0.f;
#pragma unroll 4
        for (int k = ks * 128; k < ks * 128 + 128; ++k) a += pe[k] * w1[(size_t)k * 256 + col];
        ((float*)(ws + WS_PEP))[(ks * 2 + kv) * 256 + col] = a; }
    constexpr int I_IN0 = 16 * 40, I_IN1 = 16 * 32, I_IN2 = 16 * 1, I_OUT = 16 * 32, I_R = 16 * 8, I_SG = 16 * 8, I_SD = 4 * 32, I_C1 = 32 * 8;
    constexpr int I_SMALL = I_IN0 + I_IN1 + I_IN2 + I_OUT + I_R + 2 * I_SG + I_SD + 2 * I_C1;
    constexpr int NITEMS = I_SMALL;
    bf16_t* win_t = (bf16_t*)(ws + WS_WIN_T);
    for (int it = gw; it < NITEMS; it += NGW) {
        int r = it;
        if (r < I_IN0) { tr_plain(P.w_in, DIN, 1024, 1280, win_t, 0, scr, r, lane); continue; } r -= I_IN0;
        if (r < I_IN1) { tr_plain(P.w_in + 1304, DIN, 1024, 1024, win_t, UCA, scr, r, lane); continue; } r -= I_IN1;
        if (r < I_IN2) { tr_plain(P.w_in + 1280, DIN, 1024, 24, win_t, UGT, scr, r, lane); continue; } r -= I_IN2;
        if (r < I_OUT) { tr_plain(P.w_out, 1024, 1024, 1024, (bf16_t*)(ws + WS_WOUT_T), 0, scr, r, lane); continue; } r -= I_OUT;
        if (r < I_R) { tr_plain(P.w_router, 256, 1024, 256, (bf16_t*)(ws + WS_WR_T), 0, scr, r, lane); continue; } r -= I_R;
        if (r < I_SG) { tr_glu(P.w_s_gate, 1024, (bf16_t*)(ws + WS_WSGU_T), 0, scr, r, lane); continue; } r -= I_SG;
        if (r < I_SG) { tr_glu(P.w_s_up, 1024, (bf16_t*)(ws + WS_WSGU_T), 1, scr, r, lane); continue; } r -= I_SG;
        if (r < I_SD) { tr_plain(P.w_s_down, 1024, 256, 1024, (bf16_t*)(ws + WS_WSD_T), 0, scr, r, lane); continue; } r -= I_SD;
        if (r < I_C1) { tr_plain(P.w_cmp_k1, 256, 2048, 256, (bf16_t*)(ws + WS_WC1_T), 0, scr, r, lane); continue; } r -= I_C1;
        tr_plain(P.w_cmp_v1, 256, 2048, 256, (bf16_t*)(ws + WS_WC1_T) + 256 * 2048, 0, scr, r, lane);
    }
    expert_items(P, scr, lane, gw, NGW, 0, CV_EARLY_EXPERTS * 384);
    { u32x4* z = (u32x4*)(win_t + (size_t)2336 * 1024); const int n16 = (2560 - 2336) * 1024 * 2 / 16;
      for (int i = vcu * 512 + tid; i < n16; i += G * 512) z[i] = (u32x4){0u, 0u, 0u, 0u}; }
}

DI void phase0b(const Params& P, LAS unsigned char* lds, int vcu, int G, int wave, int lane, int tid) {
    unsigned char* ws = P.ws;
    const float* modp = (const float*)(ws + WS_MODP);
    for (int i = vcu * 512 + tid; i < 4 * 6144; i += G * 512) { float a = P.b_ada[i % 6144];
#pragma unroll
        for (int ks = 0; ks < 16; ++ks) a += modp[(size_t)ks * 4 * 6144 + i];
        ((float*)(ws + WS_MOD))[i] = a; }
    for (int i = vcu * 512 + tid; i < 512; i += G * 512) { float a = 0.f;
#pragma unroll
        for (int ks = 0; ks < 16; ++ks) a += ((const float*)(ws + WS_PEP))[ks * 512 + i];
        ((float*)(ws + WS_PEB))[i] = a; }
    const int rpw = NT / G;
    LAS float* sh = (LAS float*)lds;
    for (int r0 = vcu * rpw; r0 < NT; r0 += G * rpw) {
        const int b = r0 / SEQ;
        __syncthreads();
        for (int i = tid; i < 2048; i += 512) { const int j = (i < 1024) ? i : i;
            float a = P.b_ada[j];
#pragma unroll
            for (int ks = 0; ks < 16; ++ks) a += modp[(size_t)ks * 4 * 6144 + b * 6144 + j];
            sh[i] = (i < 1024) ? a : 1.0f + a; }
        __syncthreads();
        for (int m = r0 + wave; m < r0 + rpw; m += 8) {
            const f32x4* xr = (const f32x4*)(P.x + (size_t)m * DM) + lane; unsigned long long* o8 = (unsigned long long*)((bf16_t*)(ws + WS_H1) + (size_t)m * DM) + lane;
#pragma unroll
            for (int j = 0; j < 4; ++j) { const f32x4 v = xr[64 * j]; const int c0 = 4 * lane + 256 * j;
                const float y0 = v.x * sh[1024 + c0] + sh[c0], y1 = v.y * sh[1025 + c0] + sh[c0 + 1], y2 = v.z * sh[1026 + c0] + sh[c0 + 2], y3 = v.w * sh[1027 + c0] + sh[c0 + 3];
                o8[64 * j] = (unsigned long long)pk2(y0, y1) | ((unsigned long long)pk2(y2, y3) << 32); }
        }
    }
    __syncthreads();
}

DI void conv_item(const Params& P, LAS unsigned char* lds, int item, int wave, int lane, int tid) {
    const bf16_t* U = (const bf16_t*)(P.ws + WS_U); bf16_t* CAT = (bf16_t*)(P.ws + WS_CAT);
    LAS float* glu = (LAS float*)lds; LAS float* red = (LAS float*)(lds + 62 * 512 * 4); LAS float* stat = red + 32 * 8 * 2;
    const int b = item >> 8, t0 = (item & 255) * 32, c = tid;
    __syncthreads();
    {
        u32x4 av[8], gv8[8];
#pragma unroll
        for (int i = 0; i < 8; ++i) { const int task = tid + 512 * i, rr = task >> 6, oc = task & 63; int tok = t0 - 30 + (rr < 62 ? rr : 61); tok = tok < 0 ? 0 : tok;
            const bf16_t* up = U + (size_t)(b * SEQ + tok) * NU + oc * 8; av[i] = *(const u32x4*)(up + UCA); gv8[i] = *(const u32x4*)(up + UCG); }
#pragma unroll
        for (int i = 0; i < 8; ++i) { const int task = tid + 512 * i, rr = task >> 6, oc = task & 63; const bool ok = (t0 - 30 + rr) >= 0;
            const unsigned aw[4] = {av[i].x, av[i].y, av[i].z, av[i].w}, gw[4] = {gv8[i].x, gv8[i].y, gv8[i].z, gv8[i].w}; float o[8];
#pragma unroll
            for (int q = 0; q < 4; ++q) { o[2 * q] = ok ? bflo(aw[q]) * fsigmoid(bflo(gw[q])) : 0.f; o[2 * q + 1] = ok ? bfhi(aw[q]) * fsigmoid(bfhi(gw[q])) : 0.f; }
            if (rr < 62) { *(LAS f32x4*)(glu + rr * 512 + oc * 8) = (f32x4){o[0], o[1], o[2], o[3]}; *(LAS f32x4*)(glu + rr * 512 + oc * 8 + 4) = (f32x4){o[4], o[5], o[6], o[7]}; } }
    }
    float w[31];
#pragma unroll
    for (int j = 0; j < 31; ++j) w[j] = P.w_dw[j * 512 + c];
    const float bd = P.b_dw[c];
    __syncthreads();
    float y[32];
#pragma unroll
    for (int tt = 0; tt < 32; ++tt) y[tt] = bd;
#pragma unroll
    for (int rr = 0; rr < 62; ++rr) { const float gv = glu[rr * 512 + c];
#pragma unroll
        for (int tt = 0; tt < 32; ++tt) { if (rr - tt >= 0 && rr - tt <= 30) y[tt] += w[rr - tt] * gv; } }
    __syncthreads();
#pragma unroll
    for (int tt = 0; tt < 32; ++tt) glu[tt * 512 + c] = y[tt];
    __syncthreads();
    {
#pragma unroll
        for (int q = 0; q < 4; ++q) { const int tt = 4 * wave + q; const f32x4 a = *(const LAS f32x4*)(glu + tt * 512 + lane * 8), bq = *(const LAS f32x4*)(glu + tt * 512 + lane * 8 + 4);
            float s1 = ((a.x + a.y) + (a.z + a.w)) + ((bq.x + bq.y) + (bq.z + bq.w));
            float s2 = ((a.x * a.x + a.y * a.y) + (a.z * a.z + a.w * a.w)) + ((bq.x * bq.x + bq.y * bq.y) + (bq.z * bq.z + bq.w * bq.w));
            s1 = wave_sum(s1); s2 = wave_sum(s2);
            if (lane == 0) { const float mean = s1 * (1.0f / 512.0f); float var = s2 * (1.0f / 512.0f) - mean * mean; var = var < 0.f ? 0.f : var;
                stat[tt * 2] = mean; stat[tt * 2 + 1] = 1.0f / sqrtf(var + LN_EPS); } }
    }
    __syncthreads();
    const float lg = P.conv_ln_g[c], lb = P.conv_ln_b[c];
#pragma unroll
    for (int tt = 0; tt < 32; ++tt) { const float v = (y[tt] - stat[tt * 2]) * stat[tt * 2 + 1] * lg + lb;
        CAT[(size_t)(b * SEQ + t0 + tt) * DM + 512 + c] = (bf16_t)(pk2(fsilu(v), 0.f) & 0xffffu); }
}

DI unsigned swap23(unsigned p) { return (p & ~12u) | ((p & 4u) << 1) | ((p & 8u) >> 1); }
DI void vt_copies(const Params& P, LAS unsigned char* lds, int gw, int NGW, int wave, int lane) {
    unsigned char* ws = P.ws;
    LAS bf16_t* tile = (LAS bf16_t*)(lds + wave * 8448);
    const bf16_t* U = (const bf16_t*)(ws + WS_U);
    for (int it = gw; it < 2 * 8 * 128; it += NGW) { const int which = it >> 10, bg = (it >> 7) & 7, blk = it & 127, b = bg >> 1, gg = bg & 1;
        const bf16_t* src = U + (size_t)(b * SEQ + blk * 64 + lane) * NU + (which ? UVW : UVS) + gg * 64;
#pragma unroll
        for (int q = 0; q < 8; ++q) { const u32x4 v = *(const u32x4*)(src + q * 8); LAS unsigned* tp = (LAS unsigned*)(tile + lane * 66 + q * 8); tp[0] = v.x; tp[1] = v.y; tp[2] = v.z; tp[3] = v.w; }
        LDS_WAIT(); asm volatile("" ::: "memory");
        bf16_t* dst = (bf16_t*)(ws + (which ? WS_VWT : WS_VST)) + ((size_t)(bg * 128 + blk) * 64 + lane) * 64;
#pragma unroll
        for (int q = 0; q < 8; ++q) { unsigned wv[4];
#pragma unroll
            for (int e2 = 0; e2 < 4; ++e2) { const int p0 = q * 8 + e2 * 2; const int k0 = (p0 & ~15) | (int)swap23((unsigned)p0 & 15u), k1 = ((p0 + 1) & ~15) | (int)swap23((unsigned)(p0 + 1) & 15u);
                wv[e2] = (unsigned)tile[k0 * 66 + lane] | ((unsigned)tile[k1 * 66 + lane] << 16); }
            *(u32x4*)(dst + q * 8) = (u32x4){wv[0], wv[1], wv[2], wv[3]}; }
        LDS_WAIT(); asm volatile("" ::: "memory");
    }
}

DI void cmp2_rows(const Params& P, LAS unsigned char* lds, int kv, int row0, int nblk64, int tid) {
    unsigned char* ws = P.ws;
    const float* w2 = kv ? P.w_cmp_v2 : P.w_cmp_k2; LAS float* w2s = (LAS float*)lds;
    __syncthreads();
    for (int i = tid; i < 256 * 64 / 4; i += 512) ((LAS f32x4*)w2s)[i] = ((const f32x4*)w2)[i];
    __syncthreads();
    for (int blk = 0; blk < nblk64; ++blk) {
        const int row = row0 + blk * 64 + (tid >> 3), oc = tid & 7;
        const bf16_t* hrow = (const bf16_t*)(ws + WS_HCMP) + ((size_t)kv * 4096 + row) * 256;
        float acc[8];
#pragma unroll
        for (int j = 0; j < 8; ++j) acc[j] = 0.f;
        for (int k8 = 0; k8 < 32; ++k8) { const u32x4 hv = *(const u32x4*)(hrow + k8 * 8); const unsigned hw[4] = {hv.x, hv.y, hv.z, hv.w};
#pragma unroll
            for (int q = 0; q < 4; ++q) {
#pragma unroll
                for (int hh = 0; hh < 2; ++hh) { const float hval = hh ? bfhi(hw[q]) : bflo(hw[q]); const int k = k8 * 8 + q * 2 + hh;
                    const f32x4 wa = *(const LAS f32x4*)(w2s + k * 64 + oc * 8), wb = *(const LAS f32x4*)(w2s + k * 64 + oc * 8 + 4);
                    acc[0] += hval * wa.x; acc[1] += hval * wa.y; acc[2] += hval * wa.z; acc[3] += hval * wa.w; acc[4] += hval * wb.x; acc[5] += hval * wb.y; acc[6] += hval * wb.z; acc[7] += hval * wb.w; } } }
        const int bg = row >> 9, n = row & 511;
        if (n == 511) {
#pragma unroll
            for (int j = 0; j < 8; ++j) acc[j] = 0.f; }
        if (kv == 0) { u32x4 o; o.x = pk2(acc[0], acc[1]); o.y = pk2(acc[2], acc[3]); o.z = pk2(acc[4], acc[5]); o.w = pk2(acc[6], acc[7]);
            *(u32x4*)((bf16_t*)(ws + WS_KC) + ((size_t)bg * 512 + n) * 64 + oc * 8) = o; }
        else { bf16_t* vt = (bf16_t*)(ws + WS_VCT) + (size_t)bg * 64 * 512; const int pos = (n & ~15) | (int)swap23((unsigned)n & 15u);
#pragma unroll
            for (int j = 0; j < 8; ++j) vt[(size_t)(oc * 8 + j) * 512 + pos] = (bf16_t)(pk2(acc[j], 0.f) & 0xffffu); }
    }
    __syncthreads();
}
DI void phase_cmp2(const Params& P, LAS unsigned char* lds, int vcu, int G, int wave, int lane, int tid) {
    for (int it = vcu; it < 128; it += G) cmp2_rows(P, lds, it >> 6, (it & 63) * 64, 1, tid);
    __syncthreads();
}
namespace attn {
constexpr int ROWB = 144;
constexpr int TROW = 128, TILEB = 64 * TROW;
constexpr int OFF_K = 0, OFF_V = 2 * TILEB, OFF_IMPG = 36864, OFF_IMPL = OFF_IMPG + 32768;
constexpr int OFF_SELM = LDS_TAB, OFF_MREF = LDS_TAB + 1024, OFF_LSUM = LDS_TAB + 2048, OFF_LIST = LDS_TAB + 4096, OFF_TM = LDS_TAB + 6144;
constexpr int OFF_QS = 0, OFF_PBUF = 36864, PSLOT = 32 * ROWB;
constexpr float NEG = -1e30f, MFLOOR = -1e20f;
#define MFMA32(a, b, c) __builtin_amdgcn_mfma_f32_32x32x16_bf16((a), (b), (c), 0, 0, 0)
DI float fexp2(float x) { return __builtin_amdgcn_exp2f(x); }
DI void dma_tile(const bf16_t* base, unsigned pitch, LAS unsigned char* buf, int wave, int lane) {
    const int row = 8 * wave + (lane >> 3), ch = (lane & 7) ^ ((row >> 1) & 7);
    __builtin_amdgcn_global_load_lds((const unsigned*)(base + (unsigned)(row * pitch + ch * 8)), (LAS unsigned*)(buf + wave * 1024), 16, 0, 0); }
DI bf16x8 pack8(const f32x16& p, int s2) { u32x4 w; w.x = pk2(p[8 * s2], p[8 * s2 + 1]); w.y = pk2(p[8 * s2 + 2], p[8 * s2 + 3]); w.z = pk2(p[8 * s2 + 4], p[8 * s2 + 5]); w.w = pk2(p[8 * s2 + 6], p[8 * s2 + 7]); return __builtin_bit_cast(bf16x8, w); }

constexpr int CV_PER_EXPERT = 1536, CV_TOTAL = NEXP * CV_PER_EXPERT;
struct CvState { int next, end, nfly; bool xafter; };
DI LAS unsigned char* cv_buf(LAS unsigned char* lds, int wave, int seq) { return lds + (wave < 4 ? 110592 + wave * 4096 : LDS_TAB + 8192 + (wave - 4) * 4096) + (seq & 1) * 2048; }
DI void cv_decode(int m, int& e, int& mat, int& k0, int& n0) { e = m / CV_PER_EXPERT; const int q = m % CV_PER_EXPERT; mat = q >> 9; const int w = q & 511;
    if (mat < 2) { n0 = (w >> 6) * 32; k0 = (w & 63) * 16; } else { n0 = (w >> 4) * 32; k0 = (w & 15) * 16; } }
DI void cv_issue(const Params& P, CvState& c, LAS unsigned char* lds, int wave, int lane) {
    int e, mat, k0, n0; cv_decode(c.next, e, mat, k0, n0);
    LAS unsigned* st = (LAS unsigned*)cv_buf(lds, wave, c.next);
    const int ldw = (mat < 2) ? 256 : 1024;
    const float* W = (mat == 0 ? P.w_e_gate : mat == 1 ? P.w_e_up : P.w_e_down) + (size_t)e * 1024 * 256;
    const float* src = W + (size_t)(k0 + (lane >> 3)) * ldw + n0 + 4 * (lane & 7);
#pragma unroll
    for (int j = 0; j < 2; ++j) __builtin_amdgcn_global_load_lds((const unsigned*)(src + (size_t)(8 * j) * ldw), st + j * 256, 16, 0, 0);
    ++c.nfly; ++c.next; c.xafter = true;
}
DI void cv_finish(const Params& P, CvState& c, LAS unsigned char* lds, int wave, int lane) {
    const int m = c.next - c.nfly; int e, mat, k0, n0; cv_decode(m, e, mat, k0, n0);
    const int nl = lane >> 1, kc = (lane & 1) * 8;
    const LAS float* st = (const LAS float*)cv_buf(lds, wave, m) + kc * 32 + nl;
    u32x4 o; o.x = pk2(st[0 * 32], st[1 * 32]); o.y = pk2(st[2 * 32], st[3 * 32]); o.z = pk2(st[4 * 32], st[5 * 32]); o.w = pk2(st[6 * 32], st[7 * 32]);
    const int n = n0 + nl; bf16_t* dst;
    if (mat < 2) dst = (bf16_t*)(P.ws + WS_WGU_T) + (size_t)e * 512 * 1024 + (size_t)((n >> 7) * 256 + mat * 128 + (n & 127)) * 1024 + k0 + kc;
    else dst = (bf16_t*)(P.ws + WS_WDN_T) + (size_t)e * 1024 * 256 + (size_t)n * 256 + k0 + kc;
    asm volatile("s_waitcnt lgkmcnt(0)" ::: "memory");
    *(u32x4*)dst = o; --c.nfly;
}

template <int MODE>
DI void tile_compute(const LAS unsigned char* Kb, const LAS unsigned char* Vb, const bf16x8 (&qf)[4], int r, int h, int lo, int hi, bool elem,
                     float& m, float& l, f32x16 (&O)[2], float meff_in, float linv, LAS float* impg, LAS float* impl, int sb0) {
    const bool rowfull = (lo <= 0 && hi >= 63);
    const int lo2 = lo - 4 * h, hi2 = hi - 4 * h, swz = (r >> 1) & 7;
#pragma unroll
    for (int kh = 0; kh < 2; ++kh) {
        f32x16 s;
#pragma unroll
        for (int i = 0; i < 16; ++i) s[i] = 0.f;
#pragma unroll
        for (int ks = 0; ks < 4; ++ks) { const bf16x8 a = *(const LAS bf16x8*)(Kb + (32 * kh + r) * TROW + (((2 * ks + h) ^ swz) << 4)); s = MFMA32(a, qf[ks], s); }
        if (elem) {
#pragma unroll
            for (int i = 0; i < 16; ++i) { const int k0 = (i & 3) + 8 * (i >> 2) + 32 * kh; s[i] = (k0 >= lo2 && k0 <= hi2) ? s[i] : NEG; }
        }
        float cref;
        if (MODE != 2) {
            float tm = s[0];
#pragma unroll
            for (int i = 1; i < 16; ++i) tm = fmaxf(tm, s[i]);
            tm = fmaxf(tm, __shfl_xor(tm, 32));
            if (!elem) tm = rowfull ? tm : NEG;
            const bool need = tm > m + 8.0f;
            if (__any(need)) {
                const float mnew = need ? tm : m;
                const float alpha = fexp2(fmaxf(m, MFLOOR) - fmaxf(mnew, MFLOOR));
                l *= alpha; m = mnew;
                if (MODE == 0) {
#pragma unroll
                    for (int i = 0; i < 16; ++i) { O[0][i] *= alpha; O[1][i] *= alpha; } }
            }
            cref = (elem || rowfull) ? fmaxf(m, MFLOOR) : 1e30f;
            float rs = 0.f;
#pragma unroll
            for (int i = 0; i < 16; ++i) { s[i] = fexp2(s[i] - cref); rs += s[i]; }
            rs += __shfl_xor(rs, 32);
            l += rs;
        } else {
            cref = (elem || rowfull) ? meff_in : 1e30f;
#pragma unroll
            for (int i = 0; i < 16; ++i) s[i] = fexp2(s[i] - cref);
        }
        if (MODE == 1) continue;
        if (MODE == 2) {
#pragma unroll
            for (int gq = 0; gq < 4; ++gq) {
                float Gs = ((s[4 * gq] + s[4 * gq + 1]) + (s[4 * gq + 2] + s[4 * gq + 3])) * linv, Ls = s[4 * gq + 3] * linv;
                Gs += __shfl_xor(Gs, 1); Gs += __shfl_xor(Gs, 2); Ls += __shfl_xor(Ls, 1); Ls += __shfl_xor(Ls, 2);
                if ((r & 3) == 0) { const int sb = sb0 + 8 * kh + 2 * gq + h; impg[sb] = Gs; impl[sb] = Ls; } }
        }
#pragma unroll
        for (int s2 = 0; s2 < 2; ++s2) { const bf16x8 pf = pack8(s, s2);
#pragma unroll
            for (int dt = 0; dt < 2; ++dt) { const bf16x8 a = *(const LAS bf16x8*)(Vb + (32 * dt + r) * TROW + (((4 * kh + 2 * s2 + h) ^ swz) << 4));
                O[dt] = MFMA32(a, pf, O[dt]); } }
    }
}

DI void attn_unit(const Params& P, LAS unsigned char* lds, int bg, int qt, int wave, int lane_in, int tid_in, int& it, CvState& cv) {
    int lane = lane_in; asm volatile("" : "+v"(lane));
    const int tid = wave * 64 + lane;
    unsigned char* ws = P.ws;
    const bf16_t* U = (const bf16_t*)(ws + WS_U);
    const int b = bg >> 1, gg = bg & 1, t0 = qt * 64, r = lane & 31, h = lane >> 5, tokl = 8 * wave + (r >> 2), hp = r & 3, t = t0 + tokl;
    LAS float* IMPG = (LAS float*)(lds + OFF_IMPG); LAS float* IMPL = (LAS float*)(lds + OFF_IMPL); LAS unsigned* SELM = (LAS unsigned*)(lds + OFF_SELM);
#define ATT_UROW(name) int lq_ = lane; asm volatile("" : "+v"(lq_)); const bf16_t* name = U + (size_t)(b * SEQ + t0 + 8 * wave + ((lq_ & 31) >> 2)) * NU; const int hq_ = lq_ & 3, hh_ = lq_ >> 5; (void)hq_; (void)hh_;
    bf16x8 qf[4];
#define ATT_LOADQ() do { ATT_UROW(urow_) _Pragma("unroll") for (int ks = 0; ks < 4; ++ks) qf[ks] = *(const bf16x8*)(urow_ + UQ + (4 * gg + hq_) * 64 + 16 * ks + 8 * hh_); } while (0)
    ATT_LOADQ();
    f32x16 OA[2];
#pragma unroll
    for (int i = 0; i < 16; ++i) { OA[0][i] = 0.f; OA[1][i] = 0.f; }
    __syncthreads();
#pragma unroll
    for (int j = 0; j < 4; ++j) { *(LAS f32x4*)(IMPG + 8 * wave * 128 + lane * 4 + 256 * j) = (f32x4){0.f, 0.f, 0.f, 0.f}; *(LAS f32x4*)(IMPL + 8 * wave * 128 + lane * 4 + 256 * j) = (f32x4){0.f, 0.f, 0.f, 0.f}; }
    f32x16 O[2]; float m, l;
#define ATT_RESET() do { m = NEG; l = 0.f; _Pragma("unroll") for (int i = 0; i < 16; ++i) { O[0][i] = 0.f; O[1][i] = 0.f; } } while (0)
#define ATT_FOLD(br) do { ATT_UROW(urow_) const float gate_ = fsigmoid(bf2f(urow_[UGT + gg * 12 + hq_ * 3 + (br)])); const float sc_ = (l > 0.f) ? gate_ / l : 0.f; _Pragma("unroll") for (int i = 0; i < 16; ++i) { OA[0][i] += sc_ * O[0][i]; OA[1][i] += sc_ * O[1][i]; } } while (0)

#define ATT_STEP(CUR, NXT, TI, KPTR, KPITCH, VPTR, VPITCH, USEV, ...) { \
            LAS unsigned char* Kb = lds + OFF_K + (CUR) * TILEB; LAS unsigned char* Vb = lds + OFF_V + (CUR) * TILEB; \
            int nfin_; if (cv.xafter) { asm volatile("s_waitcnt vmcnt(2)" ::: "memory"); nfin_ = cv.nfly - 1; } else { asm volatile("s_waitcnt vmcnt(0)" ::: "memory"); nfin_ = cv.nfly; } \
            for (int f_ = 0; f_ < nfin_; ++f_) cv_finish(P, cv, lds, wave, tz_); \
            asm volatile("s_waitcnt lgkmcnt(0)" ::: "memory"); __builtin_amdgcn_s_barrier(); asm volatile("" ::: "memory"); \
            if ((TI) + 1 < n_) { const int pi = (TI) + 1; dma_tile(KPTR, KPITCH, lds + OFF_K + (NXT) * TILEB, wave, tz_); if (USEV) dma_tile(VPTR, VPITCH, lds + OFF_V + (NXT) * TILEB, wave, tz_); cv.xafter = false; } \
            if (cv.next < cv.end && cv.nfly < 2) cv_issue(P, cv, lds, wave, tz_); \
            { const int ti = (TI); __VA_ARGS__ } ++it; }
#define ATT_LOOP(NTILES, KPTR, KPITCH, VPTR, VPITCH, USEV, ...) { const int n_ = (NTILES); int tz_ = lane; asm volatile("" : "+v"(tz_)); \
        asm volatile("s_waitcnt lgkmcnt(0)" ::: "memory"); __builtin_amdgcn_s_barrier(); asm volatile("" ::: "memory");     \
        if (n_ > 0) { const int pi = 0; dma_tile(KPTR, KPITCH, lds + OFF_K, wave, tz_); if (USEV) dma_tile(VPTR, VPITCH, lds + OFF_V, wave, tz_); cv.xafter = false; } \
        for (int i_ = 0; i_ < n_; i_ += 2) { \
            ATT_STEP(0, 1, i_, KPTR, KPITCH, VPTR, VPITCH, USEV, __VA_ARGS__) \
            if (i_ + 1 < n_) ATT_STEP(1, 0, i_ + 1, KPTR, KPITCH, VPTR, VPITCH, USEV, __VA_ARGS__) } }

    const bf16_t* KC = (const bf16_t*)(ws + WS_KC) + (size_t)bg * 512 * 64; const bf16_t* VCT = (const bf16_t*)(ws + WS_VCT) + (size_t)bg * 64 * 512;
    const int hin = (t - 31) >> 4;
    const int ntc = (((t0 + 32) >> 4) >> 6) + 1;
    ATT_RESET();
    ATT_LOOP(ntc, KC + (size_t)pi * 64 * 64, 64, KC, 64, false, {
        const int hi = hin - 64 * ti; const bool fe = (hi >= 63) || (hi < 0);
        if (!__all(hi < 0)) tile_compute<1>(Kb, Kb, qf, r, h, 0, hi, !__all(fe), m, l, O, 0.f, 0.f, nullptr, nullptr, 0); })
    {
        const float meff = fmaxf(m, MFLOOR), linv = (l > 0.f) ? 1.0f / l : 0.f;
        ATT_LOOP(ntc, KC + (size_t)pi * 64 * 64, 64, VCT + pi * 64, 512, true, {
            const int hi = hin - 64 * ti; const bool fe = (hi >= 63) || (hi < 0);
            float md = m, ld_ = l;
            if (!__all(hi < 0)) tile_compute<2>(Kb, Vb, qf, r, h, 0, hi, !__all(fe), md, ld_, O, meff, linv, IMPG + tokl * 128, IMPL + tokl * 128, 16 * ti); })
        ATT_FOLD(0);
    }
    for (int tk = 0; tk < 8; ++tk) { const int trow = 8 * wave + tk;
        const float ilo = IMPG[trow * 128 + lane] + (lane > 0 ? IMPL[trow * 128 + lane - 1] : 0.f), ihi = IMPG[trow * 128 + 64 + lane] + IMPL[trow * 128 + 63 + lane];
        const int slo = lane, shi = 64 + lane;
        const bool clo = slo <= qt, chi = shi <= qt, flo = (slo == 0) || (slo == qt) || (slo + 1 == qt), fhi = (shi == qt) || (shi + 1 == qt);
        const unsigned klo = clo ? ((flo ? 0xFFFFFF80u : (__float_as_uint(ilo) & 0xFFFFFF80u)) | (unsigned)(127 - slo)) : 0u;
        const unsigned khi = chi ? ((fhi ? 0xFFFFFF80u : (__float_as_uint(ihi) & 0xFFFFFF80u)) | (unsigned)(127 - shi)) : 0u;
        unsigned T = 0u;
        for (int bit = 31; bit >= 0; --bit) { const unsigned cand = T | (1u << bit);
            const int cnt = __popcll(__ballot(klo >= cand)) + __popcll(__ballot(khi >= cand)); if (cnt >= 16) T = cand; }
        const unsigned long long blo = __ballot(klo >= T && klo != 0u), bhi = __ballot(khi >= T && khi != 0u);
        if (lane == 0) { *(LAS u32x4*)(SELM + trow * 4) = (u32x4){(unsigned)blo, (unsigned)(blo >> 32), (unsigned)bhi, (unsigned)(bhi >> 32)}; }
    }
    { int lp_ = lane; asm volatile("" : "+v"(lp_)); float* oapark = (float*)(ws + WS_HIDM) + ((size_t)(blockIdx.x * 8 + wave) * 32) * 64 + lp_;
#pragma unroll
      for (int i = 0; i < 16; ++i) { oapark[i * 64] = OA[0][i]; oapark[(16 + i) * 64] = OA[1][i]; } }
    ATT_RESET();
    const bf16_t* KS = U + (size_t)(b * SEQ) * NU + UKS + gg * 64; const bf16_t* VST = (const bf16_t*)(ws + WS_VST) + (size_t)bg * 128 * 4096;
    constexpr int QT_COMPACT = 96;
    if (qt < QT_COMPACT) {
        const u32x4 selw = *(const LAS u32x4*)(SELM + tokl * 4);
        ATT_LOOP(qt + 1, KS + (size_t)pi * 64 * NU, NU, VST + (size_t)pi * 4096, 64, true, {
            const int j = ti;
            const unsigned wsel = (j < 32) ? selw.x : (j < 64) ? selw.y : (j < 96) ? selw.z : selw.w; const bool sel = (wsel >> (j & 31)) & 1u;
            const int hi = !sel ? -1 : (j == qt ? tokl : 63);
            if (!__all(!sel)) tile_compute<0>(Kb, Vb, qf, r, h, 0, hi, j == qt, m, l, O, 0.f, 0.f, nullptr, nullptr, 0); })
    } else {
        {
#define JMAP(i) ((i) == 0 ? 0 : qt - (2 - (i)))
            ATT_LOOP(3, KS + (size_t)JMAP(pi) * 64 * NU, NU, VST + (size_t)JMAP(pi) * 4096, 64, true, {
                const int j = JMAP(ti);
                tile_compute<0>(Kb, Vb, qf, r, h, 0, (j == qt ? tokl : 63), j == qt, m, l, O, 0.f, 0.f, nullptr, nullptr, 0); })
#undef JMAP
        }
        int lz = lane; asm volatile("" : "+v"(lz));
        const int r = lz & 31, h = lz >> 5, hp = r & 3, tokl = 8 * wave + (r >> 2), lane = lz, tid = wave * 64 + lz;
        LAS unsigned char* Qs = lds + OFF_QS; LAS float* MREF = (LAS float*)(lds + OFF_MREF); LAS float* LSUM = (LAS float*)(lds + OFF_LSUM); LAS int* LIST = (LAS int*)(lds + OFF_LIST) + wave * 64;
        LAS unsigned long long* TM = (LAS unsigned long long*)(lds + OFF_TM);
        if (h == 0) MREF[32 * wave + r] = fmaxf(m, MFLOOR);
        for (int j = wave; j < 128; j += 8) { const unsigned long long mk = __ballot((SELM[lane * 4 + (j >> 5)] >> (j & 31)) & 1u); if (lane == 0) TM[j] = mk; }
        __syncthreads();
#pragma unroll
        for (int q4 = 0; q4 < 4; ++q4) { const int ch = tid + 512 * q4, row = ch >> 3, c8 = ch & 7;
            *(LAS u32x4*)(Qs + row * ROWB + c8 * 16) = *(const u32x4*)(U + (size_t)(b * SEQ + t0 + (row >> 2)) * NU + UQ + (4 * gg + (row & 3)) * 64 + c8 * 8); }
        __syncthreads();
        const int jend = qt - 2; int jn = 1, rk = 0;
        const unsigned long long ltl = (1ull << tokl) - 1ull;
        int pjs = 0, pcnt = 0;
#define FAR_TM(dst, jj) { const unsigned long long tv_ = TM[(jj) <= jend ? (jj) : 0]; const unsigned lo_ = __builtin_amdgcn_readfirstlane((unsigned)tv_), hi_ = __builtin_amdgcn_readfirstlane((unsigned)(tv_ >> 32)); \
            dst = ((jj) <= jend) ? (((unsigned long long)hi_ << 32) | lo_) : 0ull; }
        for (;;) {
            int cnt = 0, used = 0, myj = -1, myc = 0; unsigned long long mymask = 0ull;
#pragma unroll
            for (int i = 0; i < 8; ++i) { const int jj = jn + i; unsigned long long mk; FAR_TM(mk, jj) const int nch = (__popcll(mk) + 7) >> 3;
                const bool take = (cnt == i) && (jj <= jend) && (used + nch <= 8);
                if (take) { if (wave >= used && wave < used + nch) { myj = jj; myc = wave - used; mymask = mk; } used += nch; ++cnt; } }
            if (cnt == 0 && pcnt == 0) break;
            const int cjs = jn; jn += cnt;
            bf16x8 kf[2][4], vf[2][4];
            if (myj >= 0) { const bf16_t* Kg = KS + (size_t)(myj * 64 + r) * NU + 8 * h; const bf16_t* Vg = VST + (size_t)myj * 4096 + r * 64 + 8 * h;
#pragma unroll
                for (int kh = 0; kh < 2; ++kh)
#pragma unroll
                    for (int ks = 0; ks < 4; ++ks) { kf[kh][ks] = *(const bf16x8*)(Kg + (size_t)(32 * kh) * NU + 16 * ks); vf[kh][ks] = *(const bf16x8*)(Vg + kh * 32 * 64 + ks * 16); } }
            if (pcnt > 0) { int base = 0;
#pragma unroll
                for (int i = 0; i < 8; ++i) { unsigned long long mk; FAR_TM(mk, pjs + i) if (i >= pcnt) mk = 0ull; const int nch = (__popcll(mk) + 7) >> 3;
                    const bool act = (mk >> tokl) & 1ull;
                    if (__any(act)) { const int rank = __popcll(mk & ltl), slot = base + (rank >> 3), prow = (rank & 7) * 4 + hp;
                        const LAS unsigned char* Pb = lds + OFF_PBUF + (((rk + 1) & 1) * 8 + slot) * PSLOT + prow * ROWB + h * 8;
#pragma unroll
                        for (int dt = 0; dt < 2; ++dt)
#pragma unroll
                            for (int gq = 0; gq < 4; ++gq) { u32x2 w = *(const LAS u32x2*)(Pb + (32 * dt + 8 * gq) * 2); if (!act) w = (u32x2){0u, 0u};
                                O[dt][4 * gq] += bflo(w.x); O[dt][4 * gq + 1] += bfhi(w.x); O[dt][4 * gq + 2] += bflo(w.y); O[dt][4 * gq + 3] += bfhi(w.y); }
                        l += act ? LSUM[(((rk + 1) & 1) * 8 + slot) * 32 + prow] : 0.f; }
                    base += nch; } }
            if (myj >= 0) {
                LAS unsigned char* Pw = lds + OFF_PBUF + ((rk & 1) * 8 + wave) * PSLOT;
                if ((mymask >> lane) & 1ull) LIST[__popcll(mymask & ((1ull << lane) - 1ull))] = lane;
                const int rank = 8 * myc + (r >> 2); const bool valid = rank < __popcll(mymask);
                const int tok = valid ? LIST[rank] : 0; const int qrow = tok * 4 + hp;
                bf16x8 qg[4];
#pragma unroll
                for (int ks = 0; ks < 4; ++ks) qg[ks] = *(const LAS bf16x8*)(Qs + qrow * ROWB + ks * 32 + h * 16);
                const float mr = MREF[qrow];
                float rs = 0.f; f32x16 Oc[2];
#pragma unroll
                for (int i = 0; i < 16; ++i) { Oc[0][i] = 0.f; Oc[1][i] = 0.f; }
#pragma unroll
                for (int kh = 0; kh < 2; ++kh) { f32x16 sv;
#pragma unroll
                    for (int i = 0; i < 16; ++i) sv[i] = 0.f;
#pragma unroll
                    for (int ks = 0; ks < 4; ++ks) sv = MFMA32(kf[kh][ks], qg[ks], sv);
#pragma unroll
                    for (int i = 0; i < 16; ++i) { sv[i] = valid ? fexp2(fminf(sv[i] - mr, 100.0f)) : 0.f; rs += sv[i]; }
#pragma unroll
                    for (int s2 = 0; s2 < 2; ++s2) { const bf16x8 pf = pack8(sv, s2);
                        Oc[0] = MFMA32(vf[0][kh * 2 + s2], pf, Oc[0]); Oc[1] = MFMA32(vf[1][kh * 2 + s2], pf, Oc[1]); } }
                rs += __shfl_xor(rs, 32);
                if (h == 0) LSUM[((rk & 1) * 8 + wave) * 32 + r] = rs;
#pragma unroll
                for (int dt = 0; dt < 2; ++dt)
#pragma unroll
                    for (int gq = 0; gq < 4; ++gq) { u32x2 w; w.x = pk2(Oc[dt][4 * gq], Oc[dt][4 * gq + 1]); w.y = pk2(Oc[dt][4 * gq + 2], Oc[dt][4 * gq + 3]);
                        *(LAS u32x2*)(Pw + r * ROWB + (32 * dt + 8 * gq + 4 * h) * 2) = w; }
            }
            __syncthreads();
            pjs = cjs; pcnt = cnt; ++rk;
        }
#undef FAR_TM
    }
    { int lp_ = lane; asm volatile("" : "+v"(lp_)); const float* oapark = (const float*)(ws + WS_HIDM) + ((size_t)(blockIdx.x * 8 + wave) * 32) * 64 + lp_;
#pragma unroll
      for (int i = 0; i < 16; ++i) { OA[0][i] = oapark[i * 64]; OA[1][i] = oapark[(16 + i) * 64]; } }
    ATT_FOLD(1);
    ATT_LOADQ();
    ATT_RESET();
    {
        int lw_ = lane; asm volatile("" : "+v"(lw_)); const int r = lw_ & 31, h = lw_ >> 5, tokl = 8 * wave + (r >> 2);
        const int jlo = qt >= 8 ? qt - 8 : 0;
        const bf16_t* KW = U + (size_t)(b * SEQ + jlo * 64) * NU + UKW + gg * 64; const bf16_t* VWT = (const bf16_t*)(ws + WS_VWT) + ((size_t)bg * 128 + jlo) * 4096;
        ATT_LOOP(qt - jlo + 1, KW + (size_t)pi * 64 * NU, NU, VWT + (size_t)pi * 4096, 64, true, {
            const int j = jlo + ti;
            const bool low = (j + 8 == qt), diag = (j == qt);
            const int lo = low ? tokl + 1 : 0, hi = diag ? tokl : 63;
            tile_compute<0>(Kb, Vb, qf, r, h, lo, hi, low || diag, m, l, O, 0.f, 0.f, nullptr, nullptr, 0); })
        ATT_FOLD(2);
    }
    int lo_ = lane; asm volatile("" : "+v"(lo_)); const int h_o = lo_ >> 5;
    bf16_t* orow = (bf16_t*)(ws + WS_CAT) + (size_t)(b * SEQ + t0 + 8 * wave + ((lo_ & 31) >> 2)) * DM + (4 * gg + (lo_ & 3)) * 64;
#pragma unroll
    for (int dt = 0; dt < 2; ++dt)
#pragma unroll
        for (int gq = 0; gq < 4; ++gq) { u32x2 w; w.x = pk2(OA[dt][4 * gq], OA[dt][4 * gq + 1]); w.y = pk2(OA[dt][4 * gq + 2], OA[dt][4 * gq + 3]);
            *(u32x2*)(orow + 32 * dt + 8 * gq + 4 * h_o) = w; }
#undef ATT_RESET
#undef ATT_FOLD
#undef ATT_LOADQ
#undef ATT_UROW
#undef ATT_LOOP
#undef ATT_STEP
}

DI void attn_phase(const Params& P, LAS unsigned char* lds, int vcu, int G, int wave, int lane, int tid) {
    int it = 0;
    CvState cv; { const int first = CV_EARLY_EXPERTS * CV_PER_EXPERT, per = (CV_TOTAL - first) / (G * 8), gw = vcu * 8 + wave; cv.next = first + gw * per; cv.end = (gw == G * 8 - 1) ? CV_TOTAL : cv.next + per; cv.nfly = 0; cv.xafter = false; }
    static constexpr unsigned char QT_TAB[32][4] = {{14,37,91,127},{30,44,68,126},{31,35,77,100},{23,48,69,125},{27,40,76,99},{10,53,79,124},{17,38,85,123},{19,32,89,122},{20,33,87,121},{29,43,70,120},{21,54,66,107},{0,58,90,119},{25,42,75,118},{22,47,74,106},{18,34,88,117},{3,51,92,105},{15,56,71,116},{11,39,93,98},{9,49,82,115},{28,36,78,114},{24,52,64,113},{16,41,84,104},{5,46,95,97},{4,59,81,112},{26,50,65,103},{8,62,72,111},{6,45,94,102},{7,55,80,96},{2,61,83,110},{13,63,67,101},{1,60,86,109},{12,57,73,108}};
    if (G == 256) {
        const int bg = vcu >> 5, s = vcu & 31;
        for (int k = 3; k >= 0; --k) { const int qt = (k == 0) ? QT_TAB[s][0] : (k == 1) ? QT_TAB[s][1] : (k == 2) ? QT_TAB[s][2] : QT_TAB[s][3]; attn_unit(P, lds, bg, qt, wave, lane, tid, it, cv); }
    } else {
        for (int ui = vcu; ui < 1024; ui += G) { const int k = ui >> 8, v = ui & 255, bg = v >> 5, s = v & 31;
            const int qt = (k == 0) ? s : (k == 1) ? 63 - s : (k == 2) ? 64 + s : 127 - s;
            attn_unit(P, lds, bg, qt, wave, lane, tid, it, cv); }
    }
    for (;;) {
        if (cv.nfly > 0) { asm volatile("s_waitcnt vmcnt(0)" ::: "memory"); while (cv.nfly > 0) cv_finish(P, cv, lds, wave, lane); }
        if (cv.next >= cv.end) break;
        cv_issue(P, cv, lds, wave, lane); if (cv.next < cv.end) cv_issue(P, cv, lds, wave, lane); }
    __syncthreads();
}
}
#ifndef CHECK_ATTN
#define CHECK_ATTN 0
#endif
#if CHECK_ATTN
constexpr int CW_ERR = 8192;
namespace attnchk {
DI float wmax(float v) {
#pragma unroll
    for (int o = 1; o < 64; o <<= 1) v = fmaxf(v, __shfl_xor(v, o));
    return v; }
DI void item(const Params& P, LAS float* scr, int bg, int t, int lane, float& se, float& sr) {
    unsigned char* ws = P.ws; const bf16_t* U = (const bf16_t*)(ws + WS_U);
    const int b = bg >> 1, gg = bg & 1;
    LAS float* q = scr; LAS float* pc = scr + 256; LAS float* sc = scr + 768;
    const bf16_t* urow = U + (size_t)(b * SEQ + t) * NU;
    for (int i = lane; i < 256; i += 64) q[i] = bf2f(urow[UQ + gg * 256 + i]);
    const bf16_t* KC = (const bf16_t*)(ws + WS_KC) + (size_t)bg * 512 * 64; const bf16_t* VCT = (const bf16_t*)(ws + WS_VCT) + (size_t)bg * 64 * 512;
    const int nvalid = t >= 31 ? ((t - 31) >> 4) + 1 : 0, cur = t >> 6;
    float oc[4], os[4], ow[4], imp0 = 0.f, imp1 = 0.f;
    for (int p = 0; p < 4; ++p) {
        float sv[8], mx = -3e38f;
        for (int i = 0; i < 8; ++i) { const int n = lane + 64 * i; float a = 0.f;
            if (n < nvalid) { for (int d = 0; d < 64; ++d) a += q[p * 64 + d] * bf2f(KC[n * 64 + d]); mx = fmaxf(mx, a); }
            sv[i] = a; }
        mx = wmax(mx); float ls = 0.f;
        for (int i = 0; i < 8; ++i) { const int n = lane + 64 * i; const float e = (n < nvalid) ? exp2f(sv[i] - mx) : 0.f; sv[i] = e; ls += e; }
        ls = wave_sum(ls); const float inv = ls > 0.f ? 1.f / ls : 0.f;
        for (int i = 0; i < 8; ++i) pc[lane + 64 * i] = sv[i] * inv;
        float o = 0.f;
        for (int n = 0; n < nvalid; ++n) { const int pos = (n & ~15) | (int)swap23((unsigned)n & 15u); o += pc[n] * bf2f(VCT[lane * 512 + pos]); }
        oc[p] = o;
        for (int k = -1; k <= 3; ++k) { const int n0 = 4 * lane + k, n1 = 4 * (lane + 64) + k;
            if (n0 >= 0 && n0 < nvalid) imp0 += pc[n0]; if (n1 < nvalid) imp1 += pc[n1]; }
    }
    const float INF = __builtin_inff();
    const int s0 = lane, s1 = lane + 64;
    const float v0 = (s0 == 0 || s0 == cur || s0 == cur - 1) ? INF : (s0 <= cur ? imp0 : -INF);
    const float v1 = (s1 == cur || s1 == cur - 1) ? INF : (s1 <= cur ? imp1 : -INF);
    int r0 = 0, r1 = 0;
    for (int j = 0; j < 128; ++j) { const float vj = (j < 64) ? __shfl(v0, j) : __shfl(v1, j - 64);
        r0 += (vj > v0 || (vj == v0 && j < s0)) ? 1 : 0; r1 += (vj > v1 || (vj == v1 && j < s1)) ? 1 : 0; }
    const unsigned long long m0 = __ballot(r0 < 16 && v0 > -INF), m1 = __ballot(r1 < 16 && v1 > -INF);
    for (int br = 0; br < 2; ++br) {
        const bf16_t* Kp = U + (size_t)(b * SEQ) * NU + (br ? UKW : UKS) + gg * 64; const bf16_t* Vp = U + (size_t)(b * SEQ) * NU + (br ? UVW : UVS) + gg * 64;
        for (int p = 0; p < 4; ++p) {
            int nk = 0; float mx = -3e38f;
            if (br == 0) {
                for (int j = 0; j < 128; ++j) { const bool on = (j < 64) ? ((m0 >> j) & 1ull) : ((m1 >> (j - 64)) & 1ull); if (!on) continue;
                    const int key = 64 * j + lane; float a = -3e38f;
                    if (key <= t) { a = 0.f; for (int d = 0; d < 64; ++d) a += q[p * 64 + d] * bf2f(Kp[(size_t)key * NU + d]); mx = fmaxf(mx, a); }
                    sc[nk * 64 + lane] = a; ++nk; }
            } else {
                for (int i = 0; i < 8; ++i) { const int key = t - 511 + lane + 64 * i; float a = -3e38f;
                    if (key >= 0 && key <= t) { a = 0.f; for (int d = 0; d < 64; ++d) a += q[p * 64 + d] * bf2f(Kp[(size_t)key * NU + d]); mx = fmaxf(mx, a); }
                    sc[i * 64 + lane] = a; }
                nk = 8;
            }
            mx = wmax(mx); float ls = 0.f;
            for (int i = 0; i < nk; ++i) { const float a = sc[i * 64 + lane]; const float e = (a > -1e38f) ? exp2f(a - mx) : 0.f; sc[i * 64 + lane] = e; ls += e; }
            ls = wave_sum(ls); const float inv = ls > 0.f ? 1.f / ls : 0.f;
            float o = 0.f;
            if (br == 0) { int idx = 0;
                for (int j = 0; j < 128; ++j) { const bool on = (j < 64) ? ((m0 >> j) & 1ull) : ((m1 >> (j - 64)) & 1ull); if (!on) continue;
                    for (int kk = 0; kk < 64; ++kk) { const float pv = sc[idx * 64 + kk]; if (pv != 0.f) o += pv * bf2f(Vp[(size_t)(64 * j + kk) * NU + lane]); }
                    ++idx; }
                os[p] = o * inv;
            } else {
                for (int i = 0; i < 8; ++i) for (int kk = 0; kk < 64; ++kk) { const int key = t - 511 + kk + 64 * i; const float pv = sc[i * 64 + kk]; if (pv != 0.f) o += pv * bf2f(Vp[(size_t)key * NU + lane]); }
                ow[p] = o * inv;
            }
        }
    }
    const bf16_t* cat = (const bf16_t*)(ws + WS_CAT) + (size_t)(b * SEQ + t) * DM;
    for (int p = 0; p < 4; ++p) {
        const float g0 = fsigmoid(bf2f(urow[UGT + gg * 12 + p * 3 + 0])), g1 = fsigmoid(bf2f(urow[UGT + gg * 12 + p * 3 + 1])), g2 = fsigmoid(bf2f(urow[UGT + gg * 12 + p * 3 + 2]));
        const float ref = g0 * oc[p] + g1 * os[p] + g2 * ow[p], got = bf2f(cat[(4 * gg + p) * 64 + lane]);
        se += (ref - got) * (ref - got); sr += ref * ref; }
}
DI void phase(const Params& P, LAS unsigned char* lds, int vcu, int G, int wave, int lane) {
    LAS float* scr = (LAS float*)(lds + wave * 8192);
    float se = 0.f, sr = 0.f;
    for (int it = vcu * 8 + wave; it < 8 * SEQ; it += G * 8) { const int bg = it / SEQ, t = it % SEQ; item(P, scr, bg, t, lane, se, sr); }
    se = wave_sum(se); sr = wave_sum(sr);
    if (lane == 0) { atomicAdd((float*)(P.ws + WS_CTL) + CW_ERR, se); atomicAdd((float*)(P.ws + WS_CTL) + CW_ERR + 1, sr); }
}
}
#endif
DI void phase_ln1(const Params& P, int vcu, int G, int wave, int lane, bf16_t* x1base) {
    const float* mod = (const float*)(P.ws + WS_MOD);
    for (int mrow = vcu * 8 + wave; mrow < NT; mrow += G * 8) { const int b = mrow / SEQ;
        const u32x2* vr = (const u32x2*)((const bf16_t*)(P.ws + WS_V1) + (size_t)mrow * DM) + lane; f32x4 v[4]; float s = 0.f;
#pragma unroll
        for (int j = 0; j < 4; ++j) { const u32x2 q = vr[64 * j]; v[j] = (f32x4){bflo(q.x), bfhi(q.x), bflo(q.y), bfhi(q.y)}; s += (v[j].x + v[j].y) + (v[j].z + v[j].w); }
        const float mean = wave_sum(s) * (1.f / DM); float s2 = 0.f;
#pragma unroll
        for (int j = 0; j < 4; ++j) { v[j] = v[j] - mean; s2 += (v[j].x * v[j].x + v[j].y * v[j].y) + (v[j].z * v[j].z + v[j].w * v[j].w); }
        const float rstd = 1.f / sqrtf(wave_sum(s2) * (1.f / DM) + LN_EPS);
        unsigned long long* o8 = (unsigned long long*)((bf16_t*)(P.ws + WS_H2) + (size_t)mrow * DM) + lane;
        unsigned long long* x8 = (unsigned long long*)(x1base + (size_t)mrow * DM) + lane;
#pragma unroll
        for (int j = 0; j < 4; ++j) { const int c0 = 4 * lane + 256 * j;
            const f32x4 g = *(const f32x4*)(P.ln1_g + c0), bb = *(const f32x4*)(P.ln1_b + c0);
            const f32x4 sh = *(const f32x4*)(mod + b * 6144 + 3 * 1024 + c0), sc = *(const f32x4*)(mod + b * 6144 + 4 * 1024 + c0);
            const f32x4 x1 = v[j] * rstd * g + bb;
            x8[64 * j] = (unsigned long long)pk2(x1.x, x1.y) | ((unsigned long long)pk2(x1.z, x1.w) << 32);
            const f32x4 y = x1 * (sc + 1.0f) + sh;
            o8[64 * j] = (unsigned long long)pk2(y.x, y.y) | ((unsigned long long)pk2(y.z, y.w) << 32); }
    }
}

DI unsigned f2ord(float f) { const unsigned u = __float_as_uint(f); return (u & 0x80000000u) ? ~u : (u | 0x80000000u); }
DI void phase_route(const Params& P, LAS unsigned char* lds, int vcu, int G, int wave, int lane, int tid) {
    unsigned char* ws = P.ws;
    LAS int* hist = (LAS int*)lds;
    const float* logit = (const float*)(ws + WS_LOGIT);
    int* tok_e = (int*)(ws + WS_TOKE); float* tok_w = (float*)(ws + WS_TOKW); int* lrank = (int*)(ws + WS_LRANK);
    { int* rt = (int*)(ws + WS_ROWTOK); for (int i = vcu * 512 + tid; i < NPAD_MAX; i += G * 512) rt[i] = 0; }
    const int hh = lane >> 5;
    float bias[4];
#pragma unroll
    for (int k = 0; k < 4; ++k) bias[k] = P.router_bias[lane + 64 * k];
    const int tpw = NT / G;
    for (int base = vcu * tpw; base < NT; base += G * tpw) {
        __syncthreads();
        if (tid < 256) hist[tid] = 0;
        __syncthreads();
        for (int tq = wave; tq < tpw; tq += 16) {
            int tkn[2]; tkn[0] = base + tq; tkn[1] = (tq + 8 < tpw) ? base + tq + 8 : base + tq;
            const bool two = (tq + 8 < tpw);
            float s[2][4], sel[2][4];
#pragma unroll
            for (int u = 0; u < 2; ++u)
#pragma unroll
                for (int k = 0; k < 4; ++k) { s[u][k] = fsigmoid(logit[(size_t)tkn[u] * 256 + lane + 64 * k]); sel[u][k] = s[u][k] + bias[k]; }
            float t1[2][4], t2[2][4];
#pragma unroll
            for (int u = 0; u < 2; ++u)
#pragma unroll
                for (int k = 0; k < 4; ++k) { t1[u][k] = sel[u][k]; t2[u][k] = -3.0e38f; }
#pragma unroll
            for (int o = 1; o < 32; o <<= 1) {
#pragma unroll
                for (int u = 0; u < 2; ++u)
#pragma unroll
                    for (int k = 0; k < 4; ++k) { const float a1 = __shfl_xor(t1[u][k], o), a2 = __shfl_xor(t2[u][k], o);
                        const float n1 = fmaxf(t1[u][k], a1), n2 = fmaxf(fminf(t1[u][k], a1), fmaxf(t2[u][k], a2)); t1[u][k] = n1; t2[u][k] = n2; } }
            unsigned key[2][4];
#pragma unroll
            for (int u = 0; u < 2; ++u) {
                float gs[8];
#pragma unroll
                for (int k = 0; k < 4; ++k) { const float mine = t1[u][k] + t2[u][k], oth = __shfl_xor(mine, 32); gs[2 * k] = hh ? oth : mine; gs[2 * k + 1] = hh ? mine : oth; }
                bool gsel[8];
#pragma unroll
                for (int a2 = 0; a2 < 8; ++a2) { int rk = 0;
#pragma unroll
                    for (int c2 = 0; c2 < 8; ++c2) rk += (gs[c2] > gs[a2] || (gs[c2] == gs[a2] && c2 < a2)) ? 1 : 0;
                    gsel[a2] = rk < 4; }
#pragma unroll
                for (int k = 0; k < 4; ++k) { const bool on = hh ? gsel[2 * k + 1] : gsel[2 * k]; key[u][k] = on ? f2ord(sel[u][k]) : 0u; }
            }
            unsigned T0 = 0u, T1 = 0u;
            for (int bit = 31; bit >= 0; --bit) { const unsigned c0 = T0 | (1u << bit), c1 = T1 | (1u << bit); int n0 = 0, n1 = 0;
#pragma unroll
                for (int k = 0; k < 4; ++k) { n0 += __popcll(__ballot(key[0][k] >= c0)); n1 += __popcll(__ballot(key[1][k] >= c1)); }
                if (n0 >= 8) T0 = c0; if (n1 >= 8) T1 = c1; }
#pragma unroll
            for (int u = 0; u < 2; ++u) { if (u == 1 && !two) break;
                const unsigned T = u ? T1 : T0;
                int ngt = 0;
#pragma unroll
                for (int k = 0; k < 4; ++k) ngt += __popcll(__ballot(key[u][k] > T));
                int need = 8 - ngt, npos = 0; const unsigned long long ltmask = (1ull << lane) - 1ull;
                bool chosen[4]; int pos[4];
#pragma unroll
                for (int k = 0; k < 4; ++k) { const unsigned long long eq = __ballot(key[u][k] == T);
                    const int myeq = __popcll(eq & ltmask); const bool ceq = (key[u][k] == T) && (myeq < need);
                    chosen[k] = (key[u][k] > T) || ceq;
                    const unsigned long long cm = __ballot(chosen[k]); pos[k] = npos + __popcll(cm & ltmask); npos += __popcll(cm);
                    const int neq = __popcll(eq); need = need > neq ? need - neq : 0; }
                float ssum = 0.f;
#pragma unroll
                for (int k = 0; k < 4; ++k) ssum += chosen[k] ? s[u][k] : 0.f;
                ssum = wave_sum(ssum);
                const float wn = 2.5f / ssum;
#pragma unroll
                for (int k = 0; k < 4; ++k) if (chosen[k]) { const int e = lane + 64 * k; const int lr = __hip_atomic_fetch_add(hist + e, 1, __ATOMIC_RELAXED, __HIP_MEMORY_SCOPE_WORKGROUP);
                    tok_e[tkn[u] * 8 + pos[k]] = e; tok_w[tkn[u] * 8 + pos[k]] = s[u][k] * wn; lrank[tkn[u] * 8 + pos[k]] = lr; }
            }
        }
        __syncthreads();
        if (tid < 256) ((int*)(ws + WS_HIST))[(base / tpw) * 256 + tid] = hist[tid];
    }
    __syncthreads();
}

DI void phase_scatter(const Params& P, LAS unsigned char* lds, int vcu, int G, int wave, int lane, int tid) {
    unsigned char* ws = P.ws;
    LAS int* sbase = (LAS int*)lds; LAS int* spad = sbase + 256; LAS int* sstart = spad + 256;
    const unsigned* hist = (const unsigned*)(ws + WS_HIST);
    const int* tok_e = (const int*)(ws + WS_TOKE); const int* lrank = (const int*)(ws + WS_LRANK);
    int* rowtok = (int*)(ws + WS_ROWTOK); int* pos_of = (int*)(ws + WS_POSOF); int* blk_e = (int*)(ws + WS_BLKE);
    const int tpw = NT / G, nslots = NT / tpw;
    for (int base = vcu * tpw; base < NT; base += G * tpw) { const int slot = base / tpw;
        __syncthreads();
        if (tid < 256) { int tot = 0, below = 0;
            for (int w2 = 0; w2 < nslots; ++w2) { const int hv = (int)hist[w2 * 256 + tid]; tot += hv; below += (w2 < slot) ? hv : 0; }
            spad[tid] = (tot + 255) & ~255; sbase[tid] = below; }
        __syncthreads();
        if (tid == 0) { int run = 0; for (int e = 0; e < 256; ++e) { sstart[e] = run; run += spad[e]; } sstart[256] = run; }
        __syncthreads();
        for (int i = tid; i < tpw * 8; i += 512) { const int a = base * 8 + i; const int e = tok_e[a]; const int pos = sstart[e] + sbase[e] + lrank[a];
            rowtok[pos] = a >> 3; pos_of[a] = pos; }
        if (slot == 0) {
            if (tid < 256) { const int b0 = sstart[tid] >> 8, b1 = (sstart[tid] + spad[tid]) >> 8; for (int bb = b0; bb < b1; ++bb) blk_e[bb] = tid; }
            if (tid == 0) blk_e[NBLK_MAX] = sstart[256] >> 8;
        }
    }
    __syncthreads();
}

DI void phase_final(const Params& P, int vcu, int G, int wave, int lane, float* dstbase) {
    unsigned char* ws = P.ws;
    const float* mod = (const float*)(ws + WS_MOD);
    const int* pos_of = (const int*)(ws + WS_POSOF); const float* tok_w = (const float*)(ws + WS_TOKW);
    const unsigned char* Y = (const unsigned char*)(ws + WS_YMOE);
    float dbg_scale = 1.0f;
#if CHECK_ATTN
    { const float se = __uint_as_float(ld_u32_agent((const unsigned*)(ws + WS_CTL) + CW_ERR)), sr = __uint_as_float(ld_u32_agent((const unsigned*)(ws + WS_CTL) + CW_ERR + 1)); const float err = sqrtf(se / fmaxf(sr, 1e-30f)); dbg_scale = 1.0f + (err < 0.005f ? 0.f : err < 0.02f ? 0.04f : err < 0.08f ? 0.055f : err < 0.3f ? 0.07f : 0.085f); }
#endif
    for (int mrow = vcu * 8 + wave; mrow < NT; mrow += G * 8) { const int b = mrow / SEQ;
        const u32x2* xr = (const u32x2*)((const bf16_t*)(ws + WS_X1) + (size_t)mrow * DM) + lane; const u32x2* sr = (const u32x2*)((const bf16_t*)(ws + WS_SH) + (size_t)mrow * DM) + lane; f32x4 v[4], ya[4];
#pragma unroll
        for (int j = 0; j < 4; ++j) { const u32x2 q = xr[64 * j], q2 = sr[64 * j]; v[j] = (f32x4){bflo(q.x), bfhi(q.x), bflo(q.y), bfhi(q.y)} * DN_ALPHA; ya[j] = (f32x4){bflo(q2.x), bfhi(q2.x), bflo(q2.y), bfhi(q2.y)}; }
        const int mypos = pos_of[(size_t)mrow * 8 + (lane & 7)]; const float myw = tok_w[(size_t)mrow * 8 + (lane & 7)];
#pragma unroll
        for (int k = 0; k < 8; ++k) { const int pos = __shfl(mypos, k); const float wk = __shfl(myw, k) * (1.0f / YMOE_SCALE);
            const unsigned* yr = (const unsigned*)(Y + (size_t)pos * DM) + lane;
#pragma unroll
            for (int j = 0; j < 4; ++j) { const int q = (int)yr[64 * j]; const f32x2 lo = __builtin_amdgcn_cvt_pk_f32_fp8(q, false), hi = __builtin_amdgcn_cvt_pk_f32_fp8(q, true);
                ya[j].x += wk * lo.x; ya[j].y += wk * lo.y; ya[j].z += wk * hi.x; ya[j].w += wk * hi.y; } }
        float s = 0.f;
#pragma unroll
        for (int j = 0; j < 4; ++j) { const f32x4 g2 = *(const f32x4*)(mod + b * 6144 + 5 * 1024 + 4 * lane + 256 * j); v[j] = v[j] + g2 * ya[j]; s += (v[j].x + v[j].y) + (v[j].z + v[j].w); }
        const float mean = wave_sum(s) * (1.f / DM); float s2 = 0.f;
#pragma unroll
        for (int j = 0; j < 4; ++j) { v[j] = v[j] - mean; s2 += (v[j].x * v[j].x + v[j].y * v[j].y) + (v[j].z * v[j].z + v[j].w * v[j].w); }
        const float rstd = 1.f / sqrtf(wave_sum(s2) * (1.f / DM) + LN_EPS);
#pragma unroll
        for (int j = 0; j < 4; ++j) { const int c0 = 4 * lane + 256 * j; const f32x4 g = *(const f32x4*)(P.ln2_g + c0), bb = *(const f32x4*)(P.ln2_b + c0);
            ((f32x4*)(dstbase + (size_t)mrow * DM) + lane)[64 * j] = (v[j] * rstd * g + bb) * dbg_scale; }
    }
}
#ifndef REP_PHASE
#define REP_PHASE -1
#endif
#ifndef MK_PER_PHASE
#define MK_PER_PHASE 0
#endif
DI void run_phase_0(const Params& P, LAS unsigned char* lds, int vcu, int G, int bx, int wave, int lane, int tid) {
    unsigned char* ws = P.ws; const float* mod = (const float*)(ws + WS_MOD); (void)mod; (void)ws;
 phase0a(P, lds, vcu, G, wave, lane, tid); }
DI void run_phase_1(const Params& P, LAS unsigned char* lds, int vcu, int G, int bx, int wave, int lane, int tid) {
    unsigned char* ws = P.ws; const float* mod = (const float*)(ws + WS_MOD); (void)mod; (void)ws;
 phase0b(P, lds, vcu, G, wave, lane, tid); }
DI void run_phase_2(const Params& P, LAS unsigned char* lds, int vcu, int G, int bx, int wave, int lane, int tid) {
    unsigned char* ws = P.ws; const float* mod = (const float*)(ws + WS_MOD); (void)mod; (void)ws;
        pg8::Gemm g{(const bf16_t*)(ws + WS_H1), (const bf16_t*)(ws + WS_WIN_T), DM, DM, DM, 128};
        pg8::DenseOrder S; S.init(g.A, DM, NT, NU, G, bx);
        pg8::EpiStoreBf16 E{(bf16_t*)(ws + WS_U), NU, 0.125f * 1.4426950408889634f, 2};
        pg8::gemm_phase<pg8::EpiStoreBf16, pg8::DenseOrder, true, false>(lds, g, S, E, nullptr);
    }
DI void run_phase_3(const Params& P, LAS unsigned char* lds, int vcu, int G, int bx, int wave, int lane, int tid) {
    unsigned char* ws = P.ws; const float* mod = (const float*)(ws + WS_MOD); (void)mod; (void)ws;
        if (bx < 32 && G > 32) {
            pg8::Gemm g{(const bf16_t*)(ws + WS_U), (const bf16_t*)(ws + WS_WC1_T), 16 * NU, 2048, 2048, NU * 2};
            pg8::CmpOrder S{G, bx, (const bf16_t*)(ws + WS_U)};
            pg8::EpiCmp E{(bf16_t*)(ws + WS_HCMP), (const float*)(ws + WS_PEB)};
            pg8::gemm_phase<pg8::EpiCmp, pg8::CmpOrder, true, false>(lds, g, S, E, nullptr);
        } else {
            const int nw = (G > 32) ? G - 32 : G, w0 = (G > 32) ? bx - 32 : bx;
            if (G <= 32) { pg8::Gemm g{(const bf16_t*)(ws + WS_U), (const bf16_t*)(ws + WS_WC1_T), 16 * NU, 2048, 2048, NU * 2};
                pg8::CmpOrder S{G, bx, (const bf16_t*)(ws + WS_U)}; pg8::EpiCmp E{(bf16_t*)(ws + WS_HCMP), (const float*)(ws + WS_PEB)};
                pg8::gemm_phase<pg8::EpiCmp, pg8::CmpOrder, true, false>(lds, g, S, E, nullptr); }
            for (int item = w0; item < 1024; item += nw) conv_item(P, lds, item, wave, lane, tid);
            if (REP_PHASE == 31) { for (int item = w0; item < 1024; item += nw) conv_item(P, lds, item, wave, lane, tid); }
            __syncthreads();
            vt_copies(P, lds, w0 * 8 + wave, nw * 8, wave, lane);
            __syncthreads();
        }
    }
DI void run_phase_4(const Params& P, LAS unsigned char* lds, int vcu, int G, int bx, int wave, int lane, int tid) {
    unsigned char* ws = P.ws; const float* mod = (const float*)(ws + WS_MOD); (void)mod; (void)ws;
 phase_cmp2(P, lds, vcu, G, wave, lane, tid); }
DI void run_phase_5(const Params& P, LAS unsigned char* lds, int vcu, int G, int bx, int wave, int lane, int tid) {
    unsigned char* ws = P.ws; const float* mod = (const float*)(ws + WS_MOD); (void)mod; (void)ws;
 attn::attn_phase(P, lds, vcu, G, wave, lane, tid); }
DI void run_phase_6(const Params& P, LAS unsigned char* lds, int vcu, int G, int bx, int wave, int lane, int tid) {
    unsigned char* ws = P.ws; const float* mod = (const float*)(ws + WS_MOD); (void)mod; (void)ws;
#if CHECK_ATTN
        attnchk::phase(P, lds, vcu, G, wave, lane); __syncthreads();
#endif
        pg8::Gemm g{(const bf16_t*)(ws + WS_CAT), (const bf16_t*)(ws + WS_WOUT_T), DM, DM, DM, 128};
        pg8::DenseOrder S; S.init(g.A, DM, NT, DM, G, bx);
        pg8::EpiResModBf16 E{P.x, (bf16_t*)(ws + WS_V1), mod + 2 * 1024, 6144};
        pg8::gemm_phase<pg8::EpiResModBf16, pg8::DenseOrder, true, false>(lds, g, S, E, nullptr);
    }
DI void run_phase_7(const Params& P, LAS unsigned char* lds, int vcu, int G, int bx, int wave, int lane, int tid) {
    unsigned char* ws = P.ws; const float* mod = (const float*)(ws + WS_MOD); (void)mod; (void)ws;
 if (REP_PHASE == 70) { phase_ln1(P, vcu, G, wave, lane, (bf16_t*)(ws + WS_HIDM)); phase_ln1(P, vcu, G, wave, lane, (bf16_t*)(ws + WS_HIDM)); }
    phase_ln1(P, vcu, G, wave, lane, (bf16_t*)(ws + WS_X1)); }
DI void run_phase_8(const Params& P, LAS unsigned char* lds, int vcu, int G, int bx, int wave, int lane, int tid) {
    unsigned char* ws = P.ws; const float* mod = (const float*)(ws + WS_MOD); (void)mod; (void)ws;
        { pg8::Gemm g{(const bf16_t*)(ws + WS_H2), (const bf16_t*)(ws + WS_WR_T), DM, DM, DM, 128};
          pg8::DenseOrder S; S.init(g.A, DM, NT, 256, G, bx);
          pg8::EpiF32 E{(float*)(ws + WS_LOGIT), 256};
          pg8::gemm_phase<pg8::EpiF32, pg8::DenseOrder, true, false>(lds, g, S, E, nullptr); }
        { pg8::Gemm g{(const bf16_t*)(ws + WS_H2), (const bf16_t*)(ws + WS_WSGU_T), DM, DM, DM, 128};
          pg8::DenseOrder S; S.init(g.A, DM, NT, 512, G, bx);
          pg8::EpiGlu E{(bf16_t*)(ws + WS_HIDS), 256};
          pg8::gemm_phase<pg8::EpiGlu, pg8::DenseOrder, true, false>(lds, g, S, E, nullptr); }
    }
DI void run_phase_9(const Params& P, LAS unsigned char* lds, int vcu, int G, int bx, int wave, int lane, int tid) {
    unsigned char* ws = P.ws; const float* mod = (const float*)(ws + WS_MOD); (void)mod; (void)ws;
        phase_route(P, lds, vcu, G, wave, lane, tid);
        if (REP_PHASE == 90) { phase_route(P, lds, vcu, G, wave, lane, tid); phase_route(P, lds, vcu, G, wave, lane, tid); }
        pg8::Gemm g{(const bf16_t*)(ws + WS_HIDS), (const bf16_t*)(ws + WS_WSD_T), 256, 256, 256, 128};
        pg8::DenseOrder S; S.init(g.A, 256, NT, DM, G, bx);
        pg8::EpiStoreBf16 E{(bf16_t*)(ws + WS_SH), DM, 1.0f, 0};
        pg8::gemm_phase<pg8::EpiStoreBf16, pg8::DenseOrder, true, false>(lds, g, S, E, nullptr);
    }
DI void run_phase_10(const Params& P, LAS unsigned char* lds, int vcu, int G, int bx, int wave, int lane, int tid) {
    unsigned char* ws = P.ws; const float* mod = (const float*)(ws + WS_MOD); (void)mod; (void)ws;
 phase_scatter(P, lds, vcu, G, wave, lane, tid); }
DI void run_phase_11(const Params& P, LAS unsigned char* lds, int vcu, int G, int bx, int wave, int lane, int tid) {
    unsigned char* ws = P.ws; const float* mod = (const float*)(ws + WS_MOD); (void)mod; (void)ws;
        const int nblk = (int)__builtin_amdgcn_readfirstlane((int)ld_u32_agent((const unsigned*)(ws + WS_BLKE) + NBLK_MAX));
        const int nunits = 2 * nblk; LAS int* tab = (LAS int*)(lds + LDS_TAB);
        { const int* rowtok = (const int*)(ws + WS_ROWTOK); int i = 0;
          for (int L = vcu; L < nunits && i < 28; L += G, ++i) { if (tid < 256) tab[i * 256 + tid] = rowtok[(L >> 1) * 256 + tid]; } }
        __syncthreads();
        pg8::Gemm g{(const bf16_t*)(ws + WS_H2), (const bf16_t*)(ws + WS_WGU_T), DM, DM, DM, 128};
        pg8::MoeOrder<2> S{G, vcu, nunits, (const int*)(ws + WS_BLKE), g.A, (size_t)0};
        pg8::EpiGlu E{(bf16_t*)(ws + WS_HIDM), 256};
        pg8::gemm_phase<pg8::EpiGlu, pg8::MoeOrder<2>, true, true>(lds, g, S, E, tab);
    }
DI void run_phase_12(const Params& P, LAS unsigned char* lds, int vcu, int G, int bx, int wave, int lane, int tid) {
    unsigned char* ws = P.ws; const float* mod = (const float*)(ws + WS_MOD); (void)mod; (void)ws;
        const int nblk = (int)__builtin_amdgcn_readfirstlane((int)ld_u32_agent((const unsigned*)(ws + WS_BLKE) + NBLK_MAX));
        pg8::Gemm g{(const bf16_t*)(ws + WS_HIDM), (const bf16_t*)(ws + WS_WDN_T), 256, 256, 256, 128};
        pg8::MoeOrder<4> S{G, vcu, 4 * nblk, (const int*)(ws + WS_BLKE), g.A, (size_t)256 * 256 * 2};
        pg8::EpiStoreFp8 E{(unsigned char*)(ws + WS_YMOE), DM, YMOE_SCALE};
        pg8::gemm_phase<pg8::EpiStoreFp8, pg8::MoeOrder<4>, true, false>(lds, g, S, E, nullptr);
    }
DI void run_phase_13(const Params& P, LAS unsigned char* lds, int vcu, int G, int bx, int wave, int lane, int tid) {
    unsigned char* ws = P.ws; const float* mod = (const float*)(ws + WS_MOD); (void)mod; (void)ws;
 if (REP_PHASE == 130) { phase_final(P, vcu, G, wave, lane, (float*)(ws + WS_HIDM)); phase_final(P, vcu, G, wave, lane, (float*)(ws + WS_HIDM)); }
    phase_final(P, vcu, G, wave, lane, P.out); }
constexpr int NPHASE = 14;
__global__ void __launch_bounds__(512, 2) nsa_conformer_moe_fwd(Params P) {
    extern __shared__ __attribute__((aligned(16))) unsigned char lds_raw[];
    LAS unsigned char* lds = (LAS unsigned char*)lds_raw;
    const int tid = threadIdx.x, lane = tid & 63, wave = __builtin_amdgcn_readfirstlane(tid >> 6);
    const int G = gridDim.x, bx = blockIdx.x, vcu = (G % 8 == 0) ? (bx % 8) * (G / 8) + bx / 8 : bx;
    unsigned char* ws = P.ws;
    volatile LAS unsigned* MISC = (volatile LAS unsigned*)(lds + LDS_MISC);
    if (tid < 64) MISC[tid] = 0u;
    __syncthreads();
    const int lo = P.ph_lo, hi = P.ph_hi;
    XcdBarrier bar; bar.bar = (unsigned*)(ws + WS_CTL) + CW_BAR; bar.x = 0; bar.st = MISC + 8;
    if (hi - lo > 1) bar = xcd_barrier_post((unsigned*)(ws + WS_CTL) + CW_BAR, MISC + 8);
#ifdef PH_ONLY
#define IN(k) ((k) == PH_ONLY && lo <= (k) && (k) < hi)
#else
#define IN(k) (lo <= (k) && (k) < hi)
#endif
#define SEAM(k) do { if (IN(k) && IN((k) + 1)) xcd_barrier(bar); } while (0)
    if (IN(0)) run_phase_0(P, lds, vcu, G, bx, wave, lane, tid);
    if (REP_PHASE == 0 && IN(0)) { run_phase_0(P, lds, vcu, G, bx, wave, lane, tid); run_phase_0(P, lds, vcu, G, bx, wave, lane, tid); }
    SEAM(0);
    if (REP_PHASE == 200 && IN(0) && IN(1)) { for (int q_ = 0; q_ < 20; ++q_) xcd_barrier(bar); }
    if (IN(1)) run_phase_1(P, lds, vcu, G, bx, wave, lane, tid);
    if (REP_PHASE == 1 && IN(1)) { run_phase_1(P, lds, vcu, G, bx, wave, lane, tid); run_phase_1(P, lds, vcu, G, bx, wave, lane, tid); }
    SEAM(1);
    if (IN(2)) run_phase_2(P, lds, vcu, G, bx, wave, lane, tid);
    if (REP_PHASE == 2 && IN(2)) { run_phase_2(P, lds, vcu, G, bx, wave, lane, tid); run_phase_2(P, lds, vcu, G, bx, wave, lane, tid); }
    SEAM(2);
    if (IN(3)) run_phase_3(P, lds, vcu, G, bx, wave, lane, tid);
    if (REP_PHASE == 3 && IN(3)) { run_phase_3(P, lds, vcu, G, bx, wave, lane, tid); run_phase_3(P, lds, vcu, G, bx, wave, lane, tid); }
    SEAM(3);
    if (IN(4)) run_phase_4(P, lds, vcu, G, bx, wave, lane, tid);
    if (REP_PHASE == 4 && IN(4)) { run_phase_4(P, lds, vcu, G, bx, wave, lane, tid); run_phase_4(P, lds, vcu, G, bx, wave, lane, tid); }
    SEAM(4);
    if (IN(5)) run_phase_5(P, lds, vcu, G, bx, wave, lane, tid);
    if (REP_PHASE == 5 && IN(5)) { run_phase_5(P, lds, vcu, G, bx, wave, lane, tid); run_phase_5(P, lds, vcu, G, bx, wave, lane, tid); }
    SEAM(5);
    if (IN(6)) run_phase_6(P, lds, vcu, G, bx, wave, lane, tid);
    if (REP_PHASE == 6 && IN(6)) { run_phase_6(P, lds, vcu, G, bx, wave, lane, tid); run_phase_6(P, lds, vcu, G, bx, wave, lane, tid); }
    SEAM(6);
    if (IN(7)) run_phase_7(P, lds, vcu, G, bx, wave, lane, tid);
    if (REP_PHASE == 7 && IN(7)) { run_phase_7(P, lds, vcu, G, bx, wave, lane, tid); run_phase_7(P, lds, vcu, G, bx, wave, lane, tid); }
    SEAM(7);
    if (IN(8)) run_phase_8(P, lds, vcu, G, bx, wave, lane, tid);
    if (REP_PHASE == 8 && IN(8)) { run_phase_8(P, lds, vcu, G, bx, wave, lane, tid); run_phase_8(P, lds, vcu, G, bx, wave, lane, tid); }
    SEAM(8);
    if (IN(9)) run_phase_9(P, lds, vcu, G, bx, wave, lane, tid);
    if (REP_PHASE == 9 && IN(9)) { run_phase_9(P, lds, vcu, G, bx, wave, lane, tid); run_phase_9(P, lds, vcu, G, bx, wave, lane, tid); }
    SEAM(9);
    if (IN(10)) run_phase_10(P, lds, vcu, G, bx, wave, lane, tid);
    if (REP_PHASE == 10 && IN(10)) { run_phase_10(P, lds, vcu, G, bx, wave, lane, tid); run_phase_10(P, lds, vcu, G, bx, wave, lane, tid); }
    SEAM(10);
    if (IN(11)) run_phase_11(P, lds, vcu, G, bx, wave, lane, tid);
    if (REP_PHASE == 11 && IN(11)) { run_phase_11(P, lds, vcu, G, bx, wave, lane, tid); run_phase_11(P, lds, vcu, G, bx, wave, lane, tid); }
    SEAM(11);
    if (IN(12)) run_phase_12(P, lds, vcu, G, bx, wave, lane, tid);
    if (REP_PHASE == 12 && IN(12)) { run_phase_12(P, lds, vcu, G, bx, wave, lane, tid); run_phase_12(P, lds, vcu, G, bx, wave, lane, tid); }
    SEAM(12);
    if (IN(13)) run_phase_13(P, lds, vcu, G, bx, wave, lane, tid);
    if (REP_PHASE == 13 && IN(13)) { run_phase_13(P, lds, vcu, G, bx, wave, lane, tid); run_phase_13(P, lds, vcu, G, bx, wave, lane, tid); }
#undef IN
#undef SEAM
}

extern "C" void kernel_launch(void* const* d_in, const int* in_sizes, int n_in, void* d_out, int out_size, void* d_ws, size_t ws_size, hipStream_t stream) {
    static int grid = 0;
    if (grid == 0) {
        if (n_in != 28 || out_size != NT * DM || ws_size < WS_END) { fprintf(stderr, "kernel_launch: unexpected arguments (n_in %d, out %d, ws %zu); nothing launched\n", n_in, out_size, ws_size); grid = -1; return; }
        int dev = 0, cus = 0, per_cu = 0;
        if (hipGetDevice(&dev) != hipSuccess || hipDeviceGetAttribute(&cus, hipDeviceAttributeMultiprocessorCount, dev) != hipSuccess) { grid = -1; return; }
        if (hipFuncSetAttribute((const void*)nsa_conformer_moe_fwd, hipFuncAttributeMaxDynamicSharedMemorySize, LDS_BYTES) != hipSuccess) { fprintf(stderr, "kernel_launch: hipFuncSetAttribute failed\n"); grid = -1; return; }
        if (hipOccupancyMaxActiveBlocksPerMultiprocessor(&per_cu, (const void*)nsa_conformer_moe_fwd, 512, LDS_BYTES) != hipSuccess || per_cu < 1) { fprintf(stderr, "kernel_launch: occupancy query says %d blocks per CU\n", per_cu); }
        (void)hipGetLastError();
        grid = cus;
    }
    if (grid < 0) return;
    (void)hipMemsetAsync((char*)d_ws + WS_CTL, 0, CTL_ZERO_BYTES, stream);
    Params p{};
    const float** pp = (const float**)&p;
    for (int i = 0; i < 28; ++i) pp[i] = (const float*)d_in[i];
    p.out = (float*)d_out; p.ws = (unsigned char*)d_ws;
#if MK_PER_PHASE
    for (int ph = 0; ph < NPHASE; ++ph) { p.ph_lo = ph; p.ph_hi = ph + 1; hipLaunchKernelGGL(nsa_conformer_moe_fwd, dim3(grid), dim3(512), LDS_BYTES, stream, p); }
#else
    p.ph_lo = 0; p.ph_hi = NPHASE;
    hipLaunchKernelGGL(nsa_conformer_moe_fwd, dim3(grid), dim3(512), LDS_BYTES, stream, p);
#endif
}
```

```cpp
#include <hip/hip_runtime.h>
#include <cstdio>
#include <cstdint>

#define DI __device__ __forceinline__
#define LAS __attribute__((address_space(3)))
#define GAS __attribute__((address_space(1)))
typedef unsigned short bf16_t;
typedef short bf16x8 __attribute__((ext_vector_type(8)));
typedef float f32x4 __attribute__((ext_vector_type(4)));
typedef float f32x16 __attribute__((ext_vector_type(16)));
typedef float f32x2 __attribute__((ext_vector_type(2)));
typedef unsigned u32x4 __attribute__((ext_vector_type(4)));
typedef unsigned u32x2 __attribute__((ext_vector_type(2)));
typedef __bf16 bf16x2_t __attribute__((ext_vector_type(2)));

constexpr int NB = 4, SEQ = 8192, DM = 1024, NT = NB * SEQ;
constexpr int NU = 2560;
constexpr int UQ = 0, UKC = 512, UVC = 640, UKS = 768, UVS = 896, UKW = 1024, UVW = 1152, UCA = 1280, UCG = 1792, UGT = 2304;
constexpr int DIN = 2328;
constexpr int NEXP = 256, DEXP = 256, TOPK = 8;
constexpr int NASSIGN = NT * TOPK;
constexpr int NPAD_MAX = NASSIGN + NEXP * 255 + 1;
constexpr int NBLK_MAX = NPAD_MAX / 256 + 1;
constexpr float LN_EPS = 1e-5f;
constexpr float YMOE_SCALE = 16.0f;
constexpr float DN_ALPHA = 1.189207115002721f;

DI unsigned pk2(float lo, float hi) { f32x2 v = {lo, hi}; bf16x2_t b = __builtin_convertvector(v, bf16x2_t); return __builtin_bit_cast(unsigned, b); }
DI float bflo(unsigned w) { return __uint_as_float(w << 16); }
DI float bfhi(unsigned w) { return __uint_as_float(w & 0xffff0000u); }
DI float bf2f(bf16_t b) { return __uint_as_float(((unsigned)b) << 16); }
DI float fsigmoid(float x) { return __builtin_amdgcn_rcpf(1.0f + __expf(-x)); }
DI float fsilu(float x) { return x * __builtin_amdgcn_rcpf(1.0f + __expf(-x)); }
DI float wave_sum(float v) {
#pragma unroll
    for (int o = 1; o < 64; o <<= 1) v += __shfl_xor(v, o);
    return v;
}
DI unsigned ld_u32_agent(const unsigned* p) { return __hip_atomic_load(p, __ATOMIC_RELAXED, __HIP_MEMORY_SCOPE_AGENT); }
#define LDS_WAIT() asm volatile("s_waitcnt lgkmcnt(0)" ::: "memory")
#define VM_WAIT() asm volatile("s_waitcnt vmcnt(0)" ::: "memory")

#define XB_TMO      128
#define XB_XCNT(j)  (256  + 64 * (j))
#define XB_XSUB(j)  (1280 + 64 * (j))
#define XB_XGEN(j)  (2304 + 64 * (j))
#define XB_TOP      3328
#define XB_TOPGEN   3392
#define XCD_BAR_WORDS 3456
#define XB_SPIN_CAP (1u << 18)
__device__ __forceinline__ unsigned xb_ld(unsigned* p)              { return __hip_atomic_load(p, __ATOMIC_RELAXED, __HIP_MEMORY_SCOPE_AGENT); }
__device__ __forceinline__ unsigned xb_add(unsigned* p, unsigned v) { return __hip_atomic_fetch_add(p, v, __ATOMIC_RELAXED, __HIP_MEMORY_SCOPE_AGENT); }
__device__ __forceinline__ unsigned xb_xcc_id() { return (unsigned)__builtin_amdgcn_s_getreg((3 << 11) | 20) & 0xFu; }
#define XB_SPIN(cond, bar) do { unsigned _sp = 0; while (cond) { __builtin_amdgcn_s_sleep(1); \
    if ((++_sp & 255u) == 0u) { if (xb_ld(&(bar)[XB_TMO])) break; if (_sp > XB_SPIN_CAP) { atomicAdd(&(bar)[XB_TMO], 1u); break; } } } } while (0)
struct XcdBarrier { unsigned* bar; unsigned x; volatile LAS unsigned* st; };
__device__ __forceinline__ XcdBarrier xcd_barrier_post(unsigned* bar, volatile LAS unsigned* st) {
    XcdBarrier b; b.bar = bar; b.x = xb_xcc_id(); b.st = st;
    if (threadIdx.x == 0) (void)xb_add(&bar[XB_XCNT(b.x)], 1u);
    return b;
}
__device__ __forceinline__ void xcd_barrier_complete(unsigned* bar, unsigned x, unsigned& nloc, unsigned& nx) {
    const unsigned G = gridDim.x * gridDim.y * gridDim.z;
    unsigned sum, cnt, mine, sp = 0u;
    for (;;) {
        sum = 0u; cnt = 0u; mine = 0u;
#pragma unroll
        for (unsigned j = 0; j < 16; ++j) { const unsigned c = xb_ld(&bar[XB_XCNT(j)]); sum += c; cnt += (c > 0u) ? 1u : 0u; mine = (j == x) ? c : mine; }
        if (sum == G) break;
        __builtin_amdgcn_s_sleep(1);
        if ((++sp & 255u) == 0u) { if (xb_ld(&bar[XB_TMO])) break; if (sp > XB_SPIN_CAP) { atomicAdd(&bar[XB_TMO], 1u); break; } }
    }
    nloc = mine > 0u ? mine : 1u; nx = cnt > 0u ? cnt : 1u;
}
__device__ __forceinline__ void xcd_barrier(const XcdBarrier& b) {
    asm volatile("s_waitcnt vmcnt(0)" ::: "memory");
    __syncthreads();
    if (threadIdx.x == 0) {
        unsigned* bar = b.bar;
        __builtin_amdgcn_s_waitcnt(0);
        unsigned nloc = b.st[0], nx = b.st[1];
        if (nloc == 0u) { xcd_barrier_complete(bar, b.x, nloc, nx); b.st[0] = nloc; b.st[1] = nx; }
        const unsigned old = xb_add(&bar[XB_XSUB(b.x)], 1u);
        const unsigned gen = old / nloc;
        if (old + 1u == (gen + 1u) * nloc) {
            __builtin_amdgcn_fence(__ATOMIC_RELEASE, "agent");
            asm volatile("s_waitcnt vmcnt(0)" ::: "memory");
            const unsigned og = xb_add(&bar[XB_TOP], 1u);
            const unsigned tg = og / nx;
            if (og + 1u == (tg + 1u) * nx) xb_add(&bar[XB_TOPGEN], 1u);
            else XB_SPIN(xb_ld(&bar[XB_TOPGEN]) == tg, bar);
            __builtin_amdgcn_fence(__ATOMIC_ACQUIRE, "agent");
            xb_add(&bar[XB_XGEN(b.x)], 1u);
            asm volatile("s_waitcnt vmcnt(0)" ::: "memory");
        } else {
            XB_SPIN(xb_ld(&bar[XB_XGEN(b.x)]) == gen, bar);
            __builtin_amdgcn_fence(__ATOMIC_ACQUIRE, "agent");
            asm volatile("s_waitcnt vmcnt(0)" ::: "memory");
        }
    }
    __syncthreads();
}

namespace pg8 {
constexpr int BM = 256, BK = 64, HALF = 128, HTB = HALF * BK * 2, STAGE_BYTES = 8 * HTB, NXCD = 8, WGM = 8;
__host__ __device__ __forceinline__ int lds_byte(int r, int c) { const int st = (r >> 4) * 2 + (c >> 5), rr = r & 15, cc = c & 31, ob = rr * 64 + cc * 2; return st * 1024 + (ob ^ (((ob >> 9) & 1) << 5)); }
__host__ __device__ __forceinline__ void stage_rc(int b, int& R, int& C) { const int st = b / 1024, sb = b % 1024, swz = sb ^ (((sb >> 9) & 1) << 5); R = (st >> 1) * 16 + swz / 64; C = (st & 1) * 32 + (swz % 64) / 2; }
__host__ __device__ __forceinline__ int perm32(int rho) { const int n = rho >> 4, i = rho & 15; return 8 * (i >> 2) + 4 * n + (i & 3); }

struct Unit { int pm, pn, po; };
struct Gemm { const bf16_t* A; const bf16_t* Bt; int lda, ldb, K, kstepA; };

struct DenseOrder {
    int nM, nN, nwg, G, c; const bf16_t* A; size_t tstepA;
    DI void init(const bf16_t* A_, int lda, int M, int N, int G_, int c_) { nM = M / BM; nN = N / BM; nwg = nM * nN; G = G_; c = c_; A = A_; tstepA = (size_t)BM * lda * 2; }
    DI bool next(int i, Unit& u) const {
        const long L = (long)i * G + c; if (L >= nwg) return false;
        int wgid = (int)L; { const int q = nwg / NXCD, r = nwg % NXCD, xcd = wgid % NXCD, off = wgid / NXCD; wgid = (xcd < r ? xcd * (q + 1) : r * (q + 1) + (xcd - r) * q) + off; }
        const int nig = WGM * nN, gid = wgid / nig, fm = gid * WGM, gsz = (nM - fm) < WGM ? (nM - fm) : WGM;
        u.pm = fm + ((wgid % nig) % gsz); u.pn = (wgid % nig) / gsz; u.po = u.pn; return true;
    }
    DI const char* abase(const Unit& u) const { return (const char*)A + (size_t)u.pm * tstepA; }
};

DI unsigned cvt_pk_bf16(float lo, float hi) { return pk2(lo, hi); }

template <class Epi, class Sched, bool ALIGN_EPI, bool GATHER>
__device__ __forceinline__ void gemm_phase(LAS unsigned char* lds, const Gemm g, const Sched& S, const Epi& E, const LAS int* rowidx  ) {
    const int tid = threadIdx.x, wid = __builtin_amdgcn_readfirstlane(tid >> 6), lane = tid & 63, wr = wid >> 2, wc = wid & 3, fr = lane & 15, fq = lane >> 4;
    const int K = g.K; int nt = K / BK; asm volatile("" : "+s"(nt));
    unsigned voffA[2], voffB[2]; int RA[2], CA[2];
#pragma unroll
    for (int i = 0; i < 2; ++i) { int R, C; stage_rc(tid * 16 + i * 8192, R, C); const int Rb = Epi::PERM ? ((R & ~31) + perm32(R & 31)) : R;
        RA[i] = R; CA[i] = C; voffA[i] = (unsigned)(R * g.lda + C) * 2u; voffB[i] = (unsigned)(Rb * g.ldb + C) * 2u; }
    const size_t kstepA = (size_t)g.kstepA, kstepB = (size_t)(BK * 2);
    const size_t hstepA = (size_t)HALF * g.lda * 2, hstepB = (size_t)HALF * g.ldb * 2;
    const size_t tstepB = 2 * hstepB;
    const unsigned ldsw = (unsigned)wid * 1024u;
    const int aoff = lds_byte(wr * 64 + fr, fq * 8), boff = lds_byte(wc * 32 + fr, fq * 8);
#define PG8_SA(b, h) (((b) * 2 + (h)) * HTB)
#define PG8_SB(b, h) ((4 + (b) * 2 + (h)) * HTB)
#define PG8_STAGE(bufoff, gbase, voff) do { _Pragma("unroll") for (int _i = 0; _i < 2; ++_i) \
        __builtin_amdgcn_global_load_lds((const unsigned*)((const char*)(gbase) + (voff)[_i]), (LAS unsigned*)(lds + (bufoff) + ldsw + _i * 8192), 16, 0, 0); } while (0)
#define PG8_LDA(dst, b, h) do { _Pragma("unroll") for (int m = 0; m < 4; ++m) _Pragma("unroll") for (int k = 0; k < 2; ++k) dst[m][k] = *(const LAS bf16x8*)(lds + PG8_SA(b, h) + aoff + m * 2048 + k * 1024); } while (0)
#define PG8_LDB(dst, b, h) do { _Pragma("unroll") for (int n = 0; n < 2; ++n) _Pragma("unroll") for (int k = 0; k < 2; ++k) dst[n][k] = *(const LAS bf16x8*)(lds + PG8_SB(b, h) + boff + n * 2048 + k * 1024); } while (0)
#define PG8_MMA(ai, bj, At, Bt) do { __builtin_amdgcn_s_setprio(1); _Pragma("unroll") for (int m = 0; m < 4; ++m) _Pragma("unroll") for (int n = 0; n < 2; ++n) _Pragma("unroll") for (int k = 0; k < 2; ++k) \
        acc[ai][bj][m][n] = __builtin_amdgcn_mfma_f32_16x16x32_bf16(Bt[n][k], At[m][k], acc[ai][bj][m][n], 0, 0, 0); __builtin_amdgcn_s_setprio(0); } while (0)
#define PG8_WAIT_V(n) asm volatile("s_waitcnt vmcnt(" #n ")" ::: "memory")
#define PG8_WAIT_L(n) asm volatile("s_waitcnt lgkmcnt(" #n ")" ::: "memory")
#define PG8_BAR __builtin_amdgcn_s_barrier()
#define PG8_SCHED __builtin_amdgcn_sched_barrier(0)
    Unit cur, nxt; int ui = 0;
    if (!S.next(0, cur)) return;
    f32x4 acc[2][2][4][2];
#pragma unroll
    for (int a = 0; a < 2; ++a)
#pragma unroll
        for (int b = 0; b < 2; ++b)
#pragma unroll
            for (int m = 0; m < 4; ++m)
#pragma unroll
                for (int n = 0; n < 2; ++n) acc[a][b][m][n] = (f32x4){0.f, 0.f, 0.f, 0.f};
    bf16x8 At[4][2], B0[2][2], B1[2][2];
    unsigned cg0[2], cg1[2], ng0[2], ng1[2];
    const char* cA; const char* cB = (const char*)g.Bt + (size_t)cur.pn * tstepB;
    if constexpr (GATHER) {
        cA = (const char*)g.A;
#pragma unroll
        for (int i = 0; i < 2; ++i) { cg0[i] = (unsigned)(rowidx[ui * 256 + RA[i]] * g.lda + CA[i]) * 2u; cg1[i] = (unsigned)(rowidx[ui * 256 + 128 + RA[i]] * g.lda + CA[i]) * 2u; ng0[i] = cg0[i]; ng1[i] = cg1[i]; }
    } else { cA = S.abase(cur); cg0[0] = cg0[1] = cg1[0] = cg1[1] = ng0[0] = ng0[1] = ng1[0] = ng1[1] = 0u; }
#define PG8_STAGE_A(bufoff, base, h, og0, og1) do { if constexpr (GATHER) { if ((h) == 0) PG8_STAGE(bufoff, base, og0); else PG8_STAGE(bufoff, base, og1); } \
        else { PG8_STAGE(bufoff, (base) + ((h) ? hstepA : (size_t)0), voffA); } } while (0)
    PG8_STAGE(PG8_SB(0, 0), cB, voffB); PG8_STAGE(PG8_SB(0, 1), cB + hstepB, voffB); PG8_STAGE_A(PG8_SA(0, 0), cA, 0, cg0, cg1); PG8_STAGE_A(PG8_SA(0, 1), cA, 1, cg0, cg1);
    if (wr == 1) PG8_BAR;
    PG8_WAIT_V(2); PG8_BAR;
    PG8_STAGE(PG8_SB(1, 0), cB + kstepB, voffB); PG8_STAGE_A(PG8_SA(1, 0), cA + kstepA, 0, cg0, cg1); PG8_STAGE(PG8_SB(1, 1), cB + hstepB + kstepB, voffB);
    PG8_WAIT_V(6); PG8_BAR;
    for (;;) {
        const bool has_next = S.next(ui + 1, nxt);
        const char* nA; const char* nB = has_next ? (const char*)g.Bt + (size_t)nxt.pn * tstepB : cB;
        if constexpr (GATHER) {
            nA = cA;
            if (has_next) {
#pragma unroll
                for (int i = 0; i < 2; ++i) { ng0[i] = (unsigned)(rowidx[(ui + 1) * 256 + RA[i]] * g.lda + CA[i]) * 2u; ng1[i] = (unsigned)(rowidx[(ui + 1) * 256 + 128 + RA[i]] * g.lda + CA[i]) * 2u; }
            } else {
#pragma unroll
                for (int i = 0; i < 2; ++i) { ng0[i] = cg0[i]; ng1[i] = cg1[i]; }
            }
        } else { nA = has_next ? S.abase(nxt) : cA; }
        for (int t = 0; t < nt; t += 2) {
            const bool last = (t == nt - 2);
            const char* a1 = cA + (size_t)(t + 1) * kstepA;
            const char* a2 = last ? nA : cA + (size_t)(t + 2) * kstepA; const char* b2 = last ? nB : cB + (size_t)(t + 2) * kstepB;
            const char* a3 = a2 + kstepA; const char* b3 = b2 + kstepB;
            unsigned xg0[2], xg1[2];
#pragma unroll
            for (int i = 0; i < 2; ++i) { xg0[i] = last ? ng0[i] : cg0[i]; xg1[i] = last ? ng1[i] : cg1[i]; }
            PG8_LDB(B0, 0, 0); PG8_LDB(B1, 0, 1); PG8_SCHED; PG8_LDA(At, 0, 0); PG8_STAGE_A(PG8_SA(1, 1), a1, 1, cg0, cg1);
            PG8_WAIT_V(8); PG8_WAIT_L(0); PG8_BAR; PG8_MMA(0, 0, At, B0); PG8_MMA(0, 1, At, B1); PG8_BAR; PG8_SCHED;
            PG8_LDA(At, 0, 1); PG8_STAGE(PG8_SB(0, 0), b2, voffB); PG8_STAGE(PG8_SB(0, 1), b2 + hstepB, voffB); PG8_STAGE_A(PG8_SA(0, 0), a2, 0, xg0, xg1);
            PG8_WAIT_V(8); PG8_WAIT_L(0); PG8_BAR; PG8_MMA(1, 0, At, B0); PG8_MMA(1, 1, At, B1); PG8_BAR; PG8_SCHED;
            PG8_LDB(B0, 1, 0); PG8_LDB(B1, 1, 1); PG8_SCHED; PG8_LDA(At, 1, 0); PG8_STAGE_A(PG8_SA(0, 1), a2, 1, xg0, xg1);
            PG8_WAIT_V(8); PG8_WAIT_L(0); PG8_BAR; PG8_MMA(0, 0, At, B0); PG8_MMA(0, 1, At, B1); PG8_BAR; PG8_SCHED;
            PG8_LDA(At, 1, 1); PG8_STAGE(PG8_SB(1, 0), b3, voffB); PG8_STAGE(PG8_SB(1, 1), b3 + hstepB, voffB); PG8_STAGE_A(PG8_SA(1, 0), a3, 0, xg0, xg1);
            PG8_WAIT_V(8); PG8_WAIT_L(0); PG8_BAR; PG8_MMA(1, 0, At, B0); PG8_MMA(1, 1, At, B1); PG8_BAR; PG8_SCHED;
        }
        if constexpr (ALIGN_EPI) { if (wr == 0) PG8_BAR; }
        E(acc, cur, wr, wc, fr, fq, wid, lane);
        if (!has_next) break;
#pragma unroll
        for (int a = 0; a < 2; ++a)
#pragma unroll
            for (int b = 0; b < 2; ++b)
#pragma unroll
                for (int m = 0; m < 4; ++m)
#pragma unroll
                    for (int n = 0; n < 2; ++n) acc[a][b][m][n] = (f32x4){0.f, 0.f, 0.f, 0.f};
        cur = nxt; cA = nA; cB = nB; ++ui;
#pragma unroll
        for (int i = 0; i < 2; ++i) { cg0[i] = ng0[i]; cg1[i] = ng1[i]; }
        if constexpr (ALIGN_EPI) { if (wr == 1) PG8_BAR; }
    }
    PG8_WAIT_V(0);
    if constexpr (!ALIGN_EPI) { if (wr == 0) PG8_BAR; }
    PG8_BAR;
#undef PG8_SA
#undef PG8_SB
#undef PG8_STAGE
#undef PG8_STAGE_A
#undef PG8_LDA
#undef PG8_LDB
#undef PG8_MMA
#undef PG8_WAIT_V
#undef PG8_WAIT_L
#undef PG8_BAR
#undef PG8_SCHED
}
}
namespace pg8 {
typedef f32x4 AccT[2][2][4][2];

struct EpiStoreBf16 {
    static constexpr bool PERM = true;
    bf16_t* O; int ldc; float scale0; int ntile0;
    DI void operator()(AccT& acc, const Unit& u, int wr, int wc, int fr, int fq, int wid, int lane) const {
        const int row0 = u.pm * BM + wr * 64 + fr, col0 = u.po * BM + wc * 32 + 8 * fq; const float sc = (u.po < ntile0) ? scale0 : 1.0f;
#pragma unroll
        for (int ai = 0; ai < 2; ++ai)
#pragma unroll
            for (int m = 0; m < 4; ++m) { bf16_t* rowp = O + (size_t)(row0 + ai * HALF + m * 16) * ldc + col0;
#pragma unroll
                for (int bj = 0; bj < 2; ++bj) { const f32x4 v0 = acc[ai][bj][m][0] * sc, v1 = acc[ai][bj][m][1] * sc;
                    u32x4 w; w.x = pk2(v0[0], v0[1]); w.y = pk2(v0[2], v0[3]); w.z = pk2(v1[0], v1[1]); w.w = pk2(v1[2], v1[3]);
                    *(u32x4*)(rowp + bj * HALF) = w; } }
    }
};
struct EpiStoreFp8 {
    static constexpr bool PERM = true;
    unsigned char* O; int ldc; float scale;
    DI void operator()(AccT& acc, const Unit& u, int wr, int wc, int fr, int fq, int wid, int lane) const {
        const int row0 = u.pm * BM + wr * 64 + fr, col0 = u.po * BM + wc * 32 + 8 * fq;
#pragma unroll
        for (int ai = 0; ai < 2; ++ai)
#pragma unroll
            for (int m = 0; m < 4; ++m) { unsigned char* rowp = O + (size_t)(row0 + ai * HALF + m * 16) * ldc + col0;
#pragma unroll
                for (int bj = 0; bj < 2; ++bj) { const f32x4 v0 = acc[ai][bj][m][0] * scale, v1 = acc[ai][bj][m][1] * scale;
                    int w0 = 0, w1 = 0;
                    w0 = __builtin_amdgcn_cvt_pk_fp8_f32(v0[0], v0[1], w0, false); w0 = __builtin_amdgcn_cvt_pk_fp8_f32(v0[2], v0[3], w0, true);
                    w1 = __builtin_amdgcn_cvt_pk_fp8_f32(v1[0], v1[1], w1, false); w1 = __builtin_amdgcn_cvt_pk_fp8_f32(v1[2], v1[3], w1, true);
                    *(u32x2*)(rowp + bj * HALF) = (u32x2){(unsigned)w0, (unsigned)w1}; } }
    }
};
DI float gelu_tanh(float x) { const float u = 0.7978845608028654f * (x + 0.044715f * x * x * x); const float e = __expf(2.0f * u); const float th = 1.0f - 2.0f / (e + 1.0f); return 0.5f * x * (1.0f + th); }
struct EpiCmp {
    static constexpr bool PERM = true;
    bf16_t* O; const float* peb;
    DI void operator()(AccT& acc, const Unit& u, int wr, int wc, int fr, int fq, int wid, int lane) const {
        const int row0 = u.pm * BM + wr * 64 + fr, col0 = wc * 32 + 8 * fq; const float* pb = peb + (u.pm >> 4) * 256;
        f32x4 bv[2][2];
#pragma unroll
        for (int bj = 0; bj < 2; ++bj)
#pragma unroll
            for (int n = 0; n < 2; ++n) bv[bj][n] = *(const f32x4*)(pb + col0 + bj * HALF + 4 * n);
#pragma unroll
        for (int ai = 0; ai < 2; ++ai)
#pragma unroll
            for (int m = 0; m < 4; ++m) { bf16_t* rowp = O + (size_t)(row0 + ai * HALF + m * 16) * 256 + col0;
#pragma unroll
                for (int bj = 0; bj < 2; ++bj) { f32x4 v0 = acc[ai][bj][m][0] + bv[bj][0], v1 = acc[ai][bj][m][1] + bv[bj][1];
#pragma unroll
                    for (int j = 0; j < 4; ++j) { v0[j] = gelu_tanh(v0[j]); v1[j] = gelu_tanh(v1[j]); }
                    u32x4 w; w.x = pk2(v0[0], v0[1]); w.y = pk2(v0[2], v0[3]); w.z = pk2(v1[0], v1[1]); w.w = pk2(v1[2], v1[3]);
                    *(u32x4*)(rowp + bj * HALF) = w; } }
    }
};
struct EpiF32 {
    static constexpr bool PERM = false;
    float* C; int ldc;
    DI void operator()(AccT& acc, const Unit& u, int wr, int wc, int fr, int fq, int wid, int lane) const {
        const int row0 = u.pm * BM + wr * 64 + fr, col0 = u.po * BM + wc * 32 + 4 * fq;
#pragma unroll
        for (int ai = 0; ai < 2; ++ai)
#pragma unroll
            for (int m = 0; m < 4; ++m) { float* rowp = C + (size_t)(row0 + ai * HALF + m * 16) * ldc + col0;
#pragma unroll
                for (int bj = 0; bj < 2; ++bj)
#pragma unroll
                    for (int n = 0; n < 2; ++n) *(f32x4*)(rowp + bj * HALF + n * 16) = acc[ai][bj][m][n]; }
    }
};
struct EpiResMod {
    static constexpr bool PERM = false;
    const float* base; float* out; const float* gate; int gate_pitch;
    DI void operator()(AccT& acc, const Unit& u, int wr, int wc, int fr, int fq, int wid, int lane) const {
        const int row0 = u.pm * BM + wr * 64 + fr, col0 = u.po * BM + wc * 32 + 4 * fq;
        const float* gp = gate + (size_t)((u.pm * BM) / SEQ) * gate_pitch + col0;
        f32x4 gv[2][2];
#pragma unroll
        for (int bj = 0; bj < 2; ++bj)
#pragma unroll
            for (int n = 0; n < 2; ++n) gv[bj][n] = *(const f32x4*)(gp + bj * HALF + n * 16);
#pragma unroll
        for (int ai = 0; ai < 2; ++ai)
#pragma unroll
            for (int m = 0; m < 4; ++m) { const size_t off = (size_t)(row0 + ai * HALF + m * 16) * DM + col0;
#pragma unroll
                for (int bj = 0; bj < 2; ++bj)
#pragma unroll
                    for (int n = 0; n < 2; ++n) { const f32x4 bs = *(const f32x4*)(base + off + bj * HALF + n * 16);
                        *(f32x4*)(out + off + bj * HALF + n * 16) = bs * DN_ALPHA + gv[bj][n] * acc[ai][bj][m][n]; } }
    }
};
struct EpiResModBf16 {
    static constexpr bool PERM = false;
    const float* base; bf16_t* out; const float* gate; int gate_pitch;
    DI void operator()(AccT& acc, const Unit& u, int wr, int wc, int fr, int fq, int wid, int lane) const {
        const int row0 = u.pm * BM + wr * 64 + fr, col0 = u.po * BM + wc * 32 + 4 * fq;
        const float* gp = gate + (size_t)((u.pm * BM) / SEQ) * gate_pitch + col0;
        f32x4 gv[2][2];
#pragma unroll
        for (int bj = 0; bj < 2; ++bj)
#pragma unroll
            for (int n = 0; n < 2; ++n) gv[bj][n] = *(const f32x4*)(gp + bj * HALF + n * 16);
#pragma unroll
        for (int ai = 0; ai < 2; ++ai)
#pragma unroll
            for (int m = 0; m < 4; ++m) { const size_t off = (size_t)(row0 + ai * HALF + m * 16) * DM + col0;
#pragma unroll
                for (int bj = 0; bj < 2; ++bj)
#pragma unroll
                    for (int n = 0; n < 2; ++n) { const f32x4 bs = *(const f32x4*)(base + off + bj * HALF + n * 16); const f32x4 v = bs * DN_ALPHA + gv[bj][n] * acc[ai][bj][m][n];
                        *(u32x2*)(out + off + bj * HALF + n * 16) = (u32x2){pk2(v.x, v.y), pk2(v.z, v.w)}; } }
    }
};
struct RoundOrder {
    DenseOrder base; int round;
    DI bool next(int i, Unit& u) const { return i == 0 ? base.next(round, u) : false; }
    DI const char* abase(const Unit& u) const { return base.abase(u); }
};
struct EpiLnFused {
    static constexpr bool PERM = false;
    const float* x; const float* g1; const float* sh2; const float* sc2; int mod_pitch; const float* lng; const float* lnb; bf16_t* X1; bf16_t* H2;
    unsigned long long* slots; unsigned* cnt; unsigned* tmo; LAS unsigned char* tab;
    DI void operator()(AccT& acc, const Unit& u, int wr, int wc, int fr, int fq, int wid, int lane) const {
        typedef float f32x2v __attribute__((ext_vector_type(2)));
        LAS f32x2v* Pt = (LAS f32x2v*)tab; LAS f32x2v* St = (LAS f32x2v*)(tab + 8192);
        const int tid = wid * 64 + lane, b = (u.pm * BM) / SEQ;
        const int row0 = u.pm * BM + wr * 64 + fr, col0 = u.po * BM + wc * 32 + 4 * fq;
#pragma unroll
        for (int bj = 0; bj < 2; ++bj)
#pragma unroll
            for (int n = 0; n < 2; ++n) { const f32x4 gv = *(const f32x4*)(g1 + (size_t)b * mod_pitch + col0 + bj * HALF + n * 16);
#pragma unroll
                for (int ai = 0; ai < 2; ++ai)
#pragma unroll
                    for (int m = 0; m < 4; ++m) { const f32x4 bs = *(const f32x4*)(x + (size_t)(row0 + ai * HALF + m * 16) * DM + col0 + bj * HALF + n * 16);
                        acc[ai][bj][m][n] = bs * DN_ALPHA + gv * acc[ai][bj][m][n]; }
                asm volatile("" : "+v"(acc[0][bj][0][n]), "+v"(acc[0][bj][1][n]), "+v"(acc[0][bj][2][n]), "+v"(acc[0][bj][3][n]), "+v"(acc[1][bj][0][n]), "+v"(acc[1][bj][1][n]), "+v"(acc[1][bj][2][n]), "+v"(acc[1][bj][3][n]) :: "memory"); }
#pragma unroll
        for (int ai = 0; ai < 2; ++ai)
#pragma unroll
            for (int m = 0; m < 4; ++m) { float s1 = 0.f, s2 = 0.f;
#pragma unroll
                for (int bj = 0; bj < 2; ++bj)
#pragma unroll
                    for (int n = 0; n < 2; ++n) { const f32x4 q = acc[ai][bj][m][n]; s1 += (q[0] + q[1]) + (q[2] + q[3]); s2 += (q[0] * q[0] + q[1] * q[1]) + (q[2] * q[2] + q[3] * q[3]); }
                s1 += __shfl_xor(s1, 16); s1 += __shfl_xor(s1, 32); s2 += __shfl_xor(s2, 16); s2 += __shfl_xor(s2, 32);
                if (fq == 0) Pt[(ai * HALF + wr * 64 + m * 16 + fr) * 4 + wc] = (f32x2v){s1, s2}; }
        asm volatile("s_waitcnt lgkmcnt(0)" ::: "memory"); __builtin_amdgcn_s_barrier(); asm volatile("" ::: "memory");
        if (tid < 256) { const f32x2v a = Pt[tid * 4 + 0], bq = Pt[tid * 4 + 1], c = Pt[tid * 4 + 2], d = Pt[tid * 4 + 3];
            const float S1 = (a.x + bq.x) + (c.x + d.x), S2 = (a.y + bq.y) + (c.y + d.y);
            __hip_atomic_store(slots + ((size_t)(u.pm * 256 + tid) * 4 + u.po), ((unsigned long long)__float_as_uint(S2) << 32) | __float_as_uint(S1), __ATOMIC_RELAXED, __HIP_MEMORY_SCOPE_AGENT); }
        asm volatile("s_waitcnt vmcnt(0) lgkmcnt(0)" ::: "memory"); __builtin_amdgcn_s_barrier(); asm volatile("" ::: "memory");
        if (tid == 0) { __hip_atomic_fetch_add(cnt + 64 * u.pm, 1u, __ATOMIC_RELAXED, __HIP_MEMORY_SCOPE_AGENT);
            const unsigned long long t0 = __builtin_amdgcn_s_memrealtime();
            while (__hip_atomic_load(cnt + 64 * u.pm, __ATOMIC_RELAXED, __HIP_MEMORY_SCOPE_AGENT) < 4u) {
                if (__builtin_amdgcn_s_memrealtime() - t0 > 2000000ull) { __hip_atomic_store(tmo, 1u, __ATOMIC_RELAXED, __HIP_MEMORY_SCOPE_AGENT); break; }
                __builtin_amdgcn_s_sleep(2); }
            __builtin_amdgcn_fence(__ATOMIC_ACQUIRE, "agent");
            asm volatile("s_waitcnt vmcnt(0)" ::: "memory"); }
        __builtin_amdgcn_s_barrier(); asm volatile("" ::: "memory");
        if (tid < 256) { const unsigned long long* sl = slots + (size_t)(u.pm * 256 + tid) * 4; float S1 = 0.f, S2 = 0.f;
#pragma unroll
            for (int t = 0; t < 4; ++t) { const unsigned long long w = __hip_atomic_load(sl + t, __ATOMIC_RELAXED, __HIP_MEMORY_SCOPE_AGENT); S1 += __uint_as_float((unsigned)w); S2 += __uint_as_float((unsigned)(w >> 32)); }
            const float mean = S1 * (1.0f / DM); float var = S2 * (1.0f / DM) - mean * mean; var = var < 0.f ? 0.f : var;
            St[tid] = (f32x2v){mean, 1.0f / sqrtf(var + LN_EPS)}; }
        asm volatile("s_waitcnt vmcnt(0) lgkmcnt(0)" ::: "memory"); __builtin_amdgcn_s_barrier(); asm volatile("" ::: "memory");
#pragma unroll
        for (int bj = 0; bj < 2; ++bj)
#pragma unroll
            for (int n = 0; n < 2; ++n) { const int c = col0 + bj * HALF + n * 16;
                const f32x4 lg = *(const f32x4*)(lng + c), lb = *(const f32x4*)(lnb + c), shv = *(const f32x4*)(sh2 + (size_t)b * mod_pitch + c), scv = *(const f32x4*)(sc2 + (size_t)b * mod_pitch + c) + 1.0f;
#pragma unroll
                for (int ai = 0; ai < 2; ++ai)
#pragma unroll
                    for (int m = 0; m < 4; ++m) { const int rl = ai * HALF + wr * 64 + m * 16 + fr; const f32x2v sr = St[rl]; const size_t off = (size_t)(u.pm * BM + rl) * DM + c;
                        const f32x4 x1 = (acc[ai][bj][m][n] - sr.x) * sr.y * lg + lb; const f32x4 y = x1 * scv + shv;
                        *(u32x2*)(X1 + off) = (u32x2){pk2(x1.x, x1.y), pk2(x1.z, x1.w)};
                        *(u32x2*)(H2 + off) = (u32x2){pk2(y.x, y.y), pk2(y.z, y.w)}; }
                asm volatile("" ::: "memory"); }
        asm volatile("s_waitcnt lgkmcnt(0)" ::: "memory"); __builtin_amdgcn_s_barrier(); asm volatile("" ::: "memory");
    }
};
struct EpiGlu {
    static constexpr bool PERM = true;
    bf16_t* O; int ldc;
    DI void operator()(AccT& acc, const Unit& u, int wr, int wc, int fr, int fq, int wid, int lane) const {
        const int row0 = u.pm * BM + wr * 64 + fr, col0 = u.po * HALF + wc * 32 + 8 * fq;
#pragma unroll
        for (int ai = 0; ai < 2; ++ai)
#pragma unroll
            for (int m = 0; m < 4; ++m) { bf16_t* rowp = O + (size_t)(row0 + ai * HALF + m * 16) * ldc + col0;
                f32x4 h0, h1;
#pragma unroll
                for (int j = 0; j < 4; ++j) { h0[j] = fsilu(acc[ai][0][m][0][j]) * acc[ai][1][m][0][j]; h1[j] = fsilu(acc[ai][0][m][1][j]) * acc[ai][1][m][1][j]; }
                u32x4 w; w.x = pk2(h0[0], h0[1]); w.y = pk2(h0[2], h0[3]); w.z = pk2(h1[0], h1[1]); w.w = pk2(h1[2], h1[3]);
                *(u32x4*)rowp = w; }
    }
};

struct CmpOrder {
    int G, c; const bf16_t* U;
    DI bool next(int i, Unit& u) const { const int L = i * G + c; if (L >= 32) return false; u.pm = L; u.pn = L >> 4; u.po = 0; return true; }
    DI const char* abase(const Unit& u) const { const int kv = u.pm >> 4, bg = (u.pm >> 1) & 7, b = bg >> 1, gg = bg & 1, half = u.pm & 1;
        return (const char*)(U + (size_t)(b * SEQ + half * 4096) * NU + (kv ? UVC : UKC) + gg * 64); }
};
template <int NSUB> struct MoeOrder {
    int G, c, nunits; const int* blk_e; const bf16_t* A; size_t tstepA;
    DI bool next(int i, Unit& u) const { const int L = i * G + c; if (L >= nunits) return false; const int blk = L / NSUB, sub = L % NSUB;
        const int e = (int)__builtin_amdgcn_readfirstlane((int)ld_u32_agent((const unsigned*)blk_e + blk)); u.pm = blk; u.pn = e * NSUB + sub; u.po = sub; return true; }
    DI const char* abase(const Unit& u) const { return (const char*)A + (size_t)u.pm * tstepA; }
};
struct MoePairOrder {
    int G, c, npairs; const int* blk_e; const bf16_t* A; size_t tstepA;
    DI bool next(int i, Unit& u) const { const int p = (i >> 1) * G + c; if (p >= npairs) return false; const int blk = p >> 1, sub = (p & 1) * 2 + (i & 1);
        const int e = (int)__builtin_amdgcn_readfirstlane((int)ld_u32_agent((const unsigned*)blk_e + blk)); u.pm = blk; u.pn = e * 4 + sub; u.po = sub; return true; }
    DI const char* abase(const Unit& u) const { return (const char*)A + (size_t)u.pm * tstepA; }
};
struct RouterOrder {
    int G, c; const bf16_t* A;
    DI bool next(int i, Unit& u) const { const int L = i * G + c; if (L >= 2 * (NT / 256)) return false; u.pm = L >> 1; u.pn = L & 1; u.po = L & 1; return true; }
    DI const char* abase(const Unit& u) const { return (const char*)(A + (size_t)u.pm * 256 * DM + u.pn * 512); }
};
struct EpiLogit {
    static constexpr bool PERM = false;
    float* C;
    DI void operator()(AccT& acc, const Unit& u, int wr, int wc, int fr, int fq, int wid, int lane) const {
        const int row0 = u.pm * BM + wr * 64 + fr, col0 = wc * 32 + 4 * fq; float* base = C + (size_t)u.po * NT * 256;
#pragma unroll
        for (int ai = 0; ai < 2; ++ai)
#pragma unroll
            for (int m = 0; m < 4; ++m) { float* rowp = base + (size_t)(row0 + ai * HALF + m * 16) * 256 + col0;
#pragma unroll
                for (int bj = 0; bj < 2; ++bj)
#pragma unroll
                    for (int n = 0; n < 2; ++n) *(f32x4*)(rowp + bj * HALF + n * 16) = acc[ai][bj][m][n]; }
    }
};
}
constexpr size_t MiB = 1u << 20;
constexpr size_t WS_CTL = 0, CTL_ZERO_BYTES = 1 * MiB;
constexpr size_t WS_MODP = 1 * MiB;
constexpr size_t WS_MOD = WS_MODP + 1536 * 1024;
constexpr size_t WS_PEP = WS_MOD + 128 * 1024;
constexpr size_t WS_PEB = WS_PEP + 32 * 1024;
constexpr size_t WS_WIN_T = 3 * MiB;
constexpr size_t WS_WOUT_T = 8 * MiB;
constexpr size_t WS_WR_T = 10 * MiB;
constexpr size_t WS_WSGU_T = 12 * MiB;
constexpr size_t WS_WSD_T = 13 * MiB;
constexpr size_t WS_WC1_T = 14 * MiB;
constexpr size_t WS_WDN_T = 16 * MiB;
constexpr size_t WS_WGU_T = 144 * MiB;
constexpr size_t WS_YMOE = 144 * MiB;
constexpr size_t WS_U = 400 * MiB;
constexpr size_t WS_H1 = 560 * MiB;
constexpr size_t WS_CAT = 624 * MiB;
constexpr size_t WS_H2 = 688 * MiB;
constexpr size_t WS_HIDS = 752 * MiB;
constexpr size_t WS_HIDM = 784 * MiB;
constexpr size_t WS_LOGIT = 624 * MiB;
constexpr size_t WS_TOKE = 976 * MiB;
constexpr size_t WS_TOKW = 977 * MiB;
constexpr size_t WS_LRANK = 978 * MiB;
constexpr size_t WS_POSOF = 979 * MiB;
constexpr size_t WS_ROWTOK = 980 * MiB;
constexpr size_t WS_HIST = 982 * MiB;
constexpr size_t WS_BLKE = 983 * MiB;
constexpr size_t WS_HCMP = 984 * MiB;
constexpr size_t WS_KC = 988 * MiB;
constexpr size_t WS_VCT = 989 * MiB;
constexpr size_t WS_VST = 990 * MiB;
constexpr size_t WS_VWT = 998 * MiB;
constexpr size_t WS_V1 = WS_H1;
constexpr size_t WS_X1 = 464 * MiB;
constexpr size_t WS_SH = 528 * MiB;
constexpr size_t WS_LNX = 1012 * MiB;
constexpr size_t WS_END = 1024 * MiB;
constexpr int CW_BAR = 4096, CW_ATTQ = 12288;
constexpr int CW_LNCNT = 16384, CW_LNTMO = 3;

constexpr int LDS_BYTES = 160 * 1024;
constexpr int LDS_MISC = 131072;
constexpr int LDS_TAB = 131072 + 1024;

struct Params {
    const float *x, *c, *w_ada, *b_ada, *w_in, *pe_k, *pe_v, *w_cmp_k1, *w_cmp_k2, *w_cmp_v1, *w_cmp_v2, *w_dw, *b_dw, *conv_ln_g, *conv_ln_b, *w_out, *ln1_g, *ln1_b,
        *w_router, *router_bias, *w_e_gate, *w_e_up, *w_e_down, *w_s_gate, *w_s_up, *w_s_down, *ln2_g, *ln2_b;
    float* out; unsigned char* ws; int ph_lo, ph_hi;
};

DI void transpose_item(const float* W, int ldw, int ncols, bf16_t* WT, int ldt, int drow0, LAS float* scr, int k0, int n0, int lane) {
    if (n0 + 32 <= ncols && (((size_t)W | (size_t)(ldw * 4)) & 15) == 0 && (n0 & 3) == 0) {
        f32x4 v[8];
#pragma unroll
        for (int i = 0; i < 8; ++i) v[i] = *(const f32x4*)(W + (size_t)(k0 + 8 * i + (lane >> 3)) * ldw + n0 + 4 * (lane & 7));
#pragma unroll
        for (int i = 0; i < 8; ++i) { LAS float* d = scr + (8 * i + (lane >> 3)) * 33 + 4 * (lane & 7); d[0] = v[i].x; d[1] = v[i].y; d[2] = v[i].z; d[3] = v[i].w; }
    } else {
        const int nn = n0 + (lane & 31); const bool okc = nn < ncols;
#pragma unroll 8
        for (int i = 0; i < 32; ++i) { const int kk = 2 * i + (lane >> 5); scr[kk * 33 + (lane & 31)] = okc ? W[(size_t)(k0 + kk) * ldw + nn] : 0.f; }
    }
    LDS_WAIT(); asm volatile("" ::: "memory");
    const int cch = lane & 7;
#pragma unroll
    for (int j = 0; j < 4; ++j) { const int n = (lane >> 3) + 8 * j; const LAS float* s = scr + (8 * cch) * 33 + n;
        u32x4 o; o.x = pk2(s[0 * 33], s[1 * 33]); o.y = pk2(s[2 * 33], s[3 * 33]); o.z = pk2(s[4 * 33], s[5 * 33]); o.w = pk2(s[6 * 33], s[7 * 33]);
        *(u32x4*)(WT + (size_t)(drow0 + n) * ldt + k0 + 8 * cch) = o; }
    LDS_WAIT(); asm volatile("" ::: "memory");
}
DI void tr_plain(const float* W, int ldw, int K, int N, bf16_t* WT, int row_off, LAS float* scr, int item, int lane) {
    const int nblk = (N + 31) / 32, kb = item / nblk, nb = item % nblk;
    transpose_item(W, ldw, N, WT, K, row_off + 32 * nb, scr, 64 * kb, 32 * nb, lane);
}
DI void tr_glu(const float* W, int K, bf16_t* WT, int up, LAS float* scr, int item, int lane) {
    const int kb = item >> 3, nb = item & 7, n0 = 32 * nb;
    transpose_item(W, 256, 256, WT, K, (n0 >> 7) * 256 + up * 128 + (n0 & 127), scr, 64 * kb, n0, lane);
}

constexpr int CV_EARLY_EXPERTS = 0;
constexpr int EXP_ITEMS = NEXP * 384, EXP_LATE = 18432;
DI void expert_items(const Params& P, LAS float* scr, int lane, int gw, int NGW, int r0, int r1) {
    unsigned char* ws = P.ws;
    for (int r = r0 + gw; r < r1; r += NGW) { const int e = r / 384, q = r % 384;
        if (q < 128) tr_glu(P.w_e_gate + (size_t)e * 1024 * 256, 1024, (bf16_t*)(ws + WS_WGU_T) + (size_t)e * 512 * 1024, 0, scr, q, lane);
        else if (q < 256) tr_glu(P.w_e_up + (size_t)e * 1024 * 256, 1024, (bf16_t*)(ws + WS_WGU_T) + (size_t)e * 512 * 1024, 1, scr, q - 128, lane);
        else tr_plain(P.w_e_down + (size_t)e * 256 * 1024, 1024, 256, 1024, (bf16_t*)(ws + WS_WDN_T) + (size_t)e * 1024 * 256, 0, scr, q - 256, lane); }
}

DI void phase0a(const Params& P, LAS unsigned char* lds, int vcu, int G, int wave, int lane, int tid) {
    unsigned char* ws = P.ws;
    LAS float* scr = (LAS float*)(lds + wave * 16384);
    const int gw = vcu * 8 + wave, NGW = G * 8;
    for (int it = gw; it < 96 * 16; it += NGW) { const int cb = it % 96, ks = it / 96; const int col = cb * 64 + lane;
        float a0 = 0.f, a1 = 0.f, a2 = 0.f, a3 = 0.f;
#pragma unroll 4
        for (int k = ks * 64; k < ks * 64 + 64; ++k) { const float w = P.w_ada[(size_t)k * 6144 + col];
            a0 += fsilu(P.c[k]) * w; a1 += fsilu(P.c[1024 + k]) * w; a2 += fsilu(P.c[2048 + k]) * w; a3 += fsilu(P.c[3072 + k]) * w; }
        float* mp = (float*)(ws + WS_MODP) + (size_t)ks * 4 * 6144 + col;
        mp[0] = a0; mp[6144] = a1; mp[2 * 6144] = a2; mp[3 * 6144] = a3; }
    for (int it = gw; it < 16 * 2 * 4; it += NGW) { const int cb = it & 3, kv = (it >> 2) & 1, ks = it >> 3; const int col = cb * 64 + lane;
        const float* pe = kv ? P.pe_v : P.pe_k; const float* w1 = kv ? P.w_cmp_v1 : P.w_cmp_k1; float a = 0.f;
#pragma unroll 4
        for (int k = ks * 128; k < ks * 128 + 128; ++k) a += pe[k] * w1[(size_t)k * 256 + col];
        ((float*)(ws + WS_PEP))[(ks * 2 + kv) * 256 + col] = a; }
    constexpr int I_IN0 = 16 * 40, I_IN1 = 16 * 32, I_IN2 = 16 * 1, I_OUT = 16 * 32, I_R = 16 * 8, I_SG = 16 * 8, I_SD = 4 * 32, I_C1 = 32 * 8;
    constexpr int I_SMALL = I_IN0 + I_IN1 + I_IN2 + I_OUT + I_R + 2 * I_SG + I_SD + 2 * I_C1;
    constexpr int NITEMS = I_SMALL;
    bf16_t* win_t = (bf16_t*)(ws + WS_WIN_T);
    for (int it = gw; it < NITEMS; it += NGW) {
        int r = it;
        if (r < I_IN0) { tr_plain(P.w_in, DIN, 1024, 1280, win_t, 0, scr, r, lane); continue; } r -= I_IN0;
        if (r < I_IN1) { tr_plain(P.w_in + 1304, DIN, 1024, 1024, win_t, UCA, scr, r, lane); continue; } r -= I_IN1;
        if (r < I_IN2) { tr_plain(P.w_in + 1280, DIN, 1024, 24, win_t, UGT, scr, r, lane); continue; } r -= I_IN2;
        if (r < I_OUT) { tr_plain(P.w_out, 1024, 1024, 1024, (bf16_t*)(ws + WS_WOUT_T), 0, scr, r, lane); continue; } r -= I_OUT;
        if (r < I_R) { tr_plain(P.w_router, 256, 1024, 256, (bf16_t*)(ws + WS_WR_T), 0, scr, r, lane); continue; } r -= I_R;
        if (r < I_SG) { tr_glu(P.w_s_gate, 1024, (bf16_t*)(ws + WS_WSGU_T), 0, scr, r, lane); continue; } r -= I_SG;
        if (r < I_SG) { tr_glu(P.w_s_up, 1024, (bf16_t*)(ws + WS_WSGU_T), 1, scr, r, lane); continue; } r -= I_SG;
        if (r < I_SD) { tr_plain(P.w_s_down, 1024, 256, 1024, (bf16_t*)(ws + WS_WSD_T), 0, scr, r, lane); continue; } r -= I_SD;
        if (r < I_C1) { tr_plain(P.w_cmp_k1, 256, 2048, 256, (bf16_t*)(ws + WS_WC1_T), 0, scr, r, lane); continue; } r -= I_C1;
        tr_plain(P.w_cmp_v1, 256, 2048, 256, (bf16_t*)(ws + WS_WC1_T) + 256 * 2048, 0, scr, r, lane);
    }
    expert_items(P, scr, lane, gw, NGW, 0, CV_EARLY_EXPERTS * 384);
    { u32x4* z = (u32x4*)(win_t + (size_t)2336 * 1024); const int n16 = (2560 - 2336) * 1024 * 2 / 16;
      for (int i = vcu * 512 + tid; i < n16; i += G * 512) z[i] = (u32x4){0u, 0u, 0u, 0u}; }
}

DI void phase0b(const Params& P, LAS unsigned char* lds, int vcu, int G, int wave, int lane, int tid) {
    unsigned char* ws = P.ws;
    const float* modp = (const float*)(ws + WS_MODP);
    for (int i = vcu * 512 + tid; i < 4 * 6144; i += G * 512) { float a = P.b_ada[i % 6144];
#pragma unroll
        for (int ks = 0; ks < 16; ++ks) a += modp[(size_t)ks * 4 * 6144 + i];
        ((float*)(ws + WS_MOD))[i] = a; }
    for (int i = vcu * 512 + tid; i < 512; i += G * 512) { float a = 0.f;
#pragma unroll
        for (int ks = 0; ks < 16; ++ks) a += ((const float*)(ws + WS_PEP))[ks * 512 + i];
        ((float*)(ws + WS_PEB))[i] = a; }
    const int rpw = NT / G;
    LAS float* sh = (LAS float*)lds;
    for (int r0 = vcu * rpw; r0 < NT; r0 += G * rpw) {
        const int b = r0 / SEQ;
        __syncthreads();
        for (int i = tid; i < 2048; i += 512) { const int j = (i < 1024) ? i : i;
            float a = P.b_ada[j];
#pragma unroll
            for (int ks = 0; ks < 16; ++ks) a += modp[(size_t)ks * 4 * 6144 + b * 6144 + j];
            sh[i] = (i < 1024) ? a : 1.0f + a; }
        __syncthreads();
        for (int m = r0 + wave; m < r0 + rpw; m += 8) {
            const f32x4* xr = (const f32x4*)(P.x + (size_t)m * DM) + lane; unsigned long long* o8 = (unsigned long long*)((bf16_t*)(ws + WS_H1) + (size_t)m * DM) + lane;
#pragma unroll
            for (int j = 0; j < 4; ++j) { const f32x4 v = xr[64 * j]; const int c0 = 4 * lane + 256 * j;
                const float y0 = v.x * sh[1024 + c0] + sh[c0], y1 = v.y * sh[1025 + c0] + sh[c0 + 1], y2 = v.z * sh[1026 + c0] + sh[c0 + 2], y3 = v.w * sh[1027 + c0] + sh[c0 + 3];
                o8[64 * j] = (unsigned long long)pk2(y0, y1) | ((unsigned long long)pk2(y2, y3) << 32); }
        }
    }
    __syncthreads();
}

#define CONV_LOAD(ITEM) { const int b_ = (ITEM) >> 8, t0_ = ((ITEM) & 255) * 32; _Pragma("unroll") for (int i = 0; i < 8; ++i) { const int task = tid + 512 * i, rr = task >> 6, oc = task & 63; int tok = t0_ - 30 + (rr < 62 ? rr : 61); tok = tok < 0 ? 0 : tok; \
        const bf16_t* up = U + (size_t)(b_ * SEQ + tok) * NU + oc * 8; av[i] = *(const u32x4*)(up + UCA); gv8[i] = *(const u32x4*)(up + UCG); } }
DI void conv_items(const Params& P, LAS unsigned char* lds, int first, int step, int wave, int lane, int tid) {
    const bf16_t* U = (const bf16_t*)(P.ws + WS_U); bf16_t* CAT = (bf16_t*)(P.ws + WS_CAT);
    LAS float* glu = (LAS float*)lds; LAS float* red = (LAS float*)(lds + 62 * 512 * 4); LAS float* stat = red + 32 * 8 * 2;
    const int c = tid;
    u32x4 av[8], gv8[8];
    if (first < 1024) CONV_LOAD(first)
  for (int item = first; item < 1024; item += step) {
    const int b = item >> 8, t0 = (item & 255) * 32;
    __syncthreads();
    {
#pragma unroll
        for (int i = 0; i < 8; ++i) { const int task = tid + 512 * i, rr = task >> 6, oc = task & 63; const bool ok = (t0 - 30 + rr) >= 0;
            const unsigned aw[4] = {av[i].x, av[i].y, av[i].z, av[i].w}, gw[4] = {gv8[i].x, gv8[i].y, gv8[i].z, gv8[i].w}; float o[8];
#pragma unroll
            for (int q = 0; q < 4; ++q) { o[2 * q] = ok ? bflo(aw[q]) * fsigmoid(bflo(gw[q])) : 0.f; o[2 * q + 1] = ok ? bfhi(aw[q]) * fsigmoid(bfhi(gw[q])) : 0.f; }
            if (rr < 62) { *(LAS f32x4*)(glu + rr * 512 + oc * 8) = (f32x4){o[0], o[1], o[2], o[3]}; *(LAS f32x4*)(glu + rr * 512 + oc * 8 + 4) = (f32x4){o[4], o[5], o[6], o[7]}; } }
    }
    if (item + step < 1024) CONV_LOAD(item + step)
    float w[31];
#pragma unroll
    for (int j = 0; j < 31; ++j) w[j] = P.w_dw[j * 512 + c];
    const float bd = P.b_dw[c];
    __syncthreads();
    float y[32];
#pragma unroll
    for (int tt = 0; tt < 32; ++tt) y[tt] = bd;
#pragma unroll
    for (int rr = 0; rr < 62; ++rr) { const float gv = glu[rr * 512 + c];
#pragma unroll
        for (int tt = 0; tt < 32; ++tt) { if (rr - tt >= 0 && rr - tt <= 30) y[tt] += w[rr - tt] * gv; } }
    __syncthreads();
#pragma unroll
    for (int tt = 0; tt < 32; ++tt) glu[tt * 512 + c] = y[tt];
    __syncthreads();
    {
#pragma unroll
        for (int q = 0; q < 4; ++q) { const int tt = 4 * wave + q; const f32x4 a = *(const LAS f32x4*)(glu + tt * 512 + lane * 8), bq = *(const LAS f32x4*)(glu + tt * 512 + lane * 8 + 4);
            float s1 = ((a.x + a.y) + (a.z + a.w)) + ((bq.x + bq.y) + (bq.z + bq.w));
            float s2 = ((a.x * a.x + a.y * a.y) + (a.z * a.z + a.w * a.w)) + ((bq.x * bq.x + bq.y * bq.y) + (bq.z * bq.z + bq.w * bq.w));
            s1 = wave_sum(s1); s2 = wave_sum(s2);
            if (lane == 0) { const float mean = s1 * (1.0f / 512.0f); float var = s2 * (1.0f / 512.0f) - mean * mean; var = var < 0.f ? 0.f : var;
                stat[tt * 2] = mean; stat[tt * 2 + 1] = 1.0f / sqrtf(var + LN_EPS); } }
    }
    __syncthreads();
    const float lg = P.conv_ln_g[c], lb = P.conv_ln_b[c];
#pragma unroll
    for (int tt = 0; tt < 32; ++tt) { const float v = (y[tt] - stat[tt * 2]) * stat[tt * 2 + 1] * lg + lb;
        CAT[(size_t)(b * SEQ + t0 + tt) * DM + 512 + c] = (bf16_t)(pk2(fsilu(v), 0.f) & 0xffffu); }
  }
}
#undef CONV_LOAD

DI unsigned swap23(unsigned p) { return (p & ~12u) | ((p & 4u) << 1) | ((p & 8u) >> 1); }
DI void vt_copies(const Params& P, LAS unsigned char* lds, int gw, int NGW, int wave, int lane) {
    unsigned char* ws = P.ws;
    LAS bf16_t* tile = (LAS bf16_t*)(lds + wave * 8448);
    const bf16_t* U = (const bf16_t*)(ws + WS_U);
    for (int it = gw; it < 2 * 8 * 128; it += NGW) { const int which = it >> 10, bg = (it >> 7) & 7, blk = it & 127, b = bg >> 1, gg = bg & 1;
        const bf16_t* src = U + (size_t)(b * SEQ + blk * 64 + lane) * NU + (which ? UVW : UVS) + gg * 64;
#pragma unroll
        for (int q = 0; q < 8; ++q) { const u32x4 v = *(const u32x4*)(src + q * 8); LAS unsigned* tp = (LAS unsigned*)(tile + lane * 66 + q * 8); tp[0] = v.x; tp[1] = v.y; tp[2] = v.z; tp[3] = v.w; }
        LDS_WAIT(); asm volatile("" ::: "memory");
        bf16_t* dst = (bf16_t*)(ws + (which ? WS_VWT : WS_VST)) + ((size_t)(bg * 128 + blk) * 64 + lane) * 64;
#pragma unroll
        for (int q = 0; q < 8; ++q) { unsigned wv[4];
#pragma unroll
            for (int e2 = 0; e2 < 4; ++e2) { const int p0 = q * 8 + e2 * 2; const int k0 = (p0 & ~15) | (int)swap23((unsigned)p0 & 15u), k1 = ((p0 + 1) & ~15) | (int)swap23((unsigned)(p0 + 1) & 15u);
                wv[e2] = (unsigned)tile[k0 * 66 + lane] | ((unsigned)tile[k1 * 66 + lane] << 16); }
            *(u32x4*)(dst + q * 8) = (u32x4){wv[0], wv[1], wv[2], wv[3]}; }
        LDS_WAIT(); asm volatile("" ::: "memory");
    }
}

DI void cmp2_rows(const Params& P, LAS unsigned char* lds, int kv, int row0, int nblk64, int tid) {
    unsigned char* ws = P.ws;
    const float* w2 = kv ? P.w_cmp_v2 : P.w_cmp_k2; LAS float* w2s = (LAS float*)lds;
    __syncthreads();
    for (int i = tid; i < 256 * 64 / 4; i += 512) ((LAS f32x4*)w2s)[i] = ((const f32x4*)w2)[i];
    __syncthreads();
    for (int blk = 0; blk < nblk64; ++blk) {
        const int row = row0 + blk * 64 + (tid >> 3), oc = tid & 7;
        const bf16_t* hrow = (const bf16_t*)(ws + WS_HCMP) + ((size_t)kv * 4096 + row) * 256;
        float acc[8];
#pragma unroll
        for (int j = 0; j < 8; ++j) acc[j] = 0.f;
        for (int k8 = 0; k8 < 32; ++k8) { const u32x4 hv = *(const u32x4*)(hrow + k8 * 8); const unsigned hw[4] = {hv.x, hv.y, hv.z, hv.w};
#pragma unroll
            for (int q = 0; q < 4; ++q) {
#pragma unroll
                for (int hh = 0; hh < 2; ++hh) { const float hval = hh ? bfhi(hw[q]) : bflo(hw[q]); const int k = k8 * 8 + q * 2 + hh;
                    const f32x4 wa = *(const LAS f32x4*)(w2s + k * 64 + oc * 8), wb = *(const LAS f32x4*)(w2s + k * 64 + oc * 8 + 4);
                    acc[0] += hval * wa.x; acc[1] += hval * wa.y; acc[2] += hval * wa.z; acc[3] += hval * wa.w; acc[4] += hval * wb.x; acc[5] += hval * wb.y; acc[6] += hval * wb.z; acc[7] += hval * wb.w; } } }
        const int bg = row >> 9, n = row & 511;
        if (n == 511) {
#pragma unroll
            for (int j = 0; j < 8; ++j) acc[j] = 0.f; }
        if (kv == 0) { u32x4 o; o.x = pk2(acc[0], acc[1]); o.y = pk2(acc[2], acc[3]); o.z = pk2(acc[4], acc[5]); o.w = pk2(acc[6], acc[7]);
            *(u32x4*)((bf16_t*)(ws + WS_KC) + ((size_t)bg * 512 + n) * 64 + oc * 8) = o; }
        else { bf16_t* vt = (bf16_t*)(ws + WS_VCT) + (size_t)bg * 64 * 512; const int pos = (n & ~15) | (int)swap23((unsigned)n & 15u);
#pragma unroll
            for (int j = 0; j < 8; ++j) vt[(size_t)(oc * 8 + j) * 512 + pos] = (bf16_t)(pk2(acc[j], 0.f) & 0xffffu); }
    }
    __syncthreads();
}
DI void phase_cmp2(const Params& P, LAS unsigned char* lds, int vcu, int G, int wave, int lane, int tid) {
    for (int it = vcu; it < 128; it += G) cmp2_rows(P, lds, it >> 6, (it & 63) * 64, 1, tid);
    __syncthreads();
}
namespace attn {
constexpr int ROWB = 144;
constexpr int TROW = 128, TILEB = 64 * TROW;
constexpr int OFF_K = 0, OFF_V = 2 * TILEB, OFF_IMPG = 36864, OFF_IMPL = OFF_IMPG + 32768;
constexpr int OFF_SELM = LDS_TAB, OFF_MREF = LDS_TAB + 1024, OFF_LSUM = LDS_TAB + 2048, OFF_LIST = LDS_TAB + 4096, OFF_TM = LDS_TAB + 6144;
constexpr int OFF_QS = 0, OFF_PBUF = 36864, PSLOT = 32 * ROWB;
constexpr float NEG = -1e30f, MFLOOR = -1e20f;
#define MFMA32(a, b, c) __builtin_amdgcn_mfma_f32_32x32x16_bf16((a), (b), (c), 0, 0, 0)
DI float fexp2(float x) { return __builtin_amdgcn_exp2f(x); }
DI void dma_tile(const bf16_t* base, unsigned pitch, LAS unsigned char* buf, int wave, int lane) {
    const int row = 8 * wave + (lane >> 3), ch = (lane & 7) ^ ((row >> 1) & 7);
    __builtin_amdgcn_global_load_lds((const unsigned*)(base + (unsigned)(row * pitch + ch * 8)), (LAS unsigned*)(buf + wave * 1024), 16, 0, 0); }
DI bf16x8 pack8(const f32x16& p, int s2) { u32x4 w; w.x = pk2(p[8 * s2], p[8 * s2 + 1]); w.y = pk2(p[8 * s2 + 2], p[8 * s2 + 3]); w.z = pk2(p[8 * s2 + 4], p[8 * s2 + 5]); w.w = pk2(p[8 * s2 + 6], p[8 * s2 + 7]); return __builtin_bit_cast(bf16x8, w); }

constexpr int CV_PER_EXPERT = 1536, CV_TOTAL = NEXP * CV_PER_EXPERT;
struct CvState { int next, end, nfly; bool xafter; };
DI LAS unsigned char* cv_buf(LAS unsigned char* lds, int wave, int seq) { return lds + (wave < 4 ? 110592 + wave * 4096 : LDS_TAB + 8192 + (wave - 4) * 4096) + (seq & 1) * 2048; }
DI void cv_decode(int m, int& e, int& mat, int& k0, int& n0) { e = m / CV_PER_EXPERT; const int q = m % CV_PER_EXPERT; mat = q >> 9; const int w = q & 511;
    if (mat < 2) { n0 = (w >> 6) * 32; k0 = (w & 63) * 16; } else { n0 = (w >> 4) * 32; k0 = (w & 15) * 16; } }
DI void cv_issue(const Params& P, CvState& c, LAS unsigned char* lds, int wave, int lane) {
    int e, mat, k0, n0; cv_decode(c.next, e, mat, k0, n0);
    LAS unsigned* st = (LAS unsigned*)cv_buf(lds, wave, c.next);
    const int ldw = (mat < 2) ? 256 : 1024;
    const float* W = (mat == 0 ? P.w_e_gate : mat == 1 ? P.w_e_up : P.w_e_down) + (size_t)e * 1024 * 256;
    const float* src = W + (size_t)(k0 + (lane >> 3)) * ldw + n0 + 4 * (lane & 7);
#pragma unroll
    for (int j = 0; j < 2; ++j) __builtin_amdgcn_global_load_lds((const unsigned*)(src + (size_t)(8 * j) * ldw), st + j * 256, 16, 0, 0);
    ++c.nfly; ++c.next; c.xafter = true;
}
DI void cv_finish(const Params& P, CvState& c, LAS unsigned char* lds, int wave, int lane) {
    const int m = c.next - c.nfly; int e, mat, k0, n0; cv_decode(m, e, mat, k0, n0);
    const int nl = lane >> 1, kc = (lane & 1) * 8;
    const LAS float* st = (const LAS float*)cv_buf(lds, wave, m) + kc * 32 + nl;
    u32x4 o; o.x = pk2(st[0 * 32], st[1 * 32]); o.y = pk2(st[2 * 32], st[3 * 32]); o.z = pk2(st[4 * 32], st[5 * 32]); o.w = pk2(st[6 * 32], st[7 * 32]);
    const int n = n0 + nl; bf16_t* dst;
    if (mat < 2) dst = (bf16_t*)(P.ws + WS_WGU_T) + (size_t)e * 512 * 1024 + (size_t)((n >> 7) * 256 + mat * 128 + (n & 127)) * 1024 + k0 + kc;
    else dst = (bf16_t*)(P.ws + WS_WDN_T) + (size_t)e * 1024 * 256 + (size_t)n * 256 + k0 + kc;
    asm volatile("s_waitcnt lgkmcnt(0)" ::: "memory");
    *(u32x4*)dst = o; --c.nfly;
}

template <int MODE>
DI void tile_compute(const LAS unsigned char* Kb, const LAS unsigned char* Vb, const bf16x8 (&qf)[4], int r, int h, int lo, int hi, bool elem,
                     float& m, float& l, f32x16 (&O)[2], float meff_in, float linv, LAS float* impg, LAS float* impl, int sb0) {
    const bool rowfull = (lo <= 0 && hi >= 63);
    const int lo2 = lo - 4 * h, hi2 = hi - 4 * h, swz = (r >> 1) & 7;
#pragma unroll
    for (int kh = 0; kh < 2; ++kh) {
        f32x16 s;
#pragma unroll
        for (int i = 0; i < 16; ++i) s[i] = 0.f;
#pragma unroll
        for (int ks = 0; ks < 4; ++ks) { const bf16x8 a = *(const LAS bf16x8*)(Kb + (32 * kh + r) * TROW + (((2 * ks + h) ^ swz) << 4)); s = MFMA32(a, qf[ks], s); }
        if (elem) {
#pragma unroll
            for (int i = 0; i < 16; ++i) { const int k0 = (i & 3) + 8 * (i >> 2) + 32 * kh; s[i] = (k0 >= lo2 && k0 <= hi2) ? s[i] : NEG; }
        }
        float cref;
        if (MODE != 2) {
            float tm = s[0];
#pragma unroll
            for (int i = 1; i < 16; ++i) tm = fmaxf(tm, s[i]);
            tm = fmaxf(tm, __shfl_xor(tm, 32));
            if (!elem) tm = rowfull ? tm : NEG;
            const bool need = tm > m + 8.0f;
            if (__any(need)) {
                const float mnew = need ? tm : m;
                const float alpha = fexp2(fmaxf(m, MFLOOR) - fmaxf(mnew, MFLOOR));
                l *= alpha; m = mnew;
                if (MODE == 0) {
#pragma unroll
                    for (int i = 0; i < 16; ++i) { O[0][i] *= alpha; O[1][i] *= alpha; } }
            }
            cref = (elem || rowfull) ? fmaxf(m, MFLOOR) : 1e30f;
            float rs = 0.f;
#pragma unroll
            for (int i = 0; i < 16; ++i) { s[i] = fexp2(s[i] - cref); rs += s[i]; }
            rs += __shfl_xor(rs, 32);
            l += rs;
        } else {
            cref = (elem || rowfull) ? meff_in : 1e30f;
#pragma unroll
            for (int i = 0; i < 16; ++i) s[i] = fexp2(s[i] - cref);
        }
        if (MODE == 1) continue;
        if (MODE == 2) {
#pragma unroll
            for (int gq = 0; gq < 4; ++gq) {
                float Gs = ((s[4 * gq] + s[4 * gq + 1]) + (s[4 * gq + 2] + s[4 * gq + 3])) * linv, Ls = s[4 * gq + 3] * linv;
                Gs += __shfl_xor(Gs, 1); Gs += __shfl_xor(Gs, 2); Ls += __shfl_xor(Ls, 1); Ls += __shfl_xor(Ls, 2);
                if ((r & 3) == 0) { const int sb = sb0 + 8 * kh + 2 * gq + h; impg[sb] = Gs; impl[sb] = Ls; } }
        }
#pragma unroll
        for (int s2 = 0; s2 < 2; ++s2) { const bf16x8 pf = pack8(s, s2);
#pragma unroll
            for (int dt = 0; dt < 2; ++dt) { const bf16x8 a = *(const LAS bf16x8*)(Vb + (32 * dt + r) * TROW + (((4 * kh + 2 * s2 + h) ^ swz) << 4));
                O[dt] = MFMA32(a, pf, O[dt]); } }
    }
}

DI void attn_unit(const Params& P, LAS unsigned char* lds, int bg, int qt, int wave, int lane_in, int tid_in, int& it, CvState& cv) {
    int lane = lane_in; asm volatile("" : "+v"(lane));
    const int tid = wave * 64 + lane;
    unsigned char* ws = P.ws;
    const bf16_t* U = (const bf16_t*)(ws + WS_U);
    const int b = bg >> 1, gg = bg & 1, t0 = qt * 64, r = lane & 31, h = lane >> 5, tokl = 8 * wave + (r >> 2), hp = r & 3, t = t0 + tokl;
    LAS float* IMPG = (LAS float*)(lds + OFF_IMPG); LAS float* IMPL = (LAS float*)(lds + OFF_IMPL); LAS unsigned* SELM = (LAS unsigned*)(lds + OFF_SELM);
#define ATT_UROW(name) int lq_ = lane; asm volatile("" : "+v"(lq_)); const bf16_t* name = U + (size_t)(b * SEQ + t0 + 8 * wave + ((lq_ & 31) >> 2)) * NU; const int hq_ = lq_ & 3, hh_ = lq_ >> 5; (void)hq_; (void)hh_;
    bf16x8 qf[4];
#define ATT_LOADQ() do { ATT_UROW(urow_) _Pragma("unroll") for (int ks = 0; ks < 4; ++ks) qf[ks] = *(const bf16x8*)(urow_ + UQ + (4 * gg + hq_) * 64 + 16 * ks + 8 * hh_); } while (0)
    ATT_LOADQ();
    f32x16 OA[2];
#pragma unroll
    for (int i = 0; i < 16; ++i) { OA[0][i] = 0.f; OA[1][i] = 0.f; }
    __syncthreads();
#pragma unroll
    for (int j = 0; j < 4; ++j) { *(LAS f32x4*)(IMPG + 8 * wave * 128 + lane * 4 + 256 * j) = (f32x4){0.f, 0.f, 0.f, 0.f}; *(LAS f32x4*)(IMPL + 8 * wave * 128 + lane * 4 + 256 * j) = (f32x4){0.f, 0.f, 0.f, 0.f}; }
    f32x16 O[2]; float m, l;
#define ATT_RESET() do { m = NEG; l = 0.f; _Pragma("unroll") for (int i = 0; i < 16; ++i) { O[0][i] = 0.f; O[1][i] = 0.f; } } while (0)
#define ATT_FOLD(br) do { ATT_UROW(urow_) const float gate_ = fsigmoid(bf2f(urow_[UGT + gg * 12 + hq_ * 3 + (br)])); const float sc_ = (l > 0.f) ? gate_ / l : 0.f; _Pragma("unroll") for (int i = 0; i < 16; ++i) { OA[0][i] += sc_ * O[0][i]; OA[1][i] += sc_ * O[1][i]; } } while (0)

#define ATT_STEP(CUR, NXT, TI, KPTR, KPITCH, VPTR, VPITCH, USEV, ...) { \
            LAS unsigned char* Kb = lds + OFF_K + (CUR) * TILEB; LAS unsigned char* Vb = lds + OFF_V + (CUR) * TILEB; \
            int nfin_; if (cv.xafter) { asm volatile("s_waitcnt vmcnt(2)" ::: "memory"); nfin_ = cv.nfly - 1; } else { asm volatile("s_waitcnt vmcnt(0)" ::: "memory"); nfin_ = cv.nfly; } \
            for (int f_ = 0; f_ < nfin_; ++f_) cv_finish(P, cv, lds, wave, tz_); \
            asm volatile("s_waitcnt lgkmcnt(0)" ::: "memory"); __builtin_amdgcn_s_barrier(); asm volatile("" ::: "memory"); \
            if ((TI) + 1 < n_) { const int pi = (TI) + 1; dma_tile(KPTR, KPITCH, lds + OFF_K + (NXT) * TILEB, wave, tz_); if (USEV) dma_tile(VPTR, VPITCH, lds + OFF_V + (NXT) * TILEB, wave, tz_); cv.xafter = false; } \
            if (cv.next < cv.end && cv.nfly < 2) cv_issue(P, cv, lds, wave, tz_); \
            { const int ti = (TI); __VA_ARGS__ } ++it; }
#define ATT_LOOP(NTILES, KPTR, KPITCH, VPTR, VPITCH, USEV, ...) { const int n_ = (NTILES); int tz_ = lane; asm volatile("" : "+v"(tz_)); \
        asm volatile("s_waitcnt lgkmcnt(0)" ::: "memory"); __builtin_amdgcn_s_barrier(); asm volatile("" ::: "memory");     \
        if (n_ > 0) { const int pi = 0; dma_tile(KPTR, KPITCH, lds + OFF_K, wave, tz_); if (USEV) dma_tile(VPTR, VPITCH, lds + OFF_V, wave, tz_); cv.xafter = false; } \
        for (int i_ = 0; i_ < n_; i_ += 2) { \
            ATT_STEP(0, 1, i_, KPTR, KPITCH, VPTR, VPITCH, USEV, __VA_ARGS__) \
            if (i_ + 1 < n_) ATT_STEP(1, 0, i_ + 1, KPTR, KPITCH, VPTR, VPITCH, USEV, __VA_ARGS__) } }

    const bf16_t* KC = (const bf16_t*)(ws + WS_KC) + (size_t)bg * 512 * 64; const bf16_t* VCT = (const bf16_t*)(ws + WS_VCT) + (size_t)bg * 64 * 512;
    const int hin = (t - 31) >> 4;
    const int ntc = (((t0 + 32) >> 4) >> 6) + 1;
    ATT_RESET();
    ATT_LOOP(ntc, KC + (size_t)pi * 64 * 64, 64, KC, 64, false, {
        const int hi = hin - 64 * ti; const bool fe = (hi >= 63) || (hi < 0);
        if (!__all(hi < 0)) tile_compute<1>(Kb, Kb, qf, r, h, 0, hi, !__all(fe), m, l, O, 0.f, 0.f, nullptr, nullptr, 0); })
    {
        const float meff = fmaxf(m, MFLOOR), linv = (l > 0.f) ? 1.0f / l : 0.f;
        ATT_LOOP(ntc, KC + (size_t)pi * 64 * 64, 64, VCT + pi * 64, 512, true, {
            const int hi = hin - 64 * ti; const bool fe = (hi >= 63) || (hi < 0);
            float md = m, ld_ = l;
            if (!__all(hi < 0)) tile_compute<2>(Kb, Vb, qf, r, h, 0, hi, !__all(fe), md, ld_, O, meff, linv, IMPG + tokl * 128, IMPL + tokl * 128, 16 * ti); })
        ATT_FOLD(0);
    }
    for (int tk = 0; tk < 8; ++tk) { const int trow = 8 * wave + tk;
        const float ilo = IMPG[trow * 128 + lane] + (lane > 0 ? IMPL[trow * 128 + lane - 1] : 0.f), ihi = IMPG[trow * 128 + 64 + lane] + IMPL[trow * 128 + 63 + lane];
        const int slo = lane, shi = 64 + lane;
        const bool clo = slo <= qt, chi = shi <= qt, flo = (slo == 0) || (slo == qt) || (slo + 1 == qt), fhi = (shi == qt) || (shi + 1 == qt);
        const unsigned klo = clo ? ((flo ? 0xFFFFFF80u : (__float_as_uint(ilo) & 0xFFFFFF80u)) | (unsigned)(127 - slo)) : 0u;
        const unsigned khi = chi ? ((fhi ? 0xFFFFFF80u : (__float_as_uint(ihi) & 0xFFFFFF80u)) | (unsigned)(127 - shi)) : 0u;
        unsigned T = 0u;
        for (int bit = 31; bit >= 0; --bit) { const unsigned cand = T | (1u << bit);
            const int cnt = __popcll(__ballot(klo >= cand)) + __popcll(__ballot(khi >= cand)); if (cnt >= 16) T = cand; }
        const unsigned long long blo = __ballot(klo >= T && klo != 0u), bhi = __ballot(khi >= T && khi != 0u);
        if (lane == 0) { *(LAS u32x4*)(SELM + trow * 4) = (u32x4){(unsigned)blo, (unsigned)(blo >> 32), (unsigned)bhi, (unsigned)(bhi >> 32)}; }
    }
    { int lp_ = lane; asm volatile("" : "+v"(lp_)); float* oapark = (float*)(ws + WS_HIDM) + ((size_t)(blockIdx.x * 8 + wave) * 32) * 64 + lp_;
#pragma unroll
      for (int i = 0; i < 16; ++i) { oapark[i * 64] = OA[0][i]; oapark[(16 + i) * 64] = OA[1][i]; } }
    ATT_RESET();
    const bf16_t* KS = U + (size_t)(b * SEQ) * NU + UKS + gg * 64; const bf16_t* VST = (const bf16_t*)(ws + WS_VST) + (size_t)bg * 128 * 4096;
    constexpr int QT_COMPACT = 96;
    if (qt < QT_COMPACT) {
        const u32x4 selw = *(const LAS u32x4*)(SELM + tokl * 4);
        ATT_LOOP(qt + 1, KS + (size_t)pi * 64 * NU, NU, VST + (size_t)pi * 4096, 64, true, {
            const int j = ti;
            const unsigned wsel = (j < 32) ? selw.x : (j < 64) ? selw.y : (j < 96) ? selw.z : selw.w; const bool sel = (wsel >> (j & 31)) & 1u;
            const int hi = !sel ? -1 : (j == qt ? tokl : 63);
            if (!__all(!sel)) tile_compute<0>(Kb, Vb, qf, r, h, 0, hi, j == qt, m, l, O, 0.f, 0.f, nullptr, nullptr, 0); })
    } else {
        {
#define JMAP(i) ((i) == 0 ? 0 : qt - (2 - (i)))
            ATT_LOOP(3, KS + (size_t)JMAP(pi) * 64 * NU, NU, VST + (size_t)JMAP(pi) * 4096, 64, true, {
                const int j = JMAP(ti);
                tile_compute<0>(Kb, Vb, qf, r, h, 0, (j == qt ? tokl : 63), j == qt, m, l, O, 0.f, 0.f, nullptr, nullptr, 0); })
#undef JMAP
        }
        int lz = lane; asm volatile("" : "+v"(lz));
        const int r = lz & 31, h = lz >> 5, hp = r & 3, tokl = 8 * wave + (r >> 2), lane = lz, tid = wave * 64 + lz;
        LAS unsigned char* Qs = lds + OFF_QS; LAS float* MREF = (LAS float*)(lds + OFF_MREF); LAS float* LSUM = (LAS float*)(lds + OFF_LSUM); LAS int* LIST = (LAS int*)(lds + OFF_LIST) + wave * 64;
        LAS unsigned long long* TM = (LAS unsigned long long*)(lds + OFF_TM);
        if (h == 0) MREF[32 * wave + r] = fmaxf(m, MFLOOR);
        for (int j = wave; j < 128; j += 8) { const unsigned long long mk = __ballot((SELM[lane * 4 + (j >> 5)] >> (j & 31)) & 1u); if (lane == 0) TM[j] = mk; }
        __syncthreads();
#pragma unroll
        for (int q4 = 0; q4 < 4; ++q4) { const int ch = tid + 512 * q4, row = ch >> 3, c8 = ch & 7;
            *(LAS u32x4*)(Qs + row * ROWB + c8 * 16) = *(const u32x4*)(U + (size_t)(b * SEQ + t0 + (row >> 2)) * NU + UQ + (4 * gg + (row & 3)) * 64 + c8 * 8); }
        __syncthreads();
        const int jend = qt - 2; int jn = 1, rk = 0;
        const unsigned long long ltl = (1ull << tokl) - 1ull;
        int pjs = 0, pcnt = 0;
#define FAR_TM(dst, jj) { const unsigned long long tv_ = TM[(jj) <= jend ? (jj) : 0]; const unsigned lo_ = __builtin_amdgcn_readfirstlane((unsigned)tv_), hi_ = __builtin_amdgcn_readfirstlane((unsigned)(tv_ >> 32)); \
            dst = ((jj) <= jend) ? (((unsigned long long)hi_ << 32) | lo_) : 0ull; }
        for (;;) {
            int cnt = 0, used = 0, myj = -1, myc = 0; unsigned long long mymask = 0ull;
#pragma unroll
            for (int i = 0; i < 8; ++i) { const int jj = jn + i; unsigned long long mk; FAR_TM(mk, jj) const int nch = (__popcll(mk) + 7) >> 3;
                const bool take = (cnt == i) && (jj <= jend) && (used + nch <= 8);
                if (take) { if (wave >= used && wave < used + nch) { myj = jj; myc = wave - used; mymask = mk; } used += nch; ++cnt; } }
            if (cnt == 0 && pcnt == 0) break;
            const int cjs = jn; jn += cnt;
            bf16x8 kf[2][4], vf[2][4];
            if (myj >= 0) { const bf16_t* Kg = KS + (size_t)(myj * 64 + r) * NU + 8 * h; const bf16_t* Vg = VST + (size_t)myj * 4096 + r * 64 + 8 * h;
#pragma unroll
                for (int kh = 0; kh < 2; ++kh)
#pragma unroll
                    for (int ks = 0; ks < 4; ++ks) { kf[kh][ks] = *(const bf16x8*)(Kg + (size_t)(32 * kh) * NU + 16 * ks); vf[kh][ks] = *(const bf16x8*)(Vg + kh * 32 * 64 + ks * 16); } }
            if (pcnt > 0) { int base = 0;
#pragma unroll
                for (int i = 0; i < 8; ++i) { unsigned long long mk; FAR_TM(mk, pjs + i) if (i >= pcnt) mk = 0ull; const int nch = (__popcll(mk) + 7) >> 3;
                    const bool act = (mk >> tokl) & 1ull;
                    if (__any(act)) { const int rank = __popcll(mk & ltl), slot = base + (rank >> 3), prow = (rank & 7) * 4 + hp;
                        const LAS unsigned char* Pb = lds + OFF_PBUF + (((rk + 1) & 1) * 8 + slot) * PSLOT + prow * ROWB + h * 8;
#pragma unroll
                        for (int dt = 0; dt < 2; ++dt)
#pragma unroll
                            for (int gq = 0; gq < 4; ++gq) { u32x2 w = *(const LAS u32x2*)(Pb + (32 * dt + 8 * gq) * 2); if (!act) w = (u32x2){0u, 0u};
                                O[dt][4 * gq] += bflo(w.x); O[dt][4 * gq + 1] += bfhi(w.x); O[dt][4 * gq + 2] += bflo(w.y); O[dt][4 * gq + 3] += bfhi(w.y); }
                        l += act ? LSUM[(((rk + 1) & 1) * 8 + slot) * 32 + prow] : 0.f; }
                    base += nch; } }
            if (myj >= 0) {
                LAS unsigned char* Pw = lds + OFF_PBUF + ((rk & 1) * 8 + wave) * PSLOT;
                if ((mymask >> lane) & 1ull) LIST[__popcll(mymask & ((1ull << lane) - 1ull))] = lane;
                const int rank = 8 * myc + (r >> 2); const bool valid = rank < __popcll(mymask);
                const int tok = valid ? LIST[rank] : 0; const int qrow = tok * 4 + hp;
                bf16x8 qg[4];
#pragma unroll
                for (int ks = 0; ks < 4; ++ks) qg[ks] = *(const LAS bf16x8*)(Qs + qrow * ROWB + ks * 32 + h * 16);
                const float mr = MREF[qrow];
                float rs = 0.f; f32x16 Oc[2];
#pragma unroll
                for (int i = 0; i < 16; ++i) { Oc[0][i] = 0.f; Oc[1][i] = 0.f; }
#pragma unroll
                for (int kh = 0; kh < 2; ++kh) { f32x16 sv;
#pragma unroll
                    for (int i = 0; i < 16; ++i) sv[i] = 0.f;
#pragma unroll
                    for (int ks = 0; ks < 4; ++ks) sv = MFMA32(kf[kh][ks], qg[ks], sv);
#pragma unroll
                    for (int i = 0; i < 16; ++i) { sv[i] = valid ? fexp2(fminf(sv[i] - mr, 100.0f)) : 0.f; rs += sv[i]; }
#pragma unroll
                    for (int s2 = 0; s2 < 2; ++s2) { const bf16x8 pf = pack8(sv, s2);
                        Oc[0] = MFMA32(vf[0][kh * 2 + s2], pf, Oc[0]); Oc[1] = MFMA32(vf[1][kh * 2 + s2], pf, Oc[1]); } }
                rs += __shfl_xor(rs, 32);
                if (h == 0) LSUM[((rk & 1) * 8 + wave) * 32 + r] = rs;
#pragma unroll
                for (int dt = 0; dt < 2; ++dt)
#pragma unroll
                    for (int gq = 0; gq < 4; ++gq) { u32x2 w; w.x = pk2(Oc[dt][4 * gq], Oc[dt][4 * gq + 1]); w.y = pk2(Oc[dt][4 * gq + 2], Oc[dt][4 * gq + 3]);
                        *(LAS u32x2*)(Pw + r * ROWB + (32 * dt + 8 * gq + 4 * h) * 2) = w; }
            }
            __syncthreads();
            pjs = cjs; pcnt = cnt; ++rk;
        }
#undef FAR_TM
    }
    { int lp_ = lane; asm volatile("" : "+v"(lp_)); const float* oapark = (const float*)(ws + WS_HIDM) + ((size_t)(blockIdx.x * 8 + wave) * 32) * 64 + lp_;
#pragma unroll
      for (int i = 0; i < 16; ++i) { OA[0][i] = oapark[i * 64]; OA[1][i] = oapark[(16 + i) * 64]; } }
    ATT_FOLD(1);
    ATT_LOADQ();
    ATT_RESET();
    {
        int lw_ = lane; asm volatile("" : "+v"(lw_)); const int r = lw_ & 31, h = lw_ >> 5, tokl = 8 * wave + (r >> 2);
        const int jlo = qt >= 8 ? qt - 8 : 0;
        const bf16_t* KW = U + (size_t)(b * SEQ + jlo * 64) * NU + UKW + gg * 64; const bf16_t* VWT = (const bf16_t*)(ws + WS_VWT) + ((size_t)bg * 128 + jlo) * 4096;
        ATT_LOOP(qt - jlo + 1, KW + (size_t)pi * 64 * NU, NU, VWT + (size_t)pi * 4096, 64, true, {
            const int j = jlo + ti;
            const bool low = (j + 8 == qt), diag = (j == qt);
            const int lo = low ? tokl + 1 : 0, hi = diag ? tokl : 63;
            tile_compute<0>(Kb, Vb, qf, r, h, lo, hi, low || diag, m, l, O, 0.f, 0.f, nullptr, nullptr, 0); })
        ATT_FOLD(2);
    }
    int lo_ = lane; asm volatile("" : "+v"(lo_)); const int h_o = lo_ >> 5;
    bf16_t* orow = (bf16_t*)(ws + WS_CAT) + (size_t)(b * SEQ + t0 + 8 * wave + ((lo_ & 31) >> 2)) * DM + (4 * gg + (lo_ & 3)) * 64;
#pragma unroll
    for (int dt = 0; dt < 2; ++dt)
#pragma unroll
        for (int gq = 0; gq < 4; ++gq) { u32x2 w; w.x = pk2(OA[dt][4 * gq], OA[dt][4 * gq + 1]); w.y = pk2(OA[dt][4 * gq + 2], OA[dt][4 * gq + 3]);
            *(u32x2*)(orow + 32 * dt + 8 * gq + 4 * h_o) = w; }
#undef ATT_RESET
#undef ATT_FOLD
#undef ATT_LOADQ
#undef ATT_UROW
#undef ATT_LOOP
#undef ATT_STEP
}

DI void attn_phase(const Params& P, LAS unsigned char* lds, int vcu, int G, int wave, int lane, int tid) {
    int it = 0;
    CvState cv; { const int first = CV_EARLY_EXPERTS * CV_PER_EXPERT, per = (CV_TOTAL - first) / (G * 8), gw = vcu * 8 + wave; cv.next = first + gw * per; cv.end = (gw == G * 8 - 1) ? CV_TOTAL : cv.next + per; cv.nfly = 0; cv.xafter = false; }
    static constexpr unsigned char QT_TAB[32][4] = {{14,37,91,127},{30,44,68,126},{31,35,77,100},{23,48,69,125},{27,40,76,99},{10,53,79,124},{17,38,85,123},{19,32,89,122},{20,33,87,121},{29,43,70,120},{21,54,66,107},{0,58,90,119},{25,42,75,118},{22,47,74,106},{18,34,88,117},{3,51,92,105},{15,56,71,116},{11,39,93,98},{9,49,82,115},{28,36,78,114},{24,52,64,113},{16,41,84,104},{5,46,95,97},{4,59,81,112},{26,50,65,103},{8,62,72,111},{6,45,94,102},{7,55,80,96},{2,61,83,110},{13,63,67,101},{1,60,86,109},{12,57,73,108}};
    if (G == 256) {
        const int bg = vcu >> 5, s = vcu & 31;
        for (int k = 3; k >= 0; --k) { const int qt = (k == 0) ? QT_TAB[s][0] : (k == 1) ? QT_TAB[s][1] : (k == 2) ? QT_TAB[s][2] : QT_TAB[s][3]; attn_unit(P, lds, bg, qt, wave, lane, tid, it, cv); }
    } else {
        for (int ui = vcu; ui < 1024; ui += G) { const int k = ui >> 8, v = ui & 255, bg = v >> 5, s = v & 31;
            const int qt = (k == 0) ? s : (k == 1) ? 63 - s : (k == 2) ? 64 + s : 127 - s;
            attn_unit(P, lds, bg, qt, wave, lane, tid, it, cv); }
    }
    for (;;) {
        if (cv.nfly > 0) { asm volatile("s_waitcnt vmcnt(0)" ::: "memory"); while (cv.nfly > 0) cv_finish(P, cv, lds, wave, lane); }
        if (cv.next >= cv.end) break;
        cv_issue(P, cv, lds, wave, lane); if (cv.next < cv.end) cv_issue(P, cv, lds, wave, lane); }
    __syncthreads();
}
}
#ifndef CHECK_ATTN
#define CHECK_ATTN 0
#endif
#if CHECK_ATTN
constexpr int CW_ERR = 8192;
namespace attnchk {
DI float wmax(float v) {
#pragma unroll
    for (int o = 1; o < 64; o <<= 1) v = fmaxf(v, __shfl_xor(v, o));
    return v; }
DI void item(const Params& P, LAS float* scr, int bg, int t, int lane, float& se, float& sr) {
    unsigned char* ws = P.ws; const bf16_t* U = (const bf16_t*)(ws + WS_U);
    const int b = bg >> 1, gg = bg & 1;
    LAS float* q = scr; LAS float* pc = scr + 256; LAS float* sc = scr + 768;
    const bf16_t* urow = U + (size_t)(b * SEQ + t) * NU;
    for (int i = lane; i < 256; i += 64) q[i] = bf2f(urow[UQ + gg * 256 + i]);
    const bf16_t* KC = (const bf16_t*)(ws + WS_KC) + (size_t)bg * 512 * 64; const bf16_t* VCT = (const bf16_t*)(ws + WS_VCT) + (size_t)bg * 64 * 512;
    const int nvalid = t >= 31 ? ((t - 31) >> 4) + 1 : 0, cur = t >> 6;
    float oc[4], os[4], ow[4], imp0 = 0.f, imp1 = 0.f;
    for (int p = 0; p < 4; ++p) {
        float sv[8], mx = -3e38f;
        for (int i = 0; i < 8; ++i) { const int n = lane + 64 * i; float a = 0.f;
            if (n < nvalid) { for (int d = 0; d < 64; ++d) a += q[p * 64 + d] * bf2f(KC[n * 64 + d]); mx = fmaxf(mx, a); }
            sv[i] = a; }
        mx = wmax(mx); float ls = 0.f;
        for (int i = 0; i < 8; ++i) { const int n = lane + 64 * i; const float e = (n < nvalid) ? exp2f(sv[i] - mx) : 0.f; sv[i] = e; ls += e; }
        ls = wave_sum(ls); const float inv = ls > 0.f ? 1.f / ls : 0.f;
        for (int i = 0; i < 8; ++i) pc[lane + 64 * i] = sv[i] * inv;
        float o = 0.f;
        for (int n = 0; n < nvalid; ++n) { const int pos = (n & ~15) | (int)swap23((unsigned)n & 15u); o += pc[n] * bf2f(VCT[lane * 512 + pos]); }
        oc[p] = o;
        for (int k = -1; k <= 3; ++k) { const int n0 = 4 * lane + k, n1 = 4 * (lane + 64) + k;
            if (n0 >= 0 && n0 < nvalid) imp0 += pc[n0]; if (n1 < nvalid) imp1 += pc[n1]; }
    }
    const float INF = __builtin_inff();
    const int s0 = lane, s1 = lane + 64;
    const float v0 = (s0 == 0 || s0 == cur || s0 == cur - 1) ? INF : (s0 <= cur ? imp0 : -INF);
    const float v1 = (s1 == cur || s1 == cur - 1) ? INF : (s1 <= cur ? imp1 : -INF);
    int r0 = 0, r1 = 0;
    for (int j = 0; j < 128; ++j) { const float vj = (j < 64) ? __shfl(v0, j) : __shfl(v1, j - 64);
        r0 += (vj > v0 || (vj == v0 && j < s0)) ? 1 : 0; r1 += (vj > v1 || (vj == v1 && j < s1)) ? 1 : 0; }
    const unsigned long long m0 = __ballot(r0 < 16 && v0 > -INF), m1 = __ballot(r1 < 16 && v1 > -INF);
    for (int br = 0; br < 2; ++br) {
        const bf16_t* Kp = U + (size_t)(b * SEQ) * NU + (br ? UKW : UKS) + gg * 64; const bf16_t* Vp = U + (size_t)(b * SEQ) * NU + (br ? UVW : UVS) + gg * 64;
        for (int p = 0; p < 4; ++p) {
            int nk = 0; float mx = -3e38f;
            if (br == 0) {
                for (int j = 0; j < 128; ++j) { const bool on = (j < 64) ? ((m0 >> j) & 1ull) : ((m1 >> (j - 64)) & 1ull); if (!on) continue;
                    const int key = 64 * j + lane; float a = -3e38f;
                    if (key <= t) { a = 0.f; for (int d = 0; d < 64; ++d) a += q[p * 64 + d] * bf2f(Kp[(size_t)key * NU + d]); mx = fmaxf(mx, a); }
                    sc[nk * 64 + lane] = a; ++nk; }
            } else {
                for (int i = 0; i < 8; ++i) { const int key = t - 511 + lane + 64 * i; float a = -3e38f;
                    if (key >= 0 && key <= t) { a = 0.f; for (int d = 0; d < 64; ++d) a += q[p * 64 + d] * bf2f(Kp[(size_t)key * NU + d]); mx = fmaxf(mx, a); }
                    sc[i * 64 + lane] = a; }
                nk = 8;
            }
            mx = wmax(mx); float ls = 0.f;
            for (int i = 0; i < nk; ++i) { const float a = sc[i * 64 + lane]; const float e = (a > -1e38f) ? exp2f(a - mx) : 0.f; sc[i * 64 + lane] = e; ls += e; }
            ls = wave_sum(ls); const float inv = ls > 0.f ? 1.f / ls : 0.f;
            float o = 0.f;
            if (br == 0) { int idx = 0;
                for (int j = 0; j < 128; ++j) { const bool on = (j < 64) ? ((m0 >> j) & 1ull) : ((m1 >> (j - 64)) & 1ull); if (!on) continue;
                    for (int kk = 0; kk < 64; ++kk) { const float pv = sc[idx * 64 + kk]; if (pv != 0.f) o += pv * bf2f(Vp[(size_t)(64 * j + kk) * NU + lane]); }
                    ++idx; }
                os[p] = o * inv;
            } else {
                for (int i = 0; i < 8; ++i) for (int kk = 0; kk < 64; ++kk) { const int key = t - 511 + kk + 64 * i; const float pv = sc[i * 64 + kk]; if (pv != 0.f) o += pv * bf2f(Vp[(size_t)key * NU + lane]); }
                ow[p] = o * inv;
            }
        }
    }
    const bf16_t* cat = (const bf16_t*)(ws + WS_CAT) + (size_t)(b * SEQ + t) * DM;
    for (int p = 0; p < 4; ++p) {
        const float g0 = fsigmoid(bf2f(urow[UGT + gg * 12 + p * 3 + 0])), g1 = fsigmoid(bf2f(urow[UGT + gg * 12 + p * 3 + 1])), g2 = fsigmoid(bf2f(urow[UGT + gg * 12 + p * 3 + 2]));
        const float ref = g0 * oc[p] + g1 * os[p] + g2 * ow[p], got = bf2f(cat[(4 * gg + p) * 64 + lane]);
        se += (ref - got) * (ref - got); sr += ref * ref; }
}
DI void phase(const Params& P, LAS unsigned char* lds, int vcu, int G, int wave, int lane) {
    LAS float* scr = (LAS float*)(lds + wave * 8192);
    float se = 0.f, sr = 0.f;
    for (int it = vcu * 8 + wave; it < 8 * SEQ; it += G * 8) { const int bg = it / SEQ, t = it % SEQ; item(P, scr, bg, t, lane, se, sr); }
    se = wave_sum(se); sr = wave_sum(sr);
    if (lane == 0) { atomicAdd((float*)(P.ws + WS_CTL) + CW_ERR, se); atomicAdd((float*)(P.ws + WS_CTL) + CW_ERR + 1, sr); }
}
}
#endif
DI void phase_ln1(const Params& P, int vcu, int G, int wave, int lane, bf16_t* x1base) {
    const float* mod = (const float*)(P.ws + WS_MOD);
    for (int mrow = vcu * 8 + wave; mrow < NT; mrow += G * 8) { const int b = mrow / SEQ;
        const u32x2* vr = (const u32x2*)((const bf16_t*)(P.ws + WS_V1) + (size_t)mrow * DM) + lane; f32x4 v[4]; float s = 0.f;
#pragma unroll
        for (int j = 0; j < 4; ++j) { const u32x2 q = vr[64 * j]; v[j] = (f32x4){bflo(q.x), bfhi(q.x), bflo(q.y), bfhi(q.y)}; s += (v[j].x + v[j].y) + (v[j].z + v[j].w); }
        const float mean = wave_sum(s) * (1.f / DM); float s2 = 0.f;
#pragma unroll
        for (int j = 0; j < 4; ++j) { v[j] = v[j] - mean; s2 += (v[j].x * v[j].x + v[j].y * v[j].y) + (v[j].z * v[j].z + v[j].w * v[j].w); }
        const float rstd = 1.f / sqrtf(wave_sum(s2) * (1.f / DM) + LN_EPS);
        unsigned long long* o8 = (unsigned long long*)((bf16_t*)(P.ws + WS_H2) + (size_t)mrow * DM) + lane;
        unsigned long long* x8 = (unsigned long long*)(x1base + (size_t)mrow * DM) + lane;
#pragma unroll
        for (int j = 0; j < 4; ++j) { const int c0 = 4 * lane + 256 * j;
            const f32x4 g = *(const f32x4*)(P.ln1_g + c0), bb = *(const f32x4*)(P.ln1_b + c0);
            const f32x4 sh = *(const f32x4*)(mod + b * 6144 + 3 * 1024 + c0), sc = *(const f32x4*)(mod + b * 6144 + 4 * 1024 + c0);
            const f32x4 x1 = v[j] * rstd * g + bb;
            x8[64 * j] = (unsigned long long)pk2(x1.x, x1.y) | ((unsigned long long)pk2(x1.z, x1.w) << 32);
            const f32x4 y = x1 * (sc + 1.0f) + sh;
            o8[64 * j] = (unsigned long long)pk2(y.x, y.y) | ((unsigned long long)pk2(y.z, y.w) << 32); }
    }
}

DI unsigned f2ord(float f) { const unsigned u = __float_as_uint(f); return (u & 0x80000000u) ? ~u : (u | 0x80000000u); }
template <int CTRL, int RMASK> DI unsigned dppu(unsigned oldv, unsigned v) { return (unsigned)__builtin_amdgcn_update_dpp((int)oldv, (int)v, CTRL, RMASK, 0xf, false); }
template <int CTRL, int RMASK> DI float dppf(float oldv, float v) { return __uint_as_float(dppu<CTRL, RMASK>(__float_as_uint(oldv), __float_as_uint(v))); }
DI unsigned wave_umax(unsigned v) {
    v = max(v, dppu<0x111, 0xf>(0u, v)); v = max(v, dppu<0x112, 0xf>(0u, v)); v = max(v, dppu<0x114, 0xf>(0u, v)); v = max(v, dppu<0x118, 0xf>(0u, v));
    v = max(v, dppu<0x142, 0xa>(0u, v)); v = max(v, dppu<0x143, 0xc>(0u, v));
    return (unsigned)__builtin_amdgcn_readlane((int)v, 63);
}
template <int CTRL, int RMASK> DI void top2_step(float& t1, float& t2) { const float NI = -3.0e38f; const float a1 = dppf<CTRL, RMASK>(NI, t1), a2 = dppf<CTRL, RMASK>(NI, t2);
    const float n1 = fmaxf(t1, a1), n2 = fmaxf(fminf(t1, a1), fmaxf(t2, a2)); t1 = n1; t2 = n2; }
DI void half_top2(float& t1, float& t2) { top2_step<0x111, 0xf>(t1, t2); top2_step<0x112, 0xf>(t1, t2); top2_step<0x114, 0xf>(t1, t2); top2_step<0x118, 0xf>(t1, t2); top2_step<0x142, 0xa>(t1, t2); }
DI void phase_route(const Params& P, LAS unsigned char* lds, int vcu, int G, int wave, int lane, int tid) {
    unsigned char* ws = P.ws;
    LAS int* hist = (LAS int*)lds;
    const float* logit = (const float*)(ws + WS_LOGIT);
    int* tok_e = (int*)(ws + WS_TOKE); float* tok_w = (float*)(ws + WS_TOKW); int* lrank = (int*)(ws + WS_LRANK);
    { int* rt = (int*)(ws + WS_ROWTOK); for (int i = vcu * 512 + tid; i < NPAD_MAX; i += G * 512) rt[i] = 0; }
    float bias[4];
#pragma unroll
    for (int k = 0; k < 4; ++k) bias[k] = P.router_bias[lane + 64 * k];
    const int tpw = NT / G;
    for (int base = vcu * tpw; base < NT; base += G * tpw) {
        __syncthreads();
        if (tid < 256) hist[tid] = 0;
        __syncthreads();
        float lg[2][4];
#pragma unroll
        for (int u = 0; u < 2; ++u) { const int tq0 = wave + 8 * u; const int t0 = base + (tq0 < tpw ? tq0 : wave);
#pragma unroll
            for (int k = 0; k < 4; ++k) lg[u][k] = logit[(size_t)t0 * 256 + lane + 64 * k]; }
        for (int tq = wave; tq < tpw; tq += 16) {
            int tkn[2]; tkn[0] = base + tq; tkn[1] = (tq + 8 < tpw) ? base + tq + 8 : base + tq;
            const bool two = (tq + 8 < tpw);
            float s[2][4], sel[2][4];
#pragma unroll
            for (int u = 0; u < 2; ++u)
#pragma unroll
                for (int k = 0; k < 4; ++k) { s[u][k] = fsigmoid(lg[u][k]); sel[u][k] = s[u][k] + bias[k]; }
            if (tq + 16 < tpw) {
#pragma unroll
                for (int u = 0; u < 2; ++u) { const int tqn = tq + 16 + 8 * u; const int tn = base + (tqn < tpw ? tqn : tq + 16);
#pragma unroll
                    for (int k = 0; k < 4; ++k) lg[u][k] = logit[(size_t)tn * 256 + lane + 64 * k]; } }
            unsigned key[2][4];
#pragma unroll
            for (int u = 0; u < 2; ++u) {
                float gs[8];
#pragma unroll
                for (int k = 0; k < 4; ++k) { float t1 = sel[u][k], t2 = -3.0e38f; half_top2(t1, t2); const float sm = t1 + t2;
                    gs[2 * k] = __uint_as_float((unsigned)__builtin_amdgcn_readlane((int)__float_as_uint(sm), 31)); gs[2 * k + 1] = __uint_as_float((unsigned)__builtin_amdgcn_readlane((int)__float_as_uint(sm), 63)); }
                bool gsel[8];
#pragma unroll
                for (int a2 = 0; a2 < 8; ++a2) { int rk = 0;
#pragma unroll
                    for (int c2 = 0; c2 < 8; ++c2) rk += (gs[c2] > gs[a2] || (gs[c2] == gs[a2] && c2 < a2)) ? 1 : 0;
                    gsel[a2] = rk < 4; }
                const int hh = lane >> 5;
#pragma unroll
                for (int k = 0; k < 4; ++k) { const bool on = hh ? gsel[2 * k + 1] : gsel[2 * k]; key[u][k] = on ? f2ord(sel[u][k]) : 0u; }
            }
            float ssum[2] = {0.f, 0.f}; int che[2][4];
#pragma unroll
            for (int u = 0; u < 2; ++u)
#pragma unroll
                for (int k = 0; k < 4; ++k) che[u][k] = -1;
            for (int it8 = 0; it8 < 8; ++it8) {
#pragma unroll
                for (int u = 0; u < 2; ++u) {
                    const unsigned lm = max(max(key[u][0], key[u][1]), max(key[u][2], key[u][3]));
                    const unsigned M = wave_umax(lm);
                    int ck = -1, cl = 0;
#pragma unroll
                    for (int k = 3; k >= 0; --k) { const unsigned long long eq = __ballot(key[u][k] == M); if (eq != 0ull) { ck = k; cl = __ffsll((long long)eq) - 1; } }
#pragma unroll
                    for (int k = 0; k < 4; ++k) { const bool mine = (k == ck) && (lane == cl); if (mine) { che[u][k] = it8; key[u][k] = 0u; } }
                }
            }
#pragma unroll
            for (int u = 0; u < 2; ++u) { if (u == 1 && !two) break;
                float sm = 0.f;
#pragma unroll
                for (int k = 0; k < 4; ++k) sm += (che[u][k] >= 0) ? s[u][k] : 0.f;
                sm = wave_sum(sm);
                const float wn = 2.5f / sm;
#pragma unroll
                for (int k = 0; k < 4; ++k) if (che[u][k] >= 0) { const int e = lane + 64 * k; const int lr = __hip_atomic_fetch_add(hist + e, 1, __ATOMIC_RELAXED, __HIP_MEMORY_SCOPE_WORKGROUP);
                    tok_e[tkn[u] * 8 + che[u][k]] = e; tok_w[tkn[u] * 8 + che[u][k]] = s[u][k] * wn; lrank[tkn[u] * 8 + che[u][k]] = lr; }
            }
            (void)ssum;
        }
        __syncthreads();
        if (tid < 256) ((int*)(ws + WS_HIST))[(base / tpw) * 256 + tid] = hist[tid];
    }
    __syncthreads();
}

DI void phase_scatter(const Params& P, LAS unsigned char* lds, int vcu, int G, int wave, int lane, int tid) {
    unsigned char* ws = P.ws;
    LAS int* sbase = (LAS int*)lds; LAS int* spad = sbase + 256; LAS int* sstart = spad + 256;
    const unsigned* hist = (const unsigned*)(ws + WS_HIST);
    const int* tok_e = (const int*)(ws + WS_TOKE); const int* lrank = (const int*)(ws + WS_LRANK);
    int* rowtok = (int*)(ws + WS_ROWTOK); int* pos_of = (int*)(ws + WS_POSOF); int* blk_e = (int*)(ws + WS_BLKE);
    const int tpw = NT / G, nslots = NT / tpw;
    for (int base = vcu * tpw; base < NT; base += G * tpw) { const int slot = base / tpw;
        __syncthreads();
        if (tid < 256) { int tot = 0, below = 0;
            for (int w2 = 0; w2 < nslots; ++w2) { const int hv = (int)hist[w2 * 256 + tid]; tot += hv; below += (w2 < slot) ? hv : 0; }
            spad[tid] = (tot + 255) & ~255; sbase[tid] = below; }
        __syncthreads();
        if (tid == 0) { int run = 0; for (int e = 0; e < 256; ++e) { sstart[e] = run; run += spad[e]; } sstart[256] = run; }
        __syncthreads();
        for (int i = tid; i < tpw * 8; i += 512) { const int a = base * 8 + i; const int e = tok_e[a]; const int pos = sstart[e] + sbase[e] + lrank[a];
            rowtok[pos] = a >> 3; pos_of[a] = pos; }
        if (slot == 0) {
            if (tid < 256) { const int b0 = sstart[tid] >> 8, b1 = (sstart[tid] + spad[tid]) >> 8; for (int bb = b0; bb < b1; ++bb) blk_e[bb] = tid; }
            if (tid == 0) blk_e[NBLK_MAX] = sstart[256] >> 8;
        }
    }
    __syncthreads();
}

DI void phase_final(const Params& P, int vcu, int G, int wave, int lane, float* dstbase) {
    unsigned char* ws = P.ws;
    const float* mod = (const float*)(ws + WS_MOD);
    const int* pos_of = (const int*)(ws + WS_POSOF); const float* tok_w = (const float*)(ws + WS_TOKW);
    const unsigned char* Y = (const unsigned char*)(ws + WS_YMOE);
    float dbg_scale = 1.0f;
#if CHECK_ATTN
    { const float se = __uint_as_float(ld_u32_agent((const unsigned*)(ws + WS_CTL) + CW_ERR)), sr = __uint_as_float(ld_u32_agent((const unsigned*)(ws + WS_CTL) + CW_ERR + 1)); const float err = sqrtf(se / fmaxf(sr, 1e-30f)); dbg_scale = 1.0f + (err < 0.005f ? 0.f : err < 0.02f ? 0.04f : err < 0.08f ? 0.055f : err < 0.3f ? 0.07f : 0.085f); }
#endif
    for (int mrow = vcu * 8 + wave; mrow < NT; mrow += G * 8) { const int b = mrow / SEQ;
        const u32x2* xr = (const u32x2*)((const bf16_t*)(ws + WS_X1) + (size_t)mrow * DM) + lane; const u32x2* sr = (const u32x2*)((const bf16_t*)(ws + WS_SH) + (size_t)mrow * DM) + lane; f32x4 v[4], ya[4];
#pragma unroll
        for (int j = 0; j < 4; ++j) { const u32x2 q = xr[64 * j], q2 = sr[64 * j]; v[j] = (f32x4){bflo(q.x), bfhi(q.x), bflo(q.y), bfhi(q.y)} * DN_ALPHA; ya[j] = (f32x4){bflo(q2.x), bfhi(q2.x), bflo(q2.y), bfhi(q2.y)}; }
        const int mypos = pos_of[(size_t)mrow * 8 + (lane & 7)]; const float myw = tok_w[(size_t)mrow * 8 + (lane & 7)];
#pragma unroll
        for (int k = 0; k < 8; ++k) { const int pos = __shfl(mypos, k); const float wk = __shfl(myw, k) * (1.0f / YMOE_SCALE);
            const unsigned* yr = (const unsigned*)(Y + (size_t)pos * DM) + lane;
#pragma unroll
            for (int j = 0; j < 4; ++j) { const int q = (int)yr[64 * j]; const f32x2 lo = __builtin_amdgcn_cvt_pk_f32_fp8(q, false), hi = __builtin_amdgcn_cvt_pk_f32_fp8(q, true);
                ya[j].x += wk * lo.x; ya[j].y += wk * lo.y; ya[j].z += wk * hi.x; ya[j].w += wk * hi.y; } }
        float s = 0.f;
#pragma unroll
        for (int j = 0; j < 4; ++j) { const f32x4 g2 = *(const f32x4*)(mod + b * 6144 + 5 * 1024 + 4 * lane + 256 * j); v[j] = v[j] + g2 * ya[j]; s += (v[j].x + v[j].y) + (v[j].z + v[j].w); }
        const float mean = wave_sum(s) * (1.f / DM); float s2 = 0.f;
#pragma unroll
        for (int j = 0; j < 4; ++j) { v[j] = v[j] - mean; s2 += (v[j].x * v[j].x + v[j].y * v[j].y) + (v[j].z * v[j].z + v[j].w * v[j].w); }
        const float rstd = 1.f / sqrtf(wave_sum(s2) * (1.f / DM) + LN_EPS);
#pragma unroll
        for (int j = 0; j < 4; ++j) { const int c0 = 4 * lane + 256 * j; const f32x4 g = *(const f32x4*)(P.ln2_g + c0), bb = *(const f32x4*)(P.ln2_b + c0);
            ((f32x4*)(dstbase + (size_t)mrow * DM) + lane)[64 * j] = (v[j] * rstd * g + bb) * dbg_scale; }
    }
}
#ifndef REP_PHASE
#define REP_PHASE -1
#endif
#ifndef LN1_FUSED
#define LN1_FUSED 0
#endif
#ifndef MK_PER_PHASE
#define MK_PER_PHASE 0
#endif
DI void run_phase_0(const Params& P, LAS unsigned char* lds, int vcu, int G, int bx, int wave, int lane, int tid) {
    unsigned char* ws = P.ws; const float* mod = (const float*)(ws + WS_MOD); (void)mod; (void)ws;
 phase0a(P, lds, vcu, G, wave, lane, tid); }
DI void run_phase_1(const Params& P, LAS unsigned char* lds, int vcu, int G, int bx, int wave, int lane, int tid) {
    unsigned char* ws = P.ws; const float* mod = (const float*)(ws + WS_MOD); (void)mod; (void)ws;
 phase0b(P, lds, vcu, G, wave, lane, tid); }
DI void run_phase_2(const Params& P, LAS unsigned char* lds, int vcu, int G, int bx, int wave, int lane, int tid) {
    unsigned char* ws = P.ws; const float* mod = (const float*)(ws + WS_MOD); (void)mod; (void)ws;
        pg8::Gemm g{(const bf16_t*)(ws + WS_H1), (const bf16_t*)(ws + WS_WIN_T), DM, DM, DM, 128};
        pg8::DenseOrder S; S.init(g.A, DM, NT, NU, G, bx);
        pg8::EpiStoreBf16 E{(bf16_t*)(ws + WS_U), NU, 0.125f * 1.4426950408889634f, 2};
        pg8::gemm_phase<pg8::EpiStoreBf16, pg8::DenseOrder, true, false>(lds, g, S, E, nullptr);
    }
DI void run_phase_3(const Params& P, LAS unsigned char* lds, int vcu, int G, int bx, int wave, int lane, int tid) {
    unsigned char* ws = P.ws; const float* mod = (const float*)(ws + WS_MOD); (void)mod; (void)ws;
        if (bx < 32 && G > 32) {
            pg8::Gemm g{(const bf16_t*)(ws + WS_U), (const bf16_t*)(ws + WS_WC1_T), 16 * NU, 2048, 2048, NU * 2};
            pg8::CmpOrder S{G, bx, (const bf16_t*)(ws + WS_U)};
            pg8::EpiCmp E{(bf16_t*)(ws + WS_HCMP), (const float*)(ws + WS_PEB)};
            pg8::gemm_phase<pg8::EpiCmp, pg8::CmpOrder, true, false>(lds, g, S, E, nullptr);
        } else {
            const int nw = (G > 32) ? G - 32 : G, w0 = (G > 32) ? bx - 32 : bx;
            if (G <= 32) { pg8::Gemm g{(const bf16_t*)(ws + WS_U), (const bf16_t*)(ws + WS_WC1_T), 16 * NU, 2048, 2048, NU * 2};
                pg8::CmpOrder S{G, bx, (const bf16_t*)(ws + WS_U)}; pg8::EpiCmp E{(bf16_t*)(ws + WS_HCMP), (const float*)(ws + WS_PEB)};
                pg8::gemm_phase<pg8::EpiCmp, pg8::CmpOrder, true, false>(lds, g, S, E, nullptr); }
            conv_items(P, lds, w0, nw, wave, lane, tid);
            if (REP_PHASE == 31) conv_items(P, lds, w0, nw, wave, lane, tid);
            __syncthreads();
            vt_copies(P, lds, w0 * 8 + wave, nw * 8, wave, lane);
            __syncthreads();
        }
    }
DI void run_phase_4(const Params& P, LAS unsigned char* lds, int vcu, int G, int bx, int wave, int lane, int tid) {
    unsigned char* ws = P.ws; const float* mod = (const float*)(ws + WS_MOD); (void)mod; (void)ws;
 phase_cmp2(P, lds, vcu, G, wave, lane, tid); }
DI void run_phase_5(const Params& P, LAS unsigned char* lds, int vcu, int G, int bx, int wave, int lane, int tid) {
    unsigned char* ws = P.ws; const float* mod = (const float*)(ws + WS_MOD); (void)mod; (void)ws;
 attn::attn_phase(P, lds, vcu, G, wave, lane, tid); }
DI void run_phase_6(const Params& P, LAS unsigned char* lds, int vcu, int G, int bx, int wave, int lane, int tid) {
    unsigned char* ws = P.ws; const float* mod = (const float*)(ws + WS_MOD); (void)mod; (void)ws;
#if CHECK_ATTN
        attnchk::phase(P, lds, vcu, G, wave, lane); __syncthreads();
#endif
        pg8::Gemm g{(const bf16_t*)(ws + WS_CAT), (const bf16_t*)(ws + WS_WOUT_T), DM, DM, DM, 128};
        pg8::DenseOrder S; S.init(g.A, DM, NT, DM, G, bx);
        if (LN1_FUSED && G == 256) {
            pg8::EpiLnFused E{P.x, mod + 2 * 1024, mod + 3 * 1024, mod + 4 * 1024, 6144, P.ln1_g, P.ln1_b, (bf16_t*)(ws + WS_X1), (bf16_t*)(ws + WS_H2),
                              (unsigned long long*)(ws + WS_LNX), (unsigned*)(ws + WS_CTL) + CW_LNCNT, (unsigned*)(ws + WS_CTL) + CW_LNTMO, lds + LDS_TAB};
            { pg8::RoundOrder R{S, 0}; pg8::gemm_phase<pg8::EpiLnFused, pg8::RoundOrder, true, false>(lds, g, R, E, nullptr); }
            { pg8::RoundOrder R{S, 1}; pg8::gemm_phase<pg8::EpiLnFused, pg8::RoundOrder, true, false>(lds, g, R, E, nullptr); }
        } else {
            pg8::EpiResModBf16 E{P.x, (bf16_t*)(ws + WS_V1), mod + 2 * 1024, 6144};
            pg8::gemm_phase<pg8::EpiResModBf16, pg8::DenseOrder, true, false>(lds, g, S, E, nullptr);
        }
    }
DI void run_phase_7(const Params& P, LAS unsigned char* lds, int vcu, int G, int bx, int wave, int lane, int tid) {
    unsigned char* ws = P.ws; const float* mod = (const float*)(ws + WS_MOD); (void)mod; (void)ws;
 if (REP_PHASE == 70) { phase_ln1(P, vcu, G, wave, lane, (bf16_t*)(ws + WS_HIDM)); phase_ln1(P, vcu, G, wave, lane, (bf16_t*)(ws + WS_HIDM)); }
    if (!(LN1_FUSED && G == 256)) phase_ln1(P, vcu, G, wave, lane, (bf16_t*)(ws + WS_X1)); }
DI void run_phase_8(const Params& P, LAS unsigned char* lds, int vcu, int G, int bx, int wave, int lane, int tid) {
    unsigned char* ws = P.ws; const float* mod = (const float*)(ws + WS_MOD); (void)mod; (void)ws;
        { pg8::Gemm g{(const bf16_t*)(ws + WS_H2), (const bf16_t*)(ws + WS_WR_T), DM, DM, DM, 128};
          pg8::DenseOrder S; S.init(g.A, DM, NT, 256, G, bx);
          pg8::EpiF32 E{(float*)(ws + WS_LOGIT), 256};
          pg8::gemm_phase<pg8::EpiF32, pg8::DenseOrder, true, false>(lds, g, S, E, nullptr); }
        { pg8::Gemm g{(const bf16_t*)(ws + WS_H2), (const bf16_t*)(ws + WS_WSGU_T), DM, DM, DM, 128};
          pg8::DenseOrder S; S.init(g.A, DM, NT, 512, G, bx);
          pg8::EpiGlu E{(bf16_t*)(ws + WS_HIDS), 256};
          pg8::gemm_phase<pg8::EpiGlu, pg8::DenseOrder, true, false>(lds, g, S, E, nullptr); }
    }
DI void run_phase_9(const Params& P, LAS unsigned char* lds, int vcu, int G, int bx, int wave, int lane, int tid) {
    unsigned char* ws = P.ws; const float* mod = (const float*)(ws + WS_MOD); (void)mod; (void)ws;
        phase_route(P, lds, vcu, G, wave, lane, tid);
        if (REP_PHASE == 90) { phase_route(P, lds, vcu, G, wave, lane, tid); phase_route(P, lds, vcu, G, wave, lane, tid); }
        pg8::Gemm g{(const bf16_t*)(ws + WS_HIDS), (const bf16_t*)(ws + WS_WSD_T), 256, 256, 256, 128};
        pg8::DenseOrder S; S.init(g.A, 256, NT, DM, G, bx);
        pg8::EpiStoreBf16 E{(bf16_t*)(ws + WS_SH), DM, 1.0f, 0};
        pg8::gemm_phase<pg8::EpiStoreBf16, pg8::DenseOrder, true, false>(lds, g, S, E, nullptr);
    }
DI void run_phase_10(const Params& P, LAS unsigned char* lds, int vcu, int G, int bx, int wave, int lane, int tid) {
    unsigned char* ws = P.ws; const float* mod = (const float*)(ws + WS_MOD); (void)mod; (void)ws;
 phase_scatter(P, lds, vcu, G, wave, lane, tid); }
DI void run_phase_11(const Params& P, LAS unsigned char* lds, int vcu, int G, int bx, int wave, int lane, int tid) {
    unsigned char* ws = P.ws; const float* mod = (const float*)(ws + WS_MOD); (void)mod; (void)ws;
        const int nblk = (int)__builtin_amdgcn_readfirstlane((int)ld_u32_agent((const unsigned*)(ws + WS_BLKE) + NBLK_MAX));
        const int nunits = 2 * nblk; LAS int* tab = (LAS int*)(lds + LDS_TAB);
        { const int* rowtok = (const int*)(ws + WS_ROWTOK); int i = 0;
          for (int L = vcu; L < nunits && i < 28; L += G, ++i) { if (tid < 256) tab[i * 256 + tid] = rowtok[(L >> 1) * 256 + tid]; } }
        __syncthreads();
        pg8::Gemm g{(const bf16_t*)(ws + WS_H2), (const bf16_t*)(ws + WS_WGU_T), DM, DM, DM, 128};
        pg8::MoeOrder<2> S{G, vcu, nunits, (const int*)(ws + WS_BLKE), g.A, (size_t)0};
        pg8::EpiGlu E{(bf16_t*)(ws + WS_HIDM), 256};
        pg8::gemm_phase<pg8::EpiGlu, pg8::MoeOrder<2>, true, true>(lds, g, S, E, tab);
    }
DI void run_phase_12(const Params& P, LAS unsigned char* lds, int vcu, int G, int bx, int wave, int lane, int tid) {
    unsigned char* ws = P.ws; const float* mod = (const float*)(ws + WS_MOD); (void)mod; (void)ws;
        const int nblk = (int)__builtin_amdgcn_readfirstlane((int)ld_u32_agent((const unsigned*)(ws + WS_BLKE) + NBLK_MAX));
        pg8::Gemm g{(const bf16_t*)(ws + WS_HIDM), (const bf16_t*)(ws + WS_WDN_T), 256, 256, 256, 128};
        pg8::MoeOrder<4> S{G, vcu, 4 * nblk, (const int*)(ws + WS_BLKE), g.A, (size_t)256 * 256 * 2};
        pg8::EpiStoreFp8 E{(unsigned char*)(ws + WS_YMOE), DM, YMOE_SCALE};
        pg8::gemm_phase<pg8::EpiStoreFp8, pg8::MoeOrder<4>, true, false>(lds, g, S, E, nullptr);
    }
DI void run_phase_13(const Params& P, LAS unsigned char* lds, int vcu, int G, int bx, int wave, int lane, int tid) {
    unsigned char* ws = P.ws; const float* mod = (const float*)(ws + WS_MOD); (void)mod; (void)ws;
 if (REP_PHASE == 130) { phase_final(P, vcu, G, wave, lane, (float*)(ws + WS_HIDM)); phase_final(P, vcu, G, wave, lane, (float*)(ws + WS_HIDM)); }
    phase_final(P, vcu, G, wave, lane, P.out); }
constexpr int NPHASE = 14;
__global__ void __launch_bounds__(512, 2) nsa_conformer_moe_fwd(Params P) {
    extern __shared__ __attribute__((aligned(16))) unsigned char lds_raw[];
    LAS unsigned char* lds = (LAS unsigned char*)lds_raw;
    const int tid = threadIdx.x, lane = tid & 63, wave = __builtin_amdgcn_readfirstlane(tid >> 6);
    const int G = gridDim.x, bx = blockIdx.x, vcu = (G % 8 == 0) ? (bx % 8) * (G / 8) + bx / 8 : bx;
    unsigned char* ws = P.ws;
    volatile LAS unsigned* MISC = (volatile LAS unsigned*)(lds + LDS_MISC);
    if (tid < 64) MISC[tid] = 0u;
    __syncthreads();
    const int lo = P.ph_lo, hi = P.ph_hi;
    XcdBarrier bar; bar.bar = (unsigned*)(ws + WS_CTL) + CW_BAR; bar.x = 0; bar.st = MISC + 8;
    if (hi - lo > 1) bar = xcd_barrier_post((unsigned*)(ws + WS_CTL) + CW_BAR, MISC + 8);
#ifdef PH_ONLY
#define IN(k) ((k) == PH_ONLY && lo <= (k) && (k) < hi)
#else
#define IN(k) (lo <= (k) && (k) < hi)
#endif
#define SEAM(k) do { if (IN(k) && IN((k) + 1) && !((k) == 6 && LN1_FUSED && G == 256)) xcd_barrier(bar); } while (0)
    if (IN(0)) run_phase_0(P, lds, vcu, G, bx, wave, lane, tid);
    if (REP_PHASE == 0 && IN(0)) { run_phase_0(P, lds, vcu, G, bx, wave, lane, tid); run_phase_0(P, lds, vcu, G, bx, wave, lane, tid); }
    SEAM(0);
    if (REP_PHASE == 200 && IN(0) && IN(1)) { for (int q_ = 0; q_ < 20; ++q_) xcd_barrier(bar); }
    if (IN(1)) run_phase_1(P, lds, vcu, G, bx, wave, lane, tid);
    if (REP_PHASE == 1 && IN(1)) { run_phase_1(P, lds, vcu, G, bx, wave, lane, tid); run_phase_1(P, lds, vcu, G, bx, wave, lane, tid); }
    SEAM(1);
    if (IN(2)) run_phase_2(P, lds, vcu, G, bx, wave, lane, tid);
    if (REP_PHASE == 2 && IN(2)) { run_phase_2(P, lds, vcu, G, bx, wave, lane, tid); run_phase_2(P, lds, vcu, G, bx, wave, lane, tid); }
    SEAM(2);
    if (IN(3)) run_phase_3(P, lds, vcu, G, bx, wave, lane, tid);
    if (REP_PHASE == 3 && IN(3)) { run_phase_3(P, lds, vcu, G, bx, wave, lane, tid); run_phase_3(P, lds, vcu, G, bx, wave, lane, tid); }
    SEAM(3);
    if (IN(4)) run_phase_4(P, lds, vcu, G, bx, wave, lane, tid);
    if (REP_PHASE == 4 && IN(4)) { run_phase_4(P, lds, vcu, G, bx, wave, lane, tid); run_phase_4(P, lds, vcu, G, bx, wave, lane, tid); }
    SEAM(4);
    if (IN(5)) run_phase_5(P, lds, vcu, G, bx, wave, lane, tid);
    if (REP_PHASE == 5 && IN(5)) { run_phase_5(P, lds, vcu, G, bx, wave, lane, tid); run_phase_5(P, lds, vcu, G, bx, wave, lane, tid); }
    SEAM(5);
    if (IN(6)) run_phase_6(P, lds, vcu, G, bx, wave, lane, tid);
    if (REP_PHASE == 6 && IN(6)) { run_phase_6(P, lds, vcu, G, bx, wave, lane, tid); run_phase_6(P, lds, vcu, G, bx, wave, lane, tid); }
    SEAM(6);
    if (IN(7)) run_phase_7(P, lds, vcu, G, bx, wave, lane, tid);
    if (REP_PHASE == 7 && IN(7)) { run_phase_7(P, lds, vcu, G, bx, wave, lane, tid); run_phase_7(P, lds, vcu, G, bx, wave, lane, tid); }
    SEAM(7);
    if (IN(8)) run_phase_8(P, lds, vcu, G, bx, wave, lane, tid);
    if (REP_PHASE == 8 && IN(8)) { run_phase_8(P, lds, vcu, G, bx, wave, lane, tid); run_phase_8(P, lds, vcu, G, bx, wave, lane, tid); }
    SEAM(8);
    if (IN(9)) run_phase_9(P, lds, vcu, G, bx, wave, lane, tid);
    if (REP_PHASE == 9 && IN(9)) { run_phase_9(P, lds, vcu, G, bx, wave, lane, tid); run_phase_9(P, lds, vcu, G, bx, wave, lane, tid); }
    SEAM(9);
    if (IN(10)) run_phase_10(P, lds, vcu, G, bx, wave, lane, tid);
    if (REP_PHASE == 10 && IN(10)) { run_phase_10(P, lds, vcu, G, bx, wave, lane, tid); run_phase_10(P, lds, vcu, G, bx, wave, lane, tid); }
    SEAM(10);
    if (IN(11)) run_phase_11(P, lds, vcu, G, bx, wave, lane, tid);
    if (REP_PHASE == 11 && IN(11)) { run_phase_11(P, lds, vcu, G, bx, wave, lane, tid); run_phase_11(P, lds, vcu, G, bx, wave, lane, tid); }
    SEAM(11);
    if (IN(12)) run_phase_12(P, lds, vcu, G, bx, wave, lane, tid);
    if (REP_PHASE == 12 && IN(12)) { run_phase_12(P, lds, vcu, G, bx, wave, lane, tid); run_phase_12(P, lds, vcu, G, bx, wave, lane, tid); }
    SEAM(12);
    if (IN(13)) run_phase_13(P, lds, vcu, G, bx, wave, lane, tid);
    if (REP_PHASE == 13 && IN(13)) { run_phase_13(P, lds, vcu, G, bx, wave, lane, tid); run_phase_13(P, lds, vcu, G, bx, wave, lane, tid); }
#undef IN
#undef SEAM
}

extern "C" void kernel_launch(void* const* d_in, const int* in_sizes, int n_in, void* d_out, int out_size, void* d_ws, size_t ws_size, hipStream_t stream) {
    static int grid = 0;
    if (grid == 0) {
        if (n_in != 28 || out_size != NT * DM || ws_size < WS_END) { fprintf(stderr, "kernel_launch: unexpected arguments (n_in %d, out %d, ws %zu); nothing launched\n", n_in, out_size, ws_size); grid = -1; return; }
        int dev = 0, cus = 0, per_cu = 0;
        if (hipGetDevice(&dev) != hipSuccess || hipDeviceGetAttribute(&cus, hipDeviceAttributeMultiprocessorCount, dev) != hipSuccess) { grid = -1; return; }
        if (hipFuncSetAttribute((const void*)nsa_conformer_moe_fwd, hipFuncAttributeMaxDynamicSharedMemorySize, LDS_BYTES) != hipSuccess) { fprintf(stderr, "kernel_launch: hipFuncSetAttribute failed\n"); grid = -1; return; }
        if (hipOccupancyMaxActiveBlocksPerMultiprocessor(&per_cu, (const void*)nsa_conformer_moe_fwd, 512, LDS_BYTES) != hipSuccess || per_cu < 1) { fprintf(stderr, "kernel_launch: occupancy query says %d blocks per CU\n", per_cu); }
        (void)hipGetLastError();
        grid = cus;
    }
    if (grid < 0) return;
    (void)hipMemsetAsync((char*)d_ws + WS_CTL, 0, CTL_ZERO_BYTES, stream);
    Params p{};
    const float** pp = (const float**)&p;
    for (int i = 0; i < 28; ++i) pp[i] = (const float*)d_in[i];
    p.out = (float*)d_out; p.ws = (unsigned char*)d_ws;
#if MK_PER_PHASE
    for (int ph = 0; ph < NPHASE; ++ph) { p.ph_lo = ph; p.ph_hi = ph + 1; hipLaunchKernelGGL(nsa_conformer_moe_fwd, dim3(grid), dim3(512), LDS_BYTES, stream, p); }
#else
    p.ph_lo = 0; p.ph_hi = NPHASE;
    hipLaunchKernelGGL(nsa_conformer_moe_fwd, dim3(grid), dim3(512), LDS_BYTES, stream, p);
#endif
}
```

```cpp
#include <hip/hip_runtime.h>
#include <cstdio>
#include <cstdint>

#define DI __device__ __forceinline__
#define LAS __attribute__((address_space(3)))
#define GAS __attribute__((address_space(1)))
typedef unsigned short bf16_t;
typedef short bf16x8 __attribute__((ext_vector_type(8)));
typedef float f32x4 __attribute__((ext_vector_type(4)));
typedef float f32x16 __attribute__((ext_vector_type(16)));
typedef float f32x2 __attribute__((ext_vector_type(2)));
typedef unsigned u32x4 __attribute__((ext_vector_type(4)));
typedef unsigned u32x2 __attribute__((ext_vector_type(2)));
typedef __bf16 bf16x2_t __attribute__((ext_vector_type(2)));

constexpr int NB = 4, SEQ = 8192, DM = 1024, NT = NB * SEQ;
constexpr int NU = 2560;
constexpr int UQ = 0, UKC = 512, UVC = 640, UKS = 768, UVS = 896, UKW = 1024, UVW = 1152, UCA = 1280, UCG = 1792, UGT = 2304;
constexpr int DIN = 2328;
constexpr int NEXP = 256, DEXP = 256, TOPK = 8;
constexpr int NASSIGN = NT * TOPK;
constexpr int NPAD_MAX = NASSIGN + NEXP * 255 + 1;
constexpr int NBLK_MAX = NPAD_MAX / 256 + 1;
constexpr float LN_EPS = 1e-5f;
constexpr float YMOE_SCALE = 16.0f;
constexpr float DN_ALPHA = 1.189207115002721f;

DI unsigned pk2(float lo, float hi) { f32x2 v = {lo, hi}; bf16x2_t b = __builtin_convertvector(v, bf16x2_t); return __builtin_bit_cast(unsigned, b); }
DI float bflo(unsigned w) { return __uint_as_float(w << 16); }
DI float bfhi(unsigned w) { return __uint_as_float(w & 0xffff0000u); }
DI float bf2f(bf16_t b) { return __uint_as_float(((unsigned)b) << 16); }
DI float fsigmoid(float x) { return __builtin_amdgcn_rcpf(1.0f + __expf(-x)); }
DI float fsilu(float x) { return x * __builtin_amdgcn_rcpf(1.0f + __expf(-x)); }
DI float wave_sum(float v) {
#pragma unroll
    for (int o = 1; o < 64; o <<= 1) v += __shfl_xor(v, o);
    return v;
}
DI unsigned ld_u32_agent(const unsigned* p) { return __hip_atomic_load(p, __ATOMIC_RELAXED, __HIP_MEMORY_SCOPE_AGENT); }
#define LDS_WAIT() asm volatile("s_waitcnt lgkmcnt(0)" ::: "memory")
#define VM_WAIT() asm volatile("s_waitcnt vmcnt(0)" ::: "memory")

#define XB_TMO      128
#define XB_XCNT(j)  (256  + 64 * (j))
#define XB_XSUB(j)  (1280 + 64 * (j))
#define XB_XGEN(j)  (2304 + 64 * (j))
#define XB_TOP      3328
#define XB_TOPGEN   3392
#define XCD_BAR_WORDS 3456
#define XB_SPIN_CAP (1u << 18)
__device__ __forceinline__ unsigned xb_ld(unsigned* p)              { return __hip_atomic_load(p, __ATOMIC_RELAXED, __HIP_MEMORY_SCOPE_AGENT); }
__device__ __forceinline__ unsigned xb_add(unsigned* p, unsigned v) { return __hip_atomic_fetch_add(p, v, __ATOMIC_RELAXED, __HIP_MEMORY_SCOPE_AGENT); }
__device__ __forceinline__ unsigned xb_xcc_id() { return (unsigned)__builtin_amdgcn_s_getreg((3 << 11) | 20) & 0xFu; }
#define XB_SPIN(cond, bar) do { unsigned _sp = 0; while (cond) { __builtin_amdgcn_s_sleep(1); \
    if ((++_sp & 255u) == 0u) { if (xb_ld(&(bar)[XB_TMO])) break; if (_sp > XB_SPIN_CAP) { atomicAdd(&(bar)[XB_TMO], 1u); break; } } } } while (0)
struct XcdBarrier { unsigned* bar; unsigned x; volatile LAS unsigned* st; };
__device__ __forceinline__ XcdBarrier xcd_barrier_post(unsigned* bar, volatile LAS unsigned* st) {
    XcdBarrier b; b.bar = bar; b.x = xb_xcc_id(); b.st = st;
    if (threadIdx.x == 0) (void)xb_add(&bar[XB_XCNT(b.x)], 1u);
    return b;
}
__device__ __forceinline__ void xcd_barrier_complete(unsigned* bar, unsigned x, unsigned& nloc, unsigned& nx) {
    const unsigned G = gridDim.x * gridDim.y * gridDim.z;
    unsigned sum, cnt, mine, sp = 0u;
    for (;;) {
        sum = 0u; cnt = 0u; mine = 0u;
#pragma unroll
        for (unsigned j = 0; j < 16; ++j) { const unsigned c = xb_ld(&bar[XB_XCNT(j)]); sum += c; cnt += (c > 0u) ? 1u : 0u; mine = (j == x) ? c : mine; }
        if (sum == G) break;
        __builtin_amdgcn_s_sleep(1);
        if ((++sp & 255u) == 0u) { if (xb_ld(&bar[XB_TMO])) break; if (sp > XB_SPIN_CAP) { atomicAdd(&bar[XB_TMO], 1u); break; } }
    }
    nloc = mine > 0u ? mine : 1u; nx = cnt > 0u ? cnt : 1u;
}
__device__ __forceinline__ void xcd_barrier(const XcdBarrier& b) {
    asm volatile("s_waitcnt vmcnt(0)" ::: "memory");
    __syncthreads();
    if (threadIdx.x == 0) {
        unsigned* bar = b.bar;
        __builtin_amdgcn_s_waitcnt(0);
        unsigned nloc = b.st[0], nx = b.st[1];
        if (nloc == 0u) { xcd_barrier_complete(bar, b.x, nloc, nx); b.st[0] = nloc; b.st[1] = nx; }
        const unsigned old = xb_add(&bar[XB_XSUB(b.x)], 1u);
        const unsigned gen = old / nloc;
        if (old + 1u == (gen + 1u) * nloc) {
            __builtin_amdgcn_fence(__ATOMIC_RELEASE, "agent");
            asm volatile("s_waitcnt vmcnt(0)" ::: "memory");
            const unsigned og = xb_add(&bar[XB_TOP], 1u);
            const unsigned tg = og / nx;
            if (og + 1u == (tg + 1u) * nx) xb_add(&bar[XB_TOPGEN], 1u);
            else XB_SPIN(xb_ld(&bar[XB_TOPGEN]) == tg, bar);
            __builtin_amdgcn_fence(__ATOMIC_ACQUIRE, "agent");
            xb_add(&bar[XB_XGEN(b.x)], 1u);
            asm volatile("s_waitcnt vmcnt(0)" ::: "memory");
        } else {
            XB_SPIN(xb_ld(&bar[XB_XGEN(b.x)]) == gen, bar);
            __builtin_amdgcn_fence(__ATOMIC_ACQUIRE, "agent");
            asm volatile("s_waitcnt vmcnt(0)" ::: "memory");
        }
    }
    __syncthreads();
}

namespace pg8 {
constexpr int BM = 256, BK = 64, HALF = 128, HTB = HALF * BK * 2, STAGE_BYTES = 8 * HTB, NXCD = 8, WGM = 8;
__host__ __device__ __forceinline__ int lds_byte(int r, int c) { const int st = (r >> 4) * 2 + (c >> 5), rr = r & 15, cc = c & 31, ob = rr * 64 + cc * 2; return st * 1024 + (ob ^ (((ob >> 9) & 1) << 5)); }
__host__ __device__ __forceinline__ void stage_rc(int b, int& R, int& C) { const int st = b / 1024, sb = b % 1024, swz = sb ^ (((sb >> 9) & 1) << 5); R = (st >> 1) * 16 + swz / 64; C = (st & 1) * 32 + (swz % 64) / 2; }
__host__ __device__ __forceinline__ int perm32(int rho) { const int n = rho >> 4, i = rho & 15; return 8 * (i >> 2) + 4 * n + (i & 3); }

struct Unit { int pm, pn, po; };
struct Gemm { const bf16_t* A; const bf16_t* Bt; int lda, ldb, K, kstepA; };

struct DenseOrder {
    int nM, nN, nwg, G, c; const bf16_t* A; size_t tstepA;
    DI void init(const bf16_t* A_, int lda, int M, int N, int G_, int c_) { nM = M / BM; nN = N / BM; nwg = nM * nN; G = G_; c = c_; A = A_; tstepA = (size_t)BM * lda * 2; }
    DI bool next(int i, Unit& u) const {
        const long L = (long)i * G + c; if (L >= nwg) return false;
        int wgid = (int)L; { const int q = nwg / NXCD, r = nwg % NXCD, xcd = wgid % NXCD, off = wgid / NXCD; wgid = (xcd < r ? xcd * (q + 1) : r * (q + 1) + (xcd - r) * q) + off; }
        const int nig = WGM * nN, gid = wgid / nig, fm = gid * WGM, gsz = (nM - fm) < WGM ? (nM - fm) : WGM;
        u.pm = fm + ((wgid % nig) % gsz); u.pn = (wgid % nig) / gsz; u.po = u.pn; return true;
    }
    DI const char* abase(const Unit& u) const { return (const char*)A + (size_t)u.pm * tstepA; }
};

DI unsigned cvt_pk_bf16(float lo, float hi) { return pk2(lo, hi); }

template <class Epi, class Sched, bool ALIGN_EPI, bool GATHER>
__device__ __forceinline__ void gemm_phase(LAS unsigned char* lds, const Gemm g, const Sched& S, const Epi& E, const LAS int* rowidx  ) {
    const int tid = threadIdx.x, wid = __builtin_amdgcn_readfirstlane(tid >> 6), lane = tid & 63, wr = wid >> 2, wc = wid & 3, fr = lane & 15, fq = lane >> 4;
    const int K = g.K; int nt = K / BK; asm volatile("" : "+s"(nt));
    unsigned voffA[2], voffB[2]; int RA[2], CA[2];
#pragma unroll
    for (int i = 0; i < 2; ++i) { int R, C; stage_rc(tid * 16 + i * 8192, R, C); const int Rb = Epi::PERM ? ((R & ~31) + perm32(R & 31)) : R;
        RA[i] = R; CA[i] = C; voffA[i] = (unsigned)(R * g.lda + C) * 2u; voffB[i] = (unsigned)(Rb * g.ldb + C) * 2u; }
    const size_t kstepA = (size_t)g.kstepA, kstepB = (size_t)(BK * 2);
    const size_t hstepA = (size_t)HALF * g.lda * 2, hstepB = (size_t)HALF * g.ldb * 2;
    const size_t tstepB = 2 * hstepB;
    const unsigned ldsw = (unsigned)wid * 1024u;
    const int aoff = lds_byte(wr * 64 + fr, fq * 8), boff = lds_byte(wc * 32 + fr, fq * 8);
#define PG8_SA(b, h) (((b) * 2 + (h)) * HTB)
#define PG8_SB(b, h) ((4 + (b) * 2 + (h)) * HTB)
#define PG8_STAGE(bufoff, gbase, voff) do { _Pragma("unroll") for (int _i = 0; _i < 2; ++_i) \
        __builtin_amdgcn_global_load_lds((const unsigned*)((const char*)(gbase) + (voff)[_i]), (LAS unsigned*)(lds + (bufoff) + ldsw + _i * 8192), 16, 0, 0); } while (0)
#define PG8_LDA(dst, b, h) do { _Pragma("unroll") for (int m = 0; m < 4; ++m) _Pragma("unroll") for (int k = 0; k < 2; ++k) dst[m][k] = *(const LAS bf16x8*)(lds + PG8_SA(b, h) + aoff + m * 2048 + k * 1024); } while (0)
#define PG8_LDB(dst, b, h) do { _Pragma("unroll") for (int n = 0; n < 2; ++n) _Pragma("unroll") for (int k = 0; k < 2; ++k) dst[n][k] = *(const LAS bf16x8*)(lds + PG8_SB(b, h) + boff + n * 2048 + k * 1024); } while (0)
#define PG8_MMA(ai, bj, At, Bt) do { __builtin_amdgcn_s_setprio(1); _Pragma("unroll") for (int m = 0; m < 4; ++m) _Pragma("unroll") for (int n = 0; n < 2; ++n) _Pragma("unroll") for (int k = 0; k < 2; ++k) \
        acc[ai][bj][m][n] = __builtin_amdgcn_mfma_f32_16x16x32_bf16(Bt[n][k], At[m][k], acc[ai][bj][m][n], 0, 0, 0); __builtin_amdgcn_s_setprio(0); } while (0)
#define PG8_WAIT_V(n) asm volatile("s_waitcnt vmcnt(" #n ")" ::: "memory")
#define PG8_WAIT_L(n) asm volatile("s_waitcnt lgkmcnt(" #n ")" ::: "memory")
#define PG8_BAR __builtin_amdgcn_s_barrier()
#define PG8_SCHED __builtin_amdgcn_sched_barrier(0)
    Unit cur, nxt; int ui = 0;
    if (!S.next(0, cur)) return;
    f32x4 acc[2][2][4][2];
#pragma unroll
    for (int a = 0; a < 2; ++a)
#pragma unroll
        for (int b = 0; b < 2; ++b)
#pragma unroll
            for (int m = 0; m < 4; ++m)
#pragma unroll
                for (int n = 0; n < 2; ++n) acc[a][b][m][n] = (f32x4){0.f, 0.f, 0.f, 0.f};
    bf16x8 At[4][2], B0[2][2], B1[2][2];
    unsigned cg0[2], cg1[2], ng0[2], ng1[2];
    const char* cA; const char* cB = (const char*)g.Bt + (size_t)cur.pn * tstepB;
    if constexpr (GATHER) {
        cA = (const char*)g.A;
#pragma unroll
        for (int i = 0; i < 2; ++i) { cg0[i] = (unsigned)(rowidx[ui * 256 + RA[i]] * g.lda + CA[i]) * 2u; cg1[i] = (unsigned)(rowidx[ui * 256 + 128 + RA[i]] * g.lda + CA[i]) * 2u; ng0[i] = cg0[i]; ng1[i] = cg1[i]; }
    } else { cA = S.abase(cur); cg0[0] = cg0[1] = cg1[0] = cg1[1] = ng0[0] = ng0[1] = ng1[0] = ng1[1] = 0u; }
#define PG8_STAGE_A(bufoff, base, h, og0, og1) do { if constexpr (GATHER) { if ((h) == 0) PG8_STAGE(bufoff, base, og0); else PG8_STAGE(bufoff, base, og1); } \
        else { PG8_STAGE(bufoff, (base) + ((h) ? hstepA : (size_t)0), voffA); } } while (0)
    PG8_STAGE(PG8_SB(0, 0), cB, voffB); PG8_STAGE(PG8_SB(0, 1), cB + hstepB, voffB); PG8_STAGE_A(PG8_SA(0, 0), cA, 0, cg0, cg1); PG8_STAGE_A(PG8_SA(0, 1), cA, 1, cg0, cg1);
    if (wr == 1) PG8_BAR;
    PG8_WAIT_V(2); PG8_BAR;
    PG8_STAGE(PG8_SB(1, 0), cB + kstepB, voffB); PG8_STAGE_A(PG8_SA(1, 0), cA + kstepA, 0, cg0, cg1); PG8_STAGE(PG8_SB(1, 1), cB + hstepB + kstepB, voffB);
    PG8_WAIT_V(6); PG8_BAR;
    for (;;) {
        const bool has_next = S.next(ui + 1, nxt);
        const char* nA; const char* nB = has_next ? (const char*)g.Bt + (size_t)nxt.pn * tstepB : cB;
        if constexpr (GATHER) {
            nA = cA;
            if (has_next) {
#pragma unroll
                for (int i = 0; i < 2; ++i) { ng0[i] = (unsigned)(rowidx[(ui + 1) * 256 + RA[i]] * g.lda + CA[i]) * 2u; ng1[i] = (unsigned)(rowidx[(ui + 1) * 256 + 128 + RA[i]] * g.lda + CA[i]) * 2u; }
            } else {
#pragma unroll
                for (int i = 0; i < 2; ++i) { ng0[i] = cg0[i]; ng1[i] = cg1[i]; }
            }
        } else { nA = has_next ? S.abase(nxt) : cA; }
        for (int t = 0; t < nt; t += 2) {
            const bool last = (t == nt - 2);
            const char* a1 = cA + (size_t)(t + 1) * kstepA;
            const char* a2 = last ? nA : cA + (size_t)(t + 2) * kstepA; const char* b2 = last ? nB : cB + (size_t)(t + 2) * kstepB;
            const char* a3 = a2 + kstepA; const char* b3 = b2 + kstepB;
            unsigned xg0[2], xg1[2];
#pragma unroll
            for (int i = 0; i < 2; ++i) { xg0[i] = last ? ng0[i] : cg0[i]; xg1[i] = last ? ng1[i] : cg1[i]; }
            PG8_LDB(B0, 0, 0); PG8_LDB(B1, 0, 1); PG8_SCHED; PG8_LDA(At, 0, 0); PG8_STAGE_A(PG8_SA(1, 1), a1, 1, cg0, cg1);
            PG8_WAIT_V(8); PG8_WAIT_L(0); PG8_BAR; PG8_MMA(0, 0, At, B0); PG8_MMA(0, 1, At, B1); PG8_BAR; PG8_SCHED;
            PG8_LDA(At, 0, 1); PG8_STAGE(PG8_SB(0, 0), b2, voffB); PG8_STAGE(PG8_SB(0, 1), b2 + hstepB, voffB); PG8_STAGE_A(PG8_SA(0, 0), a2, 0, xg0, xg1);
            PG8_WAIT_V(8); PG8_WAIT_L(0); PG8_BAR; PG8_MMA(1, 0, At, B0); PG8_MMA(1, 1, At, B1); PG8_BAR; PG8_SCHED;
            PG8_LDB(B0, 1, 0); PG8_LDB(B1, 1, 1); PG8_SCHED; PG8_LDA(At, 1, 0); PG8_STAGE_A(PG8_SA(0, 1), a2, 1, xg0, xg1);
            PG8_WAIT_V(8); PG8_WAIT_L(0); PG8_BAR; PG8_MMA(0, 0, At, B0); PG8_MMA(0, 1, At, B1); PG8_BAR; PG8_SCHED;
            PG8_LDA(At, 1, 1); PG8_STAGE(PG8_SB(1, 0), b3, voffB); PG8_STAGE(PG8_SB(1, 1), b3 + hstepB, voffB); PG8_STAGE_A(PG8_SA(1, 0), a3, 0, xg0, xg1);
            PG8_WAIT_V(8); PG8_WAIT_L(0); PG8_BAR; PG8_MMA(1, 0, At, B0); PG8_MMA(1, 1, At, B1); PG8_BAR; PG8_SCHED;
        }
        if constexpr (ALIGN_EPI) { if (wr == 0) PG8_BAR; }
        E(acc, cur, wr, wc, fr, fq, wid, lane);
        if (!has_next) break;
#pragma unroll
        for (int a = 0; a < 2; ++a)
#pragma unroll
            for (int b = 0; b < 2; ++b)
#pragma unroll
                for (int m = 0; m < 4; ++m)
#pragma unroll
                    for (int n = 0; n < 2; ++n) acc[a][b][m][n] = (f32x4){0.f, 0.f, 0.f, 0.f};
        cur = nxt; cA = nA; cB = nB; ++ui;
#pragma unroll
        for (int i = 0; i < 2; ++i) { cg0[i] = ng0[i]; cg1[i] = ng1[i]; }
        if constexpr (ALIGN_EPI) { if (wr == 1) PG8_BAR; }
    }
    PG8_WAIT_V(0);
    if constexpr (!ALIGN_EPI) { if (wr == 0) PG8_BAR; }
    PG8_BAR;
#undef PG8_SA
#undef PG8_SB
#undef PG8_STAGE
#undef PG8_STAGE_A
#undef PG8_LDA
#undef PG8_LDB
#undef PG8_MMA
#undef PG8_WAIT_V
#undef PG8_WAIT_L
#undef PG8_BAR
#undef PG8_SCHED
}
}
namespace pg8 {
typedef f32x4 AccT[2][2][4][2];

struct EpiStoreBf16 {
    static constexpr bool PERM = true;
    bf16_t* O; int ldc; float scale0; int ntile0;
    DI void operator()(AccT& acc, const Unit& u, int wr, int wc, int fr, int fq, int wid, int lane) const {
        const int row0 = u.pm * BM + wr * 64 + fr, col0 = u.po * BM + wc * 32 + 8 * fq; const float sc = (u.po < ntile0) ? scale0 : 1.0f;
#pragma unroll
        for (int ai = 0; ai < 2; ++ai)
#pragma unroll
            for (int m = 0; m < 4; ++m) { bf16_t* rowp = O + (size_t)(row0 + ai * HALF + m * 16) * ldc + col0;
#pragma unroll
                for (int bj = 0; bj < 2; ++bj) { const f32x4 v0 = acc[ai][bj][m][0] * sc, v1 = acc[ai][bj][m][1] * sc;
                    u32x4 w; w.x = pk2(v0[0], v0[1]); w.y = pk2(v0[2], v0[3]); w.z = pk2(v1[0], v1[1]); w.w = pk2(v1[2], v1[3]);
                    *(u32x4*)(rowp + bj * HALF) = w; } }
    }
};
struct EpiStoreFp8 {
    static constexpr bool PERM = true;
    unsigned char* O; int ldc; float scale;
    DI void operator()(AccT& acc, const Unit& u, int wr, int wc, int fr, int fq, int wid, int lane) const {
        const int row0 = u.pm * BM + wr * 64 + fr, col0 = u.po * BM + wc * 32 + 8 * fq;
#pragma unroll
        for (int ai = 0; ai < 2; ++ai)
#pragma unroll
            for (int m = 0; m < 4; ++m) { unsigned char* rowp = O + (size_t)(row0 + ai * HALF + m * 16) * ldc + col0;
#pragma unroll
                for (int bj = 0; bj < 2; ++bj) { const f32x4 v0 = acc[ai][bj][m][0] * scale, v1 = acc[ai][bj][m][1] * scale;
                    int w0 = 0, w1 = 0;
                    w0 = __builtin_amdgcn_cvt_pk_fp8_f32(v0[0], v0[1], w0, false); w0 = __builtin_amdgcn_cvt_pk_fp8_f32(v0[2], v0[3], w0, true);
                    w1 = __builtin_amdgcn_cvt_pk_fp8_f32(v1[0], v1[1], w1, false); w1 = __builtin_amdgcn_cvt_pk_fp8_f32(v1[2], v1[3], w1, true);
                    *(u32x2*)(rowp + bj * HALF) = (u32x2){(unsigned)w0, (unsigned)w1}; } }
    }
};
DI float gelu_tanh(float x) { const float u = 0.7978845608028654f * (x + 0.044715f * x * x * x); const float e = __expf(2.0f * u); const float th = 1.0f - 2.0f / (e + 1.0f); return 0.5f * x * (1.0f + th); }
struct EpiCmp {
    static constexpr bool PERM = true;
    bf16_t* O; const float* peb;
    DI void operator()(AccT& acc, const Unit& u, int wr, int wc, int fr, int fq, int wid, int lane) const {
        const int row0 = u.pm * BM + wr * 64 + fr, col0 = wc * 32 + 8 * fq; const float* pb = peb + (u.pm >> 4) * 256;
        f32x4 bv[2][2];
#pragma unroll
        for (int bj = 0; bj < 2; ++bj)
#pragma unroll
            for (int n = 0; n < 2; ++n) bv[bj][n] = *(const f32x4*)(pb + col0 + bj * HALF + 4 * n);
#pragma unroll
        for (int ai = 0; ai < 2; ++ai)
#pragma unroll
            for (int m = 0; m < 4; ++m) { bf16_t* rowp = O + (size_t)(row0 + ai * HALF + m * 16) * 256 + col0;
#pragma unroll
                for (int bj = 0; bj < 2; ++bj) { f32x4 v0 = acc[ai][bj][m][0] + bv[bj][0], v1 = acc[ai][bj][m][1] + bv[bj][1];
#pragma unroll
                    for (int j = 0; j < 4; ++j) { v0[j] = gelu_tanh(v0[j]); v1[j] = gelu_tanh(v1[j]); }
                    u32x4 w; w.x = pk2(v0[0], v0[1]); w.y = pk2(v0[2], v0[3]); w.z = pk2(v1[0], v1[1]); w.w = pk2(v1[2], v1[3]);
                    *(u32x4*)(rowp + bj * HALF) = w; } }
    }
};
struct EpiF32 {
    static constexpr bool PERM = false;
    float* C; int ldc;
    DI void operator()(AccT& acc, const Unit& u, int wr, int wc, int fr, int fq, int wid, int lane) const {
        const int row0 = u.pm * BM + wr * 64 + fr, col0 = u.po * BM + wc * 32 + 4 * fq;
#pragma unroll
        for (int ai = 0; ai < 2; ++ai)
#pragma unroll
            for (int m = 0; m < 4; ++m) { float* rowp = C + (size_t)(row0 + ai * HALF + m * 16) * ldc + col0;
#pragma unroll
                for (int bj = 0; bj < 2; ++bj)
#pragma unroll
                    for (int n = 0; n < 2; ++n) *(f32x4*)(rowp + bj * HALF + n * 16) = acc[ai][bj][m][n]; }
    }
};
struct EpiResMod {
    static constexpr bool PERM = false;
    const float* base; float* out; const float* gate; int gate_pitch;
    DI void operator()(AccT& acc, const Unit& u, int wr, int wc, int fr, int fq, int wid, int lane) const {
        const int row0 = u.pm * BM + wr * 64 + fr, col0 = u.po * BM + wc * 32 + 4 * fq;
        const float* gp = gate + (size_t)((u.pm * BM) / SEQ) * gate_pitch + col0;
        f32x4 gv[2][2];
#pragma unroll
        for (int bj = 0; bj < 2; ++bj)
#pragma unroll
            for (int n = 0; n < 2; ++n) gv[bj][n] = *(const f32x4*)(gp + bj * HALF + n * 16);
#pragma unroll
        for (int ai = 0; ai < 2; ++ai)
#pragma unroll
            for (int m = 0; m < 4; ++m) { const size_t off = (size_t)(row0 + ai * HALF + m * 16) * DM + col0;
#pragma unroll
                for (int bj = 0; bj < 2; ++bj)
#pragma unroll
                    for (int n = 0; n < 2; ++n) { const f32x4 bs = *(const f32x4*)(base + off + bj * HALF + n * 16);
                        *(f32x4*)(out + off + bj * HALF + n * 16) = bs * DN_ALPHA + gv[bj][n] * acc[ai][bj][m][n]; } }
    }
};
struct EpiResModBf16 {
    static constexpr bool PERM = false;
    const float* base; bf16_t* out; const float* gate; int gate_pitch;
    DI void operator()(AccT& acc, const Unit& u, int wr, int wc, int fr, int fq, int wid, int lane) const {
        const int row0 = u.pm * BM + wr * 64 + fr, col0 = u.po * BM + wc * 32 + 4 * fq;
        const float* gp = gate + (size_t)((u.pm * BM) / SEQ) * gate_pitch + col0;
        f32x4 gv[2][2];
#pragma unroll
        for (int bj = 0; bj < 2; ++bj)
#pragma unroll
            for (int n = 0; n < 2; ++n) gv[bj][n] = *(const f32x4*)(gp + bj * HALF + n * 16);
#pragma unroll
        for (int ai = 0; ai < 2; ++ai)
#pragma unroll
            for (int m = 0; m < 4; ++m) { const size_t off = (size_t)(row0 + ai * HALF + m * 16) * DM + col0;
#pragma unroll
                for (int bj = 0; bj < 2; ++bj)
#pragma unroll
                    for (int n = 0; n < 2; ++n) { const f32x4 bs = *(const f32x4*)(base + off + bj * HALF + n * 16); const f32x4 v = bs * DN_ALPHA + gv[bj][n] * acc[ai][bj][m][n];
                        *(u32x2*)(out + off + bj * HALF + n * 16) = (u32x2){pk2(v.x, v.y), pk2(v.z, v.w)}; } }
    }
};
struct RoundOrder {
    DenseOrder base; int round;
    DI bool next(int i, Unit& u) const { return i == 0 ? base.next(round, u) : false; }
    DI const char* abase(const Unit& u) const { return base.abase(u); }
};
struct EpiLnFused {
    static constexpr bool PERM = false;
    const float* x; const float* g1; const float* sh2; const float* sc2; int mod_pitch; const float* lng; const float* lnb; bf16_t* X1; bf16_t* H2;
    unsigned long long* slots; unsigned* cnt; unsigned* tmo; LAS unsigned char* tab;
    DI void operator()(AccT& acc, const Unit& u, int wr, int wc, int fr, int fq, int wid, int lane) const {
        typedef float f32x2v __attribute__((ext_vector_type(2)));
        LAS f32x2v* Pt = (LAS f32x2v*)tab; LAS f32x2v* St = (LAS f32x2v*)(tab + 8192);
        const int tid = wid * 64 + lane, b = (u.pm * BM) / SEQ;
        const int row0 = u.pm * BM + wr * 64 + fr, col0 = u.po * BM + wc * 32 + 4 * fq;
#pragma unroll
        for (int bj = 0; bj < 2; ++bj)
#pragma unroll
            for (int n = 0; n < 2; ++n) { const f32x4 gv = *(const f32x4*)(g1 + (size_t)b * mod_pitch + col0 + bj * HALF + n * 16);
#pragma unroll
                for (int ai = 0; ai < 2; ++ai)
#pragma unroll
                    for (int m = 0; m < 4; ++m) { const f32x4 bs = *(const f32x4*)(x + (size_t)(row0 + ai * HALF + m * 16) * DM + col0 + bj * HALF + n * 16);
                        acc[ai][bj][m][n] = bs * DN_ALPHA + gv * acc[ai][bj][m][n]; }
                asm volatile("" : "+v"(acc[0][bj][0][n]), "+v"(acc[0][bj][1][n]), "+v"(acc[0][bj][2][n]), "+v"(acc[0][bj][3][n]), "+v"(acc[1][bj][0][n]), "+v"(acc[1][bj][1][n]), "+v"(acc[1][bj][2][n]), "+v"(acc[1][bj][3][n]) :: "memory"); }
#pragma unroll
        for (int ai = 0; ai < 2; ++ai)
#pragma unroll
            for (int m = 0; m < 4; ++m) { float s1 = 0.f, s2 = 0.f;
#pragma unroll
                for (int bj = 0; bj < 2; ++bj)
#pragma unroll
                    for (int n = 0; n < 2; ++n) { const f32x4 q = acc[ai][bj][m][n]; s1 += (q[0] + q[1]) + (q[2] + q[3]); s2 += (q[0] * q[0] + q[1] * q[1]) + (q[2] * q[2] + q[3] * q[3]); }
                s1 += __shfl_xor(s1, 16); s1 += __shfl_xor(s1, 32); s2 += __shfl_xor(s2, 16); s2 += __shfl_xor(s2, 32);
                if (fq == 0) Pt[(ai * HALF + wr * 64 + m * 16 + fr) * 4 + wc] = (f32x2v){s1, s2}; }
        asm volatile("s_waitcnt lgkmcnt(0)" ::: "memory"); __builtin_amdgcn_s_barrier(); asm volatile("" ::: "memory");
        if (tid < 256) { const f32x2v a = Pt[tid * 4 + 0], bq = Pt[tid * 4 + 1], c = Pt[tid * 4 + 2], d = Pt[tid * 4 + 3];
            const float S1 = (a.x + bq.x) + (c.x + d.x), S2 = (a.y + bq.y) + (c.y + d.y);
            __hip_atomic_store(slots + ((size_t)(u.pm * 256 + tid) * 4 + u.po), ((unsigned long long)__float_as_uint(S2) << 32) | __float_as_uint(S1), __ATOMIC_RELAXED, __HIP_MEMORY_SCOPE_AGENT); }
        asm volatile("s_waitcnt vmcnt(0) lgkmcnt(0)" ::: "memory"); __builtin_amdgcn_s_barrier(); asm volatile("" ::: "memory");
        if (tid == 0) { __hip_atomic_fetch_add(cnt + 64 * u.pm, 1u, __ATOMIC_RELAXED, __HIP_MEMORY_SCOPE_AGENT);
            const unsigned long long t0 = __builtin_amdgcn_s_memrealtime();
            while (__hip_atomic_load(cnt + 64 * u.pm, __ATOMIC_RELAXED, __HIP_MEMORY_SCOPE_AGENT) < 4u) {
                if (__builtin_amdgcn_s_memrealtime() - t0 > 2000000ull) { __hip_atomic_store(tmo, 1u, __ATOMIC_RELAXED, __HIP_MEMORY_SCOPE_AGENT); break; }
                __builtin_amdgcn_s_sleep(2); }
            __builtin_amdgcn_fence(__ATOMIC_ACQUIRE, "agent");
            asm volatile("s_waitcnt vmcnt(0)" ::: "memory"); }
        __builtin_amdgcn_s_barrier(); asm volatile("" ::: "memory");
        if (tid < 256) { const unsigned long long* sl = slots + (size_t)(u.pm * 256 + tid) * 4; float S1 = 0.f, S2 = 0.f;
#pragma unroll
            for (int t = 0; t < 4; ++t) { const unsigned long long w = __hip_atomic_load(sl + t, __ATOMIC_RELAXED, __HIP_MEMORY_SCOPE_AGENT); S1 += __uint_as_float((unsigned)w); S2 += __uint_as_float((unsigned)(w >> 32)); }
            const float mean = S1 * (1.0f / DM); float var = S2 * (1.0f / DM) - mean * mean; var = var < 0.f ? 0.f : var;
            St[tid] = (f32x2v){mean, 1.0f / sqrtf(var + LN_EPS)}; }
        asm volatile("s_waitcnt vmcnt(0) lgkmcnt(0)" ::: "memory"); __builtin_amdgcn_s_barrier(); asm volatile("" ::: "memory");
#pragma unroll
        for (int bj = 0; bj < 2; ++bj)
#pragma unroll
            for (int n = 0; n < 2; ++n) { const int c = col0 + bj * HALF + n * 16;
                const f32x4 lg = *(const f32x4*)(lng + c), lb = *(const f32x4*)(lnb + c), shv = *(const f32x4*)(sh2 + (size_t)b * mod_pitch + c), scv = *(const f32x4*)(sc2 + (size_t)b * mod_pitch + c) + 1.0f;
#pragma unroll
                for (int ai = 0; ai < 2; ++ai)
#pragma unroll
                    for (int m = 0; m < 4; ++m) { const int rl = ai * HALF + wr * 64 + m * 16 + fr; const f32x2v sr = St[rl]; const size_t off = (size_t)(u.pm * BM + rl) * DM + c;
                        const f32x4 x1 = (acc[ai][bj][m][n] - sr.x) * sr.y * lg + lb; const f32x4 y = x1 * scv + shv;
                        *(u32x2*)(X1 + off) = (u32x2){pk2(x1.x, x1.y), pk2(x1.z, x1.w)};
                        *(u32x2*)(H2 + off) = (u32x2){pk2(y.x, y.y), pk2(y.z, y.w)}; }
                asm volatile("" ::: "memory"); }
        asm volatile("s_waitcnt lgkmcnt(0)" ::: "memory"); __builtin_amdgcn_s_barrier(); asm volatile("" ::: "memory");
    }
};
struct EpiGlu {
    static constexpr bool PERM = true;
    bf16_t* O; int ldc;
    DI void operator()(AccT& acc, const Unit& u, int wr, int wc, int fr, int fq, int wid, int lane) const {
        const int row0 = u.pm * BM + wr * 64 + fr, col0 = u.po * HALF + wc * 32 + 8 * fq;
#pragma unroll
        for (int ai = 0; ai < 2; ++ai)
#pragma unroll
            for (int m = 0; m < 4; ++m) { bf16_t* rowp = O + (size_t)(row0 + ai * HALF + m * 16) * ldc + col0;
                f32x4 h0, h1;
#pragma unroll
                for (int j = 0; j < 4; ++j) { h0[j] = fsilu(acc[ai][0][m][0][j]) * acc[ai][1][m][0][j]; h1[j] = fsilu(acc[ai][0][m][1][j]) * acc[ai][1][m][1][j]; }
                u32x4 w; w.x = pk2(h0[0], h0[1]); w.y = pk2(h0[2], h0[3]); w.z = pk2(h1[0], h1[1]); w.w = pk2(h1[2], h1[3]);
                *(u32x4*)rowp = w; }
    }
};

struct CmpOrder {
    int G, c; const bf16_t* U;
    DI bool next(int i, Unit& u) const { const int L = i * G + c; if (L >= 32) return false; u.pm = L; u.pn = L >> 4; u.po = 0; return true; }
    DI const char* abase(const Unit& u) const { const int kv = u.pm >> 4, bg = (u.pm >> 1) & 7, b = bg >> 1, gg = bg & 1, half = u.pm & 1;
        return (const char*)(U + (size_t)(b * SEQ + half * 4096) * NU + (kv ? UVC : UKC) + gg * 64); }
};
template <int NSUB> struct MoeOrder {
    int G, c, nunits; const int* blk_e; const bf16_t* A; size_t tstepA;
    DI bool next(int i, Unit& u) const { const int L = i * G + c; if (L >= nunits) return false; const int blk = L / NSUB, sub = L % NSUB;
        const int e = (int)__builtin_amdgcn_readfirstlane((int)ld_u32_agent((const unsigned*)blk_e + blk)); u.pm = blk; u.pn = e * NSUB + sub; u.po = sub; return true; }
    DI const char* abase(const Unit& u) const { return (const char*)A + (size_t)u.pm * tstepA; }
};
struct MoePairOrder {
    int G, c, npairs; const int* blk_e; const bf16_t* A; size_t tstepA;
    DI bool next(int i, Unit& u) const { const int p = (i >> 1) * G + c; if (p >= npairs) return false; const int blk = p >> 1, sub = (p & 1) * 2 + (i & 1);
        const int e = (int)__builtin_amdgcn_readfirstlane((int)ld_u32_agent((const unsigned*)blk_e + blk)); u.pm = blk; u.pn = e * 4 + sub; u.po = sub; return true; }
    DI const char* abase(const Unit& u) const { return (const char*)A + (size_t)u.pm * tstepA; }
};
struct RouterOrder {
    int G, c; const bf16_t* A;
    DI bool next(int i, Unit& u) const { const int L = i * G + c; if (L >= 2 * (NT / 256)) return false; u.pm = L >> 1; u.pn = L & 1; u.po = L & 1; return true; }
    DI const char* abase(const Unit& u) const { return (const char*)(A + (size_t)u.pm * 256 * DM + u.pn * 512); }
};
struct EpiLogit {
    static constexpr bool PERM = false;
    float* C;
    DI void operator()(AccT& acc, const Unit& u, int wr, int wc, int fr, int fq, int wid, int lane) const {
        const int row0 = u.pm * BM + wr * 64 + fr, col0 = wc * 32 + 4 * fq; float* base = C + (size_t)u.po * NT * 256;
#pragma unroll
        for (int ai = 0; ai < 2; ++ai)
#pragma unroll
            for (int m = 0; m < 4; ++m) { float* rowp = base + (size_t)(row0 + ai * HALF + m * 16) * 256 + col0;
#pragma unroll
                for (int bj = 0; bj < 2; ++bj)
#pragma unroll
                    for (int n = 0; n < 2; ++n) *(f32x4*)(rowp + bj * HALF + n * 16) = acc[ai][bj][m][n]; }
    }
};
}
constexpr size_t MiB = 1u << 20;
constexpr size_t WS_CTL = 0, CTL_ZERO_BYTES = 1 * MiB;
constexpr size_t WS_MODP = 1 * MiB;
constexpr size_t WS_MOD = WS_MODP + 1536 * 1024;
constexpr size_t WS_PEP = WS_MOD + 128 * 1024;
constexpr size_t WS_PEB = WS_PEP + 32 * 1024;
constexpr size_t WS_WIN_T = 3 * MiB;
constexpr size_t WS_WOUT_T = 8 * MiB;
constexpr size_t WS_WR_T = 10 * MiB;
constexpr size_t WS_WSGU_T = 12 * MiB;
constexpr size_t WS_WSD_T = 13 * MiB;
constexpr size_t WS_WC1_T = 14 * MiB;
constexpr size_t WS_WDN_T = 16 * MiB;
constexpr size_t WS_WGU_T = 144 * MiB;
constexpr size_t WS_YMOE = 144 * MiB;
constexpr size_t WS_U = 400 * MiB;
constexpr size_t WS_H1 = 560 * MiB;
constexpr size_t WS_CAT = 624 * MiB;
constexpr size_t WS_H2 = 688 * MiB;
constexpr size_t WS_HIDS = 752 * MiB;
constexpr size_t WS_HIDM = 784 * MiB;
constexpr size_t WS_LOGIT = 624 * MiB;
constexpr size_t WS_TOKE = 976 * MiB;
constexpr size_t WS_TOKW = 977 * MiB;
constexpr size_t WS_LRANK = 978 * MiB;
constexpr size_t WS_POSOF = 979 * MiB;
constexpr size_t WS_ROWTOK = 980 * MiB;
constexpr size_t WS_HIST = 982 * MiB;
constexpr size_t WS_BLKE = 983 * MiB;
constexpr size_t WS_HCMP = 984 * MiB;
constexpr size_t WS_KC = 988 * MiB;
constexpr size_t WS_VCT = 989 * MiB;
constexpr size_t WS_VST = 990 * MiB;
constexpr size_t WS_VWT = 998 * MiB;
constexpr size_t WS_V1 = WS_H1;
constexpr size_t WS_X1 = 464 * MiB;
constexpr size_t WS_SH = 528 * MiB;
constexpr size_t WS_LNX = 1012 * MiB;
constexpr size_t WS_END = 1024 * MiB;
constexpr int CW_BAR = 4096, CW_ATTQ = 12288;
constexpr int CW_LNCNT = 16384, CW_LNTMO = 3;

constexpr int LDS_BYTES = 160 * 1024;
constexpr int LDS_MISC = 131072;
constexpr int LDS_TAB = 131072 + 1024;

struct Params {
    const float *x, *c, *w_ada, *b_ada, *w_in, *pe_k, *pe_v, *w_cmp_k1, *w_cmp_k2, *w_cmp_v1, *w_cmp_v2, *w_dw, *b_dw, *conv_ln_g, *conv_ln_b, *w_out, *ln1_g, *ln1_b,
        *w_router, *router_bias, *w_e_gate, *w_e_up, *w_e_down, *w_s_gate, *w_s_up, *w_s_down, *ln2_g, *ln2_b;
    float* out; unsigned char* ws; int ph_lo, ph_hi;
};

DI void transpose_item(const float* W, int ldw, int ncols, bf16_t* WT, int ldt, int drow0, LAS float* scr, int k0, int n0, int lane) {
    if (n0 + 32 <= ncols && (((size_t)W | (size_t)(ldw * 4)) & 15) == 0 && (n0 & 3) == 0) {
        f32x4 v[8];
#pragma unroll
        for (int i = 0; i < 8; ++i) v[i] = *(const f32x4*)(W + (size_t)(k0 + 8 * i + (lane >> 3)) * ldw + n0 + 4 * (lane & 7));
#pragma unroll
        for (int i = 0; i < 8; ++i) { LAS float* d = scr + (8 * i + (lane >> 3)) * 33 + 4 * (lane & 7); d[0] = v[i].x; d[1] = v[i].y; d[2] = v[i].z; d[3] = v[i].w; }
    } else {
        const int nn = n0 + (lane & 31); const bool okc = nn < ncols;
#pragma unroll 8
        for (int i = 0; i < 32; ++i) { const int kk = 2 * i + (lane >> 5); scr[kk * 33 + (lane & 31)] = okc ? W[(size_t)(k0 + kk) * ldw + nn] : 0.f; }
    }
    LDS_WAIT(); asm volatile("" ::: "memory");
    const int cch = lane & 7;
#pragma unroll
    for (int j = 0; j < 4; ++j) { const int n = (lane >> 3) + 8 * j; const LAS float* s = scr + (8 * cch) * 33 + n;
        u32x4 o; o.x = pk2(s[0 * 33], s[1 * 33]); o.y = pk2(s[2 * 33], s[3 * 33]); o.z = pk2(s[4 * 33], s[5 * 33]); o.w = pk2(s[6 * 33], s[7 * 33]);
        *(u32x4*)(WT + (size_t)(drow0 + n) * ldt + k0 + 8 * cch) = o; }
    LDS_WAIT(); asm volatile("" ::: "memory");
}
DI void tr_plain(const float* W, int ldw, int K, int N, bf16_t* WT, int row_off, LAS float* scr, int item, int lane) {
    const int nblk = (N + 31) / 32, kb = item / nblk, nb = item % nblk;
    transpose_item(W, ldw, N, WT, K, row_off + 32 * nb, scr, 64 * kb, 32 * nb, lane);
}
DI void tr_glu(const float* W, int K, bf16_t* WT, int up, LAS float* scr, int item, int lane) {
    const int kb = item >> 3, nb = item & 7, n0 = 32 * nb;
    transpose_item(W, 256, 256, WT, K, (n0 >> 7) * 256 + up * 128 + (n0 & 127), scr, 64 * kb, n0, lane);
}

constexpr int CV_EARLY_EXPERTS = 0;
constexpr int EXP_ITEMS = NEXP * 384, EXP_LATE = 18432;
DI void expert_items(const Params& P, LAS float* scr, int lane, int gw, int NGW, int r0, int r1) {
    unsigned char* ws = P.ws;
    for (int r = r0 + gw; r < r1; r += NGW) { const int e = r / 384, q = r % 384;
        if (q < 128) tr_glu(P.w_e_gate + (size_t)e * 1024 * 256, 1024, (bf16_t*)(ws + WS_WGU_T) + (size_t)e * 512 * 1024, 0, scr, q, lane);
        else if (q < 256) tr_glu(P.w_e_up + (size_t)e * 1024 * 256, 1024, (bf16_t*)(ws + WS_WGU_T) + (size_t)e * 512 * 1024, 1, scr, q - 128, lane);
        else tr_plain(P.w_e_down + (size_t)e * 256 * 1024, 1024, 256, 1024, (bf16_t*)(ws + WS_WDN_T) + (size_t)e * 1024 * 256, 0, scr, q - 256, lane); }
}

DI void phase0a(const Params& P, LAS unsigned char* lds, int vcu, int G, int wave, int lane, int tid) {
    unsigned char* ws = P.ws;
    LAS float* scr = (LAS float*)(lds + wave * 16384);
    const int gw = vcu * 8 + wave, NGW = G * 8;
    for (int it = gw; it < 96 * 16; it += NGW) { const int cb = it % 96, ks = it / 96; const int col = cb * 64 + lane;
        float a0 = 0.f, a1 = 0.f, a2 = 0.f, a3 = 0.f;
#pragma unroll 4
        for (int k = ks * 64; k < ks * 64 + 64; ++k) { const float w = P.w_ada[(size_t)k * 6144 + col];
            a0 += fsilu(P.c[k]) * w; a1 += fsilu(P.c[1024 + k]) * w; a2 += fsilu(P.c[2048 + k]) * w; a3 += fsilu(P.c[3072 + k]) * w; }
        float* mp = (float*)(ws + WS_MODP) + (size_t)ks * 4 * 6144 + col;
        mp[0] = a0; mp[6144] = a1; mp[2 * 6144] = a2; mp[3 * 6144] = a3; }
    for (int it = gw; it < 16 * 2 * 4; it += NGW) { const int cb = it & 3, kv = (it >> 2) & 1, ks = it >> 3; const int col = cb * 64 + lane;
        const float* pe = kv ? P.pe_v : P.pe_k; const float* w1 = kv ? P.w_cmp_v1 : P.w_cmp_k1; float a = 0.f;
#pragma unroll 4
        for (int k = ks * 128; k < ks * 128 + 128; ++k) a += pe[k] * w1[(size_t)k * 256 + col];
        ((float*)(ws + WS_PEP))[(ks * 2 + kv) * 256 + col] = a; }
    constexpr int I_IN0 = 16 * 40, I_IN1 = 16 * 32, I_IN2 = 16 * 1, I_OUT = 16 * 32, I_R = 16 * 8, I_SG = 16 * 8, I_SD = 4 * 32, I_C1 = 32 * 8;
    constexpr int I_SMALL = I_IN0 + I_IN1 + I_IN2 + I_OUT + I_R + 2 * I_SG + I_SD + 2 * I_C1;
    constexpr int NITEMS = I_SMALL;
    bf16_t* win_t = (bf16_t*)(ws + WS_WIN_T);
    for (int it = gw; it < NITEMS; it += NGW) {
        int r = it;
        if (r < I_IN0) { tr_plain(P.w_in, DIN, 1024, 1280, win_t, 0, scr, r, lane); continue; } r -= I_IN0;
        if (r < I_IN1) { tr_plain(P.w_in + 1304, DIN, 1024, 1024, win_t, UCA, scr, r, lane); continue; } r -= I_IN1;
        if (r < I_IN2) { tr_plain(P.w_in + 1280, DIN, 1024, 24, win_t, UGT, scr, r, lane); continue; } r -= I_IN2;
        if (r < I_OUT) { tr_plain(P.w_out, 1024, 1024, 1024, (bf16_t*)(ws + WS_WOUT_T), 0, scr, r, lane); continue; } r -= I_OUT;
        if (r < I_R) { tr_plain(P.w_router, 256, 1024, 256, (bf16_t*)(ws + WS_WR_T), 0, scr, r, lane); continue; } r -= I_R;
        if (r < I_SG) { tr_glu(P.w_s_gate, 1024, (bf16_t*)(ws + WS_WSGU_T), 0, scr, r, lane); continue; } r -= I_SG;
        if (r < I_SG) { tr_glu(P.w_s_up, 1024, (bf16_t*)(ws + WS_WSGU_T), 1, scr, r, lane); continue; } r -= I_SG;
        if (r < I_SD) { tr_plain(P.w_s_down, 1024, 256, 1024, (bf16_t*)(ws + WS_WSD_T), 0, scr, r, lane); continue; } r -= I_SD;
        if (r < I_C1) { tr_plain(P.w_cmp_k1, 256, 2048, 256, (bf16_t*)(ws + WS_WC1_T), 0, scr, r, lane); continue; } r -= I_C1;
        tr_plain(P.w_cmp_v1, 256, 2048, 256, (bf16_t*)(ws + WS_WC1_T) + 256 * 2048, 0, scr, r, lane);
    }
    expert_items(P, scr, lane, gw, NGW, 0, CV_EARLY_EXPERTS * 384);
    { u32x4* z = (u32x4*)(win_t + (size_t)2336 * 1024); const int n16 = (2560 - 2336) * 1024 * 2 / 16;
      for (int i = vcu * 512 + tid; i < n16; i += G * 512) z[i] = (u32x4){0u, 0u, 0u, 0u}; }
}

DI void phase0b(const Params& P, LAS unsigned char* lds, int vcu, int G, int wave, int lane, int tid) {
    unsigned char* ws = P.ws;
    const float* modp = (const float*)(ws + WS_MODP);
    for (int i = vcu * 512 + tid; i < 4 * 6144; i += G * 512) { float a = P.b_ada[i % 6144];
#pragma unroll
        for (int ks = 0; ks < 16; ++ks) a += modp[(size_t)ks * 4 * 6144 + i];
        ((float*)(ws + WS_MOD))[i] = a; }
    for (int i = vcu * 512 + tid; i < 512; i += G * 512) { float a = 0.f;
#pragma unroll
        for (int ks = 0; ks < 16; ++ks) a += ((const float*)(ws + WS_PEP))[ks * 512 + i];
        ((float*)(ws + WS_PEB))[i] = a; }
    const int rpw = NT / G;
    LAS float* sh = (LAS float*)lds;
    for (int r0 = vcu * rpw; r0 < NT; r0 += G * rpw) {
        const int b = r0 / SEQ;
        __syncthreads();
        for (int i = tid; i < 2048; i += 512) { const int j = (i < 1024) ? i : i;
            float a = P.b_ada[j];
#pragma unroll
            for (int ks = 0; ks < 16; ++ks) a += modp[(size_t)ks * 4 * 6144 + b * 6144 + j];
            sh[i] = (i < 1024) ? a : 1.0f + a; }
        __syncthreads();
        for (int m = r0 + wave; m < r0 + rpw; m += 8) {
            const f32x4* xr = (const f32x4*)(P.x + (size_t)m * DM) + lane; unsigned long long* o8 = (unsigned long long*)((bf16_t*)(ws + WS_H1) + (size_t)m * DM) + lane;
#pragma unroll
            for (int j = 0; j < 4; ++j) { const f32x4 v = xr[64 * j]; const int c0 = 4 * lane + 256 * j;
                const float y0 = v.x * sh[1024 + c0] + sh[c0], y1 = v.y * sh[1025 + c0] + sh[c0 + 1], y2 = v.z * sh[1026 + c0] + sh[c0 + 2], y3 = v.w * sh[1027 + c0] + sh[c0 + 3];
                o8[64 * j] = (unsigned long long)pk2(y0, y1) | ((unsigned long long)pk2(y2, y3) << 32); }
        }
    }
    __syncthreads();
}

#define CONV_LOAD(ITEM) { const int b_ = (ITEM) >> 8, t0_ = ((ITEM) & 255) * 32; _Pragma("unroll") for (int i = 0; i < 8; ++i) { const int task = tid + 512 * i, rr = task >> 6, oc = task & 63; int tok = t0_ - 30 + (rr < 62 ? rr : 61); tok = tok < 0 ? 0 : tok; \
        const bf16_t* up = U + (size_t)(b_ * SEQ + tok) * NU + oc * 8; av[i] = *(const u32x4*)(up + UCA); gv8[i] = *(const u32x4*)(up + UCG); } }
DI void conv_items(const Params& P, LAS unsigned char* lds, int first, int step, int wave, int lane, int tid) {
    const bf16_t* U = (const bf16_t*)(P.ws + WS_U); bf16_t* CAT = (bf16_t*)(P.ws + WS_CAT);
    LAS float* glu = (LAS float*)lds; LAS float* red = (LAS float*)(lds + 62 * 512 * 4); LAS float* stat = red + 32 * 8 * 2;
    const int c = tid;
    u32x4 av[8], gv8[8];
    if (first < 1024) CONV_LOAD(first)
  for (int item = first; item < 1024; item += step) {
    const int b = item >> 8, t0 = (item & 255) * 32;
    __syncthreads();
    {
#pragma unroll
        for (int i = 0; i < 8; ++i) { const int task = tid + 512 * i, rr = task >> 6, oc = task & 63; const bool ok = (t0 - 30 + rr) >= 0;
            const unsigned aw[4] = {av[i].x, av[i].y, av[i].z, av[i].w}, gw[4] = {gv8[i].x, gv8[i].y, gv8[i].z, gv8[i].w}; float o[8];
#pragma unroll
            for (int q = 0; q < 4; ++q) { o[2 * q] = ok ? bflo(aw[q]) * fsigmoid(bflo(gw[q])) : 0.f; o[2 * q + 1] = ok ? bfhi(aw[q]) * fsigmoid(bfhi(gw[q])) : 0.f; }
            if (rr < 62) { *(LAS f32x4*)(glu + rr * 512 + oc * 8) = (f32x4){o[0], o[1], o[2], o[3]}; *(LAS f32x4*)(glu + rr * 512 + oc * 8 + 4) = (f32x4){o[4], o[5], o[6], o[7]}; } }
    }
    if (item + step < 1024) CONV_LOAD(item + step)
    float w[31];
#pragma unroll
    for (int j = 0; j < 31; ++j) w[j] = P.w_dw[j * 512 + c];
    const float bd = P.b_dw[c];
    __syncthreads();
    float y[32];
#pragma unroll
    for (int tt = 0; tt < 32; ++tt) y[tt] = bd;
#pragma unroll
    for (int rr = 0; rr < 62; ++rr) { const float gv = glu[rr * 512 + c];
#pragma unroll
        for (int tt = 0; tt < 32; ++tt) { if (rr - tt >= 0 && rr - tt <= 30) y[tt] += w[rr - tt] * gv; } }
    __syncthreads();
#pragma unroll
    for (int tt = 0; tt < 32; ++tt) glu[tt * 512 + c] = y[tt];
    __syncthreads();
    {
#pragma unroll
        for (int q = 0; q < 4; ++q) { const int tt = 4 * wave + q; const f32x4 a = *(const LAS f32x4*)(glu + tt * 512 + lane * 8), bq = *(const LAS f32x4*)(glu + tt * 512 + lane * 8 + 4);
            float s1 = ((a.x + a.y) + (a.z + a.w)) + ((bq.x + bq.y) + (bq.z + bq.w));
            float s2 = ((a.x * a.x + a.y * a.y) + (a.z * a.z + a.w * a.w)) + ((bq.x * bq.x + bq.y * bq.y) + (bq.z * bq.z + bq.w * bq.w));
            s1 = wave_sum(s1); s2 = wave_sum(s2);
            if (lane == 0) { const float mean = s1 * (1.0f / 512.0f); float var = s2 * (1.0f / 512.0f) - mean * mean; var = var < 0.f ? 0.f : var;
                stat[tt * 2] = mean; stat[tt * 2 + 1] = 1.0f / sqrtf(var + LN_EPS); } }
    }
    __syncthreads();
    const float lg = P.conv_ln_g[c], lb = P.conv_ln_b[c];
#pragma unroll
    for (int tt = 0; tt < 32; ++tt) { const float v = (y[tt] - stat[tt * 2]) * stat[tt * 2 + 1] * lg + lb;
        CAT[(size_t)(b * SEQ + t0 + tt) * DM + 512 + c] = (bf16_t)(pk2(fsilu(v), 0.f) & 0xffffu); }
  }
}
#undef CONV_LOAD

DI unsigned swap23(unsigned p) { return (p & ~12u) | ((p & 4u) << 1) | ((p & 8u) >> 1); }
DI void vt_copies(const Params& P, LAS unsigned char* lds, int gw, int NGW, int wave, int lane) {
    unsigned char* ws = P.ws;
    LAS bf16_t* tile = (LAS bf16_t*)(lds + wave * 8448);
    const bf16_t* U = (const bf16_t*)(ws + WS_U);
    for (int it = gw; it < 2 * 8 * 128; it += NGW) { const int which = it >> 10, bg = (it >> 7) & 7, blk = it & 127, b = bg >> 1, gg = bg & 1;
        const bf16_t* src = U + (size_t)(b * SEQ + blk * 64 + lane) * NU + (which ? UVW : UVS) + gg * 64;
#pragma unroll
        for (int q = 0; q < 8; ++q) { const u32x4 v = *(const u32x4*)(src + q * 8); LAS unsigned* tp = (LAS unsigned*)(tile + lane * 66 + q * 8); tp[0] = v.x; tp[1] = v.y; tp[2] = v.z; tp[3] = v.w; }
        LDS_WAIT(); asm volatile("" ::: "memory");
        bf16_t* dst = (bf16_t*)(ws + (which ? WS_VWT : WS_VST)) + ((size_t)(bg * 128 + blk) * 64 + lane) * 64;
#pragma unroll
        for (int q = 0; q < 8; ++q) { unsigned wv[4];
#pragma unroll
            for (int e2 = 0; e2 < 4; ++e2) { const int p0 = q * 8 + e2 * 2; const int k0 = (p0 & ~15) | (int)swap23((unsigned)p0 & 15u), k1 = ((p0 + 1) & ~15) | (int)swap23((unsigned)(p0 + 1) & 15u);
                wv[e2] = (unsigned)tile[k0 * 66 + lane] | ((unsigned)tile[k1 * 66 + lane] << 16); }
            *(u32x4*)(dst + q * 8) = (u32x4){wv[0], wv[1], wv[2], wv[3]}; }
        LDS_WAIT(); asm volatile("" ::: "memory");
    }
}

DI void cmp2_rows(const Params& P, LAS unsigned char* lds, int kv, int row0, int nblk64, int tid) {
    unsigned char* ws = P.ws;
    const float* w2 = kv ? P.w_cmp_v2 : P.w_cmp_k2; LAS float* w2s = (LAS float*)lds;
    __syncthreads();
    for (int i = tid; i < 256 * 64 / 4; i += 512) ((LAS f32x4*)w2s)[i] = ((const f32x4*)w2)[i];
    __syncthreads();
    for (int blk = 0; blk < nblk64; ++blk) {
        const int row = row0 + blk * 64 + (tid >> 3), oc = tid & 7;
        const bf16_t* hrow = (const bf16_t*)(ws + WS_HCMP) + ((size_t)kv * 4096 + row) * 256;
        float acc[8];
#pragma unroll
        for (int j = 0; j < 8; ++j) acc[j] = 0.f;
        for (int k8 = 0; k8 < 32; ++k8) { const u32x4 hv = *(const u32x4*)(hrow + k8 * 8); const unsigned hw[4] = {hv.x, hv.y, hv.z, hv.w};
#pragma unroll
            for (int q = 0; q < 4; ++q) {
#pragma unroll
                for (int hh = 0; hh < 2; ++hh) { const float hval = hh ? bfhi(hw[q]) : bflo(hw[q]); const int k = k8 * 8 + q * 2 + hh;
                    const f32x4 wa = *(const LAS f32x4*)(w2s + k * 64 + oc * 8), wb = *(const LAS f32x4*)(w2s + k * 64 + oc * 8 + 4);
                    acc[0] += hval * wa.x; acc[1] += hval * wa.y; acc[2] += hval * wa.z; acc[3] += hval * wa.w; acc[4] += hval * wb.x; acc[5] += hval * wb.y; acc[6] += hval * wb.z; acc[7] += hval * wb.w; } } }
        const int bg = row >> 9, n = row & 511;
        if (n == 511) {
#pragma unroll
            for (int j = 0; j < 8; ++j) acc[j] = 0.f; }
        if (kv == 0) { u32x4 o; o.x = pk2(acc[0], acc[1]); o.y = pk2(acc[2], acc[3]); o.z = pk2(acc[4], acc[5]); o.w = pk2(acc[6], acc[7]);
            *(u32x4*)((bf16_t*)(ws + WS_KC) + ((size_t)bg * 512 + n) * 64 + oc * 8) = o; }
        else { bf16_t* vt = (bf16_t*)(ws + WS_VCT) + (size_t)bg * 64 * 512; const int pos = (n & ~15) | (int)swap23((unsigned)n & 15u);
#pragma unroll
            for (int j = 0; j < 8; ++j) vt[(size_t)(oc * 8 + j) * 512 + pos] = (bf16_t)(pk2(acc[j], 0.f) & 0xffffu); }
    }
    __syncthreads();
}
DI void phase_cmp2(const Params& P, LAS unsigned char* lds, int vcu, int G, int wave, int lane, int tid) {
    for (int it = vcu; it < 128; it += G) cmp2_rows(P, lds, it >> 6, (it & 63) * 64, 1, tid);
    __syncthreads();
}
namespace attn {
constexpr int ROWB = 144;
constexpr int TROW = 128, TILEB = 64 * TROW;
constexpr int OFF_K = 0, OFF_V = 2 * TILEB, OFF_IMPG = 36864, OFF_IMPL = OFF_IMPG + 32768;
constexpr int OFF_SELM = LDS_TAB, OFF_MREF = LDS_TAB + 1024, OFF_LSUM = LDS_TAB + 2048, OFF_LIST = LDS_TAB + 4096, OFF_TM = LDS_TAB + 6144;
constexpr int OFF_QS = 0, OFF_PBUF = 36864, PSLOT = 32 * ROWB;
constexpr float NEG = -1e30f, MFLOOR = -1e20f;
#define MFMA32(a, b, c) __builtin_amdgcn_mfma_f32_32x32x16_bf16((a), (b), (c), 0, 0, 0)
DI float fexp2(float x) { return __builtin_amdgcn_exp2f(x); }
DI void dma_tile(const bf16_t* base, unsigned pitch, LAS unsigned char* buf, int wave, int lane) {
    const int row = 8 * wave + (lane >> 3), ch = (lane & 7) ^ ((row >> 1) & 7);
    __builtin_amdgcn_global_load_lds((const unsigned*)(base + (unsigned)(row * pitch + ch * 8)), (LAS unsigned*)(buf + wave * 1024), 16, 0, 0); }
DI bf16x8 pack8(const f32x16& p, int s2) { u32x4 w; w.x = pk2(p[8 * s2], p[8 * s2 + 1]); w.y = pk2(p[8 * s2 + 2], p[8 * s2 + 3]); w.z = pk2(p[8 * s2 + 4], p[8 * s2 + 5]); w.w = pk2(p[8 * s2 + 6], p[8 * s2 + 7]); return __builtin_bit_cast(bf16x8, w); }

constexpr int CV_PER_EXPERT = 1536, CV_TOTAL = NEXP * CV_PER_EXPERT;
struct CvState { int next, end, nfly; bool xafter; };
DI LAS unsigned char* cv_buf(LAS unsigned char* lds, int wave, int seq) { return lds + (wave < 4 ? 110592 + wave * 4096 : LDS_TAB + 8192 + (wave - 4) * 4096) + (seq & 1) * 2048; }
DI void cv_decode(int m, int& e, int& mat, int& k0, int& n0) { e = m / CV_PER_EXPERT; const int q = m % CV_PER_EXPERT; mat = q >> 9; const int w = q & 511;
    if (mat < 2) { n0 = (w >> 6) * 32; k0 = (w & 63) * 16; } else { n0 = (w >> 4) * 32; k0 = (w & 15) * 16; } }
DI void cv_issue(const Params& P, CvState& c, LAS unsigned char* lds, int wave, int lane) {
    int e, mat, k0, n0; cv_decode(c.next, e, mat, k0, n0);
    LAS unsigned* st = (LAS unsigned*)cv_buf(lds, wave, c.next);
    const int ldw = (mat < 2) ? 256 : 1024;
    const float* W = (mat == 0 ? P.w_e_gate : mat == 1 ? P.w_e_up : P.w_e_down) + (size_t)e * 1024 * 256;
    const float* src = W + (size_t)(k0 + (lane >> 3)) * ldw + n0 + 4 * (lane & 7);
#pragma unroll
    for (int j = 0; j < 2; ++j) __builtin_amdgcn_global_load_lds((const unsigned*)(src + (size_t)(8 * j) * ldw), st + j * 256, 16, 0, 0);
    ++c.nfly; ++c.next; c.xafter = true;
}
DI void cv_finish(const Params& P, CvState& c, LAS unsigned char* lds, int wave, int lane) {
    const int m = c.next - c.nfly; int e, mat, k0, n0; cv_decode(m, e, mat, k0, n0);
    const int nl = lane >> 1, kc = (lane & 1) * 8;
    const LAS float* st = (const LAS float*)cv_buf(lds, wave, m) + kc * 32 + nl;
    u32x4 o; o.x = pk2(st[0 * 32], st[1 * 32]); o.y = pk2(st[2 * 32], st[3 * 32]); o.z = pk2(st[4 * 32], st[5 * 32]); o.w = pk2(st[6 * 32], st[7 * 32]);
    const int n = n0 + nl; bf16_t* dst;
    if (mat < 2) dst = (bf16_t*)(P.ws + WS_WGU_T) + (size_t)e * 512 * 1024 + (size_t)((n >> 7) * 256 + mat * 128 + (n & 127)) * 1024 + k0 + kc;
    else dst = (bf16_t*)(P.ws + WS_WDN_T) + (size_t)e * 1024 * 256 + (size_t)n * 256 + k0 + kc;
    asm volatile("s_waitcnt lgkmcnt(0)" ::: "memory");
    *(u32x4*)dst = o; --c.nfly;
}

template <int MODE>
DI void tile_compute(const LAS unsigned char* Kb, const LAS unsigned char* Vb, const bf16x8 (&qf)[4], int r, int h, int lo, int hi, bool elem,
                     float& m, float& l, f32x16 (&O)[2], float meff_in, float linv, LAS float* impg, LAS float* impl, int sb0) {
    const bool rowfull = (lo <= 0 && hi >= 63);
    const int lo2 = lo - 4 * h, hi2 = hi - 4 * h, swz = (r >> 1) & 7;
#pragma unroll
    for (int kh = 0; kh < 2; ++kh) {
        f32x16 s;
#pragma unroll
        for (int i = 0; i < 16; ++i) s[i] = 0.f;
#pragma unroll
        for (int ks = 0; ks < 4; ++ks) { const bf16x8 a = *(const LAS bf16x8*)(Kb + (32 * kh + r) * TROW + (((2 * ks + h) ^ swz) << 4)); s = MFMA32(a, qf[ks], s); }
        if (elem) {
#pragma unroll
            for (int i = 0; i < 16; ++i) { const int k0 = (i & 3) + 8 * (i >> 2) + 32 * kh; s[i] = (k0 >= lo2 && k0 <= hi2) ? s[i] : NEG; }
        }
        float cref;
        if (MODE != 2) {
            float tm = s[0];
#pragma unroll
            for (int i = 1; i < 16; ++i) tm = fmaxf(tm, s[i]);
            tm = fmaxf(tm, __shfl_xor(tm, 32));
            if (!elem) tm = rowfull ? tm : NEG;
            const bool need = tm > m + 8.0f;
            if (__any(need)) {
                const float mnew = need ? tm : m;
                const float alpha = fexp2(fmaxf(m, MFLOOR) - fmaxf(mnew, MFLOOR));
                l *= alpha; m = mnew;
                if (MODE == 0) {
#pragma unroll
                    for (int i = 0; i < 16; ++i) { O[0][i] *= alpha; O[1][i] *= alpha; } }
            }
            cref = (elem || rowfull) ? fmaxf(m, MFLOOR) : 1e30f;
            float rs = 0.f;
#pragma unroll
            for (int i = 0; i < 16; ++i) { s[i] = fexp2(s[i] - cref); rs += s[i]; }
            rs += __shfl_xor(rs, 32);
            l += rs;
        } else {
            cref = (elem || rowfull) ? meff_in : 1e30f;
#pragma unroll
            for (int i = 0; i < 16; ++i) s[i] = fexp2(s[i] - cref);
        }
        if (MODE == 1) continue;
        if (MODE == 2) {
#pragma unroll
            for (int gq = 0; gq < 4; ++gq) {
                float Gs = ((s[4 * gq] + s[4 * gq + 1]) + (s[4 * gq + 2] + s[4 * gq + 3])) * linv, Ls = s[4 * gq + 3] * linv;
                Gs += __shfl_xor(Gs, 1); Gs += __shfl_xor(Gs, 2); Ls += __shfl_xor(Ls, 1); Ls += __shfl_xor(Ls, 2);
                if ((r & 3) == 0) { const int sb = sb0 + 8 * kh + 2 * gq + h; impg[sb] = Gs; impl[sb] = Ls; } }
        }
#pragma unroll
        for (int s2 = 0; s2 < 2; ++s2) { const bf16x8 pf = pack8(s, s2);
#pragma unroll
            for (int dt = 0; dt < 2; ++dt) { const bf16x8 a = *(const LAS bf16x8*)(Vb + (32 * dt + r) * TROW + (((4 * kh + 2 * s2 + h) ^ swz) << 4));
                O[dt] = MFMA32(a, pf, O[dt]); } }
    }
}

template <bool ELEM>
DI void tile_frozen(const LAS unsigned char* Kb, const LAS unsigned char* Vb, const bf16x8 (&qf)[4], int r, int h, int lo, int hi, const f32x16& minit, float cap, float& lp, f32x16 (&O)[2]) {
    const int lo2 = lo - 4 * h, hi2 = hi - 4 * h, swz = (r >> 1) & 7;
    float vlow = -3.0e38f; asm volatile("" : "+s"(vlow));
#pragma unroll
    for (int kh = 0; kh < 2; ++kh) {
        f32x16 s = minit;
#pragma unroll
        for (int ks = 0; ks < 4; ++ks) { const bf16x8 a = *(const LAS bf16x8*)(Kb + (32 * kh + r) * TROW + (((2 * ks + h) ^ swz) << 4)); s = MFMA32(a, qf[ks], s); }
        if (ELEM) {
#pragma unroll
            for (int i = 0; i < 16; ++i) { const int k0 = (i & 3) + 8 * (i >> 2) + 32 * kh; s[i] = (k0 >= lo2 && k0 <= hi2) ? s[i] : NEG; }
        }
#pragma unroll
        for (int i = 0; i < 16; ++i) { s[i] = fexp2(__builtin_amdgcn_fmed3f(s[i], cap, vlow)); lp += s[i]; }
#pragma unroll
        for (int s2 = 0; s2 < 2; ++s2) { const bf16x8 pf = pack8(s, s2);
#pragma unroll
            for (int dt = 0; dt < 2; ++dt) { const bf16x8 a = *(const LAS bf16x8*)(Vb + (32 * dt + r) * TROW + (((4 * kh + 2 * s2 + h) ^ swz) << 4));
                O[dt] = MFMA32(a, pf, O[dt]); } }
    }
}

DI void attn_unit(const Params& P, LAS unsigned char* lds, int bg, int qt, int wave, int lane_in, int tid_in, int& it, CvState& cv) {
    __builtin_amdgcn_s_waitcnt(0x0F70);
    int lane = lane_in; asm volatile("" : "+v"(lane));
    const int tid = wave * 64 + lane;
    unsigned char* ws = P.ws;
    const bf16_t* U = (const bf16_t*)(ws + WS_U);
    const int b = bg >> 1, gg = bg & 1, t0 = qt * 64, r = lane & 31, h = lane >> 5, tokl = 8 * wave + (r >> 2), hp = r & 3, t = t0 + tokl;
    LAS float* IMPG = (LAS float*)(lds + OFF_IMPG); LAS float* IMPL = (LAS float*)(lds + OFF_IMPL); LAS unsigned* SELM = (LAS unsigned*)(lds + OFF_SELM);
#define ATT_UROW(name) int lq_ = lane; asm volatile("" : "+v"(lq_)); const bf16_t* name = U + (size_t)(b * SEQ + t0 + 8 * wave + ((lq_ & 31) >> 2)) * NU; const int hq_ = lq_ & 3, hh_ = lq_ >> 5; (void)hq_; (void)hh_;
    bf16x8 qf[4];
#define ATT_LOADQ() do { ATT_UROW(urow_) _Pragma("unroll") for (int ks = 0; ks < 4; ++ks) qf[ks] = *(const bf16x8*)(urow_ + UQ + (4 * gg + hq_) * 64 + 16 * ks + 8 * hh_); } while (0)
    ATT_LOADQ();
    f32x16 OA[2];
#pragma unroll
    for (int i = 0; i < 16; ++i) { OA[0][i] = 0.f; OA[1][i] = 0.f; }
    __syncthreads();
#pragma unroll
    for (int j = 0; j < 4; ++j) { *(LAS f32x4*)(IMPG + 8 * wave * 128 + lane * 4 + 256 * j) = (f32x4){0.f, 0.f, 0.f, 0.f}; *(LAS f32x4*)(IMPL + 8 * wave * 128 + lane * 4 + 256 * j) = (f32x4){0.f, 0.f, 0.f, 0.f}; }
    f32x16 O[2]; float m, l;
#define ATT_RESET() do { m = NEG; l = 0.f; _Pragma("unroll") for (int i = 0; i < 16; ++i) { O[0][i] = 0.f; O[1][i] = 0.f; } } while (0)
#define ATT_FOLD(br) do { ATT_UROW(urow_) const float gate_ = fsigmoid(bf2f(urow_[UGT + gg * 12 + hq_ * 3 + (br)])); const float sc_ = (l > 0.f) ? gate_ / l : 0.f; _Pragma("unroll") for (int i = 0; i < 16; ++i) { OA[0][i] += sc_ * O[0][i]; OA[1][i] += sc_ * O[1][i]; } } while (0)

#define ATT_STEP(CUR, NXT, TI, KPTR, KPITCH, VPTR, VPITCH, USEV, ...) { \
            LAS unsigned char* Kb = lds + OFF_K + (CUR) * TILEB; LAS unsigned char* Vb = lds + OFF_V + (CUR) * TILEB; \
            int nfin_; if (cv.xafter) { asm volatile("s_waitcnt vmcnt(2)" ::: "memory"); nfin_ = cv.nfly - 1; } else { asm volatile("s_waitcnt vmcnt(0)" ::: "memory"); nfin_ = cv.nfly; } \
            for (int f_ = 0; f_ < nfin_; ++f_) cv_finish(P, cv, lds, wave, tz_); \
            asm volatile("s_waitcnt lgkmcnt(0)" ::: "memory"); __builtin_amdgcn_s_barrier(); asm volatile("" ::: "memory"); \
            if ((TI) + 1 < n_) { const int pi = (TI) + 1; dma_tile(KPTR, KPITCH, lds + OFF_K + (NXT) * TILEB, wave, tz_); if (USEV) dma_tile(VPTR, VPITCH, lds + OFF_V + (NXT) * TILEB, wave, tz_); cv.xafter = false; } \
            if (cv.next < cv.end && cv.nfly < 2) cv_issue(P, cv, lds, wave, tz_); \
            { const int ti = (TI); __VA_ARGS__ } ++it; }
#define ATT_LOOP(NTILES, KPTR, KPITCH, VPTR, VPITCH, USEV, ...) { const int n_ = (NTILES); int tz_ = lane; asm volatile("" : "+v"(tz_)); \
        asm volatile("s_waitcnt lgkmcnt(0)" ::: "memory"); __builtin_amdgcn_s_barrier(); asm volatile("" ::: "memory");     \
        if (n_ > 0) { const int pi = 0; dma_tile(KPTR, KPITCH, lds + OFF_K, wave, tz_); if (USEV) dma_tile(VPTR, VPITCH, lds + OFF_V, wave, tz_); cv.xafter = false; } \
        for (int i_ = 0; i_ < n_; i_ += 2) { \
            ATT_STEP(0, 1, i_, KPTR, KPITCH, VPTR, VPITCH, USEV, __VA_ARGS__) \
            if (i_ + 1 < n_) ATT_STEP(1, 0, i_ + 1, KPTR, KPITCH, VPTR, VPITCH, USEV, __VA_ARGS__) } }

    const bf16_t* KC = (const bf16_t*)(ws + WS_KC) + (size_t)bg * 512 * 64; const bf16_t* VCT = (const bf16_t*)(ws + WS_VCT) + (size_t)bg * 64 * 512;
    const int hin = (t - 31) >> 4;
    const int ntc = (((t0 + 32) >> 4) >> 6) + 1;
    ATT_RESET();
    ATT_LOOP(ntc, KC + (size_t)pi * 64 * 64, 64, KC, 64, false, {
        const int hi = hin - 64 * ti; const bool fe = (hi >= 63) || (hi < 0);
        if (!__all(hi < 0)) tile_compute<1>(Kb, Kb, qf, r, h, 0, hi, !__all(fe), m, l, O, 0.f, 0.f, nullptr, nullptr, 0); })
    {
        const float meff = fmaxf(m, MFLOOR), linv = (l > 0.f) ? 1.0f / l : 0.f;
        ATT_LOOP(ntc, KC + (size_t)pi * 64 * 64, 64, VCT + pi * 64, 512, true, {
            const int hi = hin - 64 * ti; const bool fe = (hi >= 63) || (hi < 0);
            float md = m, ld_ = l;
            if (!__all(hi < 0)) tile_compute<2>(Kb, Vb, qf, r, h, 0, hi, !__all(fe), md, ld_, O, meff, linv, IMPG + tokl * 128, IMPL + tokl * 128, 16 * ti); })
        ATT_FOLD(0);
    }
    for (int tk = 0; tk < 8; ++tk) { const int trow = 8 * wave + tk;
        const float ilo = IMPG[trow * 128 + lane] + (lane > 0 ? IMPL[trow * 128 + lane - 1] : 0.f), ihi = IMPG[trow * 128 + 64 + lane] + IMPL[trow * 128 + 63 + lane];
        const int slo = lane, shi = 64 + lane;
        const bool clo = slo <= qt, chi = shi <= qt, flo = (slo == 0) || (slo == qt) || (slo + 1 == qt), fhi = (shi == qt) || (shi + 1 == qt);
        const unsigned klo = clo ? ((flo ? 0xFFFFFF80u : (__float_as_uint(ilo) & 0xFFFFFF80u)) | (unsigned)(127 - slo)) : 0u;
        const unsigned khi = chi ? ((fhi ? 0xFFFFFF80u : (__float_as_uint(ihi) & 0xFFFFFF80u)) | (unsigned)(127 - shi)) : 0u;
        unsigned T = 0u;
        for (int bit = 31; bit >= 0; --bit) { const unsigned cand = T | (1u << bit);
            const int cnt = __popcll(__ballot(klo >= cand)) + __popcll(__ballot(khi >= cand)); if (cnt >= 16) T = cand; }
        const unsigned long long blo = __ballot(klo >= T && klo != 0u), bhi = __ballot(khi >= T && khi != 0u);
        if (lane == 0) { *(LAS u32x4*)(SELM + trow * 4) = (u32x4){(unsigned)blo, (unsigned)(blo >> 32), (unsigned)bhi, (unsigned)(bhi >> 32)}; }
    }
    { int lp_ = lane; asm volatile("" : "+v"(lp_)); float* oapark = (float*)(ws + WS_HIDM) + ((size_t)(blockIdx.x * 8 + wave) * 32) * 64 + lp_;
#pragma unroll
      for (int i = 0; i < 16; ++i) { oapark[i * 64] = OA[0][i]; oapark[(16 + i) * 64] = OA[1][i]; } }
    ATT_RESET();
    const bf16_t* KS = U + (size_t)(b * SEQ) * NU + UKS + gg * 64; const bf16_t* VST = (const bf16_t*)(ws + WS_VST) + (size_t)bg * 128 * 4096;
    constexpr int QT_COMPACT = 96;
    if (qt < QT_COMPACT) {
    {
        const int nfor = qt >= 2 ? 3 : qt + 1;
#define JMAP(i) ((i) == 0 ? 0 : qt - (nfor - 1 - (i)))
        ATT_LOOP(nfor, KS + (size_t)JMAP(pi) * 64 * NU, NU, VST + (size_t)JMAP(pi) * 4096, 64, true, {
            const int j = JMAP(ti);
            tile_compute<0>(Kb, Vb, qf, r, h, 0, (j == qt ? tokl : 63), j == qt, m, l, O, 0.f, 0.f, nullptr, nullptr, 0); })
#undef JMAP
    }
        if (qt >= 3) {
            const u32x4 selw = *(const LAS u32x4*)(SELM + tokl * 4);
            f32x16 minit; { const float mneg = -fmaxf(m, MFLOOR);
#pragma unroll
                for (int i = 0; i < 16; ++i) minit[i] = mneg; }
            float lp = 0.f;
            __builtin_amdgcn_s_waitcnt(0x0F70);
            ATT_LOOP(qt - 2, KS + (size_t)(pi + 1) * 64 * NU, NU, VST + (size_t)(pi + 1) * 4096, 64, true, {
                const int j = ti + 1;
                const unsigned wsel = (j < 32) ? selw.x : (j < 64) ? selw.y : (j < 96) ? selw.z : selw.w; const bool sel = (wsel >> (j & 31)) & 1u;
                if (!__all(!sel)) tile_frozen<false>(Kb, Vb, qf, r, h, 0, 63, minit, sel ? 100.0f : NEG, lp, O); })
            l += lp + __shfl_xor(lp, 32);
        }
    } else {
        {
#define JMAP(i) ((i) == 0 ? 0 : qt - (2 - (i)))
            ATT_LOOP(3, KS + (size_t)JMAP(pi) * 64 * NU, NU, VST + (size_t)JMAP(pi) * 4096, 64, true, {
                const int j = JMAP(ti);
                tile_compute<0>(Kb, Vb, qf, r, h, 0, (j == qt ? tokl : 63), j == qt, m, l, O, 0.f, 0.f, nullptr, nullptr, 0); })
#undef JMAP
        }
        int lz = lane; asm volatile("" : "+v"(lz));
        const int r = lz & 31, h = lz >> 5, hp = r & 3, tokl = 8 * wave + (r >> 2), lane = lz, tid = wave * 64 + lz;
        LAS unsigned char* Qs = lds + OFF_QS; LAS float* MREF = (LAS float*)(lds + OFF_MREF); LAS float* LSUM = (LAS float*)(lds + OFF_LSUM); LAS int* LIST = (LAS int*)(lds + OFF_LIST) + wave * 64;
        LAS unsigned long long* TM = (LAS unsigned long long*)(lds + OFF_TM);
        if (h == 0) MREF[32 * wave + r] = fmaxf(m, MFLOOR);
        for (int j = wave; j < 128; j += 8) { const unsigned long long mk = __ballot((SELM[lane * 4 + (j >> 5)] >> (j & 31)) & 1u); if (lane == 0) TM[j] = mk; }
        __syncthreads();
#pragma unroll
        for (int q4 = 0; q4 < 4; ++q4) { const int ch = tid + 512 * q4, row = ch >> 3, c8 = ch & 7;
            *(LAS u32x4*)(Qs + row * ROWB + c8 * 16) = *(const u32x4*)(U + (size_t)(b * SEQ + t0 + (row >> 2)) * NU + UQ + (4 * gg + (row & 3)) * 64 + c8 * 8); }
        __syncthreads();
        const int jend = qt - 2; int jn = 1, rk = 0;
        const unsigned long long ltl = (1ull << tokl) - 1ull;
        int pjs = 0, pcnt = 0;
#define FAR_TM(dst, jj) { const unsigned long long tv_ = TM[(jj) <= jend ? (jj) : 0]; const unsigned lo_ = __builtin_amdgcn_readfirstlane((unsigned)tv_), hi_ = __builtin_amdgcn_readfirstlane((unsigned)(tv_ >> 32)); \
            dst = ((jj) <= jend) ? (((unsigned long long)hi_ << 32) | lo_) : 0ull; }
        for (;;) {
            int cnt = 0, used = 0, myj = -1, myc = 0; unsigned long long mymask = 0ull;
#pragma unroll
            for (int i = 0; i < 8; ++i) { const int jj = jn + i; unsigned long long mk; FAR_TM(mk, jj) const int nch = (__popcll(mk) + 7) >> 3;
                const bool take = (cnt == i) && (jj <= jend) && (used + nch <= 8);
                if (take) { if (wave >= used && wave < used + nch) { myj = jj; myc = wave - used; mymask = mk; } used += nch; ++cnt; } }
            if (cnt == 0 && pcnt == 0) break;
            const int cjs = jn; jn += cnt;
            bf16x8 kf[2][4], vf[2][4];
            if (myj >= 0) { const bf16_t* Kg = KS + (size_t)(myj * 64 + r) * NU + 8 * h; const bf16_t* Vg = VST + (size_t)myj * 4096 + r * 64 + 8 * h;
#pragma unroll
                for (int kh = 0; kh < 2; ++kh)
#pragma unroll
                    for (int ks = 0; ks < 4; ++ks) { kf[kh][ks] = *(const bf16x8*)(Kg + (size_t)(32 * kh) * NU + 16 * ks); vf[kh][ks] = *(const bf16x8*)(Vg + kh * 32 * 64 + ks * 16); } }
            if (pcnt > 0) { int base = 0;
#pragma unroll
                for (int i = 0; i < 8; ++i) { unsigned long long mk; FAR_TM(mk, pjs + i) if (i >= pcnt) mk = 0ull; const int nch = (__popcll(mk) + 7) >> 3;
                    const bool act = (mk >> tokl) & 1ull;
                    if (__any(act)) { const int rank = __popcll(mk & ltl), slot = base + (rank >> 3), prow = (rank & 7) * 4 + hp;
                        const LAS unsigned char* Pb = lds + OFF_PBUF + (((rk + 1) & 1) * 8 + slot) * PSLOT + prow * ROWB + h * 8;
#pragma unroll
                        for (int dt = 0; dt < 2; ++dt)
#pragma unroll
                            for (int gq = 0; gq < 4; ++gq) { u32x2 w = *(const LAS u32x2*)(Pb + (32 * dt + 8 * gq) * 2); if (!act) w = (u32x2){0u, 0u};
                                O[dt][4 * gq] += bflo(w.x); O[dt][4 * gq + 1] += bfhi(w.x); O[dt][4 * gq + 2] += bflo(w.y); O[dt][4 * gq + 3] += bfhi(w.y); }
                        l += act ? LSUM[(((rk + 1) & 1) * 8 + slot) * 32 + prow] : 0.f; }
                    base += nch; } }
            if (myj >= 0) {
                LAS unsigned char* Pw = lds + OFF_PBUF + ((rk & 1) * 8 + wave) * PSLOT;
                if ((mymask >> lane) & 1ull) LIST[__popcll(mymask & ((1ull << lane) - 1ull))] = lane;
                const int rank = 8 * myc + (r >> 2); const bool valid = rank < __popcll(mymask);
                const int tok = valid ? LIST[rank] : 0; const int qrow = tok * 4 + hp;
                bf16x8 qg[4];
#pragma unroll
                for (int ks = 0; ks < 4; ++ks) qg[ks] = *(const LAS bf16x8*)(Qs + qrow * ROWB + ks * 32 + h * 16);
                const float mr = MREF[qrow];
                float rs = 0.f; f32x16 Oc[2];
#pragma unroll
                for (int i = 0; i < 16; ++i) { Oc[0][i] = 0.f; Oc[1][i] = 0.f; }
#pragma unroll
                for (int kh = 0; kh < 2; ++kh) { f32x16 sv;
#pragma unroll
                    for (int i = 0; i < 16; ++i) sv[i] = 0.f;
#pragma unroll
                    for (int ks = 0; ks < 4; ++ks) sv = MFMA32(kf[kh][ks], qg[ks], sv);
#pragma unroll
                    for (int i = 0; i < 16; ++i) { sv[i] = valid ? fexp2(fminf(sv[i] - mr, 100.0f)) : 0.f; rs += sv[i]; }
#pragma unroll
                    for (int s2 = 0; s2 < 2; ++s2) { const bf16x8 pf = pack8(sv, s2);
                        Oc[0] = MFMA32(vf[0][kh * 2 + s2], pf, Oc[0]); Oc[1] = MFMA32(vf[1][kh * 2 + s2], pf, Oc[1]); } }
                rs += __shfl_xor(rs, 32);
                if (h == 0) LSUM[((rk & 1) * 8 + wave) * 32 + r] = rs;
#pragma unroll
                for (int dt = 0; dt < 2; ++dt)
#pragma unroll
                    for (int gq = 0; gq < 4; ++gq) { u32x2 w; w.x = pk2(Oc[dt][4 * gq], Oc[dt][4 * gq + 1]); w.y = pk2(Oc[dt][4 * gq + 2], Oc[dt][4 * gq + 3]);
                        *(LAS u32x2*)(Pw + r * ROWB + (32 * dt + 8 * gq + 4 * h) * 2) = w; }
            }
            __syncthreads();
            pjs = cjs; pcnt = cnt; ++rk;
        }
#undef FAR_TM
    }
    { int lp_ = lane; asm volatile("" : "+v"(lp_)); const float* oapark = (const float*)(ws + WS_HIDM) + ((size_t)(blockIdx.x * 8 + wave) * 32) * 64 + lp_;
#pragma unroll
      for (int i = 0; i < 16; ++i) { OA[0][i] = oapark[i * 64]; OA[1][i] = oapark[(16 + i) * 64]; } }
    ATT_FOLD(1);
    ATT_LOADQ();
    ATT_RESET();
    {
        int lw_ = lane; asm volatile("" : "+v"(lw_)); const int r = lw_ & 31, h = lw_ >> 5, tokl = 8 * wave + (r >> 2);
        const int jlo = qt >= 8 ? qt - 8 : 0;
        const bf16_t* KW = U + (size_t)(b * SEQ + jlo * 64) * NU + UKW + gg * 64; const bf16_t* VWT = (const bf16_t*)(ws + WS_VWT) + ((size_t)bg * 128 + jlo) * 4096;
        ATT_LOOP(qt - jlo + 1, KW + (size_t)pi * 64 * NU, NU, VWT + (size_t)pi * 4096, 64, true, {
            const int j = jlo + ti;
            const bool low = (j + 8 == qt), diag = (j == qt);
            const int lo = low ? tokl + 1 : 0, hi = diag ? tokl : 63;
            tile_compute<0>(Kb, Vb, qf, r, h, lo, hi, low || diag, m, l, O, 0.f, 0.f, nullptr, nullptr, 0); })
        ATT_FOLD(2);
    }
    int lo_ = lane; asm volatile("" : "+v"(lo_)); const int h_o = lo_ >> 5;
    bf16_t* orow = (bf16_t*)(ws + WS_CAT) + (size_t)(b * SEQ + t0 + 8 * wave + ((lo_ & 31) >> 2)) * DM + (4 * gg + (lo_ & 3)) * 64;
#pragma unroll
    for (int dt = 0; dt < 2; ++dt)
#pragma unroll
        for (int gq = 0; gq < 4; ++gq) { u32x2 w; w.x = pk2(OA[dt][4 * gq], OA[dt][4 * gq + 1]); w.y = pk2(OA[dt][4 * gq + 2], OA[dt][4 * gq + 3]);
            *(u32x2*)(orow + 32 * dt + 8 * gq + 4 * h_o) = w; }
#undef ATT_RESET
#undef ATT_FOLD
#undef ATT_LOADQ
#undef ATT_UROW
#undef ATT_LOOP
#undef ATT_STEP
}

DI void attn_phase(const Params& P, LAS unsigned char* lds, int vcu, int G, int wave, int lane, int tid) {
    int it = 0;
    CvState cv; { const int first = CV_EARLY_EXPERTS * CV_PER_EXPERT, per = (CV_TOTAL - first) / (G * 8), gw = vcu * 8 + wave; cv.next = first + gw * per; cv.end = (gw == G * 8 - 1) ? CV_TOTAL : cv.next + per; cv.nfly = 0; cv.xafter = false; }
    static constexpr unsigned char QT_TAB[32][4] = {{14,37,91,127},{30,44,68,126},{31,35,77,100},{23,48,69,125},{27,40,76,99},{10,53,79,124},{17,38,85,123},{19,32,89,122},{20,33,87,121},{29,43,70,120},{21,54,66,107},{0,58,90,119},{25,42,75,118},{22,47,74,106},{18,34,88,117},{3,51,92,105},{15,56,71,116},{11,39,93,98},{9,49,82,115},{28,36,78,114},{24,52,64,113},{16,41,84,104},{5,46,95,97},{4,59,81,112},{26,50,65,103},{8,62,72,111},{6,45,94,102},{7,55,80,96},{2,61,83,110},{13,63,67,101},{1,60,86,109},{12,57,73,108}};
    if (G == 256) {
        const int bg = vcu >> 5, s = vcu & 31;
        for (int k = 3; k >= 0; --k) { const int qt = (k == 0) ? QT_TAB[s][0] : (k == 1) ? QT_TAB[s][1] : (k == 2) ? QT_TAB[s][2] : QT_TAB[s][3]; attn_unit(P, lds, bg, qt, wave, lane, tid, it, cv); }
    } else {
        for (int ui = vcu; ui < 1024; ui += G) { const int k = ui >> 8, v = ui & 255, bg = v >> 5, s = v & 31;
            const int qt = (k == 0) ? s : (k == 1) ? 63 - s : (k == 2) ? 64 + s : 127 - s;
            attn_unit(P, lds, bg, qt, wave, lane, tid, it, cv); }
    }
    for (;;) {
        if (cv.nfly > 0) { asm volatile("s_waitcnt vmcnt(0)" ::: "memory"); while (cv.nfly > 0) cv_finish(P, cv, lds, wave, lane); }
        if (cv.next >= cv.end) break;
        cv_issue(P, cv, lds, wave, lane); if (cv.next < cv.end) cv_issue(P, cv, lds, wave, lane); }
    __syncthreads();
}
}
#ifndef CHECK_ATTN
#define CHECK_ATTN 0
#endif
#if CHECK_ATTN
constexpr int CW_ERR = 8192;
namespace attnchk {
DI float wmax(float v) {
#pragma unroll
    for (int o = 1; o < 64; o <<= 1) v = fmaxf(v, __shfl_xor(v, o));
    return v; }
DI void item(const Params& P, LAS float* scr, int bg, int t, int lane, float& se, float& sr) {
    unsigned char* ws = P.ws; const bf16_t* U = (const bf16_t*)(ws + WS_U);
    const int b = bg >> 1, gg = bg & 1;
    LAS float* q = scr; LAS float* pc = scr + 256; LAS float* sc = scr + 768;
    const bf16_t* urow = U + (size_t)(b * SEQ + t) * NU;
    for (int i = lane; i < 256; i += 64) q[i] = bf2f(urow[UQ + gg * 256 + i]);
    const bf16_t* KC = (const bf16_t*)(ws + WS_KC) + (size_t)bg * 512 * 64; const bf16_t* VCT = (const bf16_t*)(ws + WS_VCT) + (size_t)bg * 64 * 512;
    const int nvalid = t >= 31 ? ((t - 31) >> 4) + 1 : 0, cur = t >> 6;
    float oc[4], os[4], ow[4], imp0 = 0.f, imp1 = 0.f;
    for (int p = 0; p < 4; ++p) {
        float sv[8], mx = -3e38f;
        for (int i = 0; i < 8; ++i) { const int n = lane + 64 * i; float a = 0.f;
            if (n < nvalid) { for (int d = 0; d < 64; ++d) a += q[p * 64 + d] * bf2f(KC[n * 64 + d]); mx = fmaxf(mx, a); }
            sv[i] = a; }
        mx = wmax(mx); float ls = 0.f;
        for (int i = 0; i < 8; ++i) { const int n = lane + 64 * i; const float e = (n < nvalid) ? exp2f(sv[i] - mx) : 0.f; sv[i] = e; ls += e; }
        ls = wave_sum(ls); const float inv = ls > 0.f ? 1.f / ls : 0.f;
        for (int i = 0; i < 8; ++i) pc[lane + 64 * i] = sv[i] * inv;
        float o = 0.f;
        for (int n = 0; n < nvalid; ++n) { const int pos = (n & ~15) | (int)swap23((unsigned)n & 15u); o += pc[n] * bf2f(VCT[lane * 512 + pos]); }
        oc[p] = o;
        for (int k = -1; k <= 3; ++k) { const int n0 = 4 * lane + k, n1 = 4 * (lane + 64) + k;
            if (n0 >= 0 && n0 < nvalid) imp0 += pc[n0]; if (n1 < nvalid) imp1 += pc[n1]; }
    }
    const float INF = __builtin_inff();
    const int s0 = lane, s1 = lane + 64;
    const float v0 = (s0 == 0 || s0 == cur || s0 == cur - 1) ? INF : (s0 <= cur ? imp0 : -INF);
    const float v1 = (s1 == cur || s1 == cur - 1) ? INF : (s1 <= cur ? imp1 : -INF);
    int r0 = 0, r1 = 0;
    for (int j = 0; j < 128; ++j) { const float vj = (j < 64) ? __shfl(v0, j) : __shfl(v1, j - 64);
        r0 += (vj > v0 || (vj == v0 && j < s0)) ? 1 : 0; r1 += (vj > v1 || (vj == v1 && j < s1)) ? 1 : 0; }
    const unsigned long long m0 = __ballot(r0 < 16 && v0 > -INF), m1 = __ballot(r1 < 16 && v1 > -INF);
    for (int br = 0; br < 2; ++br) {
        const bf16_t* Kp = U + (size_t)(b * SEQ) * NU + (br ? UKW : UKS) + gg * 64; const bf16_t* Vp = U + (size_t)(b * SEQ) * NU + (br ? UVW : UVS) + gg * 64;
        for (int p = 0; p < 4; ++p) {
            int nk = 0; float mx = -3e38f;
            if (br == 0) {
                for (int j = 0; j < 128; ++j) { const bool on = (j < 64) ? ((m0 >> j) & 1ull) : ((m1 >> (j - 64)) & 1ull); if (!on) continue;
                    const int key = 64 * j + lane; float a = -3e38f;
                    if (key <= t) { a = 0.f; for (int d = 0; d < 64; ++d) a += q[p * 64 + d] * bf2f(Kp[(size_t)key * NU + d]); mx = fmaxf(mx, a); }
                    sc[nk * 64 + lane] = a; ++nk; }
            } else {
                for (int i = 0; i < 8; ++i) { const int key = t - 511 + lane + 64 * i; float a = -3e38f;
                    if (key >= 0 && key <= t) { a = 0.f; for (int d = 0; d < 64; ++d) a += q[p * 64 + d] * bf2f(Kp[(size_t)key * NU + d]); mx = fmaxf(mx, a); }
                    sc[i * 64 + lane] = a; }
                nk = 8;
            }
            mx = wmax(mx); float ls = 0.f;
            for (int i = 0; i < nk; ++i) { const float a = sc[i * 64 + lane]; const float e = (a > -1e38f) ? exp2f(a - mx) : 0.f; sc[i * 64 + lane] = e; ls += e; }
            ls = wave_sum(ls); const float inv = ls > 0.f ? 1.f / ls : 0.f;
            float o = 0.f;
            if (br == 0) { int idx = 0;
                for (int j = 0; j < 128; ++j) { const bool on = (j < 64) ? ((m0 >> j) & 1ull) : ((m1 >> (j - 64)) & 1ull); if (!on) continue;
                    for (int kk = 0; kk < 64; ++kk) { const float pv = sc[idx * 64 + kk]; if (pv != 0.f) o += pv * bf2f(Vp[(size_t)(64 * j + kk) * NU + lane]); }
                    ++idx; }
                os[p] = o * inv;
            } else {
                for (int i = 0; i < 8; ++i) for (int kk = 0; kk < 64; ++kk) { const int key = t - 511 + kk + 64 * i; const float pv = sc[i * 64 + kk]; if (pv != 0.f) o += pv * bf2f(Vp[(size_t)key * NU + lane]); }
                ow[p] = o * inv;
            }
        }
    }
    const bf16_t* cat = (const bf16_t*)(ws + WS_CAT) + (size_t)(b * SEQ + t) * DM;
    for (int p = 0; p < 4; ++p) {
        const float g0 = fsigmoid(bf2f(urow[UGT + gg * 12 + p * 3 + 0])), g1 = fsigmoid(bf2f(urow[UGT + gg * 12 + p * 3 + 1])), g2 = fsigmoid(bf2f(urow[UGT + gg * 12 + p * 3 + 2]));
        const float ref = g0 * oc[p] + g1 * os[p] + g2 * ow[p], got = bf2f(cat[(4 * gg + p) * 64 + lane]);
        se += (ref - got) * (ref - got); sr += ref * ref; }
}
DI void phase(const Params& P, LAS unsigned char* lds, int vcu, int G, int wave, int lane) {
    LAS float* scr = (LAS float*)(lds + wave * 8192);
    float se = 0.f, sr = 0.f;
    for (int it = vcu * 8 + wave; it < 8 * SEQ; it += G * 8) { const int bg = it / SEQ, t = it % SEQ; item(P, scr, bg, t, lane, se, sr); }
    se = wave_sum(se); sr = wave_sum(sr);
    if (lane == 0) { atomicAdd((float*)(P.ws + WS_CTL) + CW_ERR, se); atomicAdd((float*)(P.ws + WS_CTL) + CW_ERR + 1, sr); }
}
}
#endif
DI void phase_ln1(const Params& P, int vcu, int G, int wave, int lane, bf16_t* x1base) {
    const float* mod = (const float*)(P.ws + WS_MOD);
    for (int mrow = vcu * 8 + wave; mrow < NT; mrow += G * 8) { const int b = mrow / SEQ;
        const u32x2* vr = (const u32x2*)((const bf16_t*)(P.ws + WS_V1) + (size_t)mrow * DM) + lane; f32x4 v[4]; float s = 0.f;
#pragma unroll
        for (int j = 0; j < 4; ++j) { const u32x2 q = vr[64 * j]; v[j] = (f32x4){bflo(q.x), bfhi(q.x), bflo(q.y), bfhi(q.y)}; s += (v[j].x + v[j].y) + (v[j].z + v[j].w); }
        const float mean = wave_sum(s) * (1.f / DM); float s2 = 0.f;
#pragma unroll
        for (int j = 0; j < 4; ++j) { v[j] = v[j] - mean; s2 += (v[j].x * v[j].x + v[j].y * v[j].y) + (v[j].z * v[j].z + v[j].w * v[j].w); }
        const float rstd = 1.f / sqrtf(wave_sum(s2) * (1.f / DM) + LN_EPS);
        unsigned long long* o8 = (unsigned long long*)((bf16_t*)(P.ws + WS_H2) + (size_t)mrow * DM) + lane;
        unsigned long long* x8 = (unsigned long long*)(x1base + (size_t)mrow * DM) + lane;
#pragma unroll
        for (int j = 0; j < 4; ++j) { const int c0 = 4 * lane + 256 * j;
            const f32x4 g = *(const f32x4*)(P.ln1_g + c0), bb = *(const f32x4*)(P.ln1_b + c0);
            const f32x4 sh = *(const f32x4*)(mod + b * 6144 + 3 * 1024 + c0), sc = *(const f32x4*)(mod + b * 6144 + 4 * 1024 + c0);
            const f32x4 x1 = v[j] * rstd * g + bb;
            x8[64 * j] = (unsigned long long)pk2(x1.x, x1.y) | ((unsigned long long)pk2(x1.z, x1.w) << 32);
            const f32x4 y = x1 * (sc + 1.0f) + sh;
            o8[64 * j] = (unsigned long long)pk2(y.x, y.y) | ((unsigned long long)pk2(y.z, y.w) << 32); }
    }
}

DI unsigned f2ord(float f) { const unsigned u = __float_as_uint(f); return (u & 0x80000000u) ? ~u : (u | 0x80000000u); }
template <int CTRL, int RMASK> DI unsigned dppu(unsigned oldv, unsigned v) { return (unsigned)__builtin_amdgcn_update_dpp((int)oldv, (int)v, CTRL, RMASK, 0xf, false); }
template <int CTRL, int RMASK> DI float dppf(float oldv, float v) { return __uint_as_float(dppu<CTRL, RMASK>(__float_as_uint(oldv), __float_as_uint(v))); }
DI unsigned wave_umax(unsigned v) {
    v = max(v, dppu<0x111, 0xf>(0u, v)); v = max(v, dppu<0x112, 0xf>(0u, v)); v = max(v, dppu<0x114, 0xf>(0u, v)); v = max(v, dppu<0x118, 0xf>(0u, v));
    v = max(v, dppu<0x142, 0xa>(0u, v)); v = max(v, dppu<0x143, 0xc>(0u, v));
    return (unsigned)__builtin_amdgcn_readlane((int)v, 63);
}
template <int CTRL, int RMASK> DI void top2_step(float& t1, float& t2) { const float NI = -3.0e38f; const float a1 = dppf<CTRL, RMASK>(NI, t1), a2 = dppf<CTRL, RMASK>(NI, t2);
    const float n1 = fmaxf(t1, a1), n2 = fmaxf(fminf(t1, a1), fmaxf(t2, a2)); t1 = n1; t2 = n2; }
DI void half_top2(float& t1, float& t2) { top2_step<0x111, 0xf>(t1, t2); top2_step<0x112, 0xf>(t1, t2); top2_step<0x114, 0xf>(t1, t2); top2_step<0x118, 0xf>(t1, t2); top2_step<0x142, 0xa>(t1, t2); }
DI void phase_route(const Params& P, LAS unsigned char* lds, int vcu, int G, int wave, int lane, int tid) {
    unsigned char* ws = P.ws;
    LAS int* hist = (LAS int*)lds;
    const float* logit = (const float*)(ws + WS_LOGIT);
    int* tok_e = (int*)(ws + WS_TOKE); float* tok_w = (float*)(ws + WS_TOKW); int* lrank = (int*)(ws + WS_LRANK);
    { int* rt = (int*)(ws + WS_ROWTOK); for (int i = vcu * 512 + tid; i < NPAD_MAX; i += G * 512) rt[i] = 0; }
    float bias[4];
#pragma unroll
    for (int k = 0; k < 4; ++k) bias[k] = P.router_bias[lane + 64 * k];
    const int tpw = NT / G;
    for (int base = vcu * tpw; base < NT; base += G * tpw) {
        __syncthreads();
        if (tid < 256) hist[tid] = 0;
        __syncthreads();
        float lg[2][4];
#pragma unroll
        for (int u = 0; u < 2; ++u) { const int tq0 = wave + 8 * u; const int t0 = base + (tq0 < tpw ? tq0 : wave);
#pragma unroll
            for (int k = 0; k < 4; ++k) lg[u][k] = logit[(size_t)t0 * 256 + lane + 64 * k]; }
        for (int tq = wave; tq < tpw; tq += 16) {
            int tkn[2]; tkn[0] = base + tq; tkn[1] = (tq + 8 < tpw) ? base + tq + 8 : base + tq;
            const bool two = (tq + 8 < tpw);
            float s[2][4], sel[2][4];
#pragma unroll
            for (int u = 0; u < 2; ++u)
#pragma unroll
                for (int k = 0; k < 4; ++k) { s[u][k] = fsigmoid(lg[u][k]); sel[u][k] = s[u][k] + bias[k]; }
            if (tq + 16 < tpw) {
#pragma unroll
                for (int u = 0; u < 2; ++u) { const int tqn = tq + 16 + 8 * u; const int tn = base + (tqn < tpw ? tqn : tq + 16);
#pragma unroll
                    for (int k = 0; k < 4; ++k) lg[u][k] = logit[(size_t)tn * 256 + lane + 64 * k]; } }
            unsigned key[2][4];
#pragma unroll
            for (int u = 0; u < 2; ++u) {
                float gs[8];
#pragma unroll
                for (int k = 0; k < 4; ++k) { float t1 = sel[u][k], t2 = -3.0e38f; half_top2(t1, t2); const float sm = t1 + t2;
                    gs[2 * k] = __uint_as_float((unsigned)__builtin_amdgcn_readlane((int)__float_as_uint(sm), 31)); gs[2 * k + 1] = __uint_as_float((unsigned)__builtin_amdgcn_readlane((int)__float_as_uint(sm), 63)); }
                bool gsel[8];
#pragma unroll
                for (int a2 = 0; a2 < 8; ++a2) { int rk = 0;
#pragma unroll
                    for (int c2 = 0; c2 < 8; ++c2) rk += (gs[c2] > gs[a2] || (gs[c2] == gs[a2] && c2 < a2)) ? 1 : 0;
                    gsel[a2] = rk < 4; }
                const int hh = lane >> 5;
#pragma unroll
                for (int k = 0; k < 4; ++k) { const bool on = hh ? gsel[2 * k + 1] : gsel[2 * k]; key[u][k] = on ? f2ord(sel[u][k]) : 0u; }
            }
            float ssum[2] = {0.f, 0.f}; int che[2][4];
#pragma unroll
            for (int u = 0; u < 2; ++u)
#pragma unroll
                for (int k = 0; k < 4; ++k) che[u][k] = -1;
            for (int it8 = 0; it8 < 8; ++it8) {
#pragma unroll
                for (int u = 0; u < 2; ++u) {
                    const unsigned lm = max(max(key[u][0], key[u][1]), max(key[u][2], key[u][3]));
                    const unsigned M = wave_umax(lm);
                    int ck = -1, cl = 0;
#pragma unroll
                    for (int k = 3; k >= 0; --k) { const unsigned long long eq = __ballot(key[u][k] == M); if (eq != 0ull) { ck = k; cl = __ffsll((long long)eq) - 1; } }
#pragma unroll
                    for (int k = 0; k < 4; ++k) { const bool mine = (k == ck) && (lane == cl); if (mine) { che[u][k] = it8; key[u][k] = 0u; } }
                }
            }
#pragma unroll
            for (int u = 0; u < 2; ++u) { if (u == 1 && !two) break;
                float sm = 0.f;
#pragma unroll
                for (int k = 0; k < 4; ++k) sm += (che[u][k] >= 0) ? s[u][k] : 0.f;
                sm = wave_sum(sm);
                const float wn = 2.5f / sm;
#pragma unroll
                for (int k = 0; k < 4; ++k) if (che[u][k] >= 0) { const int e = lane + 64 * k; const int lr = __hip_atomic_fetch_add(hist + e, 1, __ATOMIC_RELAXED, __HIP_MEMORY_SCOPE_WORKGROUP);
                    tok_e[tkn[u] * 8 + che[u][k]] = e; tok_w[tkn[u] * 8 + che[u][k]] = s[u][k] * wn; lrank[tkn[u] * 8 + che[u][k]] = lr; }
            }
            (void)ssum;
        }
        __syncthreads();
        if (tid < 256) ((int*)(ws + WS_HIST))[(base / tpw) * 256 + tid] = hist[tid];
    }
    __syncthreads();
}

DI void phase_scatter(const Params& P, LAS unsigned char* lds, int vcu, int G, int wave, int lane, int tid) {
    unsigned char* ws = P.ws;
    LAS int* sbase = (LAS int*)lds; LAS int* spad = sbase + 256; LAS int* sstart = spad + 256;
    const unsigned* hist = (const unsigned*)(ws + WS_HIST);
    const int* tok_e = (const int*)(ws + WS_TOKE); const int* lrank = (const int*)(ws + WS_LRANK);
    int* rowtok = (int*)(ws + WS_ROWTOK); int* pos_of = (int*)(ws + WS_POSOF); int* blk_e = (int*)(ws + WS_BLKE);
    const int tpw = NT / G, nslots = NT / tpw;
    for (int base = vcu * tpw; base < NT; base += G * tpw) { const int slot = base / tpw;
        __syncthreads();
        if (tid < 256) { int tot = 0, below = 0;
            for (int w2 = 0; w2 < nslots; ++w2) { const int hv = (int)hist[w2 * 256 + tid]; tot += hv; below += (w2 < slot) ? hv : 0; }
            spad[tid] = (tot + 255) & ~255; sbase[tid] = below; }
        __syncthreads();
        if (tid == 0) { int run = 0; for (int e = 0; e < 256; ++e) { sstart[e] = run; run += spad[e]; } sstart[256] = run; }
        __syncthreads();
        for (int i = tid; i < tpw * 8; i += 512) { const int a = base * 8 + i; const int e = tok_e[a]; const int pos = sstart[e] + sbase[e] + lrank[a];
            rowtok[pos] = a >> 3; pos_of[a] = pos; }
        if (slot == 0) {
            if (tid < 256) { const int b0 = sstart[tid] >> 8, b1 = (sstart[tid] + spad[tid]) >> 8; for (int bb = b0; bb < b1; ++bb) blk_e[bb] = tid; }
            if (tid == 0) blk_e[NBLK_MAX] = sstart[256] >> 8;
        }
    }
    __syncthreads();
}

DI void phase_final(const Params& P, int vcu, int G, int wave, int lane, float* dstbase) {
    unsigned char* ws = P.ws;
    const float* mod = (const float*)(ws + WS_MOD);
    const int* pos_of = (const int*)(ws + WS_POSOF); const float* tok_w = (const float*)(ws + WS_TOKW);
    const unsigned char* Y = (const unsigned char*)(ws + WS_YMOE);
    float dbg_scale = 1.0f;
#if CHECK_ATTN
    { const float se = __uint_as_float(ld_u32_agent((const unsigned*)(ws + WS_CTL) + CW_ERR)), sr = __uint_as_float(ld_u32_agent((const unsigned*)(ws + WS_CTL) + CW_ERR + 1)); const float err = sqrtf(se / fmaxf(sr, 1e-30f)); dbg_scale = 1.0f + (err < 0.005f ? 0.f : err < 0.02f ? 0.04f : err < 0.08f ? 0.055f : err < 0.3f ? 0.07f : 0.085f); }
#endif
    for (int mrow = vcu * 8 + wave; mrow < NT; mrow += G * 8) { const int b = mrow / SEQ;
        const u32x2* xr = (const u32x2*)((const bf16_t*)(ws + WS_X1) + (size_t)mrow * DM) + lane; const u32x2* sr = (const u32x2*)((const bf16_t*)(ws + WS_SH) + (size_t)mrow * DM) + lane; f32x4 v[4], ya[4];
#pragma unroll
        for (int j = 0; j < 4; ++j) { const u32x2 q = xr[64 * j], q2 = sr[64 * j]; v[j] = (f32x4){bflo(q.x), bfhi(q.x), bflo(q.y), bfhi(q.y)} * DN_ALPHA; ya[j] = (f32x4){bflo(q2.x), bfhi(q2.x), bflo(q2.y), bfhi(q2.y)}; }
        const int mypos = pos_of[(size_t)mrow * 8 + (lane & 7)]; const float myw = tok_w[(size_t)mrow * 8 + (lane & 7)];
#pragma unroll
        for (int k = 0; k < 8; ++k) { const int pos = __shfl(mypos, k); const float wk = __shfl(myw, k) * (1.0f / YMOE_SCALE);
            const unsigned* yr = (const unsigned*)(Y + (size_t)pos * DM) + lane;
#pragma unroll
            for (int j = 0; j < 4; ++j) { const int q = (int)yr[64 * j]; const f32x2 lo = __builtin_amdgcn_cvt_pk_f32_fp8(q, false), hi = __builtin_amdgcn_cvt_pk_f32_fp8(q, true);
                ya[j].x += wk * lo.x; ya[j].y += wk * lo.y; ya[j].z += wk * hi.x; ya[j].w += wk * hi.y; } }
        float s = 0.f;
#pragma unroll
        for (int j = 0; j < 4; ++j) { const f32x4 g2 = *(const f32x4*)(mod + b * 6144 + 5 * 1024 + 4 * lane + 256 * j); v[j] = v[j] + g2 * ya[j]; s += (v[j].x + v[j].y) + (v[j].z + v[j].w); }
        const float mean = wave_sum(s) * (1.f / DM); float s2 = 0.f;
#pragma unroll
        for (int j = 0; j < 4; ++j) { v[j] = v[j] - mean; s2 += (v[j].x * v[j].x + v[j].y * v[j].y) + (v[j].z * v[j].z + v[j].w * v[j].w); }
        const float rstd = 1.f / sqrtf(wave_sum(s2) * (1.f / DM) + LN_EPS);
#pragma unroll
        for (int j = 0; j < 4; ++j) { const int c0 = 4 * lane + 256 * j; const f32x4 g = *(const f32x4*)(P.ln2_g + c0), bb = *(const f32x4*)(P.ln2_b + c0);
            ((f32x4*)(dstbase + (size_t)mrow * DM) + lane)[64 * j] = (v[j] * rstd * g + bb) * dbg_scale; }
    }
}
#ifndef REP_PHASE
#define REP_PHASE -1
#endif
#ifndef LN1_FUSED
#define LN1_FUSED 0
#endif
#ifndef MK_PER_PHASE
#define MK_PER_PHASE 0
#endif
DI void run_phase_0(const Params& P, LAS unsigned char* lds, int vcu, int G, int bx, int wave, int lane, int tid) {
    unsigned char* ws = P.ws; const float* mod = (const float*)(ws + WS_MOD); (void)mod; (void)ws;
 phase0a(P, lds, vcu, G, wave, lane, tid); }
DI void run_phase_1(const Params& P, LAS unsigned char* lds, int vcu, int G, int bx, int wave, int lane, int tid) {
    unsigned char* ws = P.ws; const float* mod = (const float*)(ws + WS_MOD); (void)mod; (void)ws;
 phase0b(P, lds, vcu, G, wave, lane, tid); }
DI void run_phase_2(const Params& P, LAS unsigned char* lds, int vcu, int G, int bx, int wave, int lane, int tid) {
    unsigned char* ws = P.ws; const float* mod = (const float*)(ws + WS_MOD); (void)mod; (void)ws;
        pg8::Gemm g{(const bf16_t*)(ws + WS_H1), (const bf16_t*)(ws + WS_WIN_T), DM, DM, DM, 128};
        pg8::DenseOrder S; S.init(g.A, DM, NT, NU, G, bx);
        pg8::EpiStoreBf16 E{(bf16_t*)(ws + WS_U), NU, 0.125f * 1.4426950408889634f, 2};
        pg8::gemm_phase<pg8::EpiStoreBf16, pg8::DenseOrder, true, false>(lds, g, S, E, nullptr);
    }
DI void run_phase_3(const Params& P, LAS unsigned char* lds, int vcu, int G, int bx, int wave, int lane, int tid) {
    unsigned char* ws = P.ws; const float* mod = (const float*)(ws + WS_MOD); (void)mod; (void)ws;
        if (bx < 32 && G > 32) {
            pg8::Gemm g{(const bf16_t*)(ws + WS_U), (const bf16_t*)(ws + WS_WC1_T), 16 * NU, 2048, 2048, NU * 2};
            pg8::CmpOrder S{G, bx, (const bf16_t*)(ws + WS_U)};
            pg8::EpiCmp E{(bf16_t*)(ws + WS_HCMP), (const float*)(ws + WS_PEB)};
            pg8::gemm_phase<pg8::EpiCmp, pg8::CmpOrder, true, false>(lds, g, S, E, nullptr);
        } else {
            const int nw = (G > 32) ? G - 32 : G, w0 = (G > 32) ? bx - 32 : bx;
            if (G <= 32) { pg8::Gemm g{(const bf16_t*)(ws + WS_U), (const bf16_t*)(ws + WS_WC1_T), 16 * NU, 2048, 2048, NU * 2};
                pg8::CmpOrder S{G, bx, (const bf16_t*)(ws + WS_U)}; pg8::EpiCmp E{(bf16_t*)(ws + WS_HCMP), (const float*)(ws + WS_PEB)};
                pg8::gemm_phase<pg8::EpiCmp, pg8::CmpOrder, true, false>(lds, g, S, E, nullptr); }
            conv_items(P, lds, w0, nw, wave, lane, tid);
            if (REP_PHASE == 31) conv_items(P, lds, w0, nw, wave, lane, tid);
            __syncthreads();
            vt_copies(P, lds, w0 * 8 + wave, nw * 8, wave, lane);
            __syncthreads();
        }
    }
DI void run_phase_4(const Params& P, LAS unsigned char* lds, int vcu, int G, int bx, int wave, int lane, int tid) {
    unsigned char* ws = P.ws; const float* mod = (const float*)(ws + WS_MOD); (void)mod; (void)ws;
 phase_cmp2(P, lds, vcu, G, wave, lane, tid); }
DI void run_phase_5(const Params& P, LAS unsigned char* lds, int vcu, int G, int bx, int wave, int lane, int tid) {
    unsigned char* ws = P.ws; const float* mod = (const float*)(ws + WS_MOD); (void)mod; (void)ws;
 attn::attn_phase(P, lds, vcu, G, wave, lane, tid); }
DI void run_phase_6(const Params& P, LAS unsigned char* lds, int vcu, int G, int bx, int wave, int lane, int tid) {
    unsigned char* ws = P.ws; const float* mod = (const float*)(ws + WS_MOD); (void)mod; (void)ws;
#if CHECK_ATTN
        attnchk::phase(P, lds, vcu, G, wave, lane); __syncthreads();
#endif
        pg8::Gemm g{(const bf16_t*)(ws + WS_CAT), (const bf16_t*)(ws + WS_WOUT_T), DM, DM, DM, 128};
        pg8::DenseOrder S; S.init(g.A, DM, NT, DM, G, bx);
        if (LN1_FUSED && G == 256) {
            pg8::EpiLnFused E{P.x, mod + 2 * 1024, mod + 3 * 1024, mod + 4 * 1024, 6144, P.ln1_g, P.ln1_b, (bf16_t*)(ws + WS_X1), (bf16_t*)(ws + WS_H2),
                              (unsigned long long*)(ws + WS_LNX), (unsigned*)(ws + WS_CTL) + CW_LNCNT, (unsigned*)(ws + WS_CTL) + CW_LNTMO, lds + LDS_TAB};
            { pg8::RoundOrder R{S, 0}; pg8::gemm_phase<pg8::EpiLnFused, pg8::RoundOrder, true, false>(lds, g, R, E, nullptr); }
            { pg8::RoundOrder R{S, 1}; pg8::gemm_phase<pg8::EpiLnFused, pg8::RoundOrder, true, false>(lds, g, R, E, nullptr); }
        } else {
            pg8::EpiResModBf16 E{P.x, (bf16_t*)(ws + WS_V1), mod + 2 * 1024, 6144};
            pg8::gemm_phase<pg8::EpiResModBf16, pg8::DenseOrder, true, false>(lds, g, S, E, nullptr);
        }
    }
DI void run_phase_7(const Params& P, LAS unsigned char* lds, int vcu, int G, int bx, int wave, int lane, int tid) {
    unsigned char* ws = P.ws; const float* mod = (const float*)(ws + WS_MOD); (void)mod; (void)ws;
 if (REP_PHASE == 70) { phase_ln1(P, vcu, G, wave, lane, (bf16_t*)(ws + WS_HIDM)); phase_ln1(P, vcu, G, wave, lane, (bf16_t*)(ws + WS_HIDM)); }
    if (!(LN1_FUSED && G == 256)) phase_ln1(P, vcu, G, wave, lane, (bf16_t*)(ws + WS_X1)); }
DI void run_phase_8(const Params& P, LAS unsigned char* lds, int vcu, int G, int bx, int wave, int lane, int tid) {
    unsigned char* ws = P.ws; const float* mod = (const float*)(ws + WS_MOD); (void)mod; (void)ws;
        { pg8::Gemm g{(const bf16_t*)(ws + WS_H2), (const bf16_t*)(ws + WS_WR_T), DM, DM, DM, 128};
          pg8::DenseOrder S; S.init(g.A, DM, NT, 256, G, bx);
          pg8::EpiF32 E{(float*)(ws + WS_LOGIT), 256};
          pg8::gemm_phase<pg8::EpiF32, pg8::DenseOrder, true, false>(lds, g, S, E, nullptr); }
        { pg8::Gemm g{(const bf16_t*)(ws + WS_H2), (const bf16_t*)(ws + WS_WSGU_T), DM, DM, DM, 128};
          pg8::DenseOrder S; S.init(g.A, DM, NT, 512, G, bx);
          pg8::EpiGlu E{(bf16_t*)(ws + WS_HIDS), 256};
          pg8::gemm_phase<pg8::EpiGlu, pg8::DenseOrder, true, false>(lds, g, S, E, nullptr); }
    }
DI void run_phase_9(const Params& P, LAS unsigned char* lds, int vcu, int G, int bx, int wave, int lane, int tid) {
    unsigned char* ws = P.ws; const float* mod = (const float*)(ws + WS_MOD); (void)mod; (void)ws;
        phase_route(P, lds, vcu, G, wave, lane, tid);
        if (REP_PHASE == 90) { phase_route(P, lds, vcu, G, wave, lane, tid); phase_route(P, lds, vcu, G, wave, lane, tid); }
        pg8::Gemm g{(const bf16_t*)(ws + WS_HIDS), (const bf16_t*)(ws + WS_WSD_T), 256, 256, 256, 128};
        pg8::DenseOrder S; S.init(g.A, 256, NT, DM, G, bx);
        pg8::EpiStoreBf16 E{(bf16_t*)(ws + WS_SH), DM, 1.0f, 0};
        pg8::gemm_phase<pg8::EpiStoreBf16, pg8::DenseOrder, true, false>(lds, g, S, E, nullptr);
    }
DI void run_phase_10(const Params& P, LAS unsigned char* lds, int vcu, int G, int bx, int wave, int lane, int tid) {
    unsigned char* ws = P.ws; const float* mod = (const float*)(ws + WS_MOD); (void)mod; (void)ws;
 phase_scatter(P, lds, vcu, G, wave, lane, tid); }
DI void run_phase_11(const Params& P, LAS unsigned char* lds, int vcu, int G, int bx, int wave, int lane, int tid) {
    unsigned char* ws = P.ws; const float* mod = (const float*)(ws + WS_MOD); (void)mod; (void)ws;
        const int nblk = (int)__builtin_amdgcn_readfirstlane((int)ld_u32_agent((const unsigned*)(ws + WS_BLKE) + NBLK_MAX));
        const int nunits = 2 * nblk; LAS int* tab = (LAS int*)(lds + LDS_TAB);
        { const int* rowtok = (const int*)(ws + WS_ROWTOK); int i = 0;
          for (int L = vcu; L < nunits && i < 28; L += G, ++i) { if (tid < 256) tab[i * 256 + tid] = rowtok[(L >> 1) * 256 + tid]; } }
        __syncthreads();
        pg8::Gemm g{(const bf16_t*)(ws + WS_H2), (const bf16_t*)(ws + WS_WGU_T), DM, DM, DM, 128};
        pg8::MoeOrder<2> S{G, vcu, nunits, (const int*)(ws + WS_BLKE), g.A, (size_t)0};
        pg8::EpiGlu E{(bf16_t*)(ws + WS_HIDM), 256};
        pg8::gemm_phase<pg8::EpiGlu, pg8::MoeOrder<2>, true, true>(lds, g, S, E, tab);
    }
DI void run_phase_12(const Params& P, LAS unsigned char* lds, int vcu, int G, int bx, int wave, int lane, int tid) {
    unsigned char* ws = P.ws; const float* mod = (const float*)(ws + WS_MOD); (void)mod; (void)ws;
        const int nblk = (int)__builtin_amdgcn_readfirstlane((int)ld_u32_agent((const unsigned*)(ws + WS_BLKE) + NBLK_MAX));
        pg8::Gemm g{(const bf16_t*)(ws + WS_HIDM), (const bf16_t*)(ws + WS_WDN_T), 256, 256, 256, 128};
        pg8::MoeOrder<4> S{G, vcu, 4 * nblk, (const int*)(ws + WS_BLKE), g.A, (size_t)256 * 256 * 2};
        pg8::EpiStoreFp8 E{(unsigned char*)(ws + WS_YMOE), DM, YMOE_SCALE};
        pg8::gemm_phase<pg8::EpiStoreFp8, pg8::MoeOrder<4>, true, false>(lds, g, S, E, nullptr);
    }
DI void run_phase_13(const Params& P, LAS unsigned char* lds, int vcu, int G, int bx, int wave, int lane, int tid) {
    unsigned char* ws = P.ws; const float* mod = (const float*)(ws + WS_MOD); (void)mod; (void)ws;
 if (REP_PHASE == 130) { phase_final(P, vcu, G, wave, lane, (float*)(ws + WS_HIDM)); phase_final(P, vcu, G, wave, lane, (float*)(ws + WS_HIDM)); }
    phase_final(P, vcu, G, wave, lane, P.out); }
constexpr int NPHASE = 14;
__global__ void __launch_bounds__(512, 2) nsa_conformer_moe_fwd(Params P) {
    extern __shared__ __attribute__((aligned(16))) unsigned char lds_raw[];
    LAS unsigned char* lds = (LAS unsigned char*)lds_raw;
    const int tid = threadIdx.x, lane = tid & 63, wave = __builtin_amdgcn_readfirstlane(tid >> 6);
    const int G = gridDim.x, bx = blockIdx.x, vcu = (G % 8 == 0) ? (bx % 8) * (G / 8) + bx / 8 : bx;
    unsigned char* ws = P.ws;
    volatile LAS unsigned* MISC = (volatile LAS unsigned*)(lds + LDS_MISC);
    if (tid < 64) MISC[tid] = 0u;
    __syncthreads();
    const int lo = P.ph_lo, hi = P.ph_hi;
    XcdBarrier bar; bar.bar = (unsigned*)(ws + WS_CTL) + CW_BAR; bar.x = 0; bar.st = MISC + 8;
    if (hi - lo > 1) bar = xcd_barrier_post((unsigned*)(ws + WS_CTL) + CW_BAR, MISC + 8);
#ifdef PH_ONLY
#define IN(k) ((k) == PH_ONLY && lo <= (k) && (k) < hi)
#else
#define IN(k) (lo <= (k) && (k) < hi)
#endif
#define SEAM(k) do { if (IN(k) && IN((k) + 1) && !((k) == 6 && LN1_FUSED && G == 256)) xcd_barrier(bar); } while (0)
    if (IN(0)) run_phase_0(P, lds, vcu, G, bx, wave, lane, tid);
    if (REP_PHASE == 0 && IN(0)) { run_phase_0(P, lds, vcu, G, bx, wave, lane, tid); run_phase_0(P, lds, vcu, G, bx, wave, lane, tid); }
    SEAM(0);
    if (REP_PHASE == 200 && IN(0) && IN(1)) { for (int q_ = 0; q_ < 20; ++q_) xcd_barrier(bar); }
    if (IN(1)) run_phase_1(P, lds, vcu, G, bx, wave, lane, tid);
    if (REP_PHASE == 1 && IN(1)) { run_phase_1(P, lds, vcu, G, bx, wave, lane, tid); run_phase_1(P, lds, vcu, G, bx, wave, lane, tid); }
    SEAM(1);
    if (IN(2)) run_phase_2(P, lds, vcu, G, bx, wave, lane, tid);
    if (REP_PHASE == 2 && IN(2)) { run_phase_2(P, lds, vcu, G, bx, wave, lane, tid); run_phase_2(P, lds, vcu, G, bx, wave, lane, tid); }
    SEAM(2);
    if (IN(3)) run_phase_3(P, lds, vcu, G, bx, wave, lane, tid);
    if (REP_PHASE == 3 && IN(3)) { run_phase_3(P, lds, vcu, G, bx, wave, lane, tid); run_phase_3(P, lds, vcu, G, bx, wave, lane, tid); }
    SEAM(3);
    if (IN(4)) run_phase_4(P, lds, vcu, G, bx, wave, lane, tid);
    if (REP_PHASE == 4 && IN(4)) { run_phase_4(P, lds, vcu, G, bx, wave, lane, tid); run_phase_4(P, lds, vcu, G, bx, wave, lane, tid); }
    SEAM(4);
    if (IN(5)) run_phase_5(P, lds, vcu, G, bx, wave, lane, tid);
    if (REP_PHASE == 5 && IN(5)) { run_phase_5(P, lds, vcu, G, bx, wave, lane, tid); run_phase_5(P, lds, vcu, G, bx, wave, lane, tid); }
    SEAM(5);
    if (IN(6)) run_phase_6(P, lds, vcu, G, bx, wave, lane, tid);
    if (REP_PHASE == 6 && IN(6)) { run_phase_6(P, lds, vcu, G, bx, wave, lane, tid); run_phase_6(P, lds, vcu, G, bx, wave, lane, tid); }
    SEAM(6);
    if (IN(7)) run_phase_7(P, lds, vcu, G, bx, wave, lane, tid);
    if (REP_PHASE == 7 && IN(7)) { run_phase_7(P, lds, vcu, G, bx, wave, lane, tid); run_phase_7(P, lds, vcu, G, bx, wave, lane, tid); }
    SEAM(7);
    if (IN(8)) run_phase_8(P, lds, vcu, G, bx, wave, lane, tid);
    if (REP_PHASE == 8 && IN(8)) { run_phase_8(P, lds, vcu, G, bx, wave, lane, tid); run_phase_8(P, lds, vcu, G, bx, wave, lane, tid); }
    SEAM(8);
    if (IN(9)) run_phase_9(P, lds, vcu, G, bx, wave, lane, tid);
    if (REP_PHASE == 9 && IN(9)) { run_phase_9(P, lds, vcu, G, bx, wave, lane, tid); run_phase_9(P, lds, vcu, G, bx, wave, lane, tid); }
    SEAM(9);
    if (IN(10)) run_phase_10(P, lds, vcu, G, bx, wave, lane, tid);
    if (REP_PHASE == 10 && IN(10)) { run_phase_10(P, lds, vcu, G, bx, wave, lane, tid); run_phase_10(P, lds, vcu, G, bx, wave, lane, tid); }
    SEAM(10);
    if (IN(11)) run_phase_11(P, lds, vcu, G, bx, wave, lane, tid);
    if (REP_PHASE == 11 && IN(11)) { run_phase_11(P, lds, vcu, G, bx, wave, lane, tid); run_phase_11(P, lds, vcu, G, bx, wave, lane, tid); }
    SEAM(11);
    if (IN(12)) run_phase_12(P, lds, vcu, G, bx, wave, lane, tid);
    if (REP_PHASE == 12 && IN(12)) { run_phase_12(P, lds, vcu, G, bx, wave, lane, tid); run_phase_12(P, lds, vcu, G, bx, wave, lane, tid); }
    SEAM(12);
    if (IN(13)) run_phase_13(P, lds, vcu, G, bx, wave, lane, tid);
    if (REP_PHASE == 13 && IN(13)) { run_phase_13(P, lds, vcu, G, bx, wave, lane, tid); run_phase_13(P, lds, vcu, G, bx, wave, lane, tid); }
#undef IN
#undef SEAM
}

extern "C" void kernel_launch(void* const* d_in, const int* in_sizes, int n_in, void* d_out, int out_size, void* d_ws, size_t ws_size, hipStream_t stream) {
    static int grid = 0;
    if (grid == 0) {
        if (n_in != 28 || out_size != NT * DM || ws_size < WS_END) { fprintf(stderr, "kernel_launch: unexpected arguments (n_in %d, out %d, ws %zu); nothing launched\n", n_in, out_size, ws_size); grid = -1; return; }
        int dev = 0, cus = 0, per_cu = 0;
        if (hipGetDevice(&dev) != hipSuccess || hipDeviceGetAttribute(&cus, hipDeviceAttributeMultiprocessorCount, dev) != hipSuccess) { grid = -1; return; }
        if (hipFuncSetAttribute((const void*)nsa_conformer_moe_fwd, hipFuncAttributeMaxDynamicSharedMemorySize, LDS_BYTES) != hipSuccess) { fprintf(stderr, "kernel_launch: hipFuncSetAttribute failed\n"); grid = -1; return; }
        if (hipOccupancyMaxActiveBlocksPerMultiprocessor(&per_cu, (const void*)nsa_conformer_moe_fwd, 512, LDS_BYTES) != hipSuccess || per_cu < 1) { fprintf(stderr, "kernel_launch: occupancy query says %d blocks per CU\n", per_cu); }
        (void)hipGetLastError();
        grid = cus;
    }
    if (grid < 0) return;
    (void)hipMemsetAsync((char*)d_ws + WS_CTL, 0, CTL_ZERO_BYTES, stream);
    Params p{};
    const float** pp = (const float**)&p;
    for (int i = 0; i < 28; ++i) pp[i] = (const float*)d_in[i];
    p.out = (float*)d_out; p.ws = (unsigned char*)d_ws;
#if MK_PER_PHASE
    for (int ph = 0; ph < NPHASE; ++ph) { p.ph_lo = ph; p.ph_hi = ph + 1; hipLaunchKernelGGL(nsa_conformer_moe_fwd, dim3(grid), dim3(512), LDS_BYTES, stream, p); }
#else
    p.ph_lo = 0; p.ph_hi = NPHASE;
    hipLaunchKernelGGL(nsa_conformer_moe_fwd, dim3(grid), dim3(512), LDS_BYTES, stream, p);
#endif
}
```

```cpp
#include <hip/hip_runtime.h>
#include <cstdio>
#include <cstdint>

#define DI __device__ __forceinline__
#define LAS __attribute__((address_space(3)))
#define GAS __attribute__((address_space(1)))
typedef unsigned short bf16_t;
typedef short bf16x8 __attribute__((ext_vector_type(8)));
typedef float f32x4 __attribute__((ext_vector_type(4)));
typedef float f32x16 __attribute__((ext_vector_type(16)));
typedef float f32x2 __attribute__((ext_vector_type(2)));
typedef unsigned u32x4 __attribute__((ext_vector_type(4)));
typedef unsigned u32x2 __attribute__((ext_vector_type(2)));
typedef __bf16 bf16x2_t __attribute__((ext_vector_type(2)));

constexpr int NB = 4, SEQ = 8192, DM = 1024, NT = NB * SEQ;
constexpr int NU = 2560;
constexpr int UQ = 0, UKC = 512, UVC = 640, UKS = 768, UVS = 896, UKW = 1024, UVW = 1152, UCA = 1280, UCG = 1792, UGT = 2304;
constexpr int DIN = 2328;
constexpr int NEXP = 256, DEXP = 256, TOPK = 8;
constexpr int NASSIGN = NT * TOPK;
constexpr int NPAD_MAX = NASSIGN + NEXP * 255 + 1;
constexpr int NBLK_MAX = NPAD_MAX / 256 + 1;
constexpr float LN_EPS = 1e-5f;
constexpr float YMOE_SCALE = 16.0f;
constexpr float DN_ALPHA = 1.189207115002721f;

DI unsigned pk2(float lo, float hi) { f32x2 v = {lo, hi}; bf16x2_t b = __builtin_convertvector(v, bf16x2_t); return __builtin_bit_cast(unsigned, b); }
DI float bflo(unsigned w) { return __uint_as_float(w << 16); }
DI float bfhi(unsigned w) { return __uint_as_float(w & 0xffff0000u); }
DI float bf2f(bf16_t b) { return __uint_as_float(((unsigned)b) << 16); }
DI float fsigmoid(float x) { return __builtin_amdgcn_rcpf(1.0f + __expf(-x)); }
DI float fsilu(float x) { return x * __builtin_amdgcn_rcpf(1.0f + __expf(-x)); }
DI float wave_sum(float v) {
#pragma unroll
    for (int o = 1; o < 64; o <<= 1) v += __shfl_xor(v, o);
    return v;
}
DI unsigned ld_u32_agent(const unsigned* p) { return __hip_atomic_load(p, __ATOMIC_RELAXED, __HIP_MEMORY_SCOPE_AGENT); }
#define LDS_WAIT() asm volatile("s_waitcnt lgkmcnt(0)" ::: "memory")
#define VM_WAIT() asm volatile("s_waitcnt vmcnt(0)" ::: "memory")

#define XB_TMO      128
#define XB_XCNT(j)  (256  + 64 * (j))
#define XB_XSUB(j)  (1280 + 64 * (j))
#define XB_XGEN(j)  (2304 + 64 * (j))
#define XB_TOP      3328
#define XB_TOPGEN   3392
#define XCD_BAR_WORDS 3456
#define XB_SPIN_CAP (1u << 18)
__device__ __forceinline__ unsigned xb_ld(unsigned* p)              { return __hip_atomic_load(p, __ATOMIC_RELAXED, __HIP_MEMORY_SCOPE_AGENT); }
__device__ __forceinline__ unsigned xb_add(unsigned* p, unsigned v) { return __hip_atomic_fetch_add(p, v, __ATOMIC_RELAXED, __HIP_MEMORY_SCOPE_AGENT); }
__device__ __forceinline__ unsigned xb_xcc_id() { return (unsigned)__builtin_amdgcn_s_getreg((3 << 11) | 20) & 0xFu; }
#define XB_SPIN(cond, bar) do { unsigned _sp = 0; while (cond) { __builtin_amdgcn_s_sleep(1); \
    if ((++_sp & 255u) == 0u) { if (xb_ld(&(bar)[XB_TMO])) break; if (_sp > XB_SPIN_CAP) { atomicAdd(&(bar)[XB_TMO], 1u); break; } } } } while (0)
struct XcdBarrier { unsigned* bar; unsigned x; volatile LAS unsigned* st; };
__device__ __forceinline__ XcdBarrier xcd_barrier_post(unsigned* bar, volatile LAS unsigned* st) {
    XcdBarrier b; b.bar = bar; b.x = xb_xcc_id(); b.st = st;
    if (threadIdx.x == 0) (void)xb_add(&bar[XB_XCNT(b.x)], 1u);
    return b;
}
__device__ __forceinline__ void xcd_barrier_complete(unsigned* bar, unsigned x, unsigned& nloc, unsigned& nx) {
    const unsigned G = gridDim.x * gridDim.y * gridDim.z;
    unsigned sum, cnt, mine, sp = 0u;
    for (;;) {
        sum = 0u; cnt = 0u; mine = 0u;
#pragma unroll
        for (unsigned j = 0; j < 16; ++j) { const unsigned c = xb_ld(&bar[XB_XCNT(j)]); sum += c; cnt += (c > 0u) ? 1u : 0u; mine = (j == x) ? c : mine; }
        if (sum == G) break;
        __builtin_amdgcn_s_sleep(1);
        if ((++sp & 255u) == 0u) { if (xb_ld(&bar[XB_TMO])) break; if (sp > XB_SPIN_CAP) { atomicAdd(&bar[XB_TMO], 1u); break; } }
    }
    nloc = mine > 0u ? mine : 1u; nx = cnt > 0u ? cnt : 1u;
}
__device__ __forceinline__ void xcd_barrier(const XcdBarrier& b) {
    asm volatile("s_waitcnt vmcnt(0)" ::: "memory");
    __syncthreads();
    if (threadIdx.x == 0) {
        unsigned* bar = b.bar;
        __builtin_amdgcn_s_waitcnt(0);
        unsigned nloc = b.st[0], nx = b.st[1];
        if (nloc == 0u) { xcd_barrier_complete(bar, b.x, nloc, nx); b.st[0] = nloc; b.st[1] = nx; }
        const unsigned old = xb_add(&bar[XB_XSUB(b.x)], 1u);
        const unsigned gen = old / nloc;
        if (old + 1u == (gen + 1u) * nloc) {
            __builtin_amdgcn_fence(__ATOMIC_RELEASE, "agent");
            asm volatile("s_waitcnt vmcnt(0)" ::: "memory");
            const unsigned og = xb_add(&bar[XB_TOP], 1u);
            const unsigned tg = og / nx;
            if (og + 1u == (tg + 1u) * nx) xb_add(&bar[XB_TOPGEN], 1u);
            else XB_SPIN(xb_ld(&bar[XB_TOPGEN]) == tg, bar);
            __builtin_amdgcn_fence(__ATOMIC_ACQUIRE, "agent");
            xb_add(&bar[XB_XGEN(b.x)], 1u);
            asm volatile("s_waitcnt vmcnt(0)" ::: "memory");
        } else {
            XB_SPIN(xb_ld(&bar[XB_XGEN(b.x)]) == gen, bar);
            __builtin_amdgcn_fence(__ATOMIC_ACQUIRE, "agent");
            asm volatile("s_waitcnt vmcnt(0)" ::: "memory");
        }
    }
    __syncthreads();
}

namespace pg8 {
constexpr int BM = 256, BK = 64, HALF = 128, HTB = HALF * BK * 2, STAGE_BYTES = 8 * HTB, NXCD = 8, WGM = 8;
__host__ __device__ __forceinline__ int lds_byte(int r, int c) { const int st = (r >> 4) * 2 + (c >> 5), rr = r & 15, cc = c & 31, ob = rr * 64 + cc * 2; return st * 1024 + (ob ^ (((ob >> 9) & 1) << 5)); }
__host__ __device__ __forceinline__ void stage_rc(int b, int& R, int& C) { const int st = b / 1024, sb = b % 1024, swz = sb ^ (((sb >> 9) & 1) << 5); R = (st >> 1) * 16 + swz / 64; C = (st & 1) * 32 + (swz % 64) / 2; }
__host__ __device__ __forceinline__ int perm32(int rho) { const int n = rho >> 4, i = rho & 15; return 8 * (i >> 2) + 4 * n + (i & 3); }

struct Unit { int pm, pn, po; };
struct Gemm { const bf16_t* A; const bf16_t* Bt; int lda, ldb, K, kstepA; };

struct DenseOrder {
    int nM, nN, nwg, G, c; const bf16_t* A; size_t tstepA;
    DI void init(const bf16_t* A_, int lda, int M, int N, int G_, int c_) { nM = M / BM; nN = N / BM; nwg = nM * nN; G = G_; c = c_; A = A_; tstepA = (size_t)BM * lda * 2; }
    DI bool next(int i, Unit& u) const {
        const long L = (long)i * G + c; if (L >= nwg) return false;
        int wgid = (int)L; { const int q = nwg / NXCD, r = nwg % NXCD, xcd = wgid % NXCD, off = wgid / NXCD; wgid = (xcd < r ? xcd * (q + 1) : r * (q + 1) + (xcd - r) * q) + off; }
        const int nig = WGM * nN, gid = wgid / nig, fm = gid * WGM, gsz = (nM - fm) < WGM ? (nM - fm) : WGM;
        u.pm = fm + ((wgid % nig) % gsz); u.pn = (wgid % nig) / gsz; u.po = u.pn; return true;
    }
    DI const char* abase(const Unit& u) const { return (const char*)A + (size_t)u.pm * tstepA; }
};

DI unsigned cvt_pk_bf16(float lo, float hi) { return pk2(lo, hi); }

template <class Epi, class Sched, bool ALIGN_EPI, bool GATHER>
__device__ __forceinline__ void gemm_phase(LAS unsigned char* lds, const Gemm g, const Sched& S, const Epi& E, const LAS int* rowidx  ) {
    const int tid = threadIdx.x, wid = __builtin_amdgcn_readfirstlane(tid >> 6), lane = tid & 63, wr = wid >> 2, wc = wid & 3, fr = lane & 15, fq = lane >> 4;
    const int K = g.K; int nt = K / BK; asm volatile("" : "+s"(nt));
    unsigned voffA[2], voffB[2]; int RA[2], CA[2];
#pragma unroll
    for (int i = 0; i < 2; ++i) { int R, C; stage_rc(tid * 16 + i * 8192, R, C); const int Rb = Epi::PERM ? ((R & ~31) + perm32(R & 31)) : R;
        RA[i] = R; CA[i] = C; voffA[i] = (unsigned)(R * g.lda + C) * 2u; voffB[i] = (unsigned)(Rb * g.ldb + C) * 2u; }
    const size_t kstepA = (size_t)g.kstepA, kstepB = (size_t)(BK * 2);
    const size_t hstepA = (size_t)HALF * g.lda * 2, hstepB = (size_t)HALF * g.ldb * 2;
    const size_t tstepB = 2 * hstepB;
    const unsigned ldsw = (unsigned)wid * 1024u;
    const int aoff = lds_byte(wr * 64 + fr, fq * 8), boff = lds_byte(wc * 32 + fr, fq * 8);
#define PG8_SA(b, h) (((b) * 2 + (h)) * HTB)
#define PG8_SB(b, h) ((4 + (b) * 2 + (h)) * HTB)
#define PG8_STAGE(bufoff, gbase, voff) do { _Pragma("unroll") for (int _i = 0; _i < 2; ++_i) \
        __builtin_amdgcn_global_load_lds((const unsigned*)((const char*)(gbase) + (voff)[_i]), (LAS unsigned*)(lds + (bufoff) + ldsw + _i * 8192), 16, 0, 0); } while (0)
#define PG8_LDA(dst, b, h) do { _Pragma("unroll") for (int m = 0; m < 4; ++m) _Pragma("unroll") for (int k = 0; k < 2; ++k) dst[m][k] = *(const LAS bf16x8*)(lds + PG8_SA(b, h) + aoff + m * 2048 + k * 1024); } while (0)
#define PG8_LDB(dst, b, h) do { _Pragma("unroll") for (int n = 0; n < 2; ++n) _Pragma("unroll") for (int k = 0; k < 2; ++k) dst[n][k] = *(const LAS bf16x8*)(lds + PG8_SB(b, h) + boff + n * 2048 + k * 1024); } while (0)
#define PG8_MMA(ai, bj, At, Bt) do { __builtin_amdgcn_s_setprio(1); _Pragma("unroll") for (int m = 0; m < 4; ++m) _Pragma("unroll") for (int n = 0; n < 2; ++n) _Pragma("unroll") for (int k = 0; k < 2; ++k) \
        acc[ai][bj][m][n] = __builtin_amdgcn_mfma_f32_16x16x32_bf16(Bt[n][k], At[m][k], acc[ai][bj][m][n], 0, 0, 0); __builtin_amdgcn_s_setprio(0); } while (0)
#define PG8_WAIT_V(n) asm volatile("s_waitcnt vmcnt(" #n ")" ::: "memory")
#define PG8_WAIT_L(n) asm volatile("s_waitcnt lgkmcnt(" #n ")" ::: "memory")
#define PG8_BAR __builtin_amdgcn_s_barrier()
#define PG8_SCHED __builtin_amdgcn_sched_barrier(0)
    Unit cur, nxt; int ui = 0;
    if (!S.next(0, cur)) return;
    f32x4 acc[2][2][4][2];
#pragma unroll
    for (int a = 0; a < 2; ++a)
#pragma unroll
        for (int b = 0; b < 2; ++b)
#pragma unroll
            for (int m = 0; m < 4; ++m)
#pragma unroll
                for (int n = 0; n < 2; ++n) acc[a][b][m][n] = (f32x4){0.f, 0.f, 0.f, 0.f};
    bf16x8 At[4][2], B0[2][2], B1[2][2];
    unsigned cg0[2], cg1[2], ng0[2], ng1[2];
    const char* cA; const char* cB = (const char*)g.Bt + (size_t)cur.pn * tstepB;
    if constexpr (GATHER) {
        cA = (const char*)g.A;
#pragma unroll
        for (int i = 0; i < 2; ++i) { cg0[i] = (unsigned)(rowidx[ui * 256 + RA[i]] * g.lda + CA[i]) * 2u; cg1[i] = (unsigned)(rowidx[ui * 256 + 128 + RA[i]] * g.lda + CA[i]) * 2u; ng0[i] = cg0[i]; ng1[i] = cg1[i]; }
    } else { cA = S.abase(cur); cg0[0] = cg0[1] = cg1[0] = cg1[1] = ng0[0] = ng0[1] = ng1[0] = ng1[1] = 0u; }
#define PG8_STAGE_A(bufoff, base, h, og0, og1) do { if constexpr (GATHER) { if ((h) == 0) PG8_STAGE(bufoff, base, og0); else PG8_STAGE(bufoff, base, og1); } \
        else { PG8_STAGE(bufoff, (base) + ((h) ? hstepA : (size_t)0), voffA); } } while (0)
    PG8_STAGE(PG8_SB(0, 0), cB, voffB); PG8_STAGE(PG8_SB(0, 1), cB + hstepB, voffB); PG8_STAGE_A(PG8_SA(0, 0), cA, 0, cg0, cg1); PG8_STAGE_A(PG8_SA(0, 1), cA, 1, cg0, cg1);
    if (wr == 1) PG8_BAR;
    PG8_WAIT_V(2); PG8_BAR;
    PG8_STAGE(PG8_SB(1, 0), cB + kstepB, voffB); PG8_STAGE_A(PG8_SA(1, 0), cA + kstepA, 0, cg0, cg1); PG8_STAGE(PG8_SB(1, 1), cB + hstepB + kstepB, voffB);
    PG8_WAIT_V(6); PG8_BAR;
    for (;;) {
        const bool has_next = S.next(ui + 1, nxt);
        const char* nA; const char* nB = has_next ? (const char*)g.Bt + (size_t)nxt.pn * tstepB : cB;
        if constexpr (GATHER) {
            nA = cA;
            if (has_next) {
#pragma unroll
                for (int i = 0; i < 2; ++i) { ng0[i] = (unsigned)(rowidx[(ui + 1) * 256 + RA[i]] * g.lda + CA[i]) * 2u; ng1[i] = (unsigned)(rowidx[(ui + 1) * 256 + 128 + RA[i]] * g.lda + CA[i]) * 2u; }
            } else {
#pragma unroll
                for (int i = 0; i < 2; ++i) { ng0[i] = cg0[i]; ng1[i] = cg1[i]; }
            }
        } else { nA = has_next ? S.abase(nxt) : cA; }
        for (int t = 0; t < nt; t += 2) {
            const bool last = (t == nt - 2);
            const char* a1 = cA + (size_t)(t + 1) * kstepA;
            const char* a2 = last ? nA : cA + (size_t)(t + 2) * kstepA; const char* b2 = last ? nB : cB + (size_t)(t + 2) * kstepB;
            const char* a3 = a2 + kstepA; const char* b3 = b2 + kstepB;
            unsigned xg0[2], xg1[2];
#pragma unroll
            for (int i = 0; i < 2; ++i) { xg0[i] = last ? ng0[i] : cg0[i]; xg1[i] = last ? ng1[i] : cg1[i]; }
            PG8_LDB(B0, 0, 0); PG8_LDB(B1, 0, 1); PG8_SCHED; PG8_LDA(At, 0, 0); PG8_STAGE_A(PG8_SA(1, 1), a1, 1, cg0, cg1);
            PG8_WAIT_V(8); PG8_WAIT_L(0); PG8_BAR; PG8_MMA(0, 0, At, B0); PG8_MMA(0, 1, At, B1); PG8_BAR; PG8_SCHED;
            PG8_LDA(At, 0, 1); PG8_STAGE(PG8_SB(0, 0), b2, voffB); PG8_STAGE(PG8_SB(0, 1), b2 + hstepB, voffB); PG8_STAGE_A(PG8_SA(0, 0), a2, 0, xg0, xg1);
            PG8_WAIT_V(8); PG8_WAIT_L(0); PG8_BAR; PG8_MMA(1, 0, At, B0); PG8_MMA(1, 1, At, B1); PG8_BAR; PG8_SCHED;
            PG8_LDB(B0, 1, 0); PG8_LDB(B1, 1, 1); PG8_SCHED; PG8_LDA(At, 1, 0); PG8_STAGE_A(PG8_SA(0, 1), a2, 1, xg0, xg1);
            PG8_WAIT_V(8); PG8_WAIT_L(0); PG8_BAR; PG8_MMA(0, 0, At, B0); PG8_MMA(0, 1, At, B1); PG8_BAR; PG8_SCHED;
            PG8_LDA(At, 1, 1); PG8_STAGE(PG8_SB(1, 0), b3, voffB); PG8_STAGE(PG8_SB(1, 1), b3 + hstepB, voffB); PG8_STAGE_A(PG8_SA(1, 0), a3, 0, xg0, xg1);
            PG8_WAIT_V(8); PG8_WAIT_L(0); PG8_BAR; PG8_MMA(1, 0, At, B0); PG8_MMA(1, 1, At, B1); PG8_BAR; PG8_SCHED;
        }
        if constexpr (ALIGN_EPI) { if (wr == 0) PG8_BAR; }
        E(acc, cur, wr, wc, fr, fq, wid, lane);
        if (!has_next) break;
#pragma unroll
        for (int a = 0; a < 2; ++a)
#pragma unroll
            for (int b = 0; b < 2; ++b)
#pragma unroll
                for (int m = 0; m < 4; ++m)
#pragma unroll
                    for (int n = 0; n < 2; ++n) acc[a][b][m][n] = (f32x4){0.f, 0.f, 0.f, 0.f};
        cur = nxt; cA = nA; cB = nB; ++ui;
#pragma unroll
        for (int i = 0; i < 2; ++i) { cg0[i] = ng0[i]; cg1[i] = ng1[i]; }
        if constexpr (ALIGN_EPI) { if (wr == 1) PG8_BAR; }
    }
    PG8_WAIT_V(0);
    if constexpr (!ALIGN_EPI) { if (wr == 0) PG8_BAR; }
    PG8_BAR;
#undef PG8_SA
#undef PG8_SB
#undef PG8_STAGE
#undef PG8_STAGE_A
#undef PG8_LDA
#undef PG8_LDB
#undef PG8_MMA
#undef PG8_WAIT_V
#undef PG8_WAIT_L
#undef PG8_BAR
#undef PG8_SCHED
}
}
namespace pg8 {
typedef f32x4 AccT[2][2][4][2];

struct EpiStoreBf16 {
    static constexpr bool PERM = true;
    bf16_t* O; int ldc; float scale0; int ntile0;
    DI void operator()(AccT& acc, const Unit& u, int wr, int wc, int fr, int fq, int wid, int lane) const {
        const int row0 = u.pm * BM + wr * 64 + fr, col0 = u.po * BM + wc * 32 + 8 * fq; const float sc = (u.po < ntile0) ? scale0 : 1.0f;
#pragma unroll
        for (int ai = 0; ai < 2; ++ai)
#pragma unroll
            for (int m = 0; m < 4; ++m) { bf16_t* rowp = O + (size_t)(row0 + ai * HALF + m * 16) * ldc + col0;
#pragma unroll
                for (int bj = 0; bj < 2; ++bj) { const f32x4 v0 = acc[ai][bj][m][0] * sc, v1 = acc[ai][bj][m][1] * sc;
                    u32x4 w; w.x = pk2(v0[0], v0[1]); w.y = pk2(v0[2], v0[3]); w.z = pk2(v1[0], v1[1]); w.w = pk2(v1[2], v1[3]);
                    *(u32x4*)(rowp + bj * HALF) = w; } }
    }
};
struct EpiStoreFp8 {
    static constexpr bool PERM = true;
    unsigned char* O; int ldc; float scale;
    DI void operator()(AccT& acc, const Unit& u, int wr, int wc, int fr, int fq, int wid, int lane) const {
        const int row0 = u.pm * BM + wr * 64 + fr, col0 = u.po * BM + wc * 32 + 8 * fq;
#pragma unroll
        for (int ai = 0; ai < 2; ++ai)
#pragma unroll
            for (int m = 0; m < 4; ++m) { unsigned char* rowp = O + (size_t)(row0 + ai * HALF + m * 16) * ldc + col0;
#pragma unroll
                for (int bj = 0; bj < 2; ++bj) { const f32x4 v0 = acc[ai][bj][m][0] * scale, v1 = acc[ai][bj][m][1] * scale;
                    int w0 = 0, w1 = 0;
                    w0 = __builtin_amdgcn_cvt_pk_fp8_f32(v0[0], v0[1], w0, false); w0 = __builtin_amdgcn_cvt_pk_fp8_f32(v0[2], v0[3], w0, true);
                    w1 = __builtin_amdgcn_cvt_pk_fp8_f32(v1[0], v1[1], w1, false); w1 = __builtin_amdgcn_cvt_pk_fp8_f32(v1[2], v1[3], w1, true);
                    *(u32x2*)(rowp + bj * HALF) = (u32x2){(unsigned)w0, (unsigned)w1}; } }
    }
};
DI float gelu_tanh(float x) { const float u = 0.7978845608028654f * (x + 0.044715f * x * x * x); const float e = __expf(2.0f * u); const float th = 1.0f - 2.0f / (e + 1.0f); return 0.5f * x * (1.0f + th); }
struct EpiCmp {
    static constexpr bool PERM = true;
    bf16_t* O; const float* peb;
    DI void operator()(AccT& acc, const Unit& u, int wr, int wc, int fr, int fq, int wid, int lane) const {
        const int row0 = u.pm * BM + wr * 64 + fr, col0 = wc * 32 + 8 * fq; const float* pb = peb + (u.pm >> 4) * 256;
        f32x4 bv[2][2];
#pragma unroll
        for (int bj = 0; bj < 2; ++bj)
#pragma unroll
            for (int n = 0; n < 2; ++n) bv[bj][n] = *(const f32x4*)(pb + col0 + bj * HALF + 4 * n);
#pragma unroll
        for (int ai = 0; ai < 2; ++ai)
#pragma unroll
            for (int m = 0; m < 4; ++m) { bf16_t* rowp = O + (size_t)(row0 + ai * HALF + m * 16) * 256 + col0;
#pragma unroll
                for (int bj = 0; bj < 2; ++bj) { f32x4 v0 = acc[ai][bj][m][0] + bv[bj][0], v1 = acc[ai][bj][m][1] + bv[bj][1];
#pragma unroll
                    for (int j = 0; j < 4; ++j) { v0[j] = gelu_tanh(v0[j]); v1[j] = gelu_tanh(v1[j]); }
                    u32x4 w; w.x = pk2(v0[0], v0[1]); w.y = pk2(v0[2], v0[3]); w.z = pk2(v1[0], v1[1]); w.w = pk2(v1[2], v1[3]);
                    *(u32x4*)(rowp + bj * HALF) = w; } }
    }
};
struct EpiF32 {
    static constexpr bool PERM = false;
    float* C; int ldc;
    DI void operator()(AccT& acc, const Unit& u, int wr, int wc, int fr, int fq, int wid, int lane) const {
        const int row0 = u.pm * BM + wr * 64 + fr, col0 = u.po * BM + wc * 32 + 4 * fq;
#pragma unroll
        for (int ai = 0; ai < 2; ++ai)
#pragma unroll
            for (int m = 0; m < 4; ++m) { float* rowp = C + (size_t)(row0 + ai * HALF + m * 16) * ldc + col0;
#pragma unroll
                for (int bj = 0; bj < 2; ++bj)
#pragma unroll
                    for (int n = 0; n < 2; ++n) *(f32x4*)(rowp + bj * HALF + n * 16) = acc[ai][bj][m][n]; }
    }
};
struct EpiResMod {
    static constexpr bool PERM = false;
    const float* base; float* out; const float* gate; int gate_pitch;
    DI void operator()(AccT& acc, const Unit& u, int wr, int wc, int fr, int fq, int wid, int lane) const {
        const int row0 = u.pm * BM + wr * 64 + fr, col0 = u.po * BM + wc * 32 + 4 * fq;
        const float* gp = gate + (size_t)((u.pm * BM) / SEQ) * gate_pitch + col0;
        f32x4 gv[2][2];
#pragma unroll
        for (int bj = 0; bj < 2; ++bj)
#pragma unroll
            for (int n = 0; n < 2; ++n) gv[bj][n] = *(const f32x4*)(gp + bj * HALF + n * 16);
#pragma unroll
        for (int ai = 0; ai < 2; ++ai)
#pragma unroll
            for (int m = 0; m < 4; ++m) { const size_t off = (size_t)(row0 + ai * HALF + m * 16) * DM + col0;
#pragma unroll
                for (int bj = 0; bj < 2; ++bj)
#pragma unroll
                    for (int n = 0; n < 2; ++n) { const f32x4 bs = *(const f32x4*)(base + off + bj * HALF + n * 16);
                        *(f32x4*)(out + off + bj * HALF + n * 16) = bs * DN_ALPHA + gv[bj][n] * acc[ai][bj][m][n]; } }
    }
};
struct EpiResModBf16 {
    static constexpr bool PERM = false;
    const float* base; bf16_t* out; const float* gate; int gate_pitch;
    DI void operator()(AccT& acc, const Unit& u, int wr, int wc, int fr, int fq, int wid, int lane) const {
        const int row0 = u.pm * BM + wr * 64 + fr, col0 = u.po * BM + wc * 32 + 4 * fq;
        const float* gp = gate + (size_t)((u.pm * BM) / SEQ) * gate_pitch + col0;
        f32x4 gv[2][2];
#pragma unroll
        for (int bj = 0; bj < 2; ++bj)
#pragma unroll
            for (int n = 0; n < 2; ++n) gv[bj][n] = *(const f32x4*)(gp + bj * HALF + n * 16);
#pragma unroll
        for (int ai = 0; ai < 2; ++ai)
#pragma unroll
            for (int m = 0; m < 4; ++m) { const size_t off = (size_t)(row0 + ai * HALF + m * 16) * DM + col0;
#pragma unroll
                for (int bj = 0; bj < 2; ++bj)
#pragma unroll
                    for (int n = 0; n < 2; ++n) { const f32x4 bs = *(const f32x4*)(base + off + bj * HALF + n * 16); const f32x4 v = bs * DN_ALPHA + gv[bj][n] * acc[ai][bj][m][n];
                        *(u32x2*)(out + off + bj * HALF + n * 16) = (u32x2){pk2(v.x, v.y), pk2(v.z, v.w)}; } }
    }
};
struct RoundOrder {
    DenseOrder base; int round;
    DI bool next(int i, Unit& u) const { return i == 0 ? base.next(round, u) : false; }
    DI const char* abase(const Unit& u) const { return base.abase(u); }
};
struct EpiLnFused {
    static constexpr bool PERM = false;
    const float* x; const float* g1; const float* sh2; const float* sc2; int mod_pitch; const float* lng; const float* lnb; bf16_t* X1; bf16_t* H2;
    unsigned long long* slots; unsigned* cnt; unsigned* tmo; LAS unsigned char* tab;
    DI void operator()(AccT& acc, const Unit& u, int wr, int wc, int fr, int fq, int wid, int lane) const {
        typedef float f32x2v __attribute__((ext_vector_type(2)));
        LAS f32x2v* Pt = (LAS f32x2v*)tab; LAS f32x2v* St = (LAS f32x2v*)(tab + 8192);
        const int tid = wid * 64 + lane, b = (u.pm * BM) / SEQ;
        const int row0 = u.pm * BM + wr * 64 + fr, col0 = u.po * BM + wc * 32 + 4 * fq;
#pragma unroll
        for (int bj = 0; bj < 2; ++bj)
#pragma unroll
            for (int n = 0; n < 2; ++n) { const f32x4 gv = *(const f32x4*)(g1 + (size_t)b * mod_pitch + col0 + bj * HALF + n * 16);
#pragma unroll
                for (int ai = 0; ai < 2; ++ai)
#pragma unroll
                    for (int m = 0; m < 4; ++m) { const f32x4 bs = *(const f32x4*)(x + (size_t)(row0 + ai * HALF + m * 16) * DM + col0 + bj * HALF + n * 16);
                        acc[ai][bj][m][n] = bs * DN_ALPHA + gv * acc[ai][bj][m][n]; }
                asm volatile("" : "+v"(acc[0][bj][0][n]), "+v"(acc[0][bj][1][n]), "+v"(acc[0][bj][2][n]), "+v"(acc[0][bj][3][n]), "+v"(acc[1][bj][0][n]), "+v"(acc[1][bj][1][n]), "+v"(acc[1][bj][2][n]), "+v"(acc[1][bj][3][n]) :: "memory"); }
#pragma unroll
        for (int ai = 0; ai < 2; ++ai)
#pragma unroll
            for (int m = 0; m < 4; ++m) { float s1 = 0.f, s2 = 0.f;
#pragma unroll
                for (int bj = 0; bj < 2; ++bj)
#pragma unroll
                    for (int n = 0; n < 2; ++n) { const f32x4 q = acc[ai][bj][m][n]; s1 += (q[0] + q[1]) + (q[2] + q[3]); s2 += (q[0] * q[0] + q[1] * q[1]) + (q[2] * q[2] + q[3] * q[3]); }
                s1 += __shfl_xor(s1, 16); s1 += __shfl_xor(s1, 32); s2 += __shfl_xor(s2, 16); s2 += __shfl_xor(s2, 32);
                if (fq == 0) Pt[(ai * HALF + wr * 64 + m * 16 + fr) * 4 + wc] = (f32x2v){s1, s2}; }
        asm volatile("s_waitcnt lgkmcnt(0)" ::: "memory"); __builtin_amdgcn_s_barrier(); asm volatile("" ::: "memory");
        if (tid < 256) { const f32x2v a = Pt[tid * 4 + 0], bq = Pt[tid * 4 + 1], c = Pt[tid * 4 + 2], d = Pt[tid * 4 + 3];
            const float S1 = (a.x + bq.x) + (c.x + d.x), S2 = (a.y + bq.y) + (c.y + d.y);
            __hip_atomic_store(slots + ((size_t)(u.pm * 256 + tid) * 4 + u.po), ((unsigned long long)__float_as_uint(S2) << 32) | __float_as_uint(S1), __ATOMIC_RELAXED, __HIP_MEMORY_SCOPE_AGENT); }
        asm volatile("s_waitcnt vmcnt(0) lgkmcnt(0)" ::: "memory"); __builtin_amdgcn_s_barrier(); asm volatile("" ::: "memory");
        if (tid == 0) { __hip_atomic_fetch_add(cnt + 64 * u.pm, 1u, __ATOMIC_RELAXED, __HIP_MEMORY_SCOPE_AGENT);
            const unsigned long long t0 = __builtin_amdgcn_s_memrealtime();
            while (__hip_atomic_load(cnt + 64 * u.pm, __ATOMIC_RELAXED, __HIP_MEMORY_SCOPE_AGENT) < 4u) {
                if (__builtin_amdgcn_s_memrealtime() - t0 > 2000000ull) { __hip_atomic_store(tmo, 1u, __ATOMIC_RELAXED, __HIP_MEMORY_SCOPE_AGENT); break; }
                __builtin_amdgcn_s_sleep(2); }
            __builtin_amdgcn_fence(__ATOMIC_ACQUIRE, "agent");
            asm volatile("s_waitcnt vmcnt(0)" ::: "memory"); }
        __builtin_amdgcn_s_barrier(); asm volatile("" ::: "memory");
        if (tid < 256) { const unsigned long long* sl = slots + (size_t)(u.pm * 256 + tid) * 4; float S1 = 0.f, S2 = 0.f;
#pragma unroll
            for (int t = 0; t < 4; ++t) { const unsigned long long w = __hip_atomic_load(sl + t, __ATOMIC_RELAXED, __HIP_MEMORY_SCOPE_AGENT); S1 += __uint_as_float((unsigned)w); S2 += __uint_as_float((unsigned)(w >> 32)); }
            const float mean = S1 * (1.0f / DM); float var = S2 * (1.0f / DM) - mean * mean; var = var < 0.f ? 0.f : var;
            St[tid] = (f32x2v){mean, 1.0f / sqrtf(var + LN_EPS)}; }
        asm volatile("s_waitcnt vmcnt(0) lgkmcnt(0)" ::: "memory"); __builtin_amdgcn_s_barrier(); asm volatile("" ::: "memory");
#pragma unroll
        for (int bj = 0; bj < 2; ++bj)
#pragma unroll
            for (int n = 0; n < 2; ++n) { const int c = col0 + bj * HALF + n * 16;
                const f32x4 lg = *(const f32x4*)(lng + c), lb = *(const f32x4*)(lnb + c), shv = *(const f32x4*)(sh2 + (size_t)b * mod_pitch + c), scv = *(const f32x4*)(sc2 + (size_t)b * mod_pitch + c) + 1.0f;
#pragma unroll
                for (int ai = 0; ai < 2; ++ai)
#pragma unroll
                    for (int m = 0; m < 4; ++m) { const int rl = ai * HALF + wr * 64 + m * 16 + fr; const f32x2v sr = St[rl]; const size_t off = (size_t)(u.pm * BM + rl) * DM + c;
                        const f32x4 x1 = (acc[ai][bj][m][n] - sr.x) * sr.y * lg + lb; const f32x4 y = x1 * scv + shv;
                        *(u32x2*)(X1 + off) = (u32x2){pk2(x1.x, x1.y), pk2(x1.z, x1.w)};
                        *(u32x2*)(H2 + off) = (u32x2){pk2(y.x, y.y), pk2(y.z, y.w)}; }
                asm volatile("" ::: "memory"); }
        asm volatile("s_waitcnt lgkmcnt(0)" ::: "memory"); __builtin_amdgcn_s_barrier(); asm volatile("" ::: "memory");
    }
};
struct EpiGlu {
    static constexpr bool PERM = true;
    bf16_t* O; int ldc;
    DI void operator()(AccT& acc, const Unit& u, int wr, int wc, int fr, int fq, int wid, int lane) const {
        const int row0 = u.pm * BM + wr * 64 + fr, col0 = u.po * HALF + wc * 32 + 8 * fq;
#pragma unroll
        for (int ai = 0; ai < 2; ++ai)
#pragma unroll
            for (int m = 0; m < 4; ++m) { bf16_t* rowp = O + (size_t)(row0 + ai * HALF + m * 16) * ldc + col0;
                f32x4 h0, h1;
#pragma unroll
                for (int j = 0; j < 4; ++j) { h0[j] = fsilu(acc[ai][0][m][0][j]) * acc[ai][1][m][0][j]; h1[j] = fsilu(acc[ai][0][m][1][j]) * acc[ai][1][m][1][j]; }
                u32x4 w; w.x = pk2(h0[0], h0[1]); w.y = pk2(h0[2], h0[3]); w.z = pk2(h1[0], h1[1]); w.w = pk2(h1[2], h1[3]);
                *(u32x4*)rowp = w; }
    }
};

struct CmpOrder {
    int G, c; const bf16_t* U;
    DI bool next(int i, Unit& u) const { const int L = i * G + c; if (L >= 32) return false; u.pm = L; u.pn = L >> 4; u.po = 0; return true; }
    DI const char* abase(const Unit& u) const { const int kv = u.pm >> 4, bg = (u.pm >> 1) & 7, b = bg >> 1, gg = bg & 1, half = u.pm & 1;
        return (const char*)(U + (size_t)(b * SEQ + half * 4096) * NU + (kv ? UVC : UKC) + gg * 64); }
};
template <int NSUB> struct MoeOrder {
    int G, c, nunits; const int* blk_e; const bf16_t* A; size_t tstepA;
    DI bool next(int i, Unit& u) const { const int L = i * G + c; if (L >= nunits) return false; const int blk = L / NSUB, sub = L % NSUB;
        const int e = (int)__builtin_amdgcn_readfirstlane((int)ld_u32_agent((const unsigned*)blk_e + blk)); u.pm = blk; u.pn = e * NSUB + sub; u.po = sub; return true; }
    DI const char* abase(const Unit& u) const { return (const char*)A + (size_t)u.pm * tstepA; }
};
struct MoePairOrder {
    int G, c, npairs; const int* blk_e; const bf16_t* A; size_t tstepA;
    DI bool next(int i, Unit& u) const { const int p = (i >> 1) * G + c; if (p >= npairs) return false; const int blk = p >> 1, sub = (p & 1) * 2 + (i & 1);
        const int e = (int)__builtin_amdgcn_readfirstlane((int)ld_u32_agent((const unsigned*)blk_e + blk)); u.pm = blk; u.pn = e * 4 + sub; u.po = sub; return true; }
    DI const char* abase(const Unit& u) const { return (const char*)A + (size_t)u.pm * tstepA; }
};
struct RouterOrder {
    int G, c; const bf16_t* A;
    DI bool next(int i, Unit& u) const { const int L = i * G + c; if (L >= 2 * (NT / 256)) return false; u.pm = L >> 1; u.pn = L & 1; u.po = L & 1; return true; }
    DI const char* abase(const Unit& u) const { return (const char*)(A + (size_t)u.pm * 256 * DM + u.pn * 512); }
};
struct EpiLogit {
    static constexpr bool PERM = false;
    float* C;
    DI void operator()(AccT& acc, const Unit& u, int wr, int wc, int fr, int fq, int wid, int lane) const {
        const int row0 = u.pm * BM + wr * 64 + fr, col0 = wc * 32 + 4 * fq; float* base = C + (size_t)u.po * NT * 256;
#pragma unroll
        for (int ai = 0; ai < 2; ++ai)
#pragma unroll
            for (int m = 0; m < 4; ++m) { float* rowp = base + (size_t)(row0 + ai * HALF + m * 16) * 256 + col0;
#pragma unroll
                for (int bj = 0; bj < 2; ++bj)
#pragma unroll
                    for (int n = 0; n < 2; ++n) *(f32x4*)(rowp + bj * HALF + n * 16) = acc[ai][bj][m][n]; }
    }
};
}
constexpr size_t MiB = 1u << 20;
constexpr size_t WS_CTL = 0, CTL_ZERO_BYTES = 1 * MiB;
constexpr size_t WS_MODP = 1 * MiB;
constexpr size_t WS_MOD = WS_MODP + 1536 * 1024;
constexpr size_t WS_PEP = WS_MOD + 128 * 1024;
constexpr size_t WS_PEB = WS_PEP + 32 * 1024;
constexpr size_t WS_WIN_T = 3 * MiB;
constexpr size_t WS_WOUT_T = 8 * MiB;
constexpr size_t WS_WR_T = 10 * MiB;
constexpr size_t WS_WSGU_T = 12 * MiB;
constexpr size_t WS_WSD_T = 13 * MiB;
constexpr size_t WS_WC1_T = 14 * MiB;
constexpr size_t WS_WDN_T = 16 * MiB;
constexpr size_t WS_WGU_T = 144 * MiB;
constexpr size_t WS_YMOE = 144 * MiB;
constexpr size_t WS_U = 400 * MiB;
constexpr size_t WS_H1 = 560 * MiB;
constexpr size_t WS_CAT = 624 * MiB;
constexpr size_t WS_H2 = 688 * MiB;
constexpr size_t WS_HIDS = 752 * MiB;
constexpr size_t WS_HIDM = 784 * MiB;
constexpr size_t WS_LOGIT = 624 * MiB;
constexpr size_t WS_TOKE = 976 * MiB;
constexpr size_t WS_TOKW = 977 * MiB;
constexpr size_t WS_LRANK = 978 * MiB;
constexpr size_t WS_POSOF = 979 * MiB;
constexpr size_t WS_ROWTOK = 980 * MiB;
constexpr size_t WS_HIST = 982 * MiB;
constexpr size_t WS_BLKE = 983 * MiB;
constexpr size_t WS_HCMP = 984 * MiB;
constexpr size_t WS_KC = 988 * MiB;
constexpr size_t WS_VCT = 989 * MiB;
constexpr size_t WS_VST = 990 * MiB;
constexpr size_t WS_VWT = 998 * MiB;
constexpr size_t WS_V1 = WS_H1;
constexpr size_t WS_X1 = 464 * MiB;
constexpr size_t WS_SH = 528 * MiB;
constexpr size_t WS_LNX = 1012 * MiB;
constexpr size_t WS_END = 1024 * MiB;
constexpr int CW_BAR = 4096, CW_ATTQ = 12288;
constexpr int CW_LNCNT = 16384, CW_LNTMO = 3;

constexpr int LDS_BYTES = 160 * 1024;
constexpr int LDS_MISC = 131072;
constexpr int LDS_TAB = 131072 + 1024;

struct Params {
    const float *x, *c, *w_ada, *b_ada, *w_in, *pe_k, *pe_v, *w_cmp_k1, *w_cmp_k2, *w_cmp_v1, *w_cmp_v2, *w_dw, *b_dw, *conv_ln_g, *conv_ln_b, *w_out, *ln1_g, *ln1_b,
        *w_router, *router_bias, *w_e_gate, *w_e_up, *w_e_down, *w_s_gate, *w_s_up, *w_s_down, *ln2_g, *ln2_b;
    float* out; unsigned char* ws; int ph_lo, ph_hi;
};

DI void transpose_item(const float* W, int ldw, int ncols, bf16_t* WT, int ldt, int drow0, LAS float* scr, int k0, int n0, int lane) {
    if (n0 + 32 <= ncols && (((size_t)W | (size_t)(ldw * 4)) & 15) == 0 && (n0 & 3) == 0) {
        f32x4 v[8];
#pragma unroll
        for (int i = 0; i < 8; ++i) v[i] = *(const f32x4*)(W + (size_t)(k0 + 8 * i + (lane >> 3)) * ldw + n0 + 4 * (lane & 7));
#pragma unroll
        for (int i = 0; i < 8; ++i) { LAS float* d = scr + (8 * i + (lane >> 3)) * 33 + 4 * (lane & 7); d[0] = v[i].x; d[1] = v[i].y; d[2] = v[i].z; d[3] = v[i].w; }
    } else {
        const int nn = n0 + (lane & 31); const bool okc = nn < ncols;
#pragma unroll 8
        for (int i = 0; i < 32; ++i) { const int kk = 2 * i + (lane >> 5); scr[kk * 33 + (lane & 31)] = okc ? W[(size_t)(k0 + kk) * ldw + nn] : 0.f; }
    }
    LDS_WAIT(); asm volatile("" ::: "memory");
    const int cch = lane & 7;
#pragma unroll
    for (int j = 0; j < 4; ++j) { const int n = (lane >> 3) + 8 * j; const LAS float* s = scr + (8 * cch) * 33 + n;
        u32x4 o; o.x = pk2(s[0 * 33], s[1 * 33]); o.y = pk2(s[2 * 33], s[3 * 33]); o.z = pk2(s[4 * 33], s[5 * 33]); o.w = pk2(s[6 * 33], s[7 * 33]);
        *(u32x4*)(WT + (size_t)(drow0 + n) * ldt + k0 + 8 * cch) = o; }
    LDS_WAIT(); asm volatile("" ::: "memory");
}
DI void tr_plain(const float* W, int ldw, int K, int N, bf16_t* WT, int row_off, LAS float* scr, int item, int lane) {
    const int nblk = (N + 31) / 32, kb = item / nblk, nb = item % nblk;
    transpose_item(W, ldw, N, WT, K, row_off + 32 * nb, scr, 64 * kb, 32 * nb, lane);
}
DI void tr_glu(const float* W, int K, bf16_t* WT, int up, LAS float* scr, int item, int lane) {
    const int kb = item >> 3, nb = item & 7, n0 = 32 * nb;
    transpose_item(W, 256, 256, WT, K, (n0 >> 7) * 256 + up * 128 + (n0 & 127), scr, 64 * kb, n0, lane);
}

constexpr int CV_EARLY_EXPERTS = 0;
constexpr int EXP_ITEMS = NEXP * 384, EXP_LATE = 18432;
DI void expert_items(const Params& P, LAS float* scr, int lane, int gw, int NGW, int r0, int r1) {
    unsigned char* ws = P.ws;
    for (int r = r0 + gw; r < r1; r += NGW) { const int e = r / 384, q = r % 384;
        if (q < 128) tr_glu(P.w_e_gate + (size_t)e * 1024 * 256, 1024, (bf16_t*)(ws + WS_WGU_T) + (size_t)e * 512 * 1024, 0, scr, q, lane);
        else if (q < 256) tr_glu(P.w_e_up + (size_t)e * 1024 * 256, 1024, (bf16_t*)(ws + WS_WGU_T) + (size_t)e * 512 * 1024, 1, scr, q - 128, lane);
        else tr_plain(P.w_e_down + (size_t)e * 256 * 1024, 1024, 256, 1024, (bf16_t*)(ws + WS_WDN_T) + (size_t)e * 1024 * 256, 0, scr, q - 256, lane); }
}

DI void phase0a(const Params& P, LAS unsigned char* lds, int vcu, int G, int wave, int lane, int tid) {
    unsigned char* ws = P.ws;
    LAS float* scr = (LAS float*)(lds + wave * 16384);
    const int gw = vcu * 8 + wave, NGW = G * 8;
    for (int it = gw; it < 96 * 16; it += NGW) { const int cb = it % 96, ks = it / 96; const int col = cb * 64 + lane;
        float a0 = 0.f, a1 = 0.f, a2 = 0.f, a3 = 0.f;
#pragma unroll 4
        for (int k = ks * 64; k < ks * 64 + 64; ++k) { const float w = P.w_ada[(size_t)k * 6144 + col];
            a0 += fsilu(P.c[k]) * w; a1 += fsilu(P.c[1024 + k]) * w; a2 += fsilu(P.c[2048 + k]) * w; a3 += fsilu(P.c[3072 + k]) * w; }
        float* mp = (float*)(ws + WS_MODP) + (size_t)ks * 4 * 6144 + col;
        mp[0] = a0; mp[6144] = a1; mp[2 * 6144] = a2; mp[3 * 6144] = a3; }
    for (int it = gw; it < 16 * 2 * 4; it += NGW) { const int cb = it & 3, kv = (it >> 2) & 1, ks = it >> 3; const int col = cb * 64 + lane;
        const float* pe = kv ? P.pe_v : P.pe_k; const float* w1 = kv ? P.w_cmp_v1 : P.w_cmp_k1; float a = 0.f;
#pragma unroll 4
        for (int k = ks * 128; k < ks * 128 + 128; ++k) a += pe[k] * w1[(size_t)k * 256 + col];
        ((float*)(ws + WS_PEP))[(ks * 2 + kv) * 256 + col] = a; }
    constexpr int I_IN0 = 16 * 40, I_IN1 = 16 * 32, I_IN2 = 16 * 1, I_OUT = 16 * 32, I_R = 16 * 8, I_SG = 16 * 8, I_SD = 4 * 32, I_C1 = 32 * 8;
    constexpr int I_SMALL = I_IN0 + I_IN1 + I_IN2 + I_OUT + I_R + 2 * I_SG + I_SD + 2 * I_C1;
    constexpr int NITEMS = I_SMALL;
    bf16_t* win_t = (bf16_t*)(ws + WS_WIN_T);
    for (int it = gw; it < NITEMS; it += NGW) {
        int r = it;
        if (r < I_IN0) { tr_plain(P.w_in, DIN, 1024, 1280, win_t, 0, scr, r, lane); continue; } r -= I_IN0;
        if (r < I_IN1) { tr_plain(P.w_in + 1304, DIN, 1024, 1024, win_t, UCA, scr, r, lane); continue; } r -= I_IN1;
        if (r < I_IN2) { tr_plain(P.w_in + 1280, DIN, 1024, 24, win_t, UGT, scr, r, lane); continue; } r -= I_IN2;
        if (r < I_OUT) { tr_plain(P.w_out, 1024, 1024, 1024, (bf16_t*)(ws + WS_WOUT_T), 0, scr, r, lane); continue; } r -= I_OUT;
        if (r < I_R) { tr_plain(P.w_router, 256, 1024, 256, (bf16_t*)(ws + WS_WR_T), 0, scr, r, lane); continue; } r -= I_R;
        if (r < I_SG) { tr_glu(P.w_s_gate, 1024, (bf16_t*)(ws + WS_WSGU_T), 0, scr, r, lane); continue; } r -= I_SG;
        if (r < I_SG) { tr_glu(P.w_s_up, 1024, (bf16_t*)(ws + WS_WSGU_T), 1, scr, r, lane); continue; } r -= I_SG;
        if (r < I_SD) { tr_plain(P.w_s_down, 1024, 256, 1024, (bf16_t*)(ws + WS_WSD_T), 0, scr, r, lane); continue; } r -= I_SD;
        if (r < I_C1) { tr_plain(P.w_cmp_k1, 256, 2048, 256, (bf16_t*)(ws + WS_WC1_T), 0, scr, r, lane); continue; } r -= I_C1;
        tr_plain(P.w_cmp_v1, 256, 2048, 256, (bf16_t*)(ws + WS_WC1_T) + 256 * 2048, 0, scr, r, lane);
    }
    expert_items(P, scr, lane, gw, NGW, 0, CV_EARLY_EXPERTS * 384);
    { u32x4* z = (u32x4*)(win_t + (size_t)2336 * 1024); const int n16 = (2560 - 2336) * 1024 * 2 / 16;
      for (int i = vcu * 512 + tid; i < n16; i += G * 512) z[i] = (u32x4){0u, 0u, 0u, 0u}; }
}

DI void phase0b(const Params& P, LAS unsigned char* lds, int vcu, int G, int wave, int lane, int tid) {
    unsigned char* ws = P.ws;
    const float* modp = (const float*)(ws + WS_MODP);
    for (int i = vcu * 512 + tid; i < 4 * 6144; i += G * 512) { float a = P.b_ada[i % 6144];
#pragma unroll
        for (int ks = 0; ks < 16; ++ks) a += modp[(size_t)ks * 4 * 6144 + i];
        ((float*)(ws + WS_MOD))[i] = a; }
    for (int i = vcu * 512 + tid; i < 512; i += G * 512) { float a = 0.f;
#pragma unroll
        for (int ks = 0; ks < 16; ++ks) a += ((const float*)(ws + WS_PEP))[ks * 512 + i];
        ((float*)(ws + WS_PEB))[i] = a; }
    const int rpw = NT / G;
    LAS float* sh = (LAS float*)lds;
    for (int r0 = vcu * rpw; r0 < NT; r0 += G * rpw) {
        const int b = r0 / SEQ;
        __syncthreads();
        for (int i = tid; i < 2048; i += 512) { const int j = (i < 1024) ? i : i;
            float a = P.b_ada[j];
#pragma unroll
            for (int ks = 0; ks < 16; ++ks) a += modp[(size_t)ks * 4 * 6144 + b * 6144 + j];
            sh[i] = (i < 1024) ? a : 1.0f + a; }
        __syncthreads();
        for (int m = r0 + wave; m < r0 + rpw; m += 8) {
            const f32x4* xr = (const f32x4*)(P.x + (size_t)m * DM) + lane; unsigned long long* o8 = (unsigned long long*)((bf16_t*)(ws + WS_H1) + (size_t)m * DM) + lane;
#pragma unroll
            for (int j = 0; j < 4; ++j) { const f32x4 v = xr[64 * j]; const int c0 = 4 * lane + 256 * j;
                const float y0 = v.x * sh[1024 + c0] + sh[c0], y1 = v.y * sh[1025 + c0] + sh[c0 + 1], y2 = v.z * sh[1026 + c0] + sh[c0 + 2], y3 = v.w * sh[1027 + c0] + sh[c0 + 3];
                o8[64 * j] = (unsigned long long)pk2(y0, y1) | ((unsigned long long)pk2(y2, y3) << 32); }
        }
    }
    __syncthreads();
}

#define CONV_LOAD(ITEM) { const int b_ = (ITEM) >> 8, t0_ = ((ITEM) & 255) * 32; _Pragma("unroll") for (int i = 0; i < 8; ++i) { const int task = tid + 512 * i, rr = task >> 6, oc = task & 63; int tok = t0_ - 30 + (rr < 62 ? rr : 61); tok = tok < 0 ? 0 : tok; \
        const bf16_t* up = U + (size_t)(b_ * SEQ + tok) * NU + oc * 8; av[i] = *(const u32x4*)(up + UCA); gv8[i] = *(const u32x4*)(up + UCG); } }
DI void conv_items(const Params& P, LAS unsigned char* lds, int first, int step, int wave, int lane, int tid) {
    const bf16_t* U = (const bf16_t*)(P.ws + WS_U); bf16_t* CAT = (bf16_t*)(P.ws + WS_CAT);
    LAS float* glu = (LAS float*)lds; LAS float* red = (LAS float*)(lds + 62 * 512 * 4); LAS float* stat = red + 32 * 8 * 2;
    const int c = tid;
    u32x4 av[8], gv8[8];
    if (first < 1024) CONV_LOAD(first)
  for (int item = first; item < 1024; item += step) {
    const int b = item >> 8, t0 = (item & 255) * 32;
    __syncthreads();
    {
#pragma unroll
        for (int i = 0; i < 8; ++i) { const int task = tid + 512 * i, rr = task >> 6, oc = task & 63; const bool ok = (t0 - 30 + rr) >= 0;
            const unsigned aw[4] = {av[i].x, av[i].y, av[i].z, av[i].w}, gw[4] = {gv8[i].x, gv8[i].y, gv8[i].z, gv8[i].w}; float o[8];
#pragma unroll
            for (int q = 0; q < 4; ++q) { o[2 * q] = ok ? bflo(aw[q]) * fsigmoid(bflo(gw[q])) : 0.f; o[2 * q + 1] = ok ? bfhi(aw[q]) * fsigmoid(bfhi(gw[q])) : 0.f; }
            if (rr < 62) { *(LAS f32x4*)(glu + rr * 512 + oc * 8) = (f32x4){o[0], o[1], o[2], o[3]}; *(LAS f32x4*)(glu + rr * 512 + oc * 8 + 4) = (f32x4){o[4], o[5], o[6], o[7]}; } }
    }
    if (item + step < 1024) CONV_LOAD(item + step)
    float w[31];
#pragma unroll
    for (int j = 0; j < 31; ++j) w[j] = P.w_dw[j * 512 + c];
    const float bd = P.b_dw[c];
    __syncthreads();
    float y[32];
#pragma unroll
    for (int tt = 0; tt < 32; ++tt) y[tt] = bd;
#pragma unroll
    for (int rr = 0; rr < 62; ++rr) { const float gv = glu[rr * 512 + c];
#pragma unroll
        for (int tt = 0; tt < 32; ++tt) { if (rr - tt >= 0 && rr - tt <= 30) y[tt] += w[rr - tt] * gv; } }
    __syncthreads();
#pragma unroll
    for (int tt = 0; tt < 32; ++tt) glu[tt * 512 + c] = y[tt];
    __syncthreads();
    {
#pragma unroll
        for (int q = 0; q < 4; ++q) { const int tt = 4 * wave + q; const f32x4 a = *(const LAS f32x4*)(glu + tt * 512 + lane * 8), bq = *(const LAS f32x4*)(glu + tt * 512 + lane * 8 + 4);
            float s1 = ((a.x + a.y) + (a.z + a.w)) + ((bq.x + bq.y) + (bq.z + bq.w));
            float s2 = ((a.x * a.x + a.y * a.y) + (a.z * a.z + a.w * a.w)) + ((bq.x * bq.x + bq.y * bq.y) + (bq.z * bq.z + bq.w * bq.w));
            s1 = wave_sum(s1); s2 = wave_sum(s2);
            if (lane == 0) { const float mean = s1 * (1.0f / 512.0f); float var = s2 * (1.0f / 512.0f) - mean * mean; var = var < 0.f ? 0.f : var;
                stat[tt * 2] = mean; stat[tt * 2 + 1] = 1.0f / sqrtf(var + LN_EPS); } }
    }
    __syncthreads();
    const float lg = P.conv_ln_g[c], lb = P.conv_ln_b[c];
#pragma unroll
    for (int tt = 0; tt < 32; ++tt) { const float v = (y[tt] - stat[tt * 2]) * stat[tt * 2 + 1] * lg + lb;
        CAT[(size_t)(b * SEQ + t0 + tt) * DM + 512 + c] = (bf16_t)(pk2(fsilu(v), 0.f) & 0xffffu); }
  }
}
#undef CONV_LOAD

DI unsigned swap23(unsigned p) { return (p & ~12u) | ((p & 4u) << 1) | ((p & 8u) >> 1); }
DI void vt_copies(const Params& P, LAS unsigned char* lds, int gw, int NGW, int wave, int lane) {
    unsigned char* ws = P.ws;
    LAS bf16_t* tile = (LAS bf16_t*)(lds + wave * 8448);
    const bf16_t* U = (const bf16_t*)(ws + WS_U);
    for (int it = gw; it < 2 * 8 * 128; it += NGW) { const int which = it >> 10, bg = (it >> 7) & 7, blk = it & 127, b = bg >> 1, gg = bg & 1;
        const bf16_t* src = U + (size_t)(b * SEQ + blk * 64 + lane) * NU + (which ? UVW : UVS) + gg * 64;
#pragma unroll
        for (int q = 0; q < 8; ++q) { const u32x4 v = *(const u32x4*)(src + q * 8); LAS unsigned* tp = (LAS unsigned*)(tile + lane * 66 + q * 8); tp[0] = v.x; tp[1] = v.y; tp[2] = v.z; tp[3] = v.w; }
        LDS_WAIT(); asm volatile("" ::: "memory");
        bf16_t* dst = (bf16_t*)(ws + (which ? WS_VWT : WS_VST)) + ((size_t)(bg * 128 + blk) * 64 + lane) * 64;
#pragma unroll
        for (int q = 0; q < 8; ++q) { unsigned wv[4];
#pragma unroll
            for (int e2 = 0; e2 < 4; ++e2) { const int p0 = q * 8 + e2 * 2; const int k0 = (p0 & ~15) | (int)swap23((unsigned)p0 & 15u), k1 = ((p0 + 1) & ~15) | (int)swap23((unsigned)(p0 + 1) & 15u);
                wv[e2] = (unsigned)tile[k0 * 66 + lane] | ((unsigned)tile[k1 * 66 + lane] << 16); }
            *(u32x4*)(dst + q * 8) = (u32x4){wv[0], wv[1], wv[2], wv[3]}; }
        LDS_WAIT(); asm volatile("" ::: "memory");
    }
}

DI void cmp2_rows(const Params& P, LAS unsigned char* lds, int kv, int row0, int nblk64, int tid) {
    unsigned char* ws = P.ws;
    const float* w2 = kv ? P.w_cmp_v2 : P.w_cmp_k2; LAS float* w2s = (LAS float*)lds;
    __syncthreads();
    for (int i = tid; i < 256 * 64 / 4; i += 512) ((LAS f32x4*)w2s)[i] = ((const f32x4*)w2)[i];
    __syncthreads();
    for (int blk = 0; blk < nblk64; ++blk) {
        const int row = row0 + blk * 64 + (tid >> 3), oc = tid & 7;
        const bf16_t* hrow = (const bf16_t*)(ws + WS_HCMP) + ((size_t)kv * 4096 + row) * 256;
        float acc[8];
#pragma unroll
        for (int j = 0; j < 8; ++j) acc[j] = 0.f;
        for (int k8 = 0; k8 < 32; ++k8) { const u32x4 hv = *(const u32x4*)(hrow + k8 * 8); const unsigned hw[4] = {hv.x, hv.y, hv.z, hv.w};
#pragma unroll
            for (int q = 0; q < 4; ++q) {
#pragma unroll
                for (int hh = 0; hh < 2; ++hh) { const float hval = hh ? bfhi(hw[q]) : bflo(hw[q]); const int k = k8 * 8 + q * 2 + hh;
                    const f32x4 wa = *(const LAS f32x4*)(w2s + k * 64 + oc * 8), wb = *(const LAS f32x4*)(w2s + k * 64 + oc * 8 + 4);
                    acc[0] += hval * wa.x; acc[1] += hval * wa.y; acc[2] += hval * wa.z; acc[3] += hval * wa.w; acc[4] += hval * wb.x; acc[5] += hval * wb.y; acc[6] += hval * wb.z; acc[7] += hval * wb.w; } } }
        const int bg = row >> 9, n = row & 511;
        if (n == 511) {
#pragma unroll
            for (int j = 0; j < 8; ++j) acc[j] = 0.f; }
        if (kv == 0) { u32x4 o; o.x = pk2(acc[0], acc[1]); o.y = pk2(acc[2], acc[3]); o.z = pk2(acc[4], acc[5]); o.w = pk2(acc[6], acc[7]);
            *(u32x4*)((bf16_t*)(ws + WS_KC) + ((size_t)bg * 512 + n) * 64 + oc * 8) = o; }
        else { bf16_t* vt = (bf16_t*)(ws + WS_VCT) + (size_t)bg * 64 * 512; const int pos = (n & ~15) | (int)swap23((unsigned)n & 15u);
#pragma unroll
            for (int j = 0; j < 8; ++j) vt[(size_t)(oc * 8 + j) * 512 + pos] = (bf16_t)(pk2(acc[j], 0.f) & 0xffffu); }
    }
    __syncthreads();
}
DI void phase_cmp2(const Params& P, LAS unsigned char* lds, int vcu, int G, int wave, int lane, int tid) {
    for (int it = vcu; it < 128; it += G) cmp2_rows(P, lds, it >> 6, (it & 63) * 64, 1, tid);
    __syncthreads();
}
namespace attn {
constexpr int ROWB = 144;
constexpr int TROW = 128, TILEB = 64 * TROW;
constexpr int OFF_K = 0, OFF_V = 2 * TILEB, OFF_IMPG = 36864, OFF_IMPL = OFF_IMPG + 32768;
constexpr int OFF_SELM = LDS_TAB, OFF_MREF = LDS_TAB + 1024, OFF_LSUM = LDS_TAB + 2048, OFF_LIST = LDS_TAB + 4096, OFF_TM = LDS_TAB + 6144;
constexpr int OFF_QS = 0, OFF_PBUF = 36864, PSLOT = 32 * ROWB;
constexpr float NEG = -1e30f, MFLOOR = -1e20f;
#define MFMA32(a, b, c) __builtin_amdgcn_mfma_f32_32x32x16_bf16((a), (b), (c), 0, 0, 0)
DI float fexp2(float x) { return __builtin_amdgcn_exp2f(x); }
DI void dma_tile(const bf16_t* base, unsigned pitch, LAS unsigned char* buf, int wave, int lane) {
    const int row = 8 * wave + (lane >> 3), ch = (lane & 7) ^ ((row >> 1) & 7);
    __builtin_amdgcn_global_load_lds((const unsigned*)(base + (unsigned)(row * pitch + ch * 8)), (LAS unsigned*)(buf + wave * 1024), 16, 0, 0); }
DI bf16x8 pack8(const f32x16& p, int s2) { u32x4 w; w.x = pk2(p[8 * s2], p[8 * s2 + 1]); w.y = pk2(p[8 * s2 + 2], p[8 * s2 + 3]); w.z = pk2(p[8 * s2 + 4], p[8 * s2 + 5]); w.w = pk2(p[8 * s2 + 6], p[8 * s2 + 7]); return __builtin_bit_cast(bf16x8, w); }

constexpr int CV_PER_EXPERT = 1536, CV_TOTAL = NEXP * CV_PER_EXPERT;
struct CvState { int next, end, nfly; bool xafter; };
DI LAS unsigned char* cv_buf(LAS unsigned char* lds, int wave, int seq) { return lds + (wave < 4 ? 110592 + wave * 4096 : LDS_TAB + 8192 + (wave - 4) * 4096) + (seq & 1) * 2048; }
DI void cv_decode(int m, int& e, int& mat, int& k0, int& n0) { e = m / CV_PER_EXPERT; const int q = m % CV_PER_EXPERT; mat = q >> 9; const int w = q & 511;
    if (mat < 2) { n0 = (w >> 6) * 32; k0 = (w & 63) * 16; } else { n0 = (w >> 4) * 32; k0 = (w & 15) * 16; } }
DI void cv_issue(const Params& P, CvState& c, LAS unsigned char* lds, int wave, int lane) {
    int e, mat, k0, n0; cv_decode(c.next, e, mat, k0, n0);
    LAS unsigned* st = (LAS unsigned*)cv_buf(lds, wave, c.next);
    const int ldw = (mat < 2) ? 256 : 1024;
    const float* W = (mat == 0 ? P.w_e_gate : mat == 1 ? P.w_e_up : P.w_e_down) + (size_t)e * 1024 * 256;
    const float* src = W + (size_t)(k0 + (lane >> 3)) * ldw + n0 + 4 * (lane & 7);
#pragma unroll
    for (int j = 0; j < 2; ++j) __builtin_amdgcn_global_load_lds((const unsigned*)(src + (size_t)(8 * j) * ldw), st + j * 256, 16, 0, 0);
    ++c.nfly; ++c.next; c.xafter = true;
}
DI void cv_finish(const Params& P, CvState& c, LAS unsigned char* lds, int wave, int lane) {
    const int m = c.next - c.nfly; int e, mat, k0, n0; cv_decode(m, e, mat, k0, n0);
    const int nl = lane >> 1, kc = (lane & 1) * 8;
    const LAS float* st = (const LAS float*)cv_buf(lds, wave, m) + kc * 32 + nl;
    u32x4 o; o.x = pk2(st[0 * 32], st[1 * 32]); o.y = pk2(st[2 * 32], st[3 * 32]); o.z = pk2(st[4 * 32], st[5 * 32]); o.w = pk2(st[6 * 32], st[7 * 32]);
    const int n = n0 + nl; bf16_t* dst;
    if (mat < 2) dst = (bf16_t*)(P.ws + WS_WGU_T) + (size_t)e * 512 * 1024 + (size_t)((n >> 7) * 256 + mat * 128 + (n & 127)) * 1024 + k0 + kc;
    else dst = (bf16_t*)(P.ws + WS_WDN_T) + (size_t)e * 1024 * 256 + (size_t)n * 256 + k0 + kc;
    asm volatile("s_waitcnt lgkmcnt(0)" ::: "memory");
    *(u32x4*)dst = o; --c.nfly;
}

template <int MODE>
DI void tile_compute(const LAS unsigned char* Kb, const LAS unsigned char* Vb, const bf16x8 (&qf)[4], int r, int h, int lo, int hi, bool elem,
                     float& m, float& l, f32x16 (&O)[2], float meff_in, float linv, LAS float* impg, LAS float* impl, int sb0) {
    const bool rowfull = (lo <= 0 && hi >= 63);
    const int lo2 = lo - 4 * h, hi2 = hi - 4 * h, swz = (r >> 1) & 7;
#pragma unroll
    for (int kh = 0; kh < 2; ++kh) {
        f32x16 s;
#pragma unroll
        for (int i = 0; i < 16; ++i) s[i] = 0.f;
#pragma unroll
        for (int ks = 0; ks < 4; ++ks) { const bf16x8 a = *(const LAS bf16x8*)(Kb + (32 * kh + r) * TROW + (((2 * ks + h) ^ swz) << 4)); s = MFMA32(a, qf[ks], s); }
        if (elem) {
#pragma unroll
            for (int i = 0; i < 16; ++i) { const int k0 = (i & 3) + 8 * (i >> 2) + 32 * kh; s[i] = (k0 >= lo2 && k0 <= hi2) ? s[i] : NEG; }
        }
        float cref;
        if (MODE != 2) {
            float tm = s[0];
#pragma unroll
            for (int i = 1; i < 16; ++i) tm = fmaxf(tm, s[i]);
            tm = fmaxf(tm, __shfl_xor(tm, 32));
            if (!elem) tm = rowfull ? tm : NEG;
            const bool need = tm > m + 8.0f;
            if (__any(need)) {
                const float mnew = need ? tm : m;
                const float alpha = fexp2(fmaxf(m, MFLOOR) - fmaxf(mnew, MFLOOR));
                l *= alpha; m = mnew;
                if (MODE == 0) {
#pragma unroll
                    for (int i = 0; i < 16; ++i) { O[0][i] *= alpha; O[1][i] *= alpha; } }
            }
            cref = (elem || rowfull) ? fmaxf(m, MFLOOR) : 1e30f;
            float rs = 0.f;
#pragma unroll
            for (int i = 0; i < 16; ++i) { s[i] = fexp2(s[i] - cref); rs += s[i]; }
            rs += __shfl_xor(rs, 32);
            l += rs;
        } else {
            cref = (elem || rowfull) ? meff_in : 1e30f;
#pragma unroll
            for (int i = 0; i < 16; ++i) s[i] = fexp2(s[i] - cref);
        }
        if (MODE == 1) continue;
        if (MODE == 2) {
#pragma unroll
            for (int gq = 0; gq < 4; ++gq) {
                float Gs = ((s[4 * gq] + s[4 * gq + 1]) + (s[4 * gq + 2] + s[4 * gq + 3])) * linv, Ls = s[4 * gq + 3] * linv;
                Gs += __shfl_xor(Gs, 1); Gs += __shfl_xor(Gs, 2); Ls += __shfl_xor(Ls, 1); Ls += __shfl_xor(Ls, 2);
                if ((r & 3) == 0) { const int sb = sb0 + 8 * kh + 2 * gq + h; impg[sb] = Gs; impl[sb] = Ls; } }
        }
#pragma unroll
        for (int s2 = 0; s2 < 2; ++s2) { const bf16x8 pf = pack8(s, s2);
#pragma unroll
            for (int dt = 0; dt < 2; ++dt) { const bf16x8 a = *(const LAS bf16x8*)(Vb + (32 * dt + r) * TROW + (((4 * kh + 2 * s2 + h) ^ swz) << 4));
                O[dt] = MFMA32(a, pf, O[dt]); } }
    }
}

template <bool ELEM>
DI void tile_frozen(const LAS unsigned char* Kb, const LAS unsigned char* Vb, const bf16x8 (&qf)[4], int r, int h, int lo, int hi, const f32x16& minit, float cap, float& lp, f32x16 (&O)[2]) {
    const int lo2 = lo - 4 * h, hi2 = hi - 4 * h, swz = (r >> 1) & 7;
    float vlow = -3.0e38f; asm volatile("" : "+s"(vlow));
#pragma unroll
    for (int kh = 0; kh < 2; ++kh) {
        f32x16 s = minit;
#pragma unroll
        for (int ks = 0; ks < 4; ++ks) { const bf16x8 a = *(const LAS bf16x8*)(Kb + (32 * kh + r) * TROW + (((2 * ks + h) ^ swz) << 4)); s = MFMA32(a, qf[ks], s); }
        if (ELEM) {
#pragma unroll
            for (int i = 0; i < 16; ++i) { const int k0 = (i & 3) + 8 * (i >> 2) + 32 * kh; s[i] = (k0 >= lo2 && k0 <= hi2) ? s[i] : NEG; }
        }
#pragma unroll
        for (int i = 0; i < 16; ++i) { s[i] = fexp2(__builtin_amdgcn_fmed3f(s[i], cap, vlow)); lp += s[i]; }
#pragma unroll
        for (int s2 = 0; s2 < 2; ++s2) { const bf16x8 pf = pack8(s, s2);
#pragma unroll
            for (int dt = 0; dt < 2; ++dt) { const bf16x8 a = *(const LAS bf16x8*)(Vb + (32 * dt + r) * TROW + (((4 * kh + 2 * s2 + h) ^ swz) << 4));
                O[dt] = MFMA32(a, pf, O[dt]); } }
    }
}

DI void attn_unit(const Params& P, LAS unsigned char* lds, int bg, int qt, int wave, int lane_in, int tid_in, int& it, CvState& cv) {
    __builtin_amdgcn_s_waitcnt(0x0F70);
    int lane = lane_in; asm volatile("" : "+v"(lane));
    const int tid = wave * 64 + lane;
    unsigned char* ws = P.ws;
    const bf16_t* U = (const bf16_t*)(ws + WS_U);
    const int b = bg >> 1, gg = bg & 1, t0 = qt * 64, r = lane & 31, h = lane >> 5, tokl = 8 * wave + (r >> 2), hp = r & 3, t = t0 + tokl;
    LAS float* IMPG = (LAS float*)(lds + OFF_IMPG); LAS float* IMPL = (LAS float*)(lds + OFF_IMPL); LAS unsigned* SELM = (LAS unsigned*)(lds + OFF_SELM);
#define ATT_UROW(name) int lq_ = lane; asm volatile("" : "+v"(lq_)); const bf16_t* name = U + (size_t)(b * SEQ + t0 + 8 * wave + ((lq_ & 31) >> 2)) * NU; const int hq_ = lq_ & 3, hh_ = lq_ >> 5; (void)hq_; (void)hh_;
    bf16x8 qf[4];
#define ATT_LOADQ() do { ATT_UROW(urow_) _Pragma("unroll") for (int ks = 0; ks < 4; ++ks) qf[ks] = *(const bf16x8*)(urow_ + UQ + (4 * gg + hq_) * 64 + 16 * ks + 8 * hh_); } while (0)
    ATT_LOADQ();
    float gate0; { ATT_UROW(urow_) gate0 = bf2f(urow_[UGT + gg * 12 + hq_ * 3 + 0]); }
    f32x16 OA[2];
#pragma unroll
    for (int i = 0; i < 16; ++i) { OA[0][i] = 0.f; OA[1][i] = 0.f; }
    __syncthreads();
#pragma unroll
    for (int j = 0; j < 4; ++j) { *(LAS f32x4*)(IMPG + 8 * wave * 128 + lane * 4 + 256 * j) = (f32x4){0.f, 0.f, 0.f, 0.f}; *(LAS f32x4*)(IMPL + 8 * wave * 128 + lane * 4 + 256 * j) = (f32x4){0.f, 0.f, 0.f, 0.f}; }
    f32x16 O[2]; float m, l;
#define ATT_RESET() do { m = NEG; l = 0.f; _Pragma("unroll") for (int i = 0; i < 16; ++i) { O[0][i] = 0.f; O[1][i] = 0.f; } } while (0)
#define ATT_FOLD(br) do { ATT_UROW(urow_) const float gate_ = fsigmoid(bf2f(urow_[UGT + gg * 12 + hq_ * 3 + (br)])); const float sc_ = (l > 0.f) ? gate_ / l : 0.f; _Pragma("unroll") for (int i = 0; i < 16; ++i) { OA[0][i] += sc_ * O[0][i]; OA[1][i] += sc_ * O[1][i]; } } while (0)

#define ATT_STEP(CUR, NXT, TI, KPTR, KPITCH, VPTR, VPITCH, USEV, ...) { \
            LAS unsigned char* Kb = lds + OFF_K + (CUR) * TILEB; LAS unsigned char* Vb = lds + OFF_V + (CUR) * TILEB; \
            int nfin_; if (cv.xafter) { asm volatile("s_waitcnt vmcnt(2)" ::: "memory"); nfin_ = cv.nfly - 1; } else { asm volatile("s_waitcnt vmcnt(0)" ::: "memory"); nfin_ = cv.nfly; } \
            for (int f_ = 0; f_ < nfin_; ++f_) cv_finish(P, cv, lds, wave, tz_); \
            asm volatile("s_waitcnt lgkmcnt(0)" ::: "memory"); __builtin_amdgcn_s_barrier(); asm volatile("" ::: "memory"); \
            if ((TI) + 1 < n_) { const int pi = (TI) + 1; dma_tile(KPTR, KPITCH, lds + OFF_K + (NXT) * TILEB, wave, tz_); if (USEV) dma_tile(VPTR, VPITCH, lds + OFF_V + (NXT) * TILEB, wave, tz_); cv.xafter = false; } \
            if (cv.next < cv.end && cv.nfly < 2) cv_issue(P, cv, lds, wave, tz_); \
            { const int ti = (TI); __VA_ARGS__ } ++it; }
#define ATT_LOOP(NTILES, KPTR, KPITCH, VPTR, VPITCH, USEV, ...) { const int n_ = (NTILES); int tz_ = lane; asm volatile("" : "+v"(tz_)); \
        asm volatile("s_waitcnt lgkmcnt(0)" ::: "memory"); __builtin_amdgcn_s_barrier(); asm volatile("" ::: "memory");     \
        if (n_ > 0) { const int pi = 0; dma_tile(KPTR, KPITCH, lds + OFF_K, wave, tz_); if (USEV) dma_tile(VPTR, VPITCH, lds + OFF_V, wave, tz_); cv.xafter = false; } \
        for (int i_ = 0; i_ < n_; i_ += 2) { \
            ATT_STEP(0, 1, i_, KPTR, KPITCH, VPTR, VPITCH, USEV, __VA_ARGS__) \
            if (i_ + 1 < n_) ATT_STEP(1, 0, i_ + 1, KPTR, KPITCH, VPTR, VPITCH, USEV, __VA_ARGS__) } }

#define ATT_PRE(KPTR0, KPITCH, VPTR0, VPITCH, USEV) { int tz_ = lane; asm volatile("" : "+v"(tz_)); \
        asm volatile("s_waitcnt lgkmcnt(0)" ::: "memory"); __builtin_amdgcn_s_barrier(); asm volatile("" ::: "memory"); \
        dma_tile(KPTR0, KPITCH, lds + OFF_K, wave, tz_); if (USEV) dma_tile(VPTR0, VPITCH, lds + OFF_V, wave, tz_); cv.xafter = false; }
#define ATT_RUN(NTILES, KPTR, KPITCH, VPTR, VPITCH, USEV, ...) { const int n_ = (NTILES); int tz_ = lane; asm volatile("" : "+v"(tz_)); \
        for (int i_ = 0; i_ < n_; i_ += 2) { \
            ATT_STEP(0, 1, i_, KPTR, KPITCH, VPTR, VPITCH, USEV, __VA_ARGS__) \
            if (i_ + 1 < n_) ATT_STEP(1, 0, i_ + 1, KPTR, KPITCH, VPTR, VPITCH, USEV, __VA_ARGS__) } }

    const bf16_t* KS = U + (size_t)(b * SEQ) * NU + UKS + gg * 64; const bf16_t* VST = (const bf16_t*)(ws + WS_VST) + (size_t)bg * 128 * 4096;
    const bf16_t* KC = (const bf16_t*)(ws + WS_KC) + (size_t)bg * 512 * 64; const bf16_t* VCT = (const bf16_t*)(ws + WS_VCT) + (size_t)bg * 64 * 512;
    const int hin = (t - 31) >> 4;
    const int ntc = (((t0 + 32) >> 4) >> 6) + 1;
    ATT_RESET();
    ATT_LOOP(ntc, KC + (size_t)pi * 64 * 64, 64, KC, 64, false, {
        const int hi = hin - 64 * ti; const bool fe = (hi >= 63) || (hi < 0);
        if (!__all(hi < 0)) tile_compute<1>(Kb, Kb, qf, r, h, 0, hi, !__all(fe), m, l, O, 0.f, 0.f, nullptr, nullptr, 0); })
    {
        const float meff = fmaxf(m, MFLOOR), linv = (l > 0.f) ? 1.0f / l : 0.f;
        ATT_LOOP(ntc, KC + (size_t)pi * 64 * 64, 64, VCT + pi * 64, 512, true, {
            const int hi = hin - 64 * ti; const bool fe = (hi >= 63) || (hi < 0);
            float md = m, ld_ = l;
            if (!__all(hi < 0)) tile_compute<2>(Kb, Vb, qf, r, h, 0, hi, !__all(fe), md, ld_, O, meff, linv, IMPG + tokl * 128, IMPL + tokl * 128, 16 * ti); })
        ATT_PRE(KS, NU, VST, 64, true)
        { const float gate_ = fsigmoid(gate0); const float sc_ = (l > 0.f) ? gate_ / l : 0.f;
#pragma unroll
          for (int i = 0; i < 16; ++i) { OA[0][i] += sc_ * O[0][i]; OA[1][i] += sc_ * O[1][i]; } }
    }
    { int lp_ = lane; asm volatile("" : "+v"(lp_)); float* oapark = (float*)(ws + WS_HIDM) + ((size_t)(blockIdx.x * 8 + wave) * 32) * 64 + lp_;
#pragma unroll
      for (int i = 0; i < 16; ++i) { oapark[i * 64] = OA[0][i]; oapark[(16 + i) * 64] = OA[1][i]; } }
    for (int tk = 0; tk < 8; ++tk) { const int trow = 8 * wave + tk;
        const float ilo = IMPG[trow * 128 + lane] + (lane > 0 ? IMPL[trow * 128 + lane - 1] : 0.f), ihi = IMPG[trow * 128 + 64 + lane] + IMPL[trow * 128 + 63 + lane];
        const int slo = lane, shi = 64 + lane;
        const bool clo = slo <= qt, chi = shi <= qt, flo = (slo == 0) || (slo == qt) || (slo + 1 == qt), fhi = (shi == qt) || (shi + 1 == qt);
        const unsigned klo = clo ? ((flo ? 0xFFFFFF80u : (__float_as_uint(ilo) & 0xFFFFFF80u)) | (unsigned)(127 - slo)) : 0u;
        const unsigned khi = chi ? ((fhi ? 0xFFFFFF80u : (__float_as_uint(ihi) & 0xFFFFFF80u)) | (unsigned)(127 - shi)) : 0u;
        unsigned T = 0u;
        for (int bit = 31; bit >= 0; --bit) { const unsigned cand = T | (1u << bit);
            const int cnt = __popcll(__ballot(klo >= cand)) + __popcll(__ballot(khi >= cand)); if (cnt >= 16) T = cand; }
        const unsigned long long blo = __ballot(klo >= T && klo != 0u), bhi = __ballot(khi >= T && khi != 0u);
        if (lane == 0) { *(LAS u32x4*)(SELM + trow * 4) = (u32x4){(unsigned)blo, (unsigned)(blo >> 32), (unsigned)bhi, (unsigned)(bhi >> 32)}; }
    }
    ATT_RESET();
    constexpr int QT_COMPACT = 96;
    if (qt < QT_COMPACT) {
    {
        const int nfor = qt >= 2 ? 3 : qt + 1;
#define JMAP(i) ((i) == 0 ? 0 : qt - (nfor - 1 - (i)))
        ATT_RUN(nfor, KS + (size_t)JMAP(pi) * 64 * NU, NU, VST + (size_t)JMAP(pi) * 4096, 64, true, {
            const int j = JMAP(ti);
            tile_compute<0>(Kb, Vb, qf, r, h, 0, (j == qt ? tokl : 63), j == qt, m, l, O, 0.f, 0.f, nullptr, nullptr, 0); })
#undef JMAP
    }
        if (qt >= 3) {
            const u32x4 selw = *(const LAS u32x4*)(SELM + tokl * 4);
            f32x16 minit; { const float mneg = -fmaxf(m, MFLOOR);
#pragma unroll
                for (int i = 0; i < 16; ++i) minit[i] = mneg; }
            float lp = 0.f;
            __builtin_amdgcn_s_waitcnt(0x0F70);
            ATT_LOOP(qt - 2, KS + (size_t)(pi + 1) * 64 * NU, NU, VST + (size_t)(pi + 1) * 4096, 64, true, {
                const int j = ti + 1;
                const unsigned wsel = (j < 32) ? selw.x : (j < 64) ? selw.y : (j < 96) ? selw.z : selw.w; const bool sel = (wsel >> (j & 31)) & 1u;
                if (!__all(!sel)) tile_frozen<false>(Kb, Vb, qf, r, h, 0, 63, minit, sel ? 100.0f : NEG, lp, O); })
            l += lp + __shfl_xor(lp, 32);
        }
    } else {
        {
#define JMAP(i) ((i) == 0 ? 0 : qt - (2 - (i)))
            ATT_RUN(3, KS + (size_t)JMAP(pi) * 64 * NU, NU, VST + (size_t)JMAP(pi) * 4096, 64, true, {
                const int j = JMAP(ti);
                tile_compute<0>(Kb, Vb, qf, r, h, 0, (j == qt ? tokl : 63), j == qt, m, l, O, 0.f, 0.f, nullptr, nullptr, 0); })
#undef JMAP
        }
        int lz = lane; asm volatile("" : "+v"(lz));
        const int r = lz & 31, h = lz >> 5, hp = r & 3, tokl = 8 * wave + (r >> 2), lane = lz, tid = wave * 64 + lz;
        LAS unsigned char* Qs = lds + OFF_QS; LAS float* MREF = (LAS float*)(lds + OFF_MREF); LAS float* LSUM = (LAS float*)(lds + OFF_LSUM); LAS int* LIST = (LAS int*)(lds + OFF_LIST) + wave * 64;
        LAS unsigned long long* TM = (LAS unsigned long long*)(lds + OFF_TM);
        if (h == 0) MREF[32 * wave + r] = fmaxf(m, MFLOOR);
        for (int j = wave; j < 128; j += 8) { const unsigned long long mk = __ballot((SELM[lane * 4 + (j >> 5)] >> (j & 31)) & 1u); if (lane == 0) TM[j] = mk; }
        __syncthreads();
#pragma unroll
        for (int q4 = 0; q4 < 4; ++q4) { const int ch = tid + 512 * q4, row = ch >> 3, c8 = ch & 7;
            *(LAS u32x4*)(Qs + row * ROWB + c8 * 16) = *(const u32x4*)(U + (size_t)(b * SEQ + t0 + (row >> 2)) * NU + UQ + (4 * gg + (row & 3)) * 64 + c8 * 8); }
        __syncthreads();
        const int jend = qt - 2; int jn = 1, rk = 0;
        const unsigned long long ltl = (1ull << tokl) - 1ull;
        int pjs = 0, pcnt = 0;
#define FAR_TM(dst, jj) { const unsigned long long tv_ = TM[(jj) <= jend ? (jj) : 0]; const unsigned lo_ = __builtin_amdgcn_readfirstlane((unsigned)tv_), hi_ = __builtin_amdgcn_readfirstlane((unsigned)(tv_ >> 32)); \
            dst = ((jj) <= jend) ? (((unsigned long long)hi_ << 32) | lo_) : 0ull; }
        for (;;) {
            int cnt = 0, used = 0, myj = -1, myc = 0; unsigned long long mymask = 0ull;
#pragma unroll
            for (int i = 0; i < 8; ++i) { const int jj = jn + i; unsigned long long mk; FAR_TM(mk, jj) const int nch = (__popcll(mk) + 7) >> 3;
                const bool take = (cnt == i) && (jj <= jend) && (used + nch <= 8);
                if (take) { if (wave >= used && wave < used + nch) { myj = jj; myc = wave - used; mymask = mk; } used += nch; ++cnt; } }
            if (cnt == 0 && pcnt == 0) break;
            const int cjs = jn; jn += cnt;
            bf16x8 kf[2][4], vf[2][4];
            if (myj >= 0) { const bf16_t* Kg = KS + (size_t)(myj * 64 + r) * NU + 8 * h; const bf16_t* Vg = VST + (size_t)myj * 4096 + r * 64 + 8 * h;
#pragma unroll
                for (int kh = 0; kh < 2; ++kh)
#pragma unroll
                    for (int ks = 0; ks < 4; ++ks) { kf[kh][ks] = *(const bf16x8*)(Kg + (size_t)(32 * kh) * NU + 16 * ks); vf[kh][ks] = *(const bf16x8*)(Vg + kh * 32 * 64 + ks * 16); } }
            if (pcnt > 0) { int base = 0;
#pragma unroll
                for (int i = 0; i < 8; ++i) { unsigned long long mk; FAR_TM(mk, pjs + i) if (i >= pcnt) mk = 0ull; const int nch = (__popcll(mk) + 7) >> 3;
                    const bool act = (mk >> tokl) & 1ull;
                    if (__any(act)) { const int rank = __popcll(mk & ltl), slot = base + (rank >> 3), prow = (rank & 7) * 4 + hp;
                        const LAS unsigned char* Pb = lds + OFF_PBUF + (((rk + 1) & 1) * 8 + slot) * PSLOT + prow * ROWB + h * 8;
#pragma unroll
                        for (int dt = 0; dt < 2; ++dt)
#pragma unroll
                            for (int gq = 0; gq < 4; ++gq) { u32x2 w = *(const LAS u32x2*)(Pb + (32 * dt + 8 * gq) * 2); if (!act) w = (u32x2){0u, 0u};
                                O[dt][4 * gq] += bflo(w.x); O[dt][4 * gq + 1] += bfhi(w.x); O[dt][4 * gq + 2] += bflo(w.y); O[dt][4 * gq + 3] += bfhi(w.y); }
                        l += act ? LSUM[(((rk + 1) & 1) * 8 + slot) * 32 + prow] : 0.f; }
                    base += nch; } }
            if (myj >= 0) {
                LAS unsigned char* Pw = lds + OFF_PBUF + ((rk & 1) * 8 + wave) * PSLOT;
                if ((mymask >> lane) & 1ull) LIST[__popcll(mymask & ((1ull << lane) - 1ull))] = lane;
                const int rank = 8 * myc + (r >> 2); const bool valid = rank < __popcll(mymask);
                const int tok = valid ? LIST[rank] : 0; const int qrow = tok * 4 + hp;
                bf16x8 qg[4];
#pragma unroll
                for (int ks = 0; ks < 4; ++ks) qg[ks] = *(const LAS bf16x8*)(Qs + qrow * ROWB + ks * 32 + h * 16);
                const float mr = MREF[qrow];
                float rs = 0.f; f32x16 Oc[2];
#pragma unroll
                for (int i = 0; i < 16; ++i) { Oc[0][i] = 0.f; Oc[1][i] = 0.f; }
#pragma unroll
                for (int kh = 0; kh < 2; ++kh) { f32x16 sv;
#pragma unroll
                    for (int i = 0; i < 16; ++i) sv[i] = 0.f;
#pragma unroll
                    for (int ks = 0; ks < 4; ++ks) sv = MFMA32(kf[kh][ks], qg[ks], sv);
#pragma unroll
                    for (int i = 0; i < 16; ++i) { sv[i] = valid ? fexp2(fminf(sv[i] - mr, 100.0f)) : 0.f; rs += sv[i]; }
#pragma unroll
                    for (int s2 = 0; s2 < 2; ++s2) { const bf16x8 pf = pack8(sv, s2);
                        Oc[0] = MFMA32(vf[0][kh * 2 + s2], pf, Oc[0]); Oc[1] = MFMA32(vf[1][kh * 2 + s2], pf, Oc[1]); } }
                rs += __shfl_xor(rs, 32);
                if (h == 0) LSUM[((rk & 1) * 8 + wave) * 32 + r] = rs;
#pragma unroll
                for (int dt = 0; dt < 2; ++dt)
#pragma unroll
                    for (int gq = 0; gq < 4; ++gq) { u32x2 w; w.x = pk2(Oc[dt][4 * gq], Oc[dt][4 * gq + 1]); w.y = pk2(Oc[dt][4 * gq + 2], Oc[dt][4 * gq + 3]);
                        *(LAS u32x2*)(Pw + r * ROWB + (32 * dt + 8 * gq + 4 * h) * 2) = w; }
            }
            __syncthreads();
            pjs = cjs; pcnt = cnt; ++rk;
        }
#undef FAR_TM
    }
    { int lp_ = lane; asm volatile("" : "+v"(lp_)); const float* oapark = (const float*)(ws + WS_HIDM) + ((size_t)(blockIdx.x * 8 + wave) * 32) * 64 + lp_;
#pragma unroll
      for (int i = 0; i < 16; ++i) { OA[0][i] = oapark[i * 64]; OA[1][i] = oapark[(16 + i) * 64]; } }
    ATT_FOLD(1);
    { int lp_ = lane; asm volatile("" : "+v"(lp_)); float* oapark = (float*)(ws + WS_HIDM) + ((size_t)(blockIdx.x * 8 + wave) * 32) * 64 + lp_;
#pragma unroll
      for (int i = 0; i < 16; ++i) { oapark[i * 64] = OA[0][i]; oapark[(16 + i) * 64] = OA[1][i]; } }
    ATT_LOADQ();
    ATT_RESET();
    {
        int lw_ = lane; asm volatile("" : "+v"(lw_)); const int r = lw_ & 31, h = lw_ >> 5, tokl = 8 * wave + (r >> 2);
        const int jlo = qt >= 8 ? qt - 8 : 0;
        const bf16_t* KW = U + (size_t)(b * SEQ) * NU + UKW + gg * 64; const bf16_t* VWT = (const bf16_t*)(ws + WS_VWT) + (size_t)bg * 128 * 4096;
        ATT_LOOP(1, KW + (size_t)qt * 64 * NU, NU, VWT + (size_t)qt * 4096, 64, true, {
            tile_compute<0>(Kb, Vb, qf, r, h, 0, tokl, true, m, l, O, 0.f, 0.f, nullptr, nullptr, 0); })
        if (qt > 0) {
            f32x16 minit; { const float mneg = -fmaxf(m, MFLOOR);
#pragma unroll
                for (int i = 0; i < 16; ++i) minit[i] = mneg; }
            float lp = 0.f;
            __builtin_amdgcn_s_waitcnt(0x0F70);
            ATT_LOOP(qt - jlo, KW + (size_t)(jlo + pi) * 64 * NU, NU, VWT + (size_t)(jlo + pi) * 4096, 64, true, {
                const int j = jlo + ti;
                if (j + 8 == qt) tile_frozen<true>(Kb, Vb, qf, r, h, tokl + 1, 63, minit, 100.0f, lp, O);
                else tile_frozen<false>(Kb, Vb, qf, r, h, 0, 63, minit, 100.0f, lp, O); })
            l += lp + __shfl_xor(lp, 32);
        }
        { int lp_ = lane; asm volatile("" : "+v"(lp_)); const float* oapark = (const float*)(ws + WS_HIDM) + ((size_t)(blockIdx.x * 8 + wave) * 32) * 64 + lp_;
#pragma unroll
      for (int i = 0; i < 16; ++i) { OA[0][i] = oapark[i * 64]; OA[1][i] = oapark[(16 + i) * 64]; } }
        ATT_FOLD(2);
    }
    int lo_ = lane; asm volatile("" : "+v"(lo_)); const int h_o = lo_ >> 5;
    bf16_t* orow = (bf16_t*)(ws + WS_CAT) + (size_t)(b * SEQ + t0 + 8 * wave + ((lo_ & 31) >> 2)) * DM + (4 * gg + (lo_ & 3)) * 64;
#pragma unroll
    for (int dt = 0; dt < 2; ++dt)
#pragma unroll
        for (int gq = 0; gq < 4; ++gq) { u32x2 w; w.x = pk2(OA[dt][4 * gq], OA[dt][4 * gq + 1]); w.y = pk2(OA[dt][4 * gq + 2], OA[dt][4 * gq + 3]);
            *(u32x2*)(orow + 32 * dt + 8 * gq + 4 * h_o) = w; }
#undef ATT_RESET
#undef ATT_FOLD
#undef ATT_LOADQ
#undef ATT_UROW
#undef ATT_LOOP
#undef ATT_PRE
#undef ATT_RUN
#undef ATT_STEP
}

DI void attn_phase(const Params& P, LAS unsigned char* lds, int vcu, int G, int wave, int lane, int tid) {
    int it = 0;
    CvState cv; { const int first = CV_EARLY_EXPERTS * CV_PER_EXPERT, per = (CV_TOTAL - first) / (G * 8), gw = vcu * 8 + wave; cv.next = first + gw * per; cv.end = (gw == G * 8 - 1) ? CV_TOTAL : cv.next + per; cv.nfly = 0; cv.xafter = false; }
    static constexpr unsigned char QT_TAB[32][4] = {{14,37,91,127},{30,44,68,126},{31,35,77,100},{23,48,69,125},{27,40,76,99},{10,53,79,124},{17,38,85,123},{19,32,89,122},{20,33,87,121},{29,43,70,120},{21,54,66,107},{0,58,90,119},{25,42,75,118},{22,47,74,106},{18,34,88,117},{3,51,92,105},{15,56,71,116},{11,39,93,98},{9,49,82,115},{28,36,78,114},{24,52,64,113},{16,41,84,104},{5,46,95,97},{4,59,81,112},{26,50,65,103},{8,62,72,111},{6,45,94,102},{7,55,80,96},{2,61,83,110},{13,63,67,101},{1,60,86,109},{12,57,73,108}};
    if (G == 256) {
        const int bg = vcu >> 5, s = vcu & 31;
        for (int k = 3; k >= 0; --k) { const int qt = (k == 0) ? QT_TAB[s][0] : (k == 1) ? QT_TAB[s][1] : (k == 2) ? QT_TAB[s][2] : QT_TAB[s][3]; attn_unit(P, lds, bg, qt, wave, lane, tid, it, cv); }
    } else {
        for (int ui = vcu; ui < 1024; ui += G) { const int k = ui >> 8, v = ui & 255, bg = v >> 5, s = v & 31;
            const int qt = (k == 0) ? s : (k == 1) ? 63 - s : (k == 2) ? 64 + s : 127 - s;
            attn_unit(P, lds, bg, qt, wave, lane, tid, it, cv); }
    }
    for (;;) {
        if (cv.nfly > 0) { asm volatile("s_waitcnt vmcnt(0)" ::: "memory"); while (cv.nfly > 0) cv_finish(P, cv, lds, wave, lane); }
        if (cv.next >= cv.end) break;
        cv_issue(P, cv, lds, wave, lane); if (cv.next < cv.end) cv_issue(P, cv, lds, wave, lane); }
    __syncthreads();
}
}
#ifndef CHECK_ATTN
#define CHECK_ATTN 0
#endif
#if CHECK_ATTN
constexpr int CW_ERR = 8192;
namespace attnchk {
DI float wmax(float v) {
#pragma unroll
    for (int o = 1; o < 64; o <<= 1) v = fmaxf(v, __shfl_xor(v, o));
    return v; }
DI void item(const Params& P, LAS float* scr, int bg, int t, int lane, float& se, float& sr) {
    unsigned char* ws = P.ws; const bf16_t* U = (const bf16_t*)(ws + WS_U);
    const int b = bg >> 1, gg = bg & 1;
    LAS float* q = scr; LAS float* pc = scr + 256; LAS float* sc = scr + 768;
    const bf16_t* urow = U + (size_t)(b * SEQ + t) * NU;
    for (int i = lane; i < 256; i += 64) q[i] = bf2f(urow[UQ + gg * 256 + i]);
    const bf16_t* KC = (const bf16_t*)(ws + WS_KC) + (size_t)bg * 512 * 64; const bf16_t* VCT = (const bf16_t*)(ws + WS_VCT) + (size_t)bg * 64 * 512;
    const int nvalid = t >= 31 ? ((t - 31) >> 4) + 1 : 0, cur = t >> 6;
    float oc[4], os[4], ow[4], imp0 = 0.f, imp1 = 0.f;
    for (int p = 0; p < 4; ++p) {
        float sv[8], mx = -3e38f;
        for (int i = 0; i < 8; ++i) { const int n = lane + 64 * i; float a = 0.f;
            if (n < nvalid) { for (int d = 0; d < 64; ++d) a += q[p * 64 + d] * bf2f(KC[n * 64 + d]); mx = fmaxf(mx, a); }
            sv[i] = a; }
        mx = wmax(mx); float ls = 0.f;
        for (int i = 0; i < 8; ++i) { const int n = lane + 64 * i; const float e = (n < nvalid) ? exp2f(sv[i] - mx) : 0.f; sv[i] = e; ls += e; }
        ls = wave_sum(ls); const float inv = ls > 0.f ? 1.f / ls : 0.f;
        for (int i = 0; i < 8; ++i) pc[lane + 64 * i] = sv[i] * inv;
        float o = 0.f;
        for (int n = 0; n < nvalid; ++n) { const int pos = (n & ~15) | (int)swap23((unsigned)n & 15u); o += pc[n] * bf2f(VCT[lane * 512 + pos]); }
        oc[p] = o;
        for (int k = -1; k <= 3; ++k) { const int n0 = 4 * lane + k, n1 = 4 * (lane + 64) + k;
            if (n0 >= 0 && n0 < nvalid) imp0 += pc[n0]; if (n1 < nvalid) imp1 += pc[n1]; }
    }
    const float INF = __builtin_inff();
    const int s0 = lane, s1 = lane + 64;
    const float v0 = (s0 == 0 || s0 == cur || s0 == cur - 1) ? INF : (s0 <= cur ? imp0 : -INF);
    const float v1 = (s1 == cur || s1 == cur - 1) ? INF : (s1 <= cur ? imp1 : -INF);
    int r0 = 0, r1 = 0;
    for (int j = 0; j < 128; ++j) { const float vj = (j < 64) ? __shfl(v0, j) : __shfl(v1, j - 64);
        r0 += (vj > v0 || (vj == v0 && j < s0)) ? 1 : 0; r1 += (vj > v1 || (vj == v1 && j < s1)) ? 1 : 0; }
    const unsigned long long m0 = __ballot(r0 < 16 && v0 > -INF), m1 = __ballot(r1 < 16 && v1 > -INF);
    for (int br = 0; br < 2; ++br) {
        const bf16_t* Kp = U + (size_t)(b * SEQ) * NU + (br ? UKW : UKS) + gg * 64; const bf16_t* Vp = U + (size_t)(b * SEQ) * NU + (br ? UVW : UVS) + gg * 64;
        for (int p = 0; p < 4; ++p) {
            int nk = 0; float mx = -3e38f;
            if (br == 0) {
                for (int j = 0; j < 128; ++j) { const bool on = (j < 64) ? ((m0 >> j) & 1ull) : ((m1 >> (j - 64)) & 1ull); if (!on) continue;
                    const int key = 64 * j + lane; float a = -3e38f;
                    if (key <= t) { a = 0.f; for (int d = 0; d < 64; ++d) a += q[p * 64 + d] * bf2f(Kp[(size_t)key * NU + d]); mx = fmaxf(mx, a); }
                    sc[nk * 64 + lane] = a; ++nk; }
            } else {
                for (int i = 0; i < 8; ++i) { const int key = t - 511 + lane + 64 * i; float a = -3e38f;
                    if (key >= 0 && key <= t) { a = 0.f; for (int d = 0; d < 64; ++d) a += q[p * 64 + d] * bf2f(Kp[(size_t)key * NU + d]); mx = fmaxf(mx, a); }
                    sc[i * 64 + lane] = a; }
                nk = 8;
            }
            mx = wmax(mx); float ls = 0.f;
            for (int i = 0; i < nk; ++i) { const float a = sc[i * 64 + lane]; const float e = (a > -1e38f) ? exp2f(a - mx) : 0.f; sc[i * 64 + lane] = e; ls += e; }
            ls = wave_sum(ls); const float inv = ls > 0.f ? 1.f / ls : 0.f;
            float o = 0.f;
            if (br == 0) { int idx = 0;
                for (int j = 0; j < 128; ++j) { const bool on = (j < 64) ? ((m0 >> j) & 1ull) : ((m1 >> (j - 64)) & 1ull); if (!on) continue;
                    for (int kk = 0; kk < 64; ++kk) { const float pv = sc[idx * 64 + kk]; if (pv != 0.f) o += pv * bf2f(Vp[(size_t)(64 * j + kk) * NU + lane]); }
                    ++idx; }
                os[p] = o * inv;
            } else {
                for (int i = 0; i < 8; ++i) for (int kk = 0; kk < 64; ++kk) { const int key = t - 511 + kk + 64 * i; const float pv = sc[i * 64 + kk]; if (pv != 0.f) o += pv * bf2f(Vp[(size_t)key * NU + lane]); }
                ow[p] = o * inv;
            }
        }
    }
    const bf16_t* cat = (const bf16_t*)(ws + WS_CAT) + (size_t)(b * SEQ + t) * DM;
    for (int p = 0; p < 4; ++p) {
        const float g0 = fsigmoid(bf2f(urow[UGT + gg * 12 + p * 3 + 0])), g1 = fsigmoid(bf2f(urow[UGT + gg * 12 + p * 3 + 1])), g2 = fsigmoid(bf2f(urow[UGT + gg * 12 + p * 3 + 2]));
        const float ref = g0 * oc[p] + g1 * os[p] + g2 * ow[p], got = bf2f(cat[(4 * gg + p) * 64 + lane]);
        se += (ref - got) * (ref - got); sr += ref * ref; }
}
DI void phase(const Params& P, LAS unsigned char* lds, int vcu, int G, int wave, int lane) {
    LAS float* scr = (LAS float*)(lds + wave * 8192);
    float se = 0.f, sr = 0.f;
    for (int it = vcu * 8 + wave; it < 8 * SEQ; it += G * 8) { const int bg = it / SEQ, t = it % SEQ; item(P, scr, bg, t, lane, se, sr); }
    se = wave_sum(se); sr = wave_sum(sr);
    if (lane == 0) { atomicAdd((float*)(P.ws + WS_CTL) + CW_ERR, se); atomicAdd((float*)(P.ws + WS_CTL) + CW_ERR + 1, sr); }
}
}
#endif
DI void phase_ln1(const Params& P, int vcu, int G, int wave, int lane, bf16_t* x1base) {
    const float* mod = (const float*)(P.ws + WS_MOD);
    for (int mrow = vcu * 8 + wave; mrow < NT; mrow += G * 8) { const int b = mrow / SEQ;
        const u32x2* vr = (const u32x2*)((const bf16_t*)(P.ws + WS_V1) + (size_t)mrow * DM) + lane; f32x4 v[4]; float s = 0.f;
#pragma unroll
        for (int j = 0; j < 4; ++j) { const u32x2 q = vr[64 * j]; v[j] = (f32x4){bflo(q.x), bfhi(q.x), bflo(q.y), bfhi(q.y)}; s += (v[j].x + v[j].y) + (v[j].z + v[j].w); }
        const float mean = wave_sum(s) * (1.f / DM); float s2 = 0.f;
#pragma unroll
        for (int j = 0; j < 4; ++j) { v[j] = v[j] - mean; s2 += (v[j].x * v[j].x + v[j].y * v[j].y) + (v[j].z * v[j].z + v[j].w * v[j].w); }
        const float rstd = 1.f / sqrtf(wave_sum(s2) * (1.f / DM) + LN_EPS);
        unsigned long long* o8 = (unsigned long long*)((bf16_t*)(P.ws + WS_H2) + (size_t)mrow * DM) + lane;
        unsigned long long* x8 = (unsigned long long*)(x1base + (size_t)mrow * DM) + lane;
#pragma unroll
        for (int j = 0; j < 4; ++j) { const int c0 = 4 * lane + 256 * j;
            const f32x4 g = *(const f32x4*)(P.ln1_g + c0), bb = *(const f32x4*)(P.ln1_b + c0);
            const f32x4 sh = *(const f32x4*)(mod + b * 6144 + 3 * 1024 + c0), sc = *(const f32x4*)(mod + b * 6144 + 4 * 1024 + c0);
            const f32x4 x1 = v[j] * rstd * g + bb;
            x8[64 * j] = (unsigned long long)pk2(x1.x, x1.y) | ((unsigned long long)pk2(x1.z, x1.w) << 32);
            const f32x4 y = x1 * (sc + 1.0f) + sh;
            o8[64 * j] = (unsigned long long)pk2(y.x, y.y) | ((unsigned long long)pk2(y.z, y.w) << 32); }
    }
}

DI unsigned f2ord(float f) { const unsigned u = __float_as_uint(f); return (u & 0x80000000u) ? ~u : (u | 0x80000000u); }
template <int CTRL, int RMASK> DI unsigned dppu(unsigned oldv, unsigned v) { return (unsigned)__builtin_amdgcn_update_dpp((int)oldv, (int)v, CTRL, RMASK, 0xf, false); }
template <int CTRL, int RMASK> DI float dppf(float oldv, float v) { return __uint_as_float(dppu<CTRL, RMASK>(__float_as_uint(oldv), __float_as_uint(v))); }
DI unsigned wave_umax(unsigned v) {
    v = max(v, dppu<0x111, 0xf>(0u, v)); v = max(v, dppu<0x112, 0xf>(0u, v)); v = max(v, dppu<0x114, 0xf>(0u, v)); v = max(v, dppu<0x118, 0xf>(0u, v));
    v = max(v, dppu<0x142, 0xa>(0u, v)); v = max(v, dppu<0x143, 0xc>(0u, v));
    return (unsigned)__builtin_amdgcn_readlane((int)v, 63);
}
template <int CTRL, int RMASK> DI void top2_step(float& t1, float& t2) { const float NI = -3.0e38f; const float a1 = dppf<CTRL, RMASK>(NI, t1), a2 = dppf<CTRL, RMASK>(NI, t2);
    const float n1 = fmaxf(t1, a1), n2 = fmaxf(fminf(t1, a1), fmaxf(t2, a2)); t1 = n1; t2 = n2; }
DI void half_top2(float& t1, float& t2) { top2_step<0x111, 0xf>(t1, t2); top2_step<0x112, 0xf>(t1, t2); top2_step<0x114, 0xf>(t1, t2); top2_step<0x118, 0xf>(t1, t2); top2_step<0x142, 0xa>(t1, t2); }
DI void phase_route(const Params& P, LAS unsigned char* lds, int vcu, int G, int wave, int lane, int tid) {
    unsigned char* ws = P.ws;
    LAS int* hist = (LAS int*)lds;
    const float* logit = (const float*)(ws + WS_LOGIT);
    int* tok_e = (int*)(ws + WS_TOKE); float* tok_w = (float*)(ws + WS_TOKW); int* lrank = (int*)(ws + WS_LRANK);
    { int* rt = (int*)(ws + WS_ROWTOK); for (int i = vcu * 512 + tid; i < NPAD_MAX; i += G * 512) rt[i] = 0; }
    float bias[4];
#pragma unroll
    for (int k = 0; k < 4; ++k) bias[k] = P.router_bias[lane + 64 * k];
    const int tpw = NT / G;
    for (int base = vcu * tpw; base < NT; base += G * tpw) {
        __syncthreads();
        if (tid < 256) hist[tid] = 0;
        __syncthreads();
        float lg[2][4];
#pragma unroll
        for (int u = 0; u < 2; ++u) { const int tq0 = wave + 8 * u; const int t0 = base + (tq0 < tpw ? tq0 : wave);
#pragma unroll
            for (int k = 0; k < 4; ++k) lg[u][k] = logit[(size_t)t0 * 256 + lane + 64 * k]; }
        for (int tq = wave; tq < tpw; tq += 16) {
            int tkn[2]; tkn[0] = base + tq; tkn[1] = (tq + 8 < tpw) ? base + tq + 8 : base + tq;
            const bool two = (tq + 8 < tpw);
            float s[2][4], sel[2][4];
#pragma unroll
            for (int u = 0; u < 2; ++u)
#pragma unroll
                for (int k = 0; k < 4; ++k) { s[u][k] = fsigmoid(lg[u][k]); sel[u][k] = s[u][k] + bias[k]; }
            if (tq + 16 < tpw) {
#pragma unroll
                for (int u = 0; u < 2; ++u) { const int tqn = tq + 16 + 8 * u; const int tn = base + (tqn < tpw ? tqn : tq + 16);
#pragma unroll
                    for (int k = 0; k < 4; ++k) lg[u][k] = logit[(size_t)tn * 256 + lane + 64 * k]; } }
            unsigned key[2][4];
#pragma unroll
            for (int u = 0; u < 2; ++u) {
                float gs[8];
#pragma unroll
                for (int k = 0; k < 4; ++k) { float t1 = sel[u][k], t2 = -3.0e38f; half_top2(t1, t2); const float sm = t1 + t2;
                    gs[2 * k] = __uint_as_float((unsigned)__builtin_amdgcn_readlane((int)__float_as_uint(sm), 31)); gs[2 * k + 1] = __uint_as_float((unsigned)__builtin_amdgcn_readlane((int)__float_as_uint(sm), 63)); }
                bool gsel[8];
#pragma unroll
                for (int a2 = 0; a2 < 8; ++a2) { int rk = 0;
#pragma unroll
                    for (int c2 = 0; c2 < 8; ++c2) rk += (gs[c2] > gs[a2] || (gs[c2] == gs[a2] && c2 < a2)) ? 1 : 0;
                    gsel[a2] = rk < 4; }
                const int hh = lane >> 5;
#pragma unroll
                for (int k = 0; k < 4; ++k) { const bool on = hh ? gsel[2 * k + 1] : gsel[2 * k]; key[u][k] = on ? f2ord(sel[u][k]) : 0u; }
            }
            float ssum[2] = {0.f, 0.f}; int che[2][4];
#pragma unroll
            for (int u = 0; u < 2; ++u)
#pragma unroll
                for (int k = 0; k < 4; ++k) che[u][k] = -1;
            for (int it8 = 0; it8 < 8; ++it8) {
#pragma unroll
                for (int u = 0; u < 2; ++u) {
                    const unsigned lm = max(max(key[u][0], key[u][1]), max(key[u][2], key[u][3]));
                    const unsigned M = wave_umax(lm);
                    int ck = -1, cl = 0;
#pragma unroll
                    for (int k = 3; k >= 0; --k) { const unsigned long long eq = __ballot(key[u][k] == M); if (eq != 0ull) { ck = k; cl = __ffsll((long long)eq) - 1; } }
#pragma unroll
                    for (int k = 0; k < 4; ++k) { const bool mine = (k == ck) && (lane == cl); if (mine) { che[u][k] = it8; key[u][k] = 0u; } }
                }
            }
#pragma unroll
            for (int u = 0; u < 2; ++u) { if (u == 1 && !two) break;
                float sm = 0.f;
#pragma unroll
                for (int k = 0; k < 4; ++k) sm += (che[u][k] >= 0) ? s[u][k] : 0.f;
                sm = wave_sum(sm);
                const float wn = 2.5f / sm;
#pragma unroll
                for (int k = 0; k < 4; ++k) if (che[u][k] >= 0) { const int e = lane + 64 * k; const int lr = __hip_atomic_fetch_add(hist + e, 1, __ATOMIC_RELAXED, __HIP_MEMORY_SCOPE_WORKGROUP);
                    tok_e[tkn[u] * 8 + che[u][k]] = e; tok_w[tkn[u] * 8 + che[u][k]] = s[u][k] * wn; lrank[tkn[u] * 8 + che[u][k]] = lr; }
            }
            (void)ssum;
        }
        __syncthreads();
        if (tid < 256) ((int*)(ws + WS_HIST))[(base / tpw) * 256 + tid] = hist[tid];
    }
    __syncthreads();
}

DI void phase_scatter(const Params& P, LAS unsigned char* lds, int vcu, int G, int wave, int lane, int tid) {
    unsigned char* ws = P.ws;
    LAS int* sbase = (LAS int*)lds; LAS int* spad = sbase + 256; LAS int* sstart = spad + 256;
    const unsigned* hist = (const unsigned*)(ws + WS_HIST);
    const int* tok_e = (const int*)(ws + WS_TOKE); const int* lrank = (const int*)(ws + WS_LRANK);
    int* rowtok = (int*)(ws + WS_ROWTOK); int* pos_of = (int*)(ws + WS_POSOF); int* blk_e = (int*)(ws + WS_BLKE);
    const int tpw = NT / G, nslots = NT / tpw;
    for (int base = vcu * tpw; base < NT; base += G * tpw) { const int slot = base / tpw;
        __syncthreads();
        if (tid < 256) { int tot = 0, below = 0;
            for (int w2 = 0; w2 < nslots; ++w2) { const int hv = (int)hist[w2 * 256 + tid]; tot += hv; below += (w2 < slot) ? hv : 0; }
            spad[tid] = (tot + 255) & ~255; sbase[tid] = below; }
        __syncthreads();
        if (tid == 0) { int run = 0; for (int e = 0; e < 256; ++e) { sstart[e] = run; run += spad[e]; } sstart[256] = run; }
        __syncthreads();
        for (int i = tid; i < tpw * 8; i += 512) { const int a = base * 8 + i; const int e = tok_e[a]; const int pos = sstart[e] + sbase[e] + lrank[a];
            rowtok[pos] = a >> 3; pos_of[a] = pos; }
        if (slot == 0) {
            if (tid < 256) { const int b0 = sstart[tid] >> 8, b1 = (sstart[tid] + spad[tid]) >> 8; for (int bb = b0; bb < b1; ++bb) blk_e[bb] = tid; }
            if (tid == 0) blk_e[NBLK_MAX] = sstart[256] >> 8;
        }
    }
    __syncthreads();
}

DI void phase_final(const Params& P, int vcu, int G, int wave, int lane, float* dstbase) {
    unsigned char* ws = P.ws;
    const float* mod = (const float*)(ws + WS_MOD);
    const int* pos_of = (const int*)(ws + WS_POSOF); const float* tok_w = (const float*)(ws + WS_TOKW);
    const unsigned char* Y = (const unsigned char*)(ws + WS_YMOE);
    float dbg_scale = 1.0f;
#if CHECK_ATTN
    { const float se = __uint_as_float(ld_u32_agent((const unsigned*)(ws + WS_CTL) + CW_ERR)), sr = __uint_as_float(ld_u32_agent((const unsigned*)(ws + WS_CTL) + CW_ERR + 1)); const float err = sqrtf(se / fmaxf(sr, 1e-30f)); dbg_scale = 1.0f + (err < 0.005f ? 0.f : err < 0.02f ? 0.04f : err < 0.08f ? 0.055f : err < 0.3f ? 0.07f : 0.085f); }
#endif
    for (int mrow = vcu * 8 + wave; mrow < NT; mrow += G * 8) { const int b = mrow / SEQ;
        const u32x2* xr = (const u32x2*)((const bf16_t*)(ws + WS_X1) + (size_t)mrow * DM) + lane; const u32x2* sr = (const u32x2*)((const bf16_t*)(ws + WS_SH) + (size_t)mrow * DM) + lane; f32x4 v[4], ya[4];
#pragma unroll
        for (int j = 0; j < 4; ++j) { const u32x2 q = xr[64 * j], q2 = sr[64 * j]; v[j] = (f32x4){bflo(q.x), bfhi(q.x), bflo(q.y), bfhi(q.y)} * DN_ALPHA; ya[j] = (f32x4){bflo(q2.x), bfhi(q2.x), bflo(q2.y), bfhi(q2.y)}; }
        const int mypos = pos_of[(size_t)mrow * 8 + (lane & 7)]; const float myw = tok_w[(size_t)mrow * 8 + (lane & 7)];
#pragma unroll
        for (int k = 0; k < 8; ++k) { const int pos = __shfl(mypos, k); const float wk = __shfl(myw, k) * (1.0f / YMOE_SCALE);
            const unsigned* yr = (const unsigned*)(Y + (size_t)pos * DM) + lane;
#pragma unroll
            for (int j = 0; j < 4; ++j) { const int q = (int)yr[64 * j]; const f32x2 lo = __builtin_amdgcn_cvt_pk_f32_fp8(q, false), hi = __builtin_amdgcn_cvt_pk_f32_fp8(q, true);
                ya[j].x += wk * lo.x; ya[j].y += wk * lo.y; ya[j].z += wk * hi.x; ya[j].w += wk * hi.y; } }
        float s = 0.f;
#pragma unroll
        for (int j = 0; j < 4; ++j) { const f32x4 g2 = *(const f32x4*)(mod + b * 6144 + 5 * 1024 + 4 * lane + 256 * j); v[j] = v[j] + g2 * ya[j]; s += (v[j].x + v[j].y) + (v[j].z + v[j].w); }
        const float mean = wave_sum(s) * (1.f / DM); float s2 = 0.f;
#pragma unroll
        for (int j = 0; j < 4; ++j) { v[j] = v[j] - mean; s2 += (v[j].x * v[j].x + v[j].y * v[j].y) + (v[j].z * v[j].z + v[j].w * v[j].w); }
        const float rstd = 1.f / sqrtf(wave_sum(s2) * (1.f / DM) + LN_EPS);
#pragma unroll
        for (int j = 0; j < 4; ++j) { const int c0 = 4 * lane + 256 * j; const f32x4 g = *(const f32x4*)(P.ln2_g + c0), bb = *(const f32x4*)(P.ln2_b + c0);
            ((f32x4*)(dstbase + (size_t)mrow * DM) + lane)[64 * j] = (v[j] * rstd * g + bb) * dbg_scale; }
    }
}
#ifndef REP_PHASE
#define REP_PHASE -1
#endif
#ifndef LN1_FUSED
#define LN1_FUSED 0
#endif
#ifndef MK_PER_PHASE
#define MK_PER_PHASE 0
#endif
DI void run_phase_0(const Params& P, LAS unsigned char* lds, int vcu, int G, int bx, int wave, int lane, int tid) {
    unsigned char* ws = P.ws; const float* mod = (const float*)(ws + WS_MOD); (void)mod; (void)ws;
 phase0a(P, lds, vcu, G, wave, lane, tid); }
DI void run_phase_1(const Params& P, LAS unsigned char* lds, int vcu, int G, int bx, int wave, int lane, int tid) {
    unsigned char* ws = P.ws; const float* mod = (const float*)(ws + WS_MOD); (void)mod; (void)ws;
 phase0b(P, lds, vcu, G, wave, lane, tid); }
DI void run_phase_2(const Params& P, LAS unsigned char* lds, int vcu, int G, int bx, int wave, int lane, int tid) {
    unsigned char* ws = P.ws; const float* mod = (const float*)(ws + WS_MOD); (void)mod; (void)ws;
        pg8::Gemm g{(const bf16_t*)(ws + WS_H1), (const bf16_t*)(ws + WS_WIN_T), DM, DM, DM, 128};
        pg8::DenseOrder S; S.init(g.A, DM, NT, NU, G, bx);
        pg8::EpiStoreBf16 E{(bf16_t*)(ws + WS_U), NU, 0.125f * 1.4426950408889634f, 2};
        pg8::gemm_phase<pg8::EpiStoreBf16, pg8::DenseOrder, true, false>(lds, g, S, E, nullptr);
    }
DI void run_phase_3(const Params& P, LAS unsigned char* lds, int vcu, int G, int bx, int wave, int lane, int tid) {
    unsigned char* ws = P.ws; const float* mod = (const float*)(ws + WS_MOD); (void)mod; (void)ws;
        if (bx < 32 && G > 32) {
            pg8::Gemm g{(const bf16_t*)(ws + WS_U), (const bf16_t*)(ws + WS_WC1_T), 16 * NU, 2048, 2048, NU * 2};
            pg8::CmpOrder S{G, bx, (const bf16_t*)(ws + WS_U)};
            pg8::EpiCmp E{(bf16_t*)(ws + WS_HCMP), (const float*)(ws + WS_PEB)};
            pg8::gemm_phase<pg8::EpiCmp, pg8::CmpOrder, true, false>(lds, g, S, E, nullptr);
        } else {
            const int nw = (G > 32) ? G - 32 : G, w0 = (G > 32) ? bx - 32 : bx;
            if (G <= 32) { pg8::Gemm g{(const bf16_t*)(ws + WS_U), (const bf16_t*)(ws + WS_WC1_T), 16 * NU, 2048, 2048, NU * 2};
                pg8::CmpOrder S{G, bx, (const bf16_t*)(ws + WS_U)}; pg8::EpiCmp E{(bf16_t*)(ws + WS_HCMP), (const float*)(ws + WS_PEB)};
                pg8::gemm_phase<pg8::EpiCmp, pg8::CmpOrder, true, false>(lds, g, S, E, nullptr); }
            conv_items(P, lds, w0, nw, wave, lane, tid);
            if (REP_PHASE == 31) conv_items(P, lds, w0, nw, wave, lane, tid);
            __syncthreads();
            vt_copies(P, lds, w0 * 8 + wave, nw * 8, wave, lane);
            __syncthreads();
        }
    }
DI void run_phase_4(const Params& P, LAS unsigned char* lds, int vcu, int G, int bx, int wave, int lane, int tid) {
    unsigned char* ws = P.ws; const float* mod = (const float*)(ws + WS_MOD); (void)mod; (void)ws;
 phase_cmp2(P, lds, vcu, G, wave, lane, tid); }
DI void run_phase_5(const Params& P, LAS unsigned char* lds, int vcu, int G, int bx, int wave, int lane, int tid) {
    unsigned char* ws = P.ws; const float* mod = (const float*)(ws + WS_MOD); (void)mod; (void)ws;
 attn::attn_phase(P, lds, vcu, G, wave, lane, tid); }
DI void run_phase_6(const Params& P, LAS unsigned char* lds, int vcu, int G, int bx, int wave, int lane, int tid) {
    unsigned char* ws = P.ws; const float* mod = (const float*)(ws + WS_MOD); (void)mod; (void)ws;
#if CHECK_ATTN
        attnchk::phase(P, lds, vcu, G, wave, lane); __syncthreads();
#endif
        pg8::Gemm g{(const bf16_t*)(ws + WS_CAT), (const bf16_t*)(ws + WS_WOUT_T), DM, DM, DM, 128};
        pg8::DenseOrder S; S.init(g.A, DM, NT, DM, G, bx);
        if (LN1_FUSED && G == 256) {
            pg8::EpiLnFused E{P.x, mod + 2 * 1024, mod + 3 * 1024, mod + 4 * 1024, 6144, P.ln1_g, P.ln1_b, (bf16_t*)(ws + WS_X1), (bf16_t*)(ws + WS_H2),
                              (unsigned long long*)(ws + WS_LNX), (unsigned*)(ws + WS_CTL) + CW_LNCNT, (unsigned*)(ws + WS_CTL) + CW_LNTMO, lds + LDS_TAB};
            { pg8::RoundOrder R{S, 0}; pg8::gemm_phase<pg8::EpiLnFused, pg8::RoundOrder, true, false>(lds, g, R, E, nullptr); }
            { pg8::RoundOrder R{S, 1}; pg8::gemm_phase<pg8::EpiLnFused, pg8::RoundOrder, true, false>(lds, g, R, E, nullptr); }
        } else {
            pg8::EpiResModBf16 E{P.x, (bf16_t*)(ws + WS_V1), mod + 2 * 1024, 6144};
            pg8::gemm_phase<pg8::EpiResModBf16, pg8::DenseOrder, true, false>(lds, g, S, E, nullptr);
        }
    }
DI void run_phase_7(const Params& P, LAS unsigned char* lds, int vcu, int G, int bx, int wave, int lane, int tid) {
    unsigned char* ws = P.ws; const float* mod = (const float*)(ws + WS_MOD); (void)mod; (void)ws;
 if (REP_PHASE == 70) { phase_ln1(P, vcu, G, wave, lane, (bf16_t*)(ws + WS_HIDM)); phase_ln1(P, vcu, G, wave, lane, (bf16_t*)(ws + WS_HIDM)); }
    if (!(LN1_FUSED && G == 256)) phase_ln1(P, vcu, G, wave, lane, (bf16_t*)(ws + WS_X1)); }
DI void run_phase_8(const Params& P, LAS unsigned char* lds, int vcu, int G, int bx, int wave, int lane, int tid) {
    unsigned char* ws = P.ws; const float* mod = (const float*)(ws + WS_MOD); (void)mod; (void)ws;
        { pg8::Gemm g{(const bf16_t*)(ws + WS_H2), (const bf16_t*)(ws + WS_WR_T), DM, DM, DM, 128};
          pg8::DenseOrder S; S.init(g.A, DM, NT, 256, G, bx);
          pg8::EpiF32 E{(float*)(ws + WS_LOGIT), 256};
          pg8::gemm_phase<pg8::EpiF32, pg8::DenseOrder, true, false>(lds, g, S, E, nullptr); }
        { pg8::Gemm g{(const bf16_t*)(ws + WS_H2), (const bf16_t*)(ws + WS_WSGU_T), DM, DM, DM, 128};
          pg8::DenseOrder S; S.init(g.A, DM, NT, 512, G, bx);
          pg8::EpiGlu E{(bf16_t*)(ws + WS_HIDS), 256};
          pg8::gemm_phase<pg8::EpiGlu, pg8::DenseOrder, true, false>(lds, g, S, E, nullptr); }
    }
DI void run_phase_9(const Params& P, LAS unsigned char* lds, int vcu, int G, int bx, int wave, int lane, int tid) {
    unsigned char* ws = P.ws; const float* mod = (const float*)(ws + WS_MOD); (void)mod; (void)ws;
        phase_route(P, lds, vcu, G, wave, lane, tid);
        if (REP_PHASE == 90) { phase_route(P, lds, vcu, G, wave, lane, tid); phase_route(P, lds, vcu, G, wave, lane, tid); }
        pg8::Gemm g{(const bf16_t*)(ws + WS_HIDS), (const bf16_t*)(ws + WS_WSD_T), 256, 256, 256, 128};
        pg8::DenseOrder S; S.init(g.A, 256, NT, DM, G, bx);
        pg8::EpiStoreBf16 E{(bf16_t*)(ws + WS_SH), DM, 1.0f, 0};
        pg8::gemm_phase<pg8::EpiStoreBf16, pg8::DenseOrder, true, false>(lds, g, S, E, nullptr);
    }
DI void run_phase_10(const Params& P, LAS unsigned char* lds, int vcu, int G, int bx, int wave, int lane, int tid) {
    unsigned char* ws = P.ws; const float* mod = (const float*)(ws + WS_MOD); (void)mod; (void)ws;
 phase_scatter(P, lds, vcu, G, wave, lane, tid); }
DI void run_phase_11(const Params& P, LAS unsigned char* lds, int vcu, int G, int bx, int wave, int lane, int tid) {
    unsigned char* ws = P.ws; const float* mod = (const float*)(ws + WS_MOD); (void)mod; (void)ws;
        const int nblk = (int)__builtin_amdgcn_readfirstlane((int)ld_u32_agent((const unsigned*)(ws + WS_BLKE) + NBLK_MAX));
        const int nunits = 2 * nblk; LAS int* tab = (LAS int*)(lds + LDS_TAB);
        { const int* rowtok = (const int*)(ws + WS_ROWTOK); int i = 0;
          for (int L = vcu; L < nunits && i < 28; L += G, ++i) { if (tid < 256) tab[i * 256 + tid] = rowtok[(L >> 1) * 256 + tid]; } }
        __syncthreads();
        pg8::Gemm g{(const bf16_t*)(ws + WS_H2), (const bf16_t*)(ws + WS_WGU_T), DM, DM, DM, 128};
        pg8::MoeOrder<2> S{G, vcu, nunits, (const int*)(ws + WS_BLKE), g.A, (size_t)0};
        pg8::EpiGlu E{(bf16_t*)(ws + WS_HIDM), 256};
        pg8::gemm_phase<pg8::EpiGlu, pg8::MoeOrder<2>, true, true>(lds, g, S, E, tab);
    }
DI void run_phase_12(const Params& P, LAS unsigned char* lds, int vcu, int G, int bx, int wave, int lane, int tid) {
    unsigned char* ws = P.ws; const float* mod = (const float*)(ws + WS_MOD); (void)mod; (void)ws;
        const int nblk = (int)__builtin_amdgcn_readfirstlane((int)ld_u32_agent((const unsigned*)(ws + WS_BLKE) + NBLK_MAX));
        pg8::Gemm g{(const bf16_t*)(ws + WS_HIDM), (const bf16_t*)(ws + WS_WDN_T), 256, 256, 256, 128};
        pg8::MoeOrder<4> S{G, vcu, 4 * nblk, (const int*)(ws + WS_BLKE), g.A, (size_t)256 * 256 * 2};
        pg8::EpiStoreFp8 E{(unsigned char*)(ws + WS_YMOE), DM, YMOE_SCALE};
        pg8::gemm_phase<pg8::EpiStoreFp8, pg8::MoeOrder<4>, true, false>(lds, g, S, E, nullptr);
    }
DI void run_phase_13(const Params& P, LAS unsigned char* lds, int vcu, int G, int bx, int wave, int lane, int tid) {
    unsigned char* ws = P.ws; const float* mod = (const float*)(ws + WS_MOD); (void)mod; (void)ws;
 if (REP_PHASE == 130) { phase_final(P, vcu, G, wave, lane, (float*)(ws + WS_HIDM)); phase_final(P, vcu, G, wave, lane, (float*)(ws + WS_HIDM)); }
    phase_final(P, vcu, G, wave, lane, P.out); }
constexpr int NPHASE = 14;
__global__ void __launch_bounds__(512, 2) nsa_conformer_moe_fwd(Params P) {
    extern __shared__ __attribute__((aligned(16))) unsigned char lds_raw[];
    LAS unsigned char* lds = (LAS unsigned char*)lds_raw;
    const int tid = threadIdx.x, lane = tid & 63, wave = __builtin_amdgcn_readfirstlane(tid >> 6);
    const int G = gridDim.x, bx = blockIdx.x, vcu = (G % 8 == 0) ? (bx % 8) * (G / 8) + bx / 8 : bx;
    unsigned char* ws = P.ws;
    volatile LAS unsigned* MISC = (volatile LAS unsigned*)(lds + LDS_MISC);
    if (tid < 64) MISC[tid] = 0u;
    __syncthreads();
    const int lo = P.ph_lo, hi = P.ph_hi;
    XcdBarrier bar; bar.bar = (unsigned*)(ws + WS_CTL) + CW_BAR; bar.x = 0; bar.st = MISC + 8;
    if (hi - lo > 1) bar = xcd_barrier_post((unsigned*)(ws + WS_CTL) + CW_BAR, MISC + 8);
#ifdef PH_ONLY
#define IN(k) ((k) == PH_ONLY && lo <= (k) && (k) < hi)
#else
#define IN(k) (lo <= (k) && (k) < hi)
#endif
#define SEAM(k) do { if (IN(k) && IN((k) + 1) && !((k) == 6 && LN1_FUSED && G == 256)) xcd_barrier(bar); } while (0)
    if (IN(0)) run_phase_0(P, lds, vcu, G, bx, wave, lane, tid);
    if (REP_PHASE == 0 && IN(0)) { run_phase_0(P, lds, vcu, G, bx, wave, lane, tid); run_phase_0(P, lds, vcu, G, bx, wave, lane, tid); }
    SEAM(0);
    if (REP_PHASE == 200 && IN(0) && IN(1)) { for (int q_ = 0; q_ < 20; ++q_) xcd_barrier(bar); }
    if (IN(1)) run_phase_1(P, lds, vcu, G, bx, wave, lane, tid);
    if (REP_PHASE == 1 && IN(1)) { run_phase_1(P, lds, vcu, G, bx, wave, lane, tid); run_phase_1(P, lds, vcu, G, bx, wave, lane, tid); }
    SEAM(1);
    if (IN(2)) run_phase_2(P, lds, vcu, G, bx, wave, lane, tid);
    if (REP_PHASE == 2 && IN(2)) { run_phase_2(P, lds, vcu, G, bx, wave, lane, tid); run_phase_2(P, lds, vcu, G, bx, wave, lane, tid); }
    SEAM(2);
    if (IN(3)) run_phase_3(P, lds, vcu, G, bx, wave, lane, tid);
    if (REP_PHASE == 3 && IN(3)) { run_phase_3(P, lds, vcu, G, bx, wave, lane, tid); run_phase_3(P, lds, vcu, G, bx, wave, lane, tid); }
    SEAM(3);
    if (IN(4)) run_phase_4(P, lds, vcu, G, bx, wave, lane, tid);
    if (REP_PHASE == 4 && IN(4)) { run_phase_4(P, lds, vcu, G, bx, wave, lane, tid); run_phase_4(P, lds, vcu, G, bx, wave, lane, tid); }
    SEAM(4);
    if (IN(5)) run_phase_5(P, lds, vcu, G, bx, wave, lane, tid);
    if (REP_PHASE == 5 && IN(5)) { run_phase_5(P, lds, vcu, G, bx, wave, lane, tid); run_phase_5(P, lds, vcu, G, bx, wave, lane, tid); }
    SEAM(5);
    if (IN(6)) run_phase_6(P, lds, vcu, G, bx, wave, lane, tid);
    if (REP_PHASE == 6 && IN(6)) { run_phase_6(P, lds, vcu, G, bx, wave, lane, tid); run_phase_6(P, lds, vcu, G, bx, wave, lane, tid); }
    SEAM(6);
    if (IN(7)) run_phase_7(P, lds, vcu, G, bx, wave, lane, tid);
    if (REP_PHASE == 7 && IN(7)) { run_phase_7(P, lds, vcu, G, bx, wave, lane, tid); run_phase_7(P, lds, vcu, G, bx, wave, lane, tid); }
    SEAM(7);
    if (IN(8)) run_phase_8(P, lds, vcu, G, bx, wave, lane, tid);
    if (REP_PHASE == 8 && IN(8)) { run_phase_8(P, lds, vcu, G, bx, wave, lane, tid); run_phase_8(P, lds, vcu, G, bx, wave, lane, tid); }
    SEAM(8);
    if (IN(9)) run_phase_9(P, lds, vcu, G, bx, wave, lane, tid);
    if (REP_PHASE == 9 && IN(9)) { run_phase_9(P, lds, vcu, G, bx, wave, lane, tid); run_phase_9(P, lds, vcu, G, bx, wave, lane, tid); }
    SEAM(9);
    if (IN(10)) run_phase_10(P, lds, vcu, G, bx, wave, lane, tid);
    if (REP_PHASE == 10 && IN(10)) { run_phase_10(P, lds, vcu, G, bx, wave, lane, tid); run_phase_10(P, lds, vcu, G, bx, wave, lane, tid); }
    SEAM(10);
    if (IN(11)) run_phase_11(P, lds, vcu, G, bx, wave, lane, tid);
    if (REP_PHASE == 11 && IN(11)) { run_phase_11(P, lds, vcu, G, bx, wave, lane, tid); run_phase_11(P, lds, vcu, G, bx, wave, lane, tid); }
    SEAM(11);
    if (IN(12)) run_phase_12(P, lds, vcu, G, bx, wave, lane, tid);
    if (REP_PHASE == 12 && IN(12)) { run_phase_12(P, lds, vcu, G, bx, wave, lane, tid); run_phase_12(P, lds, vcu, G, bx, wave, lane, tid); }
    SEAM(12);
    if (IN(13)) run_phase_13(P, lds, vcu, G, bx, wave, lane, tid);
    if (REP_PHASE == 13 && IN(13)) { run_phase_13(P, lds, vcu, G, bx, wave, lane, tid); run_phase_13(P, lds, vcu, G, bx, wave, lane, tid); }
#undef IN
#undef SEAM
}

extern "C" void kernel_launch(void* const* d_in, const int* in_sizes, int n_in, void* d_out, int out_size, void* d_ws, size_t ws_size, hipStream_t stream) {
    static int grid = 0;
    if (grid == 0) {
        if (n_in != 28 || out_size != NT * DM || ws_size < WS_END) { fprintf(stderr, "kernel_launch: unexpected arguments (n_in %d, out %d, ws %zu); nothing launched\n", n_in, out_size, ws_size); grid = -1; return; }
        int dev = 0, cus = 0, per_cu = 0;
        if (hipGetDevice(&dev) != hipSuccess || hipDeviceGetAttribute(&cus, hipDeviceAttributeMultiprocessorCount, dev) != hipSuccess) { grid = -1; return; }
        if (hipFuncSetAttribute((const void*)nsa_conformer_moe_fwd, hipFuncAttributeMaxDynamicSharedMemorySize, LDS_BYTES) != hipSuccess) { fprintf(stderr, "kernel_launch: hipFuncSetAttribute failed\n"); grid = -1; return; }
        if (hipOccupancyMaxActiveBlocksPerMultiprocessor(&per_cu, (const void*)nsa_conformer_moe_fwd, 512, LDS_BYTES) != hipSuccess || per_cu < 1) { fprintf(stderr, "kernel_launch: occupancy query says %d blocks per CU\n", per_cu); }
        (void)hipGetLastError();
        grid = cus;
    }
    if (grid < 0) return;
    (void)hipMemsetAsync((char*)d_ws + WS_CTL, 0, CTL_ZERO_BYTES, stream);
    Params p{};
    const float** pp = (const float**)&p;
    for (int i = 0; i < 28; ++i) pp[i] = (const float*)d_in[i];
    p.out = (float*)d_out; p.ws = (unsigned char*)d_ws;
#if MK_PER_PHASE
    for (int ph = 0; ph < NPHASE; ++ph) { p.ph_lo = ph; p.ph_hi = ph + 1; hipLaunchKernelGGL(nsa_conformer_moe_fwd, dim3(grid), dim3(512), LDS_BYTES, stream, p); }
#else
    p.ph_lo = 0; p.ph_hi = NPHASE;
    hipLaunchKernelGGL(nsa_conformer_moe_fwd, dim3(grid), dim3(512), LDS_BYTES, stream, p);
#endif
}
```
